# Optimizing an MI355X kernel written in HIP

```python
import jax
import jax.numpy as jnp
from jax import lax
import numpy as np

D_MODEL = 1024
BATCH = 4
SEQ = 4096
DEPTH = 2
DEC_BATCH = 16
DEC_SEQ = 64
PAST_LEN = 2048

CHUNK = 64
N_META = 16
RMS_EPS = 1e-6
N_HEADS = 8
HEAD_DIM = 64
ATTN_WIDTH = N_HEADS * HEAD_DIM
ROT_DIM = HEAD_DIM // 4
ROPE_THETA = 500000.0
IDX_HEADS = 4
IDX_DIM = 64
TOPK_MAX = 256
QBLOCK = 128
PAD_CHUNK = 2 ** 30
LRU_WIDTH = 512
LRU_BLOCKS = 8
LRU_BLOCK_DIM = LRU_WIDTH // LRU_BLOCKS
CONV_WIDTH = 4
LRU_C = 8.0
POOL_WIDTH = 512
POOL_WINDOWS = (2, 4, 8, 16)
POOL_GROUPS = 4
POOL_GROUP_DIM = POOL_WIDTH // POOL_GROUPS
POOL_HIST = 15
N_BRANCH = 3
BRANCH_WIDTH = 512
COL_SIZES = (ATTN_WIDTH, ATTN_WIDTH, ATTN_WIDTH, ATTN_WIDTH, IDX_HEADS * IDX_DIM, IDX_DIM, IDX_HEADS,
             LRU_WIDTH, LRU_WIDTH, POOL_WIDTH, POOL_WIDTH, N_BRANCH * D_MODEL)
N_IN = 4 * ATTN_WIDTH + IDX_HEADS * IDX_DIM + IDX_DIM + IDX_HEADS + 2 * LRU_WIDTH + 2 * POOL_WIDTH + N_BRANCH * D_MODEL

kernel_name = 'hybrid_dsa_rglru_pool_stream_step'


def rmsnorm(x, g):
    xf = x.astype(jnp.float32)
    y = xf * lax.rsqrt(jnp.mean(xf * xf, axis=-1, keepdims=True) + RMS_EPS) * g.astype(jnp.float32)
    return y.astype(x.dtype)


def rope(x, pos):
    half = ROT_DIM // 2
    inv = ROPE_THETA ** (-jnp.arange(0, ROT_DIM, 2, dtype=jnp.float32) / ROT_DIM)
    ang = pos.astype(jnp.float32)[:, None] * inv[None, :]
    cos = jnp.cos(ang)[None, :, None, :]
    sin = jnp.sin(ang)[None, :, None, :]
    xf = x.astype(jnp.float32)
    x1 = xf[..., :half]
    x2 = xf[..., half:ROT_DIM]
    out = jnp.concatenate([x1 * cos - x2 * sin, x2 * cos + x1 * sin, xf[..., ROT_DIM:]], axis=-1)
    return out.astype(x.dtype)


def sparse_attention(q, k, v, qi, ki, wi, q_chunk, k_chunk, topk):
    B, T = q.shape[0], q.shape[1]
    blk = min(QBLOCK, T)
    nb = -(-T // blk)
    pad = nb * blk - T

    def to_blocks(a):
        a = jnp.pad(a, [(0, 0), (0, pad)] + [(0, 0)] * (a.ndim - 2))
        return jnp.moveaxis(a.reshape((B, nb, blk) + a.shape[2:]), 1, 0)

    qc = jnp.pad(q_chunk, (0, pad), constant_values=PAD_CHUNK).reshape(nb, blk)
    scale = HEAD_DIM ** -0.5

    def block(args):
        qb, qib, wib, qcb = args
        s_idx = jax.nn.relu(jnp.einsum('bthd,bsd->bths', qib, ki))
        score = jnp.einsum('bth,bths->bts', wib, s_idx).astype(jnp.float32)
        ok = k_chunk[None, :] <= qcb[:, None]
        score = jnp.where(ok[None], score, -jnp.inf)
        top_val, top_idx = lax.top_k(score, topk)
        valid = jnp.isfinite(top_val)
        kg = jax.vmap(lambda kk, ii: kk[ii])(k, top_idx)
        vg = jax.vmap(lambda vv, ii: vv[ii])(v, top_idx)
        logits = jnp.einsum('bthd,btjhd->bthj', qb, kg).astype(jnp.float32) * scale
        logits = jnp.where(valid[:, :, None, :], logits, -jnp.inf)
        p = jax.nn.softmax(logits, axis=-1).astype(v.dtype)
        return jnp.einsum('bthj,btjhd->bthd', p, vg)

    out = lax.map(block, (to_blocks(q), to_blocks(qi), to_blocks(wi), qc))
    out = jnp.moveaxis(out, 0, 1).reshape((B, nb * blk) + out.shape[3:])
    return out[:, :T]


def rglru(xb, conv_st, h0, conv_w, conv_b, wa, ba, wx, bx, lam):
    B, T, W = xb.shape
    xp = jnp.concatenate([conv_st.astype(xb.dtype), xb], axis=1)
    xc = conv_b + xp[:, 0:T] * conv_w[0]
    for j in range(1, CONV_WIDTH):
        xc = xc + xp[:, j:j + T] * conv_w[j]
    xblk = xc.reshape(B, T, LRU_BLOCKS, LRU_BLOCK_DIM)
    r = jax.nn.sigmoid(jnp.einsum('btnc,ncd->btnd', xblk, wa).reshape(B, T, W) + ba)
    i = jax.nn.sigmoid(jnp.einsum('btnc,ncd->btnd', xblk, wx).reshape(B, T, W) + bx)
    log_a = -LRU_C * r.astype(jnp.float32) * jax.nn.softplus(-lam.astype(jnp.float32))
    a = jnp.exp(log_a)
    b = jnp.sqrt(-jnp.expm1(2.0 * log_a)) * (i * xc).astype(jnp.float32)
    b = b.at[:, 0].add(a[:, 0] * h0.astype(jnp.float32))

    def combine(e1, e2):
        a1, b1 = e1
        a2, b2 = e2
        return a1 * a2, a2 * b1 + b2

    _, h = lax.associative_scan(combine, (a, b), axis=1)
    return h.astype(xb.dtype), xp[:, -(CONV_WIDTH - 1):], h[:, -1].astype(xb.dtype)


def pool_mix(xc, pool_st, n_hist, pool_w, pool_scale):
    B, T, W = xc.shape
    xp = jnp.concatenate([pool_st.astype(xc.dtype), xc], axis=1).astype(jnp.float32)
    cs = jnp.concatenate([jnp.zeros((B, 1, W), jnp.float32), jnp.cumsum(xp, axis=1)], axis=1)
    t = jnp.arange(T)
    outs = []
    for g, w in enumerate(POOL_WINDOWS):
        sl = slice(g * POOL_GROUP_DIM, (g + 1) * POOL_GROUP_DIM)
        upper = cs[:, POOL_HIST + 1:POOL_HIST + 1 + T, sl]
        lower = cs[:, POOL_HIST + 1 - w:POOL_HIST + 1 - w + T, sl]
        cnt = jnp.minimum(w, t + 1 + n_hist).astype(jnp.float32)[None, :, None]
        outs.append((upper - lower) / cnt)
    pooled = jnp.concatenate(outs, axis=-1) - xp[:, POOL_HIST:]
    mixed = jnp.einsum('btgc,gcd->btgd', pooled.reshape(B, T, POOL_GROUPS, POOL_GROUP_DIM),
                       pool_w.astype(jnp.float32)).reshape(B, T, W) * pool_scale.astype(jnp.float32)
    return mixed.astype(xc.dtype), xp[:, -POOL_HIST:].astype(xc.dtype)


def mixer_layer(x, pos, q_chunk, k_chunk, topk, n_hist, k_past, v_past, ki_past, conv_st, lru_st, pool_st,
                norm_g, w_in, conv_w, conv_b, lru_wa, lru_ba, lru_wx, lru_bx, lru_lambda, pool_w, pool_scale,
                w_branch_out, w_out):
    B, T, _ = x.shape
    hn = rmsnorm(x, norm_g)
    proj = jnp.einsum('btd,dn->btn', hn, w_in)
    splits = np.cumsum(COL_SIZES)[:-1].tolist()
    q, k, v, ga, qi, ki, wi, xb, gb, xc, gc, gm = jnp.split(proj, splits, axis=-1)
    q = rope(q.reshape(B, T, N_HEADS, HEAD_DIM), pos)
    k = rope(k.reshape(B, T, N_HEADS, HEAD_DIM), pos)
    v = v.reshape(B, T, N_HEADS, HEAD_DIM)
    qi = rope(qi.reshape(B, T, IDX_HEADS, IDX_DIM), pos)
    ki = rope(ki[:, :, None, :], pos)[:, :, 0]
    k_all = jnp.concatenate([k_past.astype(k.dtype), k], axis=1)
    v_all = jnp.concatenate([v_past.astype(v.dtype), v], axis=1)
    ki_all = jnp.concatenate([ki_past.astype(ki.dtype), ki], axis=1)
    attn = sparse_attention(q, k_all, v_all, qi, ki_all, wi, q_chunk, k_chunk, topk).reshape(B, T, ATTN_WIDTH)
    y_a = attn * jax.nn.silu(ga)
    hb, conv_new, lru_new = rglru(xb, conv_st, lru_st, conv_w, conv_b, lru_wa, lru_ba, lru_wx, lru_bx, lru_lambda)
    y_b = hb * jax.nn.silu(gb)
    hc, pool_new = pool_mix(xc, pool_st, n_hist, pool_w, pool_scale)
    y_c = hc * jax.nn.silu(gc)
    branches = jnp.stack([y_a, y_b, y_c], axis=2)
    proj_b = jnp.einsum('btnc,ncd->btnd', branches, w_branch_out)
    gates = jax.nn.sigmoid(gm.reshape(B, T, N_BRANCH, D_MODEL))
    merged = jnp.sum(gates * proj_b, axis=2)
    out = x + jnp.einsum('btd,de->bte', merged, w_out)
    return out, (k, v, ki, conv_new, lru_new, pool_new)


def run_trunk(x, pos, q_chunk, k_chunk, topk, n_hist, k_past, v_past, ki_past, conv_st, lru_st, pool_st,
              norm_g, w_in, conv_w, conv_b, lru_wa, lru_ba, lru_wx, lru_bx, lru_lambda, pool_w, pool_scale,
              w_branch_out, w_out, final_norm_g):
    news = [[], [], [], [], [], []]
    for l in range(DEPTH):
        x, new = mixer_layer(x, pos, q_chunk, k_chunk, topk, n_hist, k_past[l], v_past[l], ki_past[l],
                             conv_st[l], lru_st[l], pool_st[l], norm_g[l], w_in[l], conv_w[l], conv_b[l],
                             lru_wa[l], lru_ba[l], lru_wx[l], lru_bx[l], lru_lambda[l], pool_w[l],
                             pool_scale[l], w_branch_out[l], w_out[l])
        for lst, arr in zip(news, new):
            lst.append(arr)
    y = rmsnorm(x, final_norm_g)
    k_n, v_n, ki_n, conv_n, lru_n, pool_n = [jnp.stack(lst) for lst in news]
    return y, k_n, v_n, ki_n, conv_n, lru_n, pool_n


def setup_inputs(seed: int = 0) -> dict:
    key = jax.random.key(seed)
    ks = jax.random.split(key, 24)
    f32 = jnp.float32
    nrm = lambda k, shape, s: jax.random.normal(k, shape, f32) * s
    u = jax.random.uniform(ks[16], (DEPTH, LRU_WIDTH), f32, minval=0.9, maxval=0.999)
    a0 = u ** (1.0 / LRU_C)
    lru_lambda = jnp.log(a0) - jnp.log1p(-a0)
    return {
        'x_prompt': nrm(ks[0], (BATCH, SEQ, D_MODEL), 1.0),
        'x_sample': nrm(ks[1], (DEC_BATCH, DEC_SEQ, D_MODEL), 1.0),
        'cache_k': nrm(ks[2], (DEPTH, DEC_BATCH, PAST_LEN, N_HEADS, HEAD_DIM), 1.0),
        'cache_v': nrm(ks[3], (DEPTH, DEC_BATCH, PAST_LEN, N_HEADS, HEAD_DIM), 1.0),
        'cache_kidx': nrm(ks[4], (DEPTH, DEC_BATCH, PAST_LEN, IDX_DIM), 1.0),
        'state_conv': nrm(ks[5], (DEPTH, DEC_BATCH, CONV_WIDTH - 1, LRU_WIDTH), 1.0),
        'state_lru': nrm(ks[6], (DEPTH, DEC_BATCH, LRU_WIDTH), 0.5),
        'state_pool': nrm(ks[7], (DEPTH, DEC_BATCH, POOL_HIST, POOL_WIDTH), 1.0),
        'meta_tokens': nrm(ks[8], (N_META, D_MODEL), 1.0),
        'norm_g': 1.0 + nrm(ks[9], (DEPTH, D_MODEL), 0.02),
        'w_in': nrm(ks[10], (DEPTH, D_MODEL, N_IN), D_MODEL ** -0.5),
        'conv_w': nrm(ks[11], (DEPTH, CONV_WIDTH, LRU_WIDTH), CONV_WIDTH ** -0.5),
        'conv_b': nrm(ks[12], (DEPTH, LRU_WIDTH), 0.01),
        'lru_wa': nrm(ks[13], (DEPTH, LRU_BLOCKS, LRU_BLOCK_DIM, LRU_BLOCK_DIM), LRU_BLOCK_DIM ** -0.5),
        'lru_ba': nrm(ks[14], (DEPTH, LRU_WIDTH), 0.01),
        'lru_wx': nrm(ks[15], (DEPTH, LRU_BLOCKS, LRU_BLOCK_DIM, LRU_BLOCK_DIM), LRU_BLOCK_DIM ** -0.5),
        'lru_bx': nrm(ks[17], (DEPTH, LRU_WIDTH), 0.01),
        'lru_lambda': lru_lambda,
        'pool_w': nrm(ks[18], (DEPTH, POOL_GROUPS, POOL_GROUP_DIM, POOL_GROUP_DIM), POOL_GROUP_DIM ** -0.5),
        'pool_scale': 1.0 + nrm(ks[19], (DEPTH, POOL_WIDTH), 0.02),
        'w_branch_out': nrm(ks[20], (DEPTH, N_BRANCH, BRANCH_WIDTH, D_MODEL), BRANCH_WIDTH ** -0.5),
        'w_out': nrm(ks[21], (DEPTH, D_MODEL, D_MODEL), D_MODEL ** -0.5),
        'final_norm_g': 1.0 + nrm(ks[22], (D_MODEL,), 0.02),
    }


def reference(x_prompt, x_sample, cache_k, cache_v, cache_kidx, state_conv, state_lru, state_pool,
              meta_tokens, norm_g, w_in, conv_w, conv_b, lru_wa, lru_ba, lru_wx, lru_bx, lru_lambda,
              pool_w, pool_scale, w_branch_out, w_out, final_norm_g):
    weights = (norm_g, w_in, conv_w, conv_b, lru_wa, lru_ba, lru_wx, lru_bx, lru_lambda, pool_w, pool_scale,
               w_branch_out, w_out, final_norm_g)
    dt = x_prompt.dtype
    B, S, _ = x_prompt.shape
    meta = jnp.broadcast_to(meta_tokens.astype(dt)[None], (B, N_META, D_MODEL))
    x0 = jnp.concatenate([meta, x_prompt], axis=1)
    pos_p = jnp.arange(N_META + S, dtype=jnp.int32)
    chunk_p = jnp.concatenate([jnp.zeros((N_META,), jnp.int32), jnp.arange(S, dtype=jnp.int32) // CHUNK + 1])
    y_full, k_p, v_p, ki_p, conv_p, lru_p, pool_p = run_trunk(
        x0, pos_p, chunk_p, chunk_p, min(TOPK_MAX, S // 4), 0,
        jnp.zeros((DEPTH, B, 0, N_HEADS, HEAD_DIM), dt), jnp.zeros((DEPTH, B, 0, N_HEADS, HEAD_DIM), dt),
        jnp.zeros((DEPTH, B, 0, IDX_DIM), dt), jnp.zeros((DEPTH, B, CONV_WIDTH - 1, LRU_WIDTH), dt),
        jnp.zeros((DEPTH, B, LRU_WIDTH), dt), jnp.zeros((DEPTH, B, POOL_HIST, POOL_WIDTH), dt),
        *weights)
    y_prompt = y_full[:, N_META:]
    T1 = x_sample.shape[1]
    P = cache_k.shape[2]
    pos_s = P + jnp.arange(T1, dtype=jnp.int32)
    y_sample, k_s, v_s, ki_s, conv_s, lru_s, pool_s = run_trunk(
        x_sample, pos_s, jnp.zeros((T1,), jnp.int32), jnp.zeros((P + T1,), jnp.int32),
        min(TOPK_MAX, (P + T1) // 4), P,
        cache_k, cache_v, cache_kidx, state_conv, state_lru, state_pool, *weights)
    return (y_prompt, y_sample, k_p, v_p, ki_p, conv_p, lru_p, pool_p, k_s, v_s, ki_s, conv_s, lru_s, pool_s)
```

```cpp
#include <hip/hip_runtime.h>
#include <hip/hip_cooperative_groups.h>
#include <stdint.h>
#include <cstdio>
namespace cg = cooperative_groups;

typedef unsigned short bfr;
typedef __attribute__((ext_vector_type(8))) short bf16x8;
typedef __attribute__((ext_vector_type(4))) float f32x4;
typedef __attribute__((ext_vector_type(2))) float f32x2;
typedef __attribute__((ext_vector_type(2))) __bf16 bf2_t;
#define DI __device__ __forceinline__
#define MFMA16(a, b, c) __builtin_amdgcn_mfma_f32_16x16x32_bf16((a), (b), (c), 0, 0, 0)

constexpr int DM = 1024;
constexpr int NB_P = 4, T_P = 4112, SEQ_P = 4096, NMETA = 16;
constexpr int NB_S = 16, T_S = 64, PAST = 2048, S_S = 2112;
constexpr int ROWS_P = NB_P * T_P;
constexpr int ROWS = ROWS_P + NB_S * T_S;
constexpr int MPAD = 17536;
constexpr int NIN = 7492, NPAD = 7552;
constexpr int KP_PAD = 4128;
constexpr int MW = 132;
constexpr int NTILE_P = 65;

constexpr int C_Q = 0, C_K = 512, C_V = 1024, C_GA = 1536, C_QI = 2048, C_KI = 2304, C_XB = 2368, C_GB = 2880,
              C_XC = 3392, C_GC = 3904, C_GM = 4416, C_WI = 7488;

constexpr long O_YP = 0;
constexpr long O_YS = O_YP + (long)NB_P * SEQ_P * DM;
constexpr long O_KP = O_YS + (long)NB_S * T_S * DM;
constexpr long O_VP = O_KP + 2L * NB_P * T_P * 512;
constexpr long O_KIP = O_VP + 2L * NB_P * T_P * 512;
constexpr long O_CONVP = O_KIP + 2L * NB_P * T_P * 64;
constexpr long O_LRUP = O_CONVP + 2L * NB_P * 3 * 512;
constexpr long O_POOLP = O_LRUP + 2L * NB_P * 512;
constexpr long O_KS = O_POOLP + 2L * NB_P * 15 * 512;
constexpr long O_VS = O_KS + 2L * NB_S * T_S * 512;
constexpr long O_KIS = O_VS + 2L * NB_S * T_S * 512;
constexpr long O_CONVS = O_KIS + 2L * NB_S * T_S * 64;
constexpr long O_LRUS = O_CONVS + 2L * NB_S * 3 * 512;
constexpr long O_POOLS = O_LRUS + 2L * NB_S * 512;

constexpr size_t al256(size_t x) { return (x + 255) & ~(size_t)255; }
constexpr size_t W_CTR = 0;
constexpr size_t W_ROPE = 4096;
constexpr size_t W_WINT = al256(W_ROPE + (size_t)T_P * 8 * 8);
constexpr size_t W_WBT = al256(W_WINT + 2ull * NPAD * 1024 * 2);
constexpr size_t W_WOT = al256(W_WBT + 2ull * 3 * 1024 * 512 * 2);
constexpr size_t W_WAT = al256(W_WOT + 2ull * 1024 * 1024 * 2);
constexpr size_t W_WXT = al256(W_WAT + 2ull * 8 * 64 * 64 * 2);
constexpr size_t W_PWT = al256(W_WXT + 2ull * 8 * 64 * 64 * 2);
constexpr size_t W_XRES = al256(W_PWT + 2ull * 4 * 128 * 128 * 2);
constexpr size_t W_HN = al256(W_XRES + (size_t)MPAD * 1024 * 4);
constexpr size_t W_QB = al256(W_HN + (size_t)MPAD * 1024 * 2);
constexpr size_t W_GA = al256(W_QB + (size_t)MPAD * 512 * 2);
constexpr size_t W_QIB = al256(W_GA + (size_t)MPAD * 512 * 2);
constexpr size_t W_WIB = al256(W_QIB + (size_t)MPAD * 256 * 2);
constexpr size_t W_XBB = al256(W_WIB + (size_t)MPAD * 4 * 4);
constexpr size_t W_GB = al256(W_XBB + (size_t)MPAD * 512 * 2);
constexpr size_t W_XCB = al256(W_GB + (size_t)MPAD * 512 * 2);
constexpr size_t W_GC = al256(W_XCB + (size_t)MPAD * 512 * 2);
constexpr size_t W_GM = al256(W_GC + (size_t)MPAD * 512 * 2);
constexpr size_t W_KBP = al256(W_GM + (size_t)MPAD * 3072 * 2);
constexpr size_t W_VTP = al256(W_KBP + (size_t)NB_P * KP_PAD * 512 * 2);
constexpr size_t W_KIBP = al256(W_VTP + (size_t)NB_P * 512 * KP_PAD * 2);
constexpr size_t W_KBS = al256(W_KIBP + (size_t)NB_P * KP_PAD * 64 * 2);
constexpr size_t W_VTS = al256(W_KBS + (size_t)NB_S * S_S * 512 * 2);
constexpr size_t W_KIBS = al256(W_VTS + (size_t)NB_S * 512 * S_S * 2);
constexpr size_t W_MASK = al256(W_KIBS + (size_t)NB_S * S_S * 64 * 2);
constexpr size_t W_AGG = al256(W_MASK + (size_t)ROWS * MW * 4);
constexpr size_t W_END = al256(W_AGG + (size_t)NB_P * NTILE_P * 512 * 2 * 4);

struct Params {
  const float *x_prompt, *x_sample, *cache_k, *cache_v, *cache_kidx, *state_conv, *state_lru, *state_pool, *meta,
      *norm_g, *w_in, *conv_w, *conv_b, *lru_wa, *lru_ba, *lru_wx, *lru_bx, *lru_lambda, *pool_w, *pool_scale,
      *w_branch_out, *w_out, *final_g;
  float* out;
  char* ws;
};

__shared__ __attribute__((aligned(16))) char smem[62464];
__shared__ int sh_item;
__shared__ volatile int cntbuf[64];

DI bfr f2bf(float x) {
  unsigned u = __float_as_uint(x);
  u += 0x7fffu + ((u >> 16) & 1u);
  return (bfr)(u >> 16);
}
DI float bf2f(bfr b) { return __uint_as_float(((unsigned)b) << 16); }
DI unsigned pack2(float a, float b) {
  f32x2 v = {a, b};
  bf2_t r = __builtin_convertvector(v, bf2_t);
  return __builtin_bit_cast(unsigned, r);
}
DI float sigm(float x) { return 1.f / (1.f + __expf(-x)); }
DI float silu(float x) { return x / (1.f + __expf(-x)); }
DI int get_tid() {
  int t = threadIdx.x;
  asm volatile("" : "+v"(t));
  return t;
}
DI unsigned sortable(float f) {
  unsigned u = __float_as_uint(f);
  return (u & 0x80000000u) ? ~u : (u | 0x80000000u);
}
DI void decode_row(int row, int& isP, int& sq, int& t) {
  if (row < ROWS_P) { isP = 1; sq = row / T_P; t = row - sq * T_P; }
  else { isP = 0; int r = row - ROWS_P; sq = r >> 6; t = r & 63; }
}

DI void tc_tile(const float* src, long sld, bfr* dst, long dld, int k0, int n0, float* tile, int mapmode) {
  const int tid = get_tid();
#pragma unroll 4
  for (int i = 0; i < 16; ++i) {
    int kk = i * 4 + (tid >> 6), nn = tid & 63;
    int n = n0 + nn, sn = n;
    if (mapmode) sn = n < 2368 ? n : (n < 7488 ? n + 4 : (n < 7492 ? 2368 + (n - 7488) : -1));
    tile[kk * 65 + nn] = sn >= 0 ? src[(long)(k0 + kk) * sld + sn] : 0.f;
  }
  __syncthreads();
#pragma unroll 4
  for (int i = 0; i < 16; ++i) {
    int nn = i * 4 + (tid >> 6), kk = tid & 63;
    dst[(long)(n0 + nn) * dld + k0 + kk] = f2bf(tile[kk * 65 + nn]);
  }
  __syncthreads();
}

DI void convert_cache(const Params& p, int layer, char*) {
  const int tid = get_tid();
  bfr* kbs = (bfr*)(p.ws + W_KBS);
  bfr* vts = (bfr*)(p.ws + W_VTS);
  bfr* kibs = (bfr*)(p.ws + W_KIBS);
  for (int it = blockIdx.x; it < NB_S * 32 * 8; it += gridDim.x) {
    int sb = it >> 8, r = it & 255, kt = r >> 3, nt = r & 7;
    tc_tile(p.cache_v + ((long)(layer * NB_S + sb) * PAST) * 512, 512, vts + (long)sb * 512 * S_S, S_S, kt * 64, nt * 64,
            (float*)smem, 0);
  }
  {
    const float4* src = (const float4*)(p.cache_k + (long)layer * NB_S * PAST * 512);
    const long n4 = (long)NB_S * PAST * 512 / 4;
    for (long i = (long)blockIdx.x * 256 + tid; i < n4; i += (long)gridDim.x * 256) {
      float4 v = src[i];
      long e = i * 4;
      int sb = (int)(e / ((long)PAST * 512));
      long rem = e - (long)sb * PAST * 512;
      uint2 o; o.x = pack2(v.x, v.y); o.y = pack2(v.z, v.w);
      *(uint2*)(kbs + (long)sb * S_S * 512 + rem) = o;
    }
  }
  {
    const float4* src = (const float4*)(p.cache_kidx + (long)layer * NB_S * PAST * 64);
    const long n4 = (long)NB_S * PAST * 64 / 4;
    for (long i = (long)blockIdx.x * 256 + tid; i < n4; i += (long)gridDim.x * 256) {
      float4 v = src[i];
      long e = i * 4;
      int sb = (int)(e / ((long)PAST * 64));
      long rem = e - (long)sb * PAST * 64;
      uint2 o; o.x = pack2(v.x, v.y); o.y = pack2(v.z, v.w);
      *(uint2*)(kibs + (long)sb * S_S * 64 + rem) = o;
    }
  }
}

DI void norm_phase(const Params& p, int mode) {
  const int tid = get_tid(), wid = __builtin_amdgcn_readfirstlane(tid >> 6), lane = tid & 63;
  float* xres = (float*)(p.ws + W_XRES);
  bfr* hn = (bfr*)(p.ws + W_HN);
  const float* g = mode == 0 ? p.norm_g : (mode == 1 ? p.norm_g + 1024 : p.final_g);
  for (int row = blockIdx.x * 4 + wid; row < ROWS; row += gridDim.x * 4) {
    int isP, sq, t;
    decode_row(row, isP, sq, t);
    const float* src;
    if (mode == 0) {
      if (isP) src = t < NMETA ? p.meta + (long)t * 1024 : p.x_prompt + ((long)sq * SEQ_P + t - NMETA) * 1024;
      else src = p.x_sample + (long)(row - ROWS_P) * 1024;
    } else src = xres + (long)row * 1024;
    float4 v[4];
    float ss = 0.f;
#pragma unroll
    for (int i = 0; i < 4; ++i) {
      v[i] = ((const float4*)src)[lane + i * 64];
      ss += v[i].x * v[i].x + v[i].y * v[i].y + v[i].z * v[i].z + v[i].w * v[i].w;
    }
#pragma unroll
    for (int o = 32; o >= 1; o >>= 1) ss += __shfl_xor(ss, o);
    const float inv = rsqrtf(ss * (1.f / 1024.f) + 1e-6f);
    float* dsty = nullptr;
    if (mode == 2) {
      if (isP) { if (t >= NMETA) dsty = p.out + O_YP + ((long)sq * SEQ_P + t - NMETA) * 1024; }
      else dsty = p.out + O_YS + (long)(row - ROWS_P) * 1024;
    }
#pragma unroll
    for (int i = 0; i < 4; ++i) {
      float4 gg = ((const float4*)g)[lane + i * 64];
      float4 y;
      y.x = v[i].x * inv * gg.x; y.y = v[i].y * inv * gg.y; y.z = v[i].z * inv * gg.z; y.w = v[i].w * inv * gg.w;
      if (mode == 0) ((float4*)(xres + (long)row * 1024))[lane + i * 64] = v[i];
      if (mode < 2) {
        uint2 o; o.x = pack2(y.x, y.y); o.y = pack2(y.z, y.w);
        *(uint2*)(hn + (long)row * 1024 + (lane + i * 64) * 4) = o;
      } else if (dsty) ((float4*)dsty)[lane + i * 64] = y;
    }
  }
}

DI void prep_phase(const Params& p, char*) {
  const int tid = get_tid();
  for (int it = blockIdx.x; it < 2 * 118 * 16; it += gridDim.x) {
    int l = it / (118 * 16), r = it % (118 * 16), nt = r / 16, kt = r % 16;
    tc_tile(p.w_in + (long)l * 1024 * NIN, NIN, (bfr*)(p.ws + W_WINT) + (long)l * NPAD * 1024, 1024, kt * 64, nt * 64,
            (float*)smem, 1);
  }
  for (int it = blockIdx.x; it < 6 * 16 * 8; it += gridDim.x) {
    int mtx = it / 128, r = it % 128, nt = r / 8, kt = r % 8;
    tc_tile(p.w_branch_out + (long)mtx * 512 * 1024, 1024, (bfr*)(p.ws + W_WBT) + (long)mtx * 1024 * 512, 512, kt * 64,
            nt * 64, (float*)smem, 0);
  }
  for (int it = blockIdx.x; it < 2 * 16 * 16; it += gridDim.x) {
    int l = it / 256, r = it % 256, nt = r / 16, kt = r % 16;
    tc_tile(p.w_out + (long)l * 1024 * 1024, 1024, (bfr*)(p.ws + W_WOT) + (long)l * 1024 * 1024, 1024, kt * 64, nt * 64,
            (float*)smem, 0);
  }
  for (int it = blockIdx.x; it < 32; it += gridDim.x) {
    int which = it >> 4, mtx = it & 15;
    tc_tile((which ? p.lru_wx : p.lru_wa) + (long)mtx * 4096, 64, (bfr*)(p.ws + (which ? W_WXT : W_WAT)) + (long)mtx * 4096,
            64, 0, 0, (float*)smem, 0);
  }
  for (int it = blockIdx.x; it < 32; it += gridDim.x) {
    int mtx = it >> 2, r = it & 3, nt = r >> 1, kt = r & 1;
    tc_tile(p.pool_w + (long)mtx * 16384, 128, (bfr*)(p.ws + W_PWT) + (long)mtx * 16384, 128, kt * 64, nt * 64,
            (float*)smem, 0);
  }
  {
    float2* rt = (float2*)(p.ws + W_ROPE);
    for (int e = blockIdx.x * 256 + tid; e < T_P * 8; e += gridDim.x * 256) {
      int pos = e >> 3, d = e & 7;
      float inv = powf(500000.f, -(float)d * 0.125f);
      float ang = (float)pos * inv;
      rt[e] = make_float2(cosf(ang), sinf(ang));
    }
  }
  convert_cache(p, 0, smem);
  norm_phase(p, 0);
}

template <int NF>
DI void gemm128(const bfr* A, int lda, const bfr* Bt, int ldb, int K, int brow, int bcol, char*, f32x4 (&acc)[4][NF]) {
  const int tid = get_tid(), wid = __builtin_amdgcn_readfirstlane(tid >> 6), lane = tid & 63, wr = wid >> 1, wc = wid & 1, fr = lane & 15, fq = lane >> 4;
  char* SA = smem;
  char* SB = smem + 128 * 32 * 2;
  for (int kt = 0; kt < K / 32; ++kt) {
#pragma unroll
    for (int i = 0; i < 2; ++i) {
      int b = tid * 16 + i * 4096, r = b >> 6, c = (b & 63) >> 1;
      __builtin_amdgcn_global_load_lds((const unsigned*)(A + (long)(brow + r) * lda + kt * 32 + c), (unsigned*)(SA + b), 16, 0, 0);
      if (NF == 4 || i == 0)
        __builtin_amdgcn_global_load_lds((const unsigned*)(Bt + (long)(bcol + r) * ldb + kt * 32 + c), (unsigned*)(SB + b), 16, 0, 0);
    }
    asm volatile("s_waitcnt vmcnt(0)" ::: "memory");
    __syncthreads();
    bf16x8 af[4], bfg[NF];
#pragma unroll
    for (int m = 0; m < 4; ++m) af[m] = *(const bf16x8*)(SA + (wr * 64 + m * 16 + fr) * 64 + fq * 16);
#pragma unroll
    for (int n = 0; n < NF; ++n) bfg[n] = *(const bf16x8*)(SB + (wc * NF * 16 + n * 16 + fr) * 64 + fq * 16);
#pragma unroll
    for (int m = 0; m < 4; ++m)
#pragma unroll
      for (int n = 0; n < NF; ++n) acc[m][n] = MFMA16(af[m], bfg[n], acc[m][n]);
    __syncthreads();
  }
}

template <int REG>
DI void epi_region(const Params& p, int layer, f32x4 (&acc)[4][4], int rbase0, int rel, int fr, int fq) {
  const float2* rt = (const float2*)(p.ws + W_ROPE);
  constexpr bool doRope = (REG == 0 || REG == 1 || REG == 4 || REG == 5);
#pragma unroll
  for (int m = 0; m < 4; ++m) {
    const int rbase = rbase0 + m * 16 + fq * 4;
    const bool rowsValid = rbase < ROWS;
    int isP, sq, t0;
    decode_row(rowsValid ? rbase : 0, isP, sq, t0);
    if (doRope) {
      const int pos0 = isP ? t0 : PAST + t0;
#pragma unroll
      for (int j = 0; j < 4; ++j) {
        float v = acc[m][0][j];
        float pv = __shfl_xor(v, 8);
        float2 cs = rt[(pos0 + j) * 8 + (fr & 7)];
        acc[m][0][j] = (fr < 8) ? (v * cs.x - pv * cs.y) : (v * cs.x + pv * cs.y);
      }
    }
    if (rowsValid) {
#pragma unroll
      for (int n = 0; n < 4; ++n) {
        const int col = rel + n * 16 + fr;
        if (REG == 2) {
          uint2 pk; pk.x = pack2(acc[m][n][0], acc[m][n][1]); pk.y = pack2(acc[m][n][2], acc[m][n][3]);
          if (isP) *(uint2*)((bfr*)(p.ws + W_VTP) + ((long)sq * 512 + col) * KP_PAD + t0) = pk;
          else *(uint2*)((bfr*)(p.ws + W_VTS) + ((long)sq * 512 + col) * S_S + PAST + t0) = pk;
        }
#pragma unroll
        for (int j = 0; j < 4; ++j) {
          const float v = acc[m][n][j];
          const int row = rbase + j, t = t0 + j;
          if (REG == 0) ((bfr*)(p.ws + W_QB))[(long)row * 512 + col] = f2bf(v);
          if (REG == 1) {
            if (isP) { p.out[O_KP + ((long)(layer * NB_P + sq) * T_P + t) * 512 + col] = v; ((bfr*)(p.ws + W_KBP))[((long)sq * KP_PAD + t) * 512 + col] = f2bf(v); }
            else { p.out[O_KS + ((long)(layer * NB_S + sq) * T_S + t) * 512 + col] = v; ((bfr*)(p.ws + W_KBS))[((long)sq * S_S + PAST + t) * 512 + col] = f2bf(v); }
          }
          if (REG == 2) {
            if (isP) p.out[O_VP + ((long)(layer * NB_P + sq) * T_P + t) * 512 + col] = v;
            else p.out[O_VS + ((long)(layer * NB_S + sq) * T_S + t) * 512 + col] = v;
          }
          if (REG == 3) ((bfr*)(p.ws + W_GA))[(long)row * 512 + col] = f2bf(silu(v));
          if (REG == 4) ((bfr*)(p.ws + W_QIB))[(long)row * 256 + col] = f2bf(v);
          if (REG == 5) {
            if (isP) { p.out[O_KIP + ((long)(layer * NB_P + sq) * T_P + t) * 64 + col] = v; ((bfr*)(p.ws + W_KIBP))[((long)sq * KP_PAD + t) * 64 + col] = f2bf(v); }
            else { p.out[O_KIS + ((long)(layer * NB_S + sq) * T_S + t) * 64 + col] = v; ((bfr*)(p.ws + W_KIBS))[((long)sq * S_S + PAST + t) * 64 + col] = f2bf(v); }
          }
          if (REG == 6) {
            ((bfr*)(p.ws + W_XBB))[(long)row * 512 + col] = f2bf(v);
            if (isP) { if (t >= T_P - 3) p.out[O_CONVP + ((long)(layer * NB_P + sq) * 3 + (t - (T_P - 3))) * 512 + col] = v; }
            else { if (t >= T_S - 3) p.out[O_CONVS + ((long)(layer * NB_S + sq) * 3 + (t - (T_S - 3))) * 512 + col] = v; }
          }
          if (REG == 7) ((bfr*)(p.ws + W_GB))[(long)row * 512 + col] = f2bf(silu(v));
          if (REG == 8) {
            ((bfr*)(p.ws + W_XCB))[(long)row * 512 + col] = f2bf(v);
            if (isP) { if (t >= T_P - 15) p.out[O_POOLP + ((long)(layer * NB_P + sq) * 15 + (t - (T_P - 15))) * 512 + col] = v; }
            else { if (t >= T_S - 15) p.out[O_POOLS + ((long)(layer * NB_S + sq) * 15 + (t - (T_S - 15))) * 512 + col] = v; }
          }
          if (REG == 9) ((bfr*)(p.ws + W_GC))[(long)row * 512 + col] = f2bf(silu(v));
          if (REG == 10) ((bfr*)(p.ws + W_GM))[(long)row * 3072 + col] = f2bf(sigm(v));
          if (REG == 11) { if (col < 4) ((float*)(p.ws + W_WIB))[(long)row * 4 + col] = v; }
        }
      }
    }
  }
}

DI void epi_inproj(const Params& p, int layer, f32x4 (&acc)[4][4], int brow, int bcol) {
  const int tid = get_tid(), wid = __builtin_amdgcn_readfirstlane(tid >> 6), lane = tid & 63, wr = wid >> 1, wc = wid & 1, fr = lane & 15, fq = lane >> 4;
  const int c0 = bcol + wc * 64;
  const int rb = brow + wr * 64;
  if (c0 < C_K) epi_region<0>(p, layer, acc, rb, c0 - C_Q, fr, fq);
  else if (c0 < C_V) epi_region<1>(p, layer, acc, rb, c0 - C_K, fr, fq);
  else if (c0 < C_GA) epi_region<2>(p, layer, acc, rb, c0 - C_V, fr, fq);
  else if (c0 < C_QI) epi_region<3>(p, layer, acc, rb, c0 - C_GA, fr, fq);
  else if (c0 < C_KI) epi_region<4>(p, layer, acc, rb, c0 - C_QI, fr, fq);
  else if (c0 < C_XB) epi_region<5>(p, layer, acc, rb, c0 - C_KI, fr, fq);
  else if (c0 < C_GB) epi_region<6>(p, layer, acc, rb, c0 - C_XB, fr, fq);
  else if (c0 < C_XC) epi_region<7>(p, layer, acc, rb, c0 - C_GB, fr, fq);
  else if (c0 < C_GC) epi_region<8>(p, layer, acc, rb, c0 - C_XC, fr, fq);
  else if (c0 < C_GM) epi_region<9>(p, layer, acc, rb, c0 - C_GC, fr, fq);
  else if (c0 < C_WI) epi_region<10>(p, layer, acc, rb, c0 - C_GM, fr, fq);
  else epi_region<11>(p, layer, acc, rb, c0 - C_WI, fr, fq);
}

DI void phase_inproj(const Params& p, int layer, char*) {
  const bfr* A = (const bfr*)(p.ws + W_HN);
  const bfr* Bt = (const bfr*)(p.ws + W_WINT) + (long)layer * NPAD * 1024;
  constexpr int NTM = MPAD / 128, NTN = NPAD / 128;
  for (int tile = blockIdx.x; tile < NTM * NTN; tile += gridDim.x) {
    int tn = tile / NTM, tm = tile % NTM;
    f32x4 acc[4][4];
#pragma unroll
    for (int m = 0; m < 4; ++m)
#pragma unroll
      for (int n = 0; n < 4; ++n) acc[m][n] = f32x4{0.f, 0.f, 0.f, 0.f};
    gemm128<4>(A, 1024, Bt, 1024, 1024, tm * 128, tn * 128, smem, acc);
    epi_inproj(p, layer, acc, tm * 128, tn * 128);
  }
}

DI void phase_merge(const Params& p, int layer, char*) {
  const int tid = get_tid(), wid = __builtin_amdgcn_readfirstlane(tid >> 6), lane = tid & 63, wr = wid >> 1, wc = wid & 1, fr = lane & 15, fq = lane >> 4;
  const bfr* gmb = (const bfr*)(p.ws + W_GM);
  bfr* merged = (bfr*)(p.ws + W_HN);
  constexpr int NTM = MPAD / 128, NTN = 16;
  for (int tile = blockIdx.x; tile < NTM * NTN; tile += gridDim.x) {
    int tn = tile / NTM, tm = tile % NTM;
    const int brow = tm * 128, bcol = tn * 64;
    f32x4 tot[4][2];
#pragma unroll
    for (int m = 0; m < 4; ++m)
#pragma unroll
      for (int n = 0; n < 2; ++n) tot[m][n] = f32x4{0.f, 0.f, 0.f, 0.f};
#pragma unroll 1
    for (int br = 0; br < 3; ++br) {
      const bfr* A = (const bfr*)(p.ws + (br == 0 ? W_GA : (br == 1 ? W_GB : W_GC)));
      const bfr* Bt = (const bfr*)(p.ws + W_WBT) + (long)(layer * 3 + br) * 1024 * 512;
      f32x4 acc[4][2];
#pragma unroll
      for (int m = 0; m < 4; ++m)
#pragma unroll
        for (int n = 0; n < 2; ++n) acc[m][n] = f32x4{0.f, 0.f, 0.f, 0.f};
      gemm128<2>(A, 512, Bt, 512, 512, brow, bcol, smem, acc);
#pragma unroll
      for (int m = 0; m < 4; ++m)
#pragma unroll
        for (int j = 0; j < 4; ++j) {
          int row = brow + wr * 64 + m * 16 + fq * 4 + j;
          if (row < ROWS) {
#pragma unroll
            for (int n = 0; n < 2; ++n) {
              int col = bcol + wc * 32 + n * 16 + fr;
              float g = bf2f(gmb[(long)row * 3072 + br * 1024 + col]);
              tot[m][n][j] += g * acc[m][n][j];
            }
          }
        }
    }
#pragma unroll
    for (int m = 0; m < 4; ++m)
#pragma unroll
      for (int j = 0; j < 4; ++j) {
        int row = brow + wr * 64 + m * 16 + fq * 4 + j;
        if (row < ROWS) {
#pragma unroll
          for (int n = 0; n < 2; ++n) merged[(long)row * 1024 + bcol + wc * 32 + n * 16 + fr] = f2bf(tot[m][n][j]);
        }
      }
  }
}

DI void phase_out(const Params& p, int layer, char*) {
  const int tid = get_tid(), wid = __builtin_amdgcn_readfirstlane(tid >> 6), lane = tid & 63, wr = wid >> 1, wc = wid & 1, fr = lane & 15, fq = lane >> 4;
  const bfr* A = (const bfr*)(p.ws + W_HN);
  const bfr* Bt = (const bfr*)(p.ws + W_WOT) + (long)layer * 1024 * 1024;
  float* xres = (float*)(p.ws + W_XRES);
  constexpr int NTM = MPAD / 128, NTN = 8;
  for (int tile = blockIdx.x; tile < NTM * NTN; tile += gridDim.x) {
    int tn = tile / NTM, tm = tile % NTM;
    const int brow = tm * 128, bcol = tn * 128;
    f32x4 acc[4][4];
#pragma unroll
    for (int m = 0; m < 4; ++m)
#pragma unroll
      for (int n = 0; n < 4; ++n) acc[m][n] = f32x4{0.f, 0.f, 0.f, 0.f};
    gemm128<4>(A, 1024, Bt, 1024, 1024, brow, bcol, smem, acc);
#pragma unroll
    for (int m = 0; m < 4; ++m)
#pragma unroll
      for (int j = 0; j < 4; ++j) {
        int row = brow + wr * 64 + m * 16 + fq * 4 + j;
        if (row < ROWS) {
#pragma unroll
          for (int n = 0; n < 4; ++n) xres[(long)row * 1024 + bcol + wc * 64 + n * 16 + fr] += acc[m][n][j];
        }
      }
  }
}

DI void select_item(const Params& p, int isP, int sq, int c, int sub, char*) {
  const int tid = get_tid(), wid = __builtin_amdgcn_readfirstlane(tid >> 6), lane = tid & 63, fr = lane & 15, fq = lane >> 4;
  int T0, nadm, rowbase;
  const bfr* kib;
  if (isP) {
    if (c == 0) { T0 = 0; nadm = 16; } else { T0 = 16 + 64 * (c - 1) + 16 * sub; nadm = 16 + 64 * c; }
    rowbase = sq * T_P;
    kib = (const bfr*)(p.ws + W_KIBP) + (long)sq * KP_PAD * 64;
  } else {
    T0 = 16 * sub; nadm = S_S; rowbase = ROWS_P + sq * 64;
    kib = (const bfr*)(p.ws + W_KIBS) + (long)sq * S_S * 64;
  }
  unsigned* maskg = (unsigned*)(p.ws + W_MASK);
  const int nsteps = (nadm + 31) >> 5;
  if (nadm <= 256) {
    for (int e = tid; e < 16 * nsteps; e += 256) {
      int q = e / nsteps, s = e - q * nsteps;
      unsigned w = (s * 32 + 32 <= nadm) ? 0xFFFFFFFFu : 0xFFFFu;
      maskg[(long)(rowbase + T0 + q) * MW + s] = w;
    }
    return;
  }
  const int nkt = nadm >> 4;
  const int nmine = (nkt - wid + 3) >> 2;
  const bfr* qib = (const bfr*)(p.ws + W_QIB);
  const float* wib = (const float*)(p.ws + W_WIB);
#pragma unroll 1
  for (int g = 0; g < 4; ++g) {
    const int qrow = rowbase + T0 + g * 4;
    int koff = (wid * 16 + fr) * 64 + fq * 8;
    asm volatile("" : "+v"(koff));
    const bfr* kbase = kib + koff;
    int nm = nmine;
    asm volatile("" : "+v"(nm));
    nm = __builtin_amdgcn_readfirstlane(nm);
    const bfr* qp = qib + (long)(qrow + (fr >> 2)) * 256 + (fr & 3) * 64 + fq * 8;
    const bf16x8 a0 = *(const bf16x8*)qp;
    const bf16x8 a1 = *(const bf16x8*)(qp + 32);
    const float4 w = *(const float4*)(wib + (long)(qrow + fq) * 4);
    unsigned sc[65];
#pragma unroll
    for (int ch = 0; ch < 13; ++ch) {
      bf16x8 b0[5], b1[5];
#pragma unroll
      for (int u = 0; u < 5; ++u) {
        const int i = ch * 5 + u;
        if (i < nm) {
          const bfr* kp = kbase + (long)i * 4096;
          b0[u] = *(const bf16x8*)kp;
          b1[u] = *(const bf16x8*)(kp + 32);
        }
      }
#pragma unroll
      for (int u = 0; u < 5; ++u) {
        const int i = ch * 5 + u;
        if (i < nm) {
          f32x4 a = {0.f, 0.f, 0.f, 0.f};
          a = MFMA16(a0, b0[u], a);
          a = MFMA16(a1, b1[u], a);
          float s = w.x * fmaxf(a[0], 0.f) + w.y * fmaxf(a[1], 0.f) + w.z * fmaxf(a[2], 0.f) + w.w * fmaxf(a[3], 0.f);
          sc[i] = sortable(s);
        } else sc[i] = 0u;
      }
      __builtin_amdgcn_sched_barrier(0);
    }
    unsigned thr = 0u;
#pragma unroll 1
    for (int bit = 31; bit >= 0; --bit) {
      const unsigned cand = thr | (1u << bit);
      int cnt = 0;
#pragma unroll
      for (int i = 0; i < 65; ++i) cnt += (sc[i] >= cand) ? 1 : 0;
      cnt += __shfl_xor(cnt, 1); cnt += __shfl_xor(cnt, 2); cnt += __shfl_xor(cnt, 4); cnt += __shfl_xor(cnt, 8);
      const int par = bit & 1;
      if (fr == 0) cntbuf[par * 16 + fq * 4 + wid] = cnt;
      __syncthreads();
      const int tot = cntbuf[par * 16 + fq * 4 + 0] + cntbuf[par * 16 + fq * 4 + 1] + cntbuf[par * 16 + fq * 4 + 2] +
                      cntbuf[par * 16 + fq * 4 + 3];
      if (tot >= 256) thr = cand;
    }
    int need, mism;
    {
      int cnt = 0;
#pragma unroll
      for (int i = 0; i < 65; ++i) cnt += ((sc[i] > thr) ? 1 : 0) + ((sc[i] == thr) ? 65536 : 0);
      cnt += __shfl_xor(cnt, 1); cnt += __shfl_xor(cnt, 2); cnt += __shfl_xor(cnt, 4); cnt += __shfl_xor(cnt, 8);
      if (fr == 0) cntbuf[16 + fq * 4 + wid] = cnt;
      if (tid == 0) cntbuf[63] = 0;
      __syncthreads();
      const int tot = cntbuf[16 + fq * 4 + 0] + cntbuf[16 + fq * 4 + 1] + cntbuf[16 + fq * 4 + 2] + cntbuf[16 + fq * 4 + 3];
      const int gt = tot & 0xFFFF, eq = tot >> 16;
      need = 256 - gt;
      mism = (eq != need) ? 1 : 0;
    }
    int idxcut = 0x7fffffff;
    if (mism) cntbuf[63] = 1;
    __syncthreads();
    if (cntbuf[63]) {
      int lo = 0;
#pragma unroll 1
      for (int bit = 12; bit >= 0; --bit) {
        const int cand = lo | (1 << bit);
        int cnt = 0;
#pragma unroll
        for (int i = 0; i < 65; ++i) cnt += (sc[i] == thr && ((i * 4 + wid) * 16 + fr) < cand) ? 1 : 0;
        cnt += __shfl_xor(cnt, 1); cnt += __shfl_xor(cnt, 2); cnt += __shfl_xor(cnt, 4); cnt += __shfl_xor(cnt, 8);
        const int par = bit & 1;
        if (fr == 0) cntbuf[32 + par * 16 + fq * 4 + wid] = cnt;
        __syncthreads();
        const int tot = cntbuf[32 + par * 16 + fq * 4 + 0] + cntbuf[32 + par * 16 + fq * 4 + 1] +
                        cntbuf[32 + par * 16 + fq * 4 + 2] + cntbuf[32 + par * 16 + fq * 4 + 3];
        if (tot < need) lo = cand;
      }
      if (mism) idxcut = lo;
    }
    unsigned short* mrow = (unsigned short*)(maskg + (long)(qrow + fq) * MW);
    int nm2 = nmine;
    asm volatile("" : "+v"(nm2));
    nm2 = __builtin_amdgcn_readfirstlane(nm2);
    unsigned thr2 = thr;
    asm volatile("" : "+v"(thr2));
    const bool zpad = (nkt & 1) && (((nkt - wid) & 3) == 0);
#pragma unroll
    for (int i = 0; i < 65; ++i) {
      const int kt = i * 4 + wid;
      if (i < nm2) {
        const bool sel = (sc[i] > thr2) || (sc[i] == thr2 && (kt * 16 + fr) <= idxcut);
        const unsigned long long bal = __ballot(sel);
        if (fr == 0) mrow[kt] = (unsigned short)((bal >> (fq * 16)) & 0xFFFFull);
      } else if (i == nm2 && zpad) {
        if (fr == 0) mrow[kt] = 0;
      }
    }
  }
}

DI void lru_tile(const Params& p, int layer, int isP, int sq, int tile, int nb, int pass, char*) {
  const int tid = get_tid(), wid = __builtin_amdgcn_readfirstlane(tid >> 6), lane = tid & 63, fr = lane & 15, fq = lane >> 4;
  float* xbs = (float*)smem;
  float* as_ = xbs;
  float* xcs = xbs + 67 * 64;
  float* bs_ = xcs + 64 * 64;
  float* ab = bs_ + 64 * 64;
  bfr* xca = (bfr*)(ab + 512);
  const int T = isP ? T_P : T_S;
  const int rowbase = isP ? sq * T_P : ROWS_P + sq * 64;
  const int t0 = tile * 64, ch0 = nb * 64;
  const bfr* xbb = (const bfr*)(p.ws + W_XBB);
  bfr* gby = (bfr*)(p.ws + W_GB);
  float* agg = (float*)(p.ws + W_AGG);
  {
    const int c = tid & 63;
    for (int rr = tid >> 6; rr < 67; rr += 4) {
      int tt = t0 - 3 + rr;
      float v = 0.f;
      if (tt < 0) { if (!isP) v = p.state_conv[((long)(layer * NB_S + sq) * 3 + (3 + tt)) * 512 + ch0 + c]; }
      else if (tt < T) v = bf2f(xbb[(long)(rowbase + tt) * 512 + ch0 + c]);
      xbs[rr * 64 + c] = v;
    }
  }
  __syncthreads();
  {
    const int c = tid & 63;
    const float cb = p.conv_b[layer * 512 + ch0 + c];
    const float w0 = p.conv_w[(layer * 4 + 0) * 512 + ch0 + c], w1 = p.conv_w[(layer * 4 + 1) * 512 + ch0 + c],
                w2 = p.conv_w[(layer * 4 + 2) * 512 + ch0 + c], w3 = p.conv_w[(layer * 4 + 3) * 512 + ch0 + c];
    for (int t = tid >> 6; t < 64; t += 4) {
      float xc = cb + w0 * xbs[t * 64 + c] + w1 * xbs[(t + 1) * 64 + c] + w2 * xbs[(t + 2) * 64 + c] + w3 * xbs[(t + 3) * 64 + c];
      xcs[t * 64 + c] = xc;
      xca[t * 72 + c] = f2bf(xc);
    }
  }
  __syncthreads();
  {
    const bfr* WaT = (const bfr*)(p.ws + W_WAT) + (long)(layer * 8 + nb) * 4096;
    const bfr* WxT = (const bfr*)(p.ws + W_WXT) + (long)(layer * 8 + nb) * 4096;
    bf16x8 af0 = *(const bf16x8*)(xca + (wid * 16 + fr) * 72 + fq * 8);
    bf16x8 af1 = *(const bf16x8*)(xca + (wid * 16 + fr) * 72 + 32 + fq * 8);
#pragma unroll
    for (int nt = 0; nt < 4; ++nt) {
      const int d = nt * 16 + fr;
      bf16x8 ba0 = *(const bf16x8*)(WaT + d * 64 + fq * 8), ba1 = *(const bf16x8*)(WaT + d * 64 + 32 + fq * 8);
      bf16x8 bx0 = *(const bf16x8*)(WxT + d * 64 + fq * 8), bx1 = *(const bf16x8*)(WxT + d * 64 + 32 + fq * 8);
      f32x4 ar = {0.f, 0.f, 0.f, 0.f}, ai = {0.f, 0.f, 0.f, 0.f};
      ar = MFMA16(af0, ba0, ar); ar = MFMA16(af1, ba1, ar);
      ai = MFMA16(af0, bx0, ai); ai = MFMA16(af1, bx1, ai);
      const float bav = p.lru_ba[layer * 512 + ch0 + d], bxv = p.lru_bx[layer * 512 + ch0 + d];
      const float sp = log1pf(__expf(-p.lru_lambda[layer * 512 + ch0 + d]));
#pragma unroll
      for (int j = 0; j < 4; ++j) {
        const int t = wid * 16 + fq * 4 + j;
        float r = sigm(ar[j] + bav), ig = sigm(ai[j] + bxv);
        float la = -8.f * r * sp;
        float a = expf(la);
        float b = sqrtf(-expm1f(2.f * la)) * (ig * xcs[t * 64 + d]);
        if (t0 + t >= T) { a = 1.f; b = 0.f; }
        as_[t * 64 + d] = a;
        bs_[t * 64 + d] = b;
      }
    }
  }
  __syncthreads();
  const int c = tid & 63;
  {
    float A = 1.f, B = 0.f;
#pragma unroll
    for (int tt = 0; tt < 16; ++tt) {
      float a = as_[(wid * 16 + tt) * 64 + c], b = bs_[(wid * 16 + tt) * 64 + c];
      A *= a; B = a * B + b;
    }
    ab[(wid * 64 + c) * 2] = A;
    ab[(wid * 64 + c) * 2 + 1] = B;
  }
  __syncthreads();
  if (pass == 0) {
    if (wid == 0) {
      float A = 1.f, B = 0.f;
#pragma unroll
      for (int w = 0; w < 4; ++w) { float a = ab[(w * 64 + c) * 2], b = ab[(w * 64 + c) * 2 + 1]; A *= a; B = a * B + b; }
      *(float2*)(agg + ((long)(sq * NTILE_P + tile) * 512 + ch0 + c) * 2) = make_float2(A, B);
    }
  } else {
    float h = isP ? 0.f : p.state_lru[(long)(layer * NB_S + sq) * 512 + ch0 + c];
    for (int i = 0; i < tile; ++i) {
      float2 e = *(const float2*)(agg + ((long)(sq * NTILE_P + i) * 512 + ch0 + c) * 2);
      h = e.x * h + e.y;
    }
    for (int w = 0; w < wid; ++w) h = ab[(w * 64 + c) * 2] * h + ab[(w * 64 + c) * 2 + 1];
#pragma unroll
    for (int tt = 0; tt < 16; ++tt) {
      const int t = wid * 16 + tt;
      h = as_[t * 64 + c] * h + bs_[t * 64 + c];
      if (t0 + t < T) {
        const long idx = (long)(rowbase + t0 + t) * 512 + ch0 + c;
        gby[idx] = f2bf(h * bf2f(gby[idx]));
        if (t0 + t == T - 1) {
          if (isP) p.out[O_LRUP + (long)(layer * NB_P + sq) * 512 + ch0 + c] = h;
          else p.out[O_LRUS + (long)(layer * NB_S + sq) * 512 + ch0 + c] = h;
        }
      }
    }
  }
}

DI void pool_item(const Params& p, int layer, int isP, int sq, int tile, int g, char*) {
  const int tid = get_tid(), wid = __builtin_amdgcn_readfirstlane(tid >> 6), lane = tid & 63, fr = lane & 15, fq = lane >> 4;
  float* xps = (float*)smem;
  bfr* pa = (bfr*)(xps + 79 * 128);
  const int T = isP ? T_P : T_S;
  const int rowbase = isP ? sq * T_P : ROWS_P + sq * 64;
  const int t0 = tile * 64, ch0 = g * 128;
  const bfr* xcb = (const bfr*)(p.ws + W_XCB);
  bfr* gcy = (bfr*)(p.ws + W_GC);
  {
    const int c = tid & 127;
    for (int rr = tid >> 7; rr < 79; rr += 2) {
      int tt = t0 - 15 + rr;
      float v = 0.f;
      if (tt < 0) { if (!isP) v = p.state_pool[((long)(layer * NB_S + sq) * 15 + (15 + tt)) * 512 + ch0 + c]; }
      else if (tt < T) v = bf2f(xcb[(long)(rowbase + tt) * 512 + ch0 + c]);
      xps[rr * 128 + c] = v;
    }
  }
  __syncthreads();
  {
    const int c = tid & 127;
    const int w = 2 << g;
    const int nh = isP ? 0 : PAST;
    for (int t = tid >> 7; t < 64; t += 2) {
      float s = 0.f;
      for (int i = 0; i < w; ++i) s += xps[(15 + t - i) * 128 + c];
      int cnt = min(w, t0 + t + 1 + nh);
      float v = s / (float)cnt - xps[(15 + t) * 128 + c];
      pa[t * 136 + c] = f2bf(v);
    }
  }
  __syncthreads();
  {
    const bfr* PwT = (const bfr*)(p.ws + W_PWT) + (long)(layer * 4 + g) * 16384;
    bf16x8 af[4];
#pragma unroll
    for (int ks = 0; ks < 4; ++ks) af[ks] = *(const bf16x8*)(pa + (wid * 16 + fr) * 136 + ks * 32 + fq * 8);
#pragma unroll
    for (int nt = 0; nt < 8; ++nt) {
      const int d = nt * 16 + fr;
      f32x4 acc = {0.f, 0.f, 0.f, 0.f};
#pragma unroll
      for (int ks = 0; ks < 4; ++ks) {
        bf16x8 bq = *(const bf16x8*)(PwT + d * 128 + ks * 32 + fq * 8);
        acc = MFMA16(af[ks], bq, acc);
      }
      const float scl = p.pool_scale[layer * 512 + ch0 + d];
#pragma unroll
      for (int j = 0; j < 4; ++j) {
        const int t = wid * 16 + fq * 4 + j;
        if (t0 + t < T) {
          const long idx = (long)(rowbase + t0 + t) * 512 + ch0 + d;
          gcy[idx] = f2bf(acc[j] * scl * bf2f(gcy[idx]));
        }
      }
    }
  }
}

DI void attn_unit(const Params& p, int isP, int sq, int c, int h, int half) {
  const int lane = get_tid() & 63, fr = lane & 15, fq = lane >> 4;
  int T0, nqt, nadm, rowbase, vld;
  const bfr *kb, *vt;
  if (isP) {
    if (c == 0) { T0 = 0; nqt = 1; nadm = 16; } else { T0 = 16 + 64 * (c - 1) + 32 * half; nqt = 2; nadm = 16 + 64 * c; }
    rowbase = sq * T_P;
    kb = (const bfr*)(p.ws + W_KBP) + (long)sq * KP_PAD * 512;
    vt = (const bfr*)(p.ws + W_VTP) + (long)sq * 512 * KP_PAD;
    vld = KP_PAD;
  } else {
    T0 = 32 * half; nqt = 2; nadm = S_S; rowbase = ROWS_P + sq * 64;
    kb = (const bfr*)(p.ws + W_KBS) + (long)sq * S_S * 512;
    vt = (const bfr*)(p.ws + W_VTS) + (long)sq * 512 * S_S;
    vld = S_S;
  }
  const int nsteps = (nadm + 31) >> 5;
  const int qrow0 = rowbase + T0;
  const bfr* qb = (const bfr*)(p.ws + W_QB);
  const unsigned* maskg = (const unsigned*)(p.ws + W_MASK);
  bf16x8 qf[2][2];
#pragma unroll
  for (int qt = 0; qt < 2; ++qt)
#pragma unroll
    for (int ks = 0; ks < 2; ++ks) {
      int r = qrow0 + (qt < nqt ? qt * 16 : 0) + fr;
      qf[qt][ks] = *(const bf16x8*)(qb + (long)r * 512 + h * 64 + ks * 32 + fq * 8);
    }
  f32x4 o[2][4];
#pragma unroll
  for (int qt = 0; qt < 2; ++qt)
#pragma unroll
    for (int dt = 0; dt < 4; ++dt) o[qt][dt] = f32x4{0.f, 0.f, 0.f, 0.f};
  float mrun[2] = {-1e30f, -1e30f}, lrun[2] = {0.f, 0.f};
  const unsigned* mrow0 = maskg + (long)(qrow0 + fr) * MW;
  const unsigned* mrow1 = maskg + (long)(qrow0 + (nqt > 1 ? 16 : 0) + fr) * MW;
  const float sc2 = 0.125f * 1.4426950408889634f;
  const float NINF = -__builtin_inff();
  const int kofs = (fr >> 2) * 8 + (fr & 3);
  for (int s = 0; s < nsteps; ++s) {
    const int key0 = s * 32;
    const bfr* pa = kb + (long)(key0 + kofs) * 512 + h * 64 + fq * 8;
    const bfr* pb = pa + 4 * 512;
    const bf16x8 ka0 = *(const bf16x8*)pa, ka1 = *(const bf16x8*)(pa + 32);
    const bf16x8 kb0 = *(const bf16x8*)pb, kb1 = *(const bf16x8*)(pb + 32);
    bf16x8 vf[4];
#pragma unroll
    for (int dt = 0; dt < 4; ++dt) vf[dt] = *(const bf16x8*)(vt + (long)(h * 64 + dt * 16 + fr) * vld + key0 + fq * 8);
    const unsigned mw0 = mrow0[s], mw1 = mrow1[s];
#pragma unroll
    for (int qt = 0; qt < 2; ++qt) {
      if (qt < nqt) {
        f32x4 sa = {0.f, 0.f, 0.f, 0.f}, sb = {0.f, 0.f, 0.f, 0.f};
        sa = MFMA16(ka0, qf[qt][0], sa); sa = MFMA16(ka1, qf[qt][1], sa);
        sb = MFMA16(kb0, qf[qt][0], sb); sb = MFMA16(kb1, qf[qt][1], sb);
        const unsigned mb = ((qt == 0 ? mw0 : mw1) >> (fq * 8)) & 0xFFu;
        float x[8];
#pragma unroll
        for (int i = 0; i < 4; ++i) {
          x[i] = ((mb >> i) & 1u) ? sa[i] * sc2 : NINF;
          x[4 + i] = ((mb >> (4 + i)) & 1u) ? sb[i] * sc2 : NINF;
        }
        float tm = fmaxf(fmaxf(fmaxf(x[0], x[1]), fmaxf(x[2], x[3])), fmaxf(fmaxf(x[4], x[5]), fmaxf(x[6], x[7])));
        tm = fmaxf(tm, __shfl_xor(tm, 16));
        tm = fmaxf(tm, __shfl_xor(tm, 32));
        const float mn = fmaxf(mrun[qt], tm);
        const float alpha = __builtin_amdgcn_exp2f(mrun[qt] - mn);
        float pr[8], rs = 0.f;
#pragma unroll
        for (int i = 0; i < 8; ++i) { pr[i] = __builtin_amdgcn_exp2f(x[i] - mn); rs += pr[i]; }
        rs += __shfl_xor(rs, 16);
        rs += __shfl_xor(rs, 32);
        lrun[qt] = lrun[qt] * alpha + rs;
        mrun[qt] = mn;
        union { unsigned u[4]; bf16x8 v; } pk;
        pk.u[0] = pack2(pr[0], pr[1]); pk.u[1] = pack2(pr[2], pr[3]); pk.u[2] = pack2(pr[4], pr[5]); pk.u[3] = pack2(pr[6], pr[7]);
#pragma unroll
        for (int dt = 0; dt < 4; ++dt) {
          o[qt][dt] *= alpha;
          o[qt][dt] = MFMA16(vf[dt], pk.v, o[qt][dt]);
        }
      }
    }
  }
  bfr* gay = (bfr*)(p.ws + W_GA);
#pragma unroll
  for (int qt = 0; qt < 2; ++qt) {
    if (qt < nqt) {
      const float inv = 1.f / lrun[qt];
      const long rowoff = (long)(qrow0 + qt * 16 + fr) * 512 + h * 64;
#pragma unroll
      for (int dt = 0; dt < 4; ++dt) {
        uint2* ptr = (uint2*)(gay + rowoff + dt * 16 + fq * 4);
        uint2 gv = *ptr;
        float g0 = __uint_as_float(gv.x << 16), g1 = __uint_as_float(gv.x & 0xFFFF0000u);
        float g2 = __uint_as_float(gv.y << 16), g3 = __uint_as_float(gv.y & 0xFFFF0000u);
        uint2 ov;
        ov.x = pack2(o[qt][dt][0] * inv * g0, o[qt][dt][1] * inv * g1);
        ov.y = pack2(o[qt][dt][2] * inv * g2, o[qt][dt][3] * inv * g3);
        *ptr = ov;
      }
    }
  }
}

DI int pop_block(int* ctr, int*) {
  __syncthreads();
  if (threadIdx.x == 0) sh_item = atomicAdd(ctr, 1);
  __syncthreads();
  return __builtin_amdgcn_readfirstlane(sh_item);
}

constexpr int N_SEL = 64 * 16 + 64 + 4;
constexpr int N_LRU1 = NB_P * NTILE_P * 8;
constexpr int N_POOL = NB_P * NTILE_P * 4 + NB_S * 4;
constexpr int N_LRU2 = NB_P * NTILE_P * 8 + NB_S * 8;
constexpr int N_ATT = 64 * 64 + 256 + 32;

DI void phase_b1(const Params& p, int layer, char*, int*) {
  int* ctr = (int*)(p.ws + W_CTR) + layer * 4 + 0;
  for (;;) {
    int it = pop_block(ctr, nullptr);
    if (it >= N_SEL + N_LRU1 + N_POOL) break;
    if (it < N_SEL) {
      if (it < 1024) { int c = 64 - (it >> 4), b = (it & 15) >> 2, sub = it & 3; select_item(p, 1, b, c, sub, smem); }
      else if (it < 1088) { int j = it - 1024; select_item(p, 0, j >> 2, 0, j & 3, smem); }
      else select_item(p, 1, it - 1088, 0, 0, smem);
    } else if (it < N_SEL + N_LRU1) {
      int j = it - N_SEL;
      int sq = j / (NTILE_P * 8), rem = j % (NTILE_P * 8);
      lru_tile(p, layer, 1, sq, rem >> 3, rem & 7, 0, smem);
    } else {
      int j = it - N_SEL - N_LRU1;
      if (j < NB_P * NTILE_P * 4) { int sq = j / (NTILE_P * 4), rem = j % (NTILE_P * 4); pool_item(p, layer, 1, sq, rem >> 2, rem & 3, smem); }
      else { j -= NB_P * NTILE_P * 4; pool_item(p, layer, 0, j >> 2, 0, j & 3, smem); }
    }
  }
}

DI void phase_b2(const Params& p, int layer, char*, int*) {
  int* ctr = (int*)(p.ws + W_CTR) + layer * 4 + 1;
  for (;;) {
    int it = pop_block(ctr, nullptr);
    if (it >= N_LRU2) break;
    if (it < NB_P * NTILE_P * 8) { int sq = it / (NTILE_P * 8), rem = it % (NTILE_P * 8); lru_tile(p, layer, 1, sq, rem >> 3, rem & 7, 1, smem); }
    else { int j = it - NB_P * NTILE_P * 8; lru_tile(p, layer, 0, j >> 3, 0, j & 7, 1, smem); }
  }
  int* ctr2 = (int*)(p.ws + W_CTR) + layer * 4 + 2;
  const int lane = get_tid() & 63;
  for (;;) {
    int u = 0;
    if (lane == 0) u = atomicAdd(ctr2, 1);
    u = __builtin_amdgcn_readfirstlane(u);
    if (u >= N_ATT) break;
    if (u < 4096) { int c = 64 - (u >> 6), r = u & 63; attn_unit(p, 1, r >> 4, c, (r >> 1) & 7, r & 1); }
    else if (u < 4096 + 256) { int r = u - 4096; attn_unit(p, 0, r >> 4, 0, (r >> 1) & 7, r & 1); }
    else { int r = u - 4352; attn_unit(p, 1, r >> 3, 0, r & 7, 0); }
  }
}

DI Params fresh(const Params& p) {
  Params q = p;
  int z = 0;
  asm volatile("s_mov_b32 %0, 0" : "=s"(z));
  q.ws = p.ws + z;
  q.out = p.out + z;
  return q;
}
DI int fresh_i(int v) {
  asm volatile("" : "+s"(v));
  return v;
}

__global__ void __launch_bounds__(256, 2) fwd_megakernel(Params p) {
  cg::grid_group grid = cg::this_grid();
  prep_phase(fresh(p), smem);
  grid.sync();
#pragma unroll 1
  for (int layer = 0; layer < 2; ++layer) {
    phase_inproj(fresh(p), fresh_i(layer), smem);
    grid.sync();
    phase_b1(fresh(p), fresh_i(layer), smem, &sh_item);
    grid.sync();
    phase_b2(fresh(p), fresh_i(layer), smem, &sh_item);
    grid.sync();
    phase_merge(fresh(p), fresh_i(layer), smem);
    grid.sync();
    phase_out(fresh(p), fresh_i(layer), smem);
    grid.sync();
    if (layer == 0) { convert_cache(fresh(p), 1, smem); norm_phase(fresh(p), 1); grid.sync(); }
    else norm_phase(fresh(p), 2);
  }
}

extern "C" void kernel_launch(void* const* d_in, const int* in_sizes, int n_in, void* d_out, int out_size, void* d_ws,
                              size_t ws_size, hipStream_t stream) {
  static int grid_blocks = 0;
  if (!grid_blocks) {
    int dev = 0, cus = 0, per_cu = 0;
    hipGetDevice(&dev);
    hipDeviceGetAttribute(&cus, hipDeviceAttributeMultiprocessorCount, dev);
    hipOccupancyMaxActiveBlocksPerMultiprocessor(&per_cu, fwd_megakernel, 256, 0);
    if (per_cu > 2) per_cu = 2;
    if (per_cu < 1) per_cu = 1;
    grid_blocks = cus * per_cu;
  }
  if (ws_size < W_END) { fprintf(stderr, "workspace too small: %zu < %zu\n", ws_size, (size_t)W_END); return; }
  Params p{};
  const float** f = (const float**)&p;
  for (int i = 0; i < 23; ++i) f[i] = (const float*)d_in[i];
  p.out = (float*)d_out;
  p.ws = (char*)d_ws;
  hipMemsetAsync(d_ws, 0, 4096, stream);
  void* args[] = {&p};
  hipError_t e = hipLaunchCooperativeKernel((void*)fwd_megakernel, dim3(grid_blocks), dim3(256), args, 0, stream);
  if (e != hipSuccess) fprintf(stderr, "cooperative launch failed: %s (grid %d)\n", hipGetErrorString(e), grid_blocks);
}
```

```cpp
#include <hip/hip_runtime.h>
#include <hip/hip_cooperative_groups.h>
#include <stdint.h>
#include <cstdio>
namespace cg = cooperative_groups;
#ifndef PROBE
#define PROBE 0
#endif

typedef unsigned short bfr;
typedef __attribute__((ext_vector_type(8))) short bf16x8;
typedef __attribute__((ext_vector_type(4))) float f32x4;
typedef __attribute__((ext_vector_type(2))) float f32x2;
typedef __attribute__((ext_vector_type(2))) __bf16 bf2_t;
#define DI __device__ __forceinline__
#define MFMA16(a, b, c) __builtin_amdgcn_mfma_f32_16x16x32_bf16((a), (b), (c), 0, 0, 0)

constexpr int DM = 1024;
constexpr int NB_P = 4, T_P = 4112, SEQ_P = 4096, NMETA = 16;
constexpr int NB_S = 16, T_S = 64, PAST = 2048, S_S = 2112;
constexpr int ROWS_P = NB_P * T_P;
constexpr int ROWS = ROWS_P + NB_S * T_S;
constexpr int MPAD = 17536;
constexpr int NIN = 7492, NPAD = 7552;
constexpr int KP_PAD = 4128;
constexpr int MW = 132;
constexpr int NTILE_P = 65;

constexpr int C_Q = 0, C_K = 512, C_V = 1024, C_GA = 1536, C_QI = 2048, C_KI = 2304, C_XB = 2368, C_GB = 2880,
              C_XC = 3392, C_GC = 3904, C_GM = 4416, C_WI = 7488;

constexpr long O_YP = 0;
constexpr long O_YS = O_YP + (long)NB_P * SEQ_P * DM;
constexpr long O_KP = O_YS + (long)NB_S * T_S * DM;
constexpr long O_VP = O_KP + 2L * NB_P * T_P * 512;
constexpr long O_KIP = O_VP + 2L * NB_P * T_P * 512;
constexpr long O_CONVP = O_KIP + 2L * NB_P * T_P * 64;
constexpr long O_LRUP = O_CONVP + 2L * NB_P * 3 * 512;
constexpr long O_POOLP = O_LRUP + 2L * NB_P * 512;
constexpr long O_KS = O_POOLP + 2L * NB_P * 15 * 512;
constexpr long O_VS = O_KS + 2L * NB_S * T_S * 512;
constexpr long O_KIS = O_VS + 2L * NB_S * T_S * 512;
constexpr long O_CONVS = O_KIS + 2L * NB_S * T_S * 64;
constexpr long O_LRUS = O_CONVS + 2L * NB_S * 3 * 512;
constexpr long O_POOLS = O_LRUS + 2L * NB_S * 512;

constexpr size_t al256(size_t x) { return (x + 255) & ~(size_t)255; }
constexpr size_t W_CTR = 0;
constexpr size_t W_BAR = 4096;
constexpr size_t W_ROPE = 32768;
constexpr size_t W_WINT = al256(W_ROPE + (size_t)T_P * 8 * 8);
constexpr size_t W_WBT = al256(W_WINT + 2ull * NPAD * 1024 * 2);
constexpr size_t W_WOT = al256(W_WBT + 2ull * 3 * 1024 * 512 * 2);
constexpr size_t W_WAT = al256(W_WOT + 2ull * 1024 * 1024 * 2);
constexpr size_t W_WXT = al256(W_WAT + 2ull * 8 * 64 * 64 * 2);
constexpr size_t W_PWT = al256(W_WXT + 2ull * 8 * 64 * 64 * 2);
constexpr size_t W_XRES = al256(W_PWT + 2ull * 4 * 128 * 128 * 2);
constexpr size_t W_HN = al256(W_XRES + (size_t)MPAD * 1024 * 4);
constexpr size_t W_QB = al256(W_HN + (size_t)MPAD * 1024 * 2);
constexpr size_t W_GA = al256(W_QB + (size_t)MPAD * 512 * 2);
constexpr size_t W_QIB = al256(W_GA + (size_t)MPAD * 512 * 2);
constexpr size_t W_WIB = al256(W_QIB + (size_t)MPAD * 256 * 2);
constexpr size_t W_XBB = al256(W_WIB + (size_t)MPAD * 4 * 4);
constexpr size_t W_GB = al256(W_XBB + (size_t)MPAD * 512 * 2);
constexpr size_t W_XCB = al256(W_GB + (size_t)MPAD * 512 * 2);
constexpr size_t W_GC = al256(W_XCB + (size_t)MPAD * 512 * 2);
constexpr size_t W_GM = al256(W_GC + (size_t)MPAD * 512 * 2);
constexpr size_t W_KBP = al256(W_GM + (size_t)MPAD * 3072 * 2);
constexpr size_t W_VTP = al256(W_KBP + (size_t)NB_P * KP_PAD * 512 * 2);
constexpr size_t W_KIBP = al256(W_VTP + (size_t)NB_P * 512 * KP_PAD * 2);
constexpr size_t W_KBS = al256(W_KIBP + (size_t)NB_P * KP_PAD * 64 * 2);
constexpr size_t W_VTS = al256(W_KBS + (size_t)NB_S * S_S * 512 * 2);
constexpr size_t W_KIBS = al256(W_VTS + (size_t)NB_S * 512 * S_S * 2);
constexpr size_t W_MASK = al256(W_KIBS + (size_t)NB_S * S_S * 64 * 2);
constexpr size_t W_AGG = al256(W_MASK + (size_t)ROWS * MW * 4);
constexpr size_t W_KMAX = al256(W_AGG + (size_t)NB_P * NTILE_P * 512 * 2 * 4);
constexpr size_t W_END = al256(W_KMAX + 1024);

struct Params {
  const float *x_prompt, *x_sample, *cache_k, *cache_v, *cache_kidx, *state_conv, *state_lru, *state_pool, *meta,
      *norm_g, *w_in, *conv_w, *conv_b, *lru_wa, *lru_ba, *lru_wx, *lru_bx, *lru_lambda, *pool_w, *pool_scale,
      *w_branch_out, *w_out, *final_g;
  float* out;
  char* ws;
};

__shared__ __attribute__((aligned(16))) char smem[62464];
__shared__ int sh_item;

DI bfr f2bf(float x) {
  unsigned u = __float_as_uint(x);
  u += 0x7fffu + ((u >> 16) & 1u);
  return (bfr)(u >> 16);
}
DI float bf2f(bfr b) { return __uint_as_float(((unsigned)b) << 16); }
DI unsigned pack2(float a, float b) {
  f32x2 v = {a, b};
  bf2_t r = __builtin_convertvector(v, bf2_t);
  return __builtin_bit_cast(unsigned, r);
}
DI float sigm(float x) { return 1.f / (1.f + __expf(-x)); }
DI float silu(float x) { return x / (1.f + __expf(-x)); }
DI int get_tid() {
  int t = threadIdx.x;
  asm volatile("" : "+v"(t));
  return t;
}
DI unsigned sortable(float f) {
  unsigned u = __float_as_uint(f);
  return (u & 0x80000000u) ? ~u : (u | 0x80000000u);
}
DI void decode_row(int row, int& isP, int& sq, int& t) {
  if (row < ROWS_P) { isP = 1; sq = row / T_P; t = row - sq * T_P; }
  else { isP = 0; int r = row - ROWS_P; sq = r >> 6; t = r & 63; }
}

DI void tc_tile(const float* src, long sld, bfr* dst, long dld, int k0, int n0, float* tile, int mapmode) {
  const int tid = get_tid();
#pragma unroll 4
  for (int i = 0; i < 16; ++i) {
    int kk = i * 4 + (tid >> 6), nn = tid & 63;
    int n = n0 + nn, sn = n;
    if (mapmode) sn = n < 2368 ? n : (n < 7488 ? n + 4 : (n < 7492 ? 2368 + (n - 7488) : -1));
    tile[kk * 65 + nn] = sn >= 0 ? src[(long)(k0 + kk) * sld + sn] : 0.f;
  }
  __syncthreads();
#pragma unroll 4
  for (int i = 0; i < 16; ++i) {
    int nn = i * 4 + (tid >> 6), kk = tid & 63;
    dst[(long)(n0 + nn) * dld + k0 + kk] = f2bf(tile[kk * 65 + nn]);
  }
  __syncthreads();
}

DI void convert_cache(const Params& p, int layer, char*) {
  const int tid = get_tid();
  bfr* kbs = (bfr*)(p.ws + W_KBS);
  bfr* vts = (bfr*)(p.ws + W_VTS);
  bfr* kibs = (bfr*)(p.ws + W_KIBS);
  for (int it = blockIdx.x; it < NB_S * 32 * 8; it += gridDim.x) {
    int sb = it >> 8, r = it & 255, kt = r >> 3, nt = r & 7;
    tc_tile(p.cache_v + ((long)(layer * NB_S + sb) * PAST) * 512, 512, vts + (long)sb * 512 * S_S, S_S, kt * 64, nt * 64,
            (float*)smem, 0);
  }
  {
    const float4* src = (const float4*)(p.cache_k + (long)layer * NB_S * PAST * 512);
    const long n4 = (long)NB_S * PAST * 512 / 4;
    for (long i = (long)blockIdx.x * 256 + tid; i < n4; i += (long)gridDim.x * 256) {
      float4 v = src[i];
      long e = i * 4;
      int sb = (int)(e / ((long)PAST * 512));
      long rem = e - (long)sb * PAST * 512;
      uint2 o; o.x = pack2(v.x, v.y); o.y = pack2(v.z, v.w);
      *(uint2*)(kbs + (long)sb * S_S * 512 + rem) = o;
    }
  }
  {
    const float4* src = (const float4*)(p.cache_kidx + (long)layer * NB_S * PAST * 64);
    const long n4 = (long)NB_S * PAST * 64 / 4;
    for (long i = (long)blockIdx.x * 256 + tid; i < n4; i += (long)gridDim.x * 256) {
      float4 v = src[i];
      long e = i * 4;
      int sb = (int)(e / ((long)PAST * 64));
      long rem = e - (long)sb * PAST * 64;
      uint2 o; o.x = pack2(v.x, v.y); o.y = pack2(v.z, v.w);
      *(uint2*)(kibs + (long)sb * S_S * 64 + rem) = o;
    }
  }
}

DI void norm_phase(const Params& p, int mode) {
  const int tid = get_tid(), wid = __builtin_amdgcn_readfirstlane(tid >> 6), lane = tid & 63;
  float* xres = (float*)(p.ws + W_XRES);
  bfr* hn = (bfr*)(p.ws + W_HN);
  const float* g = mode == 0 ? p.norm_g : (mode == 1 ? p.norm_g + 1024 : p.final_g);
  for (int row = blockIdx.x * 4 + wid; row < ROWS; row += gridDim.x * 4) {
    int isP, sq, t;
    decode_row(row, isP, sq, t);
    const float* src;
    if (mode == 0) {
      if (isP) src = t < NMETA ? p.meta + (long)t * 1024 : p.x_prompt + ((long)sq * SEQ_P + t - NMETA) * 1024;
      else src = p.x_sample + (long)(row - ROWS_P) * 1024;
    } else src = xres + (long)row * 1024;
    float4 v[4];
    float ss = 0.f;
#pragma unroll
    for (int i = 0; i < 4; ++i) {
      v[i] = ((const float4*)src)[lane + i * 64];
      ss += v[i].x * v[i].x + v[i].y * v[i].y + v[i].z * v[i].z + v[i].w * v[i].w;
    }
#pragma unroll
    for (int o = 32; o >= 1; o >>= 1) ss += __shfl_xor(ss, o);
    const float inv = rsqrtf(ss * (1.f / 1024.f) + 1e-6f);
    float* dsty = nullptr;
    if (mode == 2) {
      if (isP) { if (t >= NMETA) dsty = p.out + O_YP + ((long)sq * SEQ_P + t - NMETA) * 1024; }
      else dsty = p.out + O_YS + (long)(row - ROWS_P) * 1024;
    }
#pragma unroll
    for (int i = 0; i < 4; ++i) {
      float4 gg = ((const float4*)g)[lane + i * 64];
      float4 y;
      y.x = v[i].x * inv * gg.x; y.y = v[i].y * inv * gg.y; y.z = v[i].z * inv * gg.z; y.w = v[i].w * inv * gg.w;
      if (mode == 0) ((float4*)(xres + (long)row * 1024))[lane + i * 64] = v[i];
      if (mode < 2) {
        uint2 o; o.x = pack2(y.x, y.y); o.y = pack2(y.z, y.w);
        *(uint2*)(hn + (long)row * 1024 + (lane + i * 64) * 4) = o;
      } else if (dsty) ((float4*)dsty)[lane + i * 64] = y;
    }
  }
}

DI void prep_phase(const Params& p, char*) {
  const int tid = get_tid();
  for (int it = blockIdx.x; it < 2 * 118 * 16; it += gridDim.x) {
    int l = it / (118 * 16), r = it % (118 * 16), nt = r / 16, kt = r % 16;
    tc_tile(p.w_in + (long)l * 1024 * NIN, NIN, (bfr*)(p.ws + W_WINT) + (long)l * NPAD * 1024, 1024, kt * 64, nt * 64,
            (float*)smem, 1);
  }
  for (int it = blockIdx.x; it < 6 * 16 * 8; it += gridDim.x) {
    int mtx = it / 128, r = it % 128, nt = r / 8, kt = r % 8;
    tc_tile(p.w_branch_out + (long)mtx * 512 * 1024, 1024, (bfr*)(p.ws + W_WBT) + (long)mtx * 1024 * 512, 512, kt * 64,
            nt * 64, (float*)smem, 0);
  }
  for (int it = blockIdx.x; it < 2 * 16 * 16; it += gridDim.x) {
    int l = it / 256, r = it % 256, nt = r / 16, kt = r % 16;
    tc_tile(p.w_out + (long)l * 1024 * 1024, 1024, (bfr*)(p.ws + W_WOT) + (long)l * 1024 * 1024, 1024, kt * 64, nt * 64,
            (float*)smem, 0);
  }
  for (int it = blockIdx.x; it < 32; it += gridDim.x) {
    int which = it >> 4, mtx = it & 15;
    tc_tile((which ? p.lru_wx : p.lru_wa) + (long)mtx * 4096, 64, (bfr*)(p.ws + (which ? W_WXT : W_WAT)) + (long)mtx * 4096,
            64, 0, 0, (float*)smem, 0);
  }
  for (int it = blockIdx.x; it < 32; it += gridDim.x) {
    int mtx = it >> 2, r = it & 3, nt = r >> 1, kt = r & 1;
    tc_tile(p.pool_w + (long)mtx * 16384, 128, (bfr*)(p.ws + W_PWT) + (long)mtx * 16384, 128, kt * 64, nt * 64,
            (float*)smem, 0);
  }
  {
    float2* rt = (float2*)(p.ws + W_ROPE);
    for (int e = blockIdx.x * 256 + tid; e < T_P * 8; e += gridDim.x * 256) {
      int pos = e >> 3, d = e & 7;
      float inv = powf(500000.f, -(float)d * 0.125f);
      float ang = (float)pos * inv;
      rt[e] = make_float2(cosf(ang), sinf(ang));
    }
  }
  convert_cache(p, 0, smem);
  norm_phase(p, 0);
}

template <int NF>
DI void gemm128(const bfr* A, int lda, const bfr* Bt, int ldb, int K, int brow, int bcol, char*, f32x4 (&acc)[4][NF]) {
  const int tid = get_tid(), wid = __builtin_amdgcn_readfirstlane(tid >> 6), lane = tid & 63, wr = wid >> 1, wc = wid & 1, fr = lane & 15, fq = lane >> 4;
  const int b0 = tid * 16, r0 = b0 >> 6, c0 = (b0 & 63) >> 1;
  const bfr* ga0 = A + (long)(brow + r0) * lda + c0;
  const bfr* ga1 = A + (long)(brow + r0 + 64) * lda + c0;
  const bfr* gb0 = Bt + (long)(bcol + r0) * ldb + c0;
  const bfr* gb1 = Bt + (long)(bcol + r0 + 64) * ldb + c0;
  const int nk = K / 32;
  auto stage = [&](int kt, int buf) {
    char* SA = smem + buf * 16384;
    char* SB = SA + 8192;
    __builtin_amdgcn_global_load_lds((const unsigned*)(ga0 + kt * 32), (unsigned*)(SA + b0), 16, 0, 0);
    __builtin_amdgcn_global_load_lds((const unsigned*)(ga1 + kt * 32), (unsigned*)(SA + b0 + 4096), 16, 0, 0);
    __builtin_amdgcn_global_load_lds((const unsigned*)(gb0 + kt * 32), (unsigned*)(SB + b0), 16, 0, 0);
    if (NF == 4) __builtin_amdgcn_global_load_lds((const unsigned*)(gb1 + kt * 32), (unsigned*)(SB + b0 + 4096), 16, 0, 0);
  };
  __syncthreads();
  stage(0, 0);
  const unsigned lds0 = (unsigned)(size_t)smem;
  const unsigned aoff = lds0 + (wr * 64 + fr) * 64 + fq * 16;
  const unsigned boff = lds0 + 8192 + (wc * NF * 16 + fr) * 64 + fq * 16;
  for (int kt = 0; kt < nk; ++kt) {
    asm volatile("s_waitcnt vmcnt(0)" ::: "memory");
    __builtin_amdgcn_s_barrier();
    if (kt + 1 < nk) stage(kt + 1, (kt + 1) & 1);
    const unsigned bo = (kt & 1) * 16384;
    bf16x8 af[4], bfg[4];
    if (NF == 4) {
      asm volatile(
          "ds_read_b128 %0, %8\n\tds_read_b128 %1, %8 offset:1024\n\tds_read_b128 %2, %8 offset:2048\n\tds_read_b128 %3, %8 offset:3072\n\t"
          "ds_read_b128 %4, %9\n\tds_read_b128 %5, %9 offset:1024\n\tds_read_b128 %6, %9 offset:2048\n\tds_read_b128 %7, %9 offset:3072\n\t"
          "s_waitcnt lgkmcnt(0)"
          : "=&v"(af[0]), "=&v"(af[1]), "=&v"(af[2]), "=&v"(af[3]), "=&v"(bfg[0]), "=&v"(bfg[1]), "=&v"(bfg[2]), "=&v"(bfg[3])
          : "v"(aoff + bo), "v"(boff + bo)
          : "memory");
    } else {
      asm volatile(
          "ds_read_b128 %0, %6\n\tds_read_b128 %1, %6 offset:1024\n\tds_read_b128 %2, %6 offset:2048\n\tds_read_b128 %3, %6 offset:3072\n\t"
          "ds_read_b128 %4, %7\n\tds_read_b128 %5, %7 offset:1024\n\t"
          "s_waitcnt lgkmcnt(0)"
          : "=&v"(af[0]), "=&v"(af[1]), "=&v"(af[2]), "=&v"(af[3]), "=&v"(bfg[0]), "=&v"(bfg[1])
          : "v"(aoff + bo), "v"(boff + bo)
          : "memory");
    }
#pragma unroll
    for (int m = 0; m < 4; ++m)
#pragma unroll
      for (int n = 0; n < NF; ++n) acc[m][n] = MFMA16(af[m], bfg[n], acc[m][n]);
  }
}

template <int REG>
DI void epi_region(const Params& p, int layer, f32x4 (&acc)[4][4], int rbase0, int rel, int fr, int fq) {
  const float2* rt = (const float2*)(p.ws + W_ROPE);
  constexpr bool doRope = (REG == 0 || REG == 1 || REG == 4 || REG == 5);
#pragma unroll
  for (int m = 0; m < 4; ++m) {
    const int rbase = rbase0 + m * 16 + fq * 4;
    const bool rowsValid = rbase < ROWS;
    int isP, sq, t0;
    decode_row(rowsValid ? rbase : 0, isP, sq, t0);
    if (doRope) {
      const int pos0 = isP ? t0 : PAST + t0;
#pragma unroll
      for (int j = 0; j < 4; ++j) {
        float v = acc[m][0][j];
        float pv = __shfl_xor(v, 8);
        float2 cs = rt[(pos0 + j) * 8 + (fr & 7)];
        acc[m][0][j] = (fr < 8) ? (v * cs.x - pv * cs.y) : (v * cs.x + pv * cs.y);
      }
    }
    if (rowsValid) {
#pragma unroll
      for (int n = 0; n < 4; ++n) {
        const int col = rel + n * 16 + fr;
        if (REG == 2) {
          uint2 pk; pk.x = pack2(acc[m][n][0], acc[m][n][1]); pk.y = pack2(acc[m][n][2], acc[m][n][3]);
          if (isP) *(uint2*)((bfr*)(p.ws + W_VTP) + ((long)sq * 512 + col) * KP_PAD + t0) = pk;
          else *(uint2*)((bfr*)(p.ws + W_VTS) + ((long)sq * 512 + col) * S_S + PAST + t0) = pk;
        }
#pragma unroll
        for (int j = 0; j < 4; ++j) {
          const float v = acc[m][n][j];
          const int row = rbase + j, t = t0 + j;
          if (REG == 0) ((bfr*)(p.ws + W_QB))[(long)row * 512 + col] = f2bf(v);
          if (REG == 1) {
            if (isP) { p.out[O_KP + ((long)(layer * NB_P + sq) * T_P + t) * 512 + col] = v; ((bfr*)(p.ws + W_KBP))[((long)sq * KP_PAD + t) * 512 + col] = f2bf(v); }
            else { p.out[O_KS + ((long)(layer * NB_S + sq) * T_S + t) * 512 + col] = v; ((bfr*)(p.ws + W_KBS))[((long)sq * S_S + PAST + t) * 512 + col] = f2bf(v); }
          }
          if (REG == 2) {
            if (isP) p.out[O_VP + ((long)(layer * NB_P + sq) * T_P + t) * 512 + col] = v;
            else p.out[O_VS + ((long)(layer * NB_S + sq) * T_S + t) * 512 + col] = v;
          }
          if (REG == 3) ((bfr*)(p.ws + W_GA))[(long)row * 512 + col] = f2bf(silu(v));
          if (REG == 4) ((bfr*)(p.ws + W_QIB))[(long)row * 256 + col] = f2bf(v);
          if (REG == 5) {
            if (isP) { p.out[O_KIP + ((long)(layer * NB_P + sq) * T_P + t) * 64 + col] = v; ((bfr*)(p.ws + W_KIBP))[((long)sq * KP_PAD + t) * 64 + col] = f2bf(v); }
            else { p.out[O_KIS + ((long)(layer * NB_S + sq) * T_S + t) * 64 + col] = v; ((bfr*)(p.ws + W_KIBS))[((long)sq * S_S + PAST + t) * 64 + col] = f2bf(v); }
          }
          if (REG == 6) {
            ((bfr*)(p.ws + W_XBB))[(long)row * 512 + col] = f2bf(v);
            if (isP) { if (t >= T_P - 3) p.out[O_CONVP + ((long)(layer * NB_P + sq) * 3 + (t - (T_P - 3))) * 512 + col] = v; }
            else { if (t >= T_S - 3) p.out[O_CONVS + ((long)(layer * NB_S + sq) * 3 + (t - (T_S - 3))) * 512 + col] = v; }
          }
          if (REG == 7) ((bfr*)(p.ws + W_GB))[(long)row * 512 + col] = f2bf(silu(v));
          if (REG == 8) {
            ((bfr*)(p.ws + W_XCB))[(long)row * 512 + col] = f2bf(v);
            if (isP) { if (t >= T_P - 15) p.out[O_POOLP + ((long)(layer * NB_P + sq) * 15 + (t - (T_P - 15))) * 512 + col] = v; }
            else { if (t >= T_S - 15) p.out[O_POOLS + ((long)(layer * NB_S + sq) * 15 + (t - (T_S - 15))) * 512 + col] = v; }
          }
          if (REG == 9) ((bfr*)(p.ws + W_GC))[(long)row * 512 + col] = f2bf(silu(v));
          if (REG == 10) ((bfr*)(p.ws + W_GM))[(long)row * 3072 + col] = f2bf(sigm(v));
          if (REG == 11) { if (col < 4) ((float*)(p.ws + W_WIB))[(long)row * 4 + col] = v; }
        }
      }
    }
  }
}

DI void epi_inproj(const Params& p, int layer, f32x4 (&acc)[4][4], int brow, int bcol) {
  const int tid = get_tid(), wid = __builtin_amdgcn_readfirstlane(tid >> 6), lane = tid & 63, wr = wid >> 1, wc = wid & 1, fr = lane & 15, fq = lane >> 4;
  const int c0 = bcol + wc * 64;
  const int rb = brow + wr * 64;
  if (c0 < C_K) epi_region<0>(p, layer, acc, rb, c0 - C_Q, fr, fq);
  else if (c0 < C_V) epi_region<1>(p, layer, acc, rb, c0 - C_K, fr, fq);
  else if (c0 < C_GA) epi_region<2>(p, layer, acc, rb, c0 - C_V, fr, fq);
  else if (c0 < C_QI) epi_region<3>(p, layer, acc, rb, c0 - C_GA, fr, fq);
  else if (c0 < C_KI) epi_region<4>(p, layer, acc, rb, c0 - C_QI, fr, fq);
  else if (c0 < C_XB) epi_region<5>(p, layer, acc, rb, c0 - C_KI, fr, fq);
  else if (c0 < C_GB) epi_region<6>(p, layer, acc, rb, c0 - C_XB, fr, fq);
  else if (c0 < C_XC) epi_region<7>(p, layer, acc, rb, c0 - C_GB, fr, fq);
  else if (c0 < C_GC) epi_region<8>(p, layer, acc, rb, c0 - C_XC, fr, fq);
  else if (c0 < C_GM) epi_region<9>(p, layer, acc, rb, c0 - C_GC, fr, fq);
  else if (c0 < C_WI) epi_region<10>(p, layer, acc, rb, c0 - C_GM, fr, fq);
  else epi_region<11>(p, layer, acc, rb, c0 - C_WI, fr, fq);
}

DI void phase_inproj(const Params& p, int layer, char*) {
  const bfr* A = (const bfr*)(p.ws + W_HN);
  const bfr* Bt = (const bfr*)(p.ws + W_WINT) + (long)layer * NPAD * 1024;
  constexpr int NTM = MPAD / 128, NTN = NPAD / 128;
#if PROBE == 1
#pragma unroll 1
  for (int rep = 0; rep < 2; ++rep)
#endif
  for (int tile = blockIdx.x; tile < NTM * NTN; tile += gridDim.x) {
    int tn = tile / NTM, tm = tile % NTM;
    f32x4 acc[4][4];
#pragma unroll
    for (int m = 0; m < 4; ++m)
#pragma unroll
      for (int n = 0; n < 4; ++n) acc[m][n] = f32x4{0.f, 0.f, 0.f, 0.f};
    gemm128<4>(A, 1024, Bt, 1024, 1024, tm * 128, tn * 128, smem, acc);
    epi_inproj(p, layer, acc, tm * 128, tn * 128);
  }
}

DI void phase_merge(const Params& p, int layer, char*) {
  const int tid = get_tid(), wid = __builtin_amdgcn_readfirstlane(tid >> 6), lane = tid & 63, wr = wid >> 1, wc = wid & 1, fr = lane & 15, fq = lane >> 4;
  const bfr* gmb = (const bfr*)(p.ws + W_GM);
  bfr* merged = (bfr*)(p.ws + W_HN);
  constexpr int NTM = MPAD / 128, NTN = 16;
  for (int tile = blockIdx.x; tile < NTM * NTN; tile += gridDim.x) {
    int tn = tile / NTM, tm = tile % NTM;
    const int brow = tm * 128, bcol = tn * 64;
    f32x4 tot[4][2];
#pragma unroll
    for (int m = 0; m < 4; ++m)
#pragma unroll
      for (int n = 0; n < 2; ++n) tot[m][n] = f32x4{0.f, 0.f, 0.f, 0.f};
#pragma unroll 1
    for (int br = 0; br < 3; ++br) {
      const bfr* A = (const bfr*)(p.ws + (br == 0 ? W_GA : (br == 1 ? W_GB : W_GC)));
      const bfr* Bt = (const bfr*)(p.ws + W_WBT) + (long)(layer * 3 + br) * 1024 * 512;
      f32x4 acc[4][2];
#pragma unroll
      for (int m = 0; m < 4; ++m)
#pragma unroll
        for (int n = 0; n < 2; ++n) acc[m][n] = f32x4{0.f, 0.f, 0.f, 0.f};
      gemm128<2>(A, 512, Bt, 512, 512, brow, bcol, smem, acc);
#pragma unroll
      for (int m = 0; m < 4; ++m)
#pragma unroll
        for (int j = 0; j < 4; ++j) {
          int row = brow + wr * 64 + m * 16 + fq * 4 + j;
          if (row < ROWS) {
#pragma unroll
            for (int n = 0; n < 2; ++n) {
              int col = bcol + wc * 32 + n * 16 + fr;
              float g = bf2f(gmb[(long)row * 3072 + br * 1024 + col]);
              tot[m][n][j] += g * acc[m][n][j];
            }
          }
        }
    }
#pragma unroll
    for (int m = 0; m < 4; ++m)
#pragma unroll
      for (int j = 0; j < 4; ++j) {
        int row = brow + wr * 64 + m * 16 + fq * 4 + j;
        if (row < ROWS) {
#pragma unroll
          for (int n = 0; n < 2; ++n) merged[(long)row * 1024 + bcol + wc * 32 + n * 16 + fr] = f2bf(tot[m][n][j]);
        }
      }
  }
}

DI void phase_out(const Params& p, int layer, char*) {
  const int tid = get_tid(), wid = __builtin_amdgcn_readfirstlane(tid >> 6), lane = tid & 63, wr = wid >> 1, wc = wid & 1, fr = lane & 15, fq = lane >> 4;
  const bfr* A = (const bfr*)(p.ws + W_HN);
  const bfr* Bt = (const bfr*)(p.ws + W_WOT) + (long)layer * 1024 * 1024;
  float* xres = (float*)(p.ws + W_XRES);
  constexpr int NTM = MPAD / 128, NTN = 8;
  for (int tile = blockIdx.x; tile < NTM * NTN; tile += gridDim.x) {
    int tn = tile / NTM, tm = tile % NTM;
    const int brow = tm * 128, bcol = tn * 128;
    f32x4 acc[4][4];
#pragma unroll
    for (int m = 0; m < 4; ++m)
#pragma unroll
      for (int n = 0; n < 4; ++n) acc[m][n] = f32x4{0.f, 0.f, 0.f, 0.f};
    gemm128<4>(A, 1024, Bt, 1024, 1024, brow, bcol, smem, acc);
#pragma unroll
    for (int m = 0; m < 4; ++m)
#pragma unroll
      for (int j = 0; j < 4; ++j) {
        int row = brow + wr * 64 + m * 16 + fq * 4 + j;
        if (row < ROWS) {
#pragma unroll
          for (int n = 0; n < 4; ++n) xres[(long)row * 1024 + bcol + wc * 64 + n * 16 + fr] += acc[m][n][j];
        }
      }
  }
}

constexpr int SEL_QS = 2120;
DI void select_item(const Params& p, int isP, int sq, int c, int sub, char*) {
  const int tid = get_tid(), wid = __builtin_amdgcn_readfirstlane(tid >> 6), lane = tid & 63, fr = lane & 15, fq = lane >> 4;
  int T0, nadm, rowbase;
  const bfr* kib;
  if (isP) {
    if (c == 0) { T0 = 0; nadm = 16; } else { T0 = 16 + 64 * (c - 1) + 16 * sub; nadm = 16 + 64 * c; }
    rowbase = sq * T_P;
    kib = (const bfr*)(p.ws + W_KIBP) + (long)sq * KP_PAD * 64;
  } else {
    T0 = 16 * sub; nadm = S_S; rowbase = ROWS_P + sq * 64;
    kib = (const bfr*)(p.ws + W_KIBS) + (long)sq * S_S * 64;
  }
  unsigned* maskg = (unsigned*)(p.ws + W_MASK);
  const int nsteps = (nadm + 31) >> 5;
  if (nadm <= 256) {
    for (int e = tid; e < 16 * nsteps; e += 256) {
      int q = e / nsteps, s = e - q * nsteps;
      unsigned w = (s * 32 + 32 <= nadm) ? 0xFFFFFFFFu : 0xFFFFu;
      maskg[(long)(rowbase + T0 + q) * MW + s] = w;
    }
    return;
  }
  const int nkt = nadm >> 4;
  const int nmine = (nkt - wid + 3) >> 2;
  const int nregs = (nadm + 63) >> 6;
  const bfr* qib = (const bfr*)(p.ws + W_QIB);
  const float* wib = (const float*)(p.ws + W_WIB);
  unsigned* S = (unsigned*)smem;
#pragma unroll 1
  for (int g = 0; g < 4; ++g) {
    const int qrow = rowbase + T0 + g * 4;
    int koff = (wid * 16 + fr) * 64 + fq * 8;
    asm volatile("" : "+v"(koff));
    const bfr* kbase = kib + koff;
    int nm = nmine;
    asm volatile("" : "+v"(nm));
    nm = __builtin_amdgcn_readfirstlane(nm);
    const bfr* qp = qib + (long)(qrow + (fr >> 2)) * 256 + (fr & 3) * 64 + fq * 8;
    const bf16x8 a0 = *(const bf16x8*)qp;
    const bf16x8 a1 = *(const bf16x8*)(qp + 32);
    const float4 w = *(const float4*)(wib + (long)(qrow + fq) * 4);
    unsigned sc[65];
#pragma unroll
    for (int ch = 0; ch < 5; ++ch) {
      if (ch * 13 < nm) {
        bf16x8 b0[13], b1[13];
#pragma unroll
        for (int u = 0; u < 13; ++u) {
          const int ic = min(ch * 13 + u, nm - 1);
          const bfr* kp = kbase + (long)ic * 4096;
          b0[u] = *(const bf16x8*)kp;
          b1[u] = *(const bf16x8*)(kp + 32);
        }
#pragma unroll
        for (int u = 0; u < 13; ++u) {
          const int i = ch * 13 + u;
          f32x4 a = {0.f, 0.f, 0.f, 0.f};
          a = MFMA16(a0, b0[u], a);
          a = MFMA16(a1, b1[u], a);
          float s = w.x * fmaxf(a[0], 0.f) + w.y * fmaxf(a[1], 0.f) + w.z * fmaxf(a[2], 0.f) + w.w * fmaxf(a[3], 0.f);
          sc[i] = (i < nm) ? sortable(s) : 0u;
        }
      } else {
#pragma unroll
        for (int u = 0; u < 13; ++u) sc[ch * 13 + u] = 0u;
      }
      __builtin_amdgcn_sched_barrier(0);
    }
    unsigned v[65];
    __syncthreads();
#pragma unroll
    for (int i = 0; i < 33; ++i) S[fq * SEL_QS + (i * 4 + wid) * 16 + fr] = sc[i];
    __syncthreads();
#pragma unroll
    for (int j = 0; j < 33; ++j) v[j] = S[wid * SEL_QS + j * 64 + lane];
    if (nregs > 33) {
      __syncthreads();
#pragma unroll
      for (int i = 33; i < 65; ++i) S[fq * SEL_QS + (i * 4 + wid - 132) * 16 + fr] = sc[i];
      __syncthreads();
#pragma unroll
      for (int j = 0; j < 32; ++j) v[33 + j] = S[wid * SEL_QS + j * 64 + lane];
    } else {
#pragma unroll
      for (int j = 0; j < 32; ++j) v[33 + j] = 0u;
    }
    int nr = nregs;
    asm volatile("" : "+v"(nr));
    nr = __builtin_amdgcn_readfirstlane(nr);
    unsigned thr = 0u;
#pragma unroll 1
    for (int bit = 31; bit >= 0; --bit) {
      const unsigned cand = thr | (1u << bit);
      int cnt = 0;
#pragma unroll
      for (int ch = 0; ch < 5; ++ch) {
        if (ch * 13 < nr) {
#pragma unroll
          for (int u = 0; u < 13; ++u) cnt += __popcll(__ballot(v[ch * 13 + u] >= cand));
        }
      }
      if (cnt >= 256) thr = cand;
    }
    int gt = 0, eq = 0;
#pragma unroll
    for (int r = 0; r < 65; ++r) {
      gt += __popcll(__ballot(v[r] > thr));
      eq += __popcll(__ballot(v[r] == thr));
    }
    const int need = 256 - gt;
    int idxcut = 0x7fffffff;
    if (eq != need) {
      int run = 0;
      bool done = false;
#pragma unroll
      for (int r = 0; r < 65; ++r) {
        if (!done) {
          unsigned long long m = __ballot(v[r] == thr);
          int pc = __popcll(m);
          if (run + pc >= need) {
            const int k = need - run;
            for (int t = 1; t < k; ++t) m &= m - 1ull;
            idxcut = r * 64 + (__ffsll((long long)m) - 1);
            done = true;
          } else run += pc;
        }
      }
    }
    unsigned* mrowp = maskg + (long)(qrow + wid) * MW;
#pragma unroll
    for (int r = 0; r < 65; ++r) {
      if (r < nr) {
        const bool sel = (v[r] > thr) || (v[r] == thr && (r * 64 + lane) <= idxcut);
        const unsigned long long bal = __ballot(sel);
        if (lane == 0) *(uint2*)(mrowp + r * 2) = make_uint2((unsigned)bal, (unsigned)(bal >> 32));
      }
    }
  }
}

DI void lru_tile(const Params& p, int layer, int isP, int sq, int tile, int nb, int pass, char*) {
  const int tid = get_tid(), wid = __builtin_amdgcn_readfirstlane(tid >> 6), lane = tid & 63, fr = lane & 15, fq = lane >> 4;
  float* xbs = (float*)smem;
  float* as_ = xbs;
  float* xcs = xbs + 67 * 64;
  float* bs_ = xcs + 64 * 64;
  float* ab = bs_ + 64 * 64;
  bfr* xca = (bfr*)(ab + 512);
  const int T = isP ? T_P : T_S;
  const int rowbase = isP ? sq * T_P : ROWS_P + sq * 64;
  const int t0 = tile * 64, ch0 = nb * 64;
  const bfr* xbb = (const bfr*)(p.ws + W_XBB);
  bfr* gby = (bfr*)(p.ws + W_GB);
  float* agg = (float*)(p.ws + W_AGG);
  {
    const int c = tid & 63;
    for (int rr = tid >> 6; rr < 67; rr += 4) {
      int tt = t0 - 3 + rr;
      float v = 0.f;
      if (tt < 0) { if (!isP) v = p.state_conv[((long)(layer * NB_S + sq) * 3 + (3 + tt)) * 512 + ch0 + c]; }
      else if (tt < T) v = bf2f(xbb[(long)(rowbase + tt) * 512 + ch0 + c]);
      xbs[rr * 64 + c] = v;
    }
  }
  __syncthreads();
  {
    const int c = tid & 63;
    const float cb = p.conv_b[layer * 512 + ch0 + c];
    const float w0 = p.conv_w[(layer * 4 + 0) * 512 + ch0 + c], w1 = p.conv_w[(layer * 4 + 1) * 512 + ch0 + c],
                w2 = p.conv_w[(layer * 4 + 2) * 512 + ch0 + c], w3 = p.conv_w[(layer * 4 + 3) * 512 + ch0 + c];
    for (int t = tid >> 6; t < 64; t += 4) {
      float xc = cb + w0 * xbs[t * 64 + c] + w1 * xbs[(t + 1) * 64 + c] + w2 * xbs[(t + 2) * 64 + c] + w3 * xbs[(t + 3) * 64 + c];
      xcs[t * 64 + c] = xc;
      xca[t * 72 + c] = f2bf(xc);
    }
  }
  __syncthreads();
  {
    const bfr* WaT = (const bfr*)(p.ws + W_WAT) + (long)(layer * 8 + nb) * 4096;
    const bfr* WxT = (const bfr*)(p.ws + W_WXT) + (long)(layer * 8 + nb) * 4096;
    bf16x8 af0 = *(const bf16x8*)(xca + (wid * 16 + fr) * 72 + fq * 8);
    bf16x8 af1 = *(const bf16x8*)(xca + (wid * 16 + fr) * 72 + 32 + fq * 8);
#pragma unroll
    for (int nt = 0; nt < 4; ++nt) {
      const int d = nt * 16 + fr;
      bf16x8 ba0 = *(const bf16x8*)(WaT + d * 64 + fq * 8), ba1 = *(const bf16x8*)(WaT + d * 64 + 32 + fq * 8);
      bf16x8 bx0 = *(const bf16x8*)(WxT + d * 64 + fq * 8), bx1 = *(const bf16x8*)(WxT + d * 64 + 32 + fq * 8);
      f32x4 ar = {0.f, 0.f, 0.f, 0.f}, ai = {0.f, 0.f, 0.f, 0.f};
      ar = MFMA16(af0, ba0, ar); ar = MFMA16(af1, ba1, ar);
      ai = MFMA16(af0, bx0, ai); ai = MFMA16(af1, bx1, ai);
      const float bav = p.lru_ba[layer * 512 + ch0 + d], bxv = p.lru_bx[layer * 512 + ch0 + d];
      const float sp = log1pf(__expf(-p.lru_lambda[layer * 512 + ch0 + d]));
#pragma unroll
      for (int j = 0; j < 4; ++j) {
        const int t = wid * 16 + fq * 4 + j;
        float r = sigm(ar[j] + bav), ig = sigm(ai[j] + bxv);
        float la = -8.f * r * sp;
        float a = expf(la);
        float b = sqrtf(-expm1f(2.f * la)) * (ig * xcs[t * 64 + d]);
        if (t0 + t >= T) { a = 1.f; b = 0.f; }
        as_[t * 64 + d] = a;
        bs_[t * 64 + d] = b;
      }
    }
  }
  __syncthreads();
  const int c = tid & 63;
  {
    float A = 1.f, B = 0.f;
#pragma unroll
    for (int tt = 0; tt < 16; ++tt) {
      float a = as_[(wid * 16 + tt) * 64 + c], b = bs_[(wid * 16 + tt) * 64 + c];
      A *= a; B = a * B + b;
    }
    ab[(wid * 64 + c) * 2] = A;
    ab[(wid * 64 + c) * 2 + 1] = B;
  }
  __syncthreads();
  if (pass == 0) {
    if (wid == 0) {
      float A = 1.f, B = 0.f;
#pragma unroll
      for (int w = 0; w < 4; ++w) { float a = ab[(w * 64 + c) * 2], b = ab[(w * 64 + c) * 2 + 1]; A *= a; B = a * B + b; }
      *(float2*)(agg + ((long)(sq * NTILE_P + tile) * 512 + ch0 + c) * 2) = make_float2(A, B);
    }
  } else {
    float h = isP ? 0.f : p.state_lru[(long)(layer * NB_S + sq) * 512 + ch0 + c];
    for (int i = 0; i < tile; ++i) {
      float2 e = *(const float2*)(agg + ((long)(sq * NTILE_P + i) * 512 + ch0 + c) * 2);
      h = e.x * h + e.y;
    }
    for (int w = 0; w < wid; ++w) h = ab[(w * 64 + c) * 2] * h + ab[(w * 64 + c) * 2 + 1];
#pragma unroll
    for (int tt = 0; tt < 16; ++tt) {
      const int t = wid * 16 + tt;
      h = as_[t * 64 + c] * h + bs_[t * 64 + c];
      if (t0 + t < T) {
        const long idx = (long)(rowbase + t0 + t) * 512 + ch0 + c;
        gby[idx] = f2bf(h * bf2f(gby[idx]));
        if (t0 + t == T - 1) {
          if (isP) p.out[O_LRUP + (long)(layer * NB_P + sq) * 512 + ch0 + c] = h;
          else p.out[O_LRUS + (long)(layer * NB_S + sq) * 512 + ch0 + c] = h;
        }
      }
    }
  }
}

DI void pool_item(const Params& p, int layer, int isP, int sq, int tile, int g, char*) {
  const int tid = get_tid(), wid = __builtin_amdgcn_readfirstlane(tid >> 6), lane = tid & 63, fr = lane & 15, fq = lane >> 4;
  float* xps = (float*)smem;
  bfr* pa = (bfr*)(xps + 79 * 128);
  const int T = isP ? T_P : T_S;
  const int rowbase = isP ? sq * T_P : ROWS_P + sq * 64;
  const int t0 = tile * 64, ch0 = g * 128;
  const bfr* xcb = (const bfr*)(p.ws + W_XCB);
  bfr* gcy = (bfr*)(p.ws + W_GC);
  {
    const int c = tid & 127;
    for (int rr = tid >> 7; rr < 79; rr += 2) {
      int tt = t0 - 15 + rr;
      float v = 0.f;
      if (tt < 0) { if (!isP) v = p.state_pool[((long)(layer * NB_S + sq) * 15 + (15 + tt)) * 512 + ch0 + c]; }
      else if (tt < T) v = bf2f(xcb[(long)(rowbase + tt) * 512 + ch0 + c]);
      xps[rr * 128 + c] = v;
    }
  }
  __syncthreads();
  {
    const int c = tid & 127;
    const int w = 2 << g;
    const int nh = isP ? 0 : PAST;
    for (int t = tid >> 7; t < 64; t += 2) {
      float s = 0.f;
      for (int i = 0; i < w; ++i) s += xps[(15 + t - i) * 128 + c];
      int cnt = min(w, t0 + t + 1 + nh);
      float v = s / (float)cnt - xps[(15 + t) * 128 + c];
      pa[t * 136 + c] = f2bf(v);
    }
  }
  __syncthreads();
  {
    const bfr* PwT = (const bfr*)(p.ws + W_PWT) + (long)(layer * 4 + g) * 16384;
    bf16x8 af[4];
#pragma unroll
    for (int ks = 0; ks < 4; ++ks) af[ks] = *(const bf16x8*)(pa + (wid * 16 + fr) * 136 + ks * 32 + fq * 8);
#pragma unroll
    for (int nt = 0; nt < 8; ++nt) {
      const int d = nt * 16 + fr;
      f32x4 acc = {0.f, 0.f, 0.f, 0.f};
#pragma unroll
      for (int ks = 0; ks < 4; ++ks) {
        bf16x8 bq = *(const bf16x8*)(PwT + d * 128 + ks * 32 + fq * 8);
        acc = MFMA16(af[ks], bq, acc);
      }
      const float scl = p.pool_scale[layer * 512 + ch0 + d];
#pragma unroll
      for (int j = 0; j < 4; ++j) {
        const int t = wid * 16 + fq * 4 + j;
        if (t0 + t < T) {
          const long idx = (long)(rowbase + t0 + t) * 512 + ch0 + d;
          gcy[idx] = f2bf(acc[j] * scl * bf2f(gcy[idx]));
        }
      }
    }
  }
}

DI void kmax_item(const Params& p, int seq, int h, char*) {
  const int tid = get_tid(), wid = __builtin_amdgcn_readfirstlane(tid >> 6), lane = tid & 63;
  const bfr* kb; int S;
  if (seq < NB_P) { kb = (const bfr*)(p.ws + W_KBP) + (long)seq * KP_PAD * 512; S = T_P; }
  else { kb = (const bfr*)(p.ws + W_KBS) + (long)(seq - NB_P) * S_S * 512; S = S_S; }
  float mx = 0.f;
  for (int key = tid; key < S; key += 256) {
    const uint4* r = (const uint4*)(kb + (long)key * 512 + h * 64);
    float ss = 0.f;
#pragma unroll
    for (int i = 0; i < 8; ++i) {
      uint4 v = r[i];
      unsigned u[4] = {v.x, v.y, v.z, v.w};
#pragma unroll
      for (int j = 0; j < 4; ++j) {
        float a = __uint_as_float(u[j] << 16), b = __uint_as_float(u[j] & 0xFFFF0000u);
        ss += a * a + b * b;
      }
    }
    mx = fmaxf(mx, ss);
  }
#pragma unroll
  for (int o = 32; o >= 1; o >>= 1) mx = fmaxf(mx, __shfl_xor(mx, o));
  float* red = (float*)smem;
  if (lane == 0) red[wid] = mx;
  __syncthreads();
  if (tid == 0) ((float*)(p.ws + W_KMAX))[seq * 8 + h] = fmaxf(fmaxf(red[0], red[1]), fmaxf(red[2], red[3]));
}

DI void attn_unit(const Params& p, int isP, int sq, int c, int h, int half, size_t dstoff = W_GA) {
  const int lane = get_tid() & 63, fr = lane & 15, fq = lane >> 4;
  int T0, nqt, nadm, rowbase, vld;
  const bfr *kb, *vt;
  if (isP) {
    if (c == 0) { T0 = 0; nqt = 1; nadm = 16; } else { T0 = 16 + 64 * (c - 1) + 32 * half; nqt = 2; nadm = 16 + 64 * c; }
    rowbase = sq * T_P;
    kb = (const bfr*)(p.ws + W_KBP) + (long)sq * KP_PAD * 512;
    vt = (const bfr*)(p.ws + W_VTP) + (long)sq * 512 * KP_PAD;
    vld = KP_PAD;
  } else {
    T0 = 32 * half; nqt = 2; nadm = S_S; rowbase = ROWS_P + sq * 64;
    kb = (const bfr*)(p.ws + W_KBS) + (long)sq * S_S * 512;
    vt = (const bfr*)(p.ws + W_VTS) + (long)sq * 512 * S_S;
    vld = S_S;
  }
  const int nsteps = (nadm + 31) >> 5;
  const int qrow0 = rowbase + T0;
  const bfr* qb = (const bfr*)(p.ws + W_QB);
  const unsigned* maskg = (const unsigned*)(p.ws + W_MASK);
  bf16x8 qf[2][2];
#pragma unroll
  for (int qt = 0; qt < 2; ++qt)
#pragma unroll
    for (int ks = 0; ks < 2; ++ks) {
      int r = qrow0 + (qt < nqt ? qt * 16 : 0) + fr;
      qf[qt][ks] = *(const bf16x8*)(qb + (long)r * 512 + h * 64 + ks * 32 + fq * 8);
    }
  f32x4 o[2][4];
#pragma unroll
  for (int qt = 0; qt < 2; ++qt)
#pragma unroll
    for (int dt = 0; dt < 4; ++dt) o[qt][dt] = f32x4{0.f, 0.f, 0.f, 0.f};
  const float sc2 = 0.125f * 1.4426950408889634f;
  const float kmax2 = ((const float*)(p.ws + W_KMAX))[(isP ? sq : NB_P + sq) * 8 + h];
  float mref[2], lsum[2] = {0.f, 0.f};
#pragma unroll
  for (int qt = 0; qt < 2; ++qt) {
    float ss = 0.f;
#pragma unroll
    for (int ks = 0; ks < 2; ++ks)
#pragma unroll
      for (int i = 0; i < 8; ++i) { float a = bf2f((bfr)qf[qt][ks][i]); ss += a * a; }
    ss += __shfl_xor(ss, 16);
    ss += __shfl_xor(ss, 32);
    mref[qt] = sqrtf(ss * kmax2) * sc2;
  }
  const unsigned* mrow0 = maskg + (long)(qrow0 + fr) * MW;
  const unsigned* mrow1 = maskg + (long)(qrow0 + (nqt > 1 ? 16 : 0) + fr) * MW;
  const int kofs = (fr >> 2) * 8 + (fr & 3);
  const bfr* kptr = kb + (long)kofs * 512 + h * 64 + fq * 8;
  const bfr* vptr = vt + (long)(h * 64 + fr) * vld + fq * 8;
  bf16x8 ka0 = *(const bf16x8*)kptr, ka1 = *(const bf16x8*)(kptr + 32);
  bf16x8 kb0 = *(const bf16x8*)(kptr + 4 * 512), kb1 = *(const bf16x8*)(kptr + 4 * 512 + 32);
  bf16x8 vf[4];
#pragma unroll
  for (int dt = 0; dt < 4; ++dt) vf[dt] = *(const bf16x8*)(vptr + (long)dt * 16 * vld);
  unsigned mw0 = mrow0[0], mw1 = mrow1[0];
  for (int s = 0; s < nsteps; ++s) {
    const int sn = min(s + 1, nsteps - 1);
    const bfr* pa = kptr + (long)sn * 32 * 512;
    const bf16x8 nka0 = *(const bf16x8*)pa, nka1 = *(const bf16x8*)(pa + 32);
    const bf16x8 nkb0 = *(const bf16x8*)(pa + 4 * 512), nkb1 = *(const bf16x8*)(pa + 4 * 512 + 32);
    bf16x8 nvf[4];
#pragma unroll
    for (int dt = 0; dt < 4; ++dt) nvf[dt] = *(const bf16x8*)(vptr + (long)dt * 16 * vld + sn * 32);
    const unsigned nmw0 = mrow0[sn], nmw1 = mrow1[sn];
#pragma unroll
    for (int qt = 0; qt < 2; ++qt) {
      if (qt < nqt) {
        f32x4 sa = {0.f, 0.f, 0.f, 0.f}, sb = {0.f, 0.f, 0.f, 0.f};
        sa = MFMA16(ka0, qf[qt][0], sa); sa = MFMA16(ka1, qf[qt][1], sa);
        sb = MFMA16(kb0, qf[qt][0], sb); sb = MFMA16(kb1, qf[qt][1], sb);
        const unsigned mb = ((qt == 0 ? mw0 : mw1) >> (fq * 8)) & 0xFFu;
        float pr[8];
#pragma unroll
        for (int i = 0; i < 4; ++i) {
          float pa_ = __builtin_amdgcn_exp2f(sa[i] * sc2 - mref[qt]);
          float pb_ = __builtin_amdgcn_exp2f(sb[i] * sc2 - mref[qt]);
          pr[i] = ((mb >> i) & 1u) ? pa_ : 0.f;
          pr[4 + i] = ((mb >> (4 + i)) & 1u) ? pb_ : 0.f;
        }
        lsum[qt] += ((pr[0] + pr[1]) + (pr[2] + pr[3])) + ((pr[4] + pr[5]) + (pr[6] + pr[7]));
        union { unsigned u[4]; bf16x8 v; } pk;
        pk.u[0] = pack2(pr[0], pr[1]); pk.u[1] = pack2(pr[2], pr[3]); pk.u[2] = pack2(pr[4], pr[5]); pk.u[3] = pack2(pr[6], pr[7]);
#pragma unroll
        for (int dt = 0; dt < 4; ++dt) o[qt][dt] = MFMA16(vf[dt], pk.v, o[qt][dt]);
      }
    }
    ka0 = nka0; ka1 = nka1; kb0 = nkb0; kb1 = nkb1;
#pragma unroll
    for (int dt = 0; dt < 4; ++dt) vf[dt] = nvf[dt];
    mw0 = nmw0; mw1 = nmw1;
  }
  bfr* gay = (bfr*)(p.ws + W_GA);
  bfr* dsty = (bfr*)(p.ws + dstoff);
#pragma unroll
  for (int qt = 0; qt < 2; ++qt) {
    if (qt < nqt) {
      float l = lsum[qt];
      l += __shfl_xor(l, 16);
      l += __shfl_xor(l, 32);
      const float inv = l > 0.f ? 1.f / l : 0.f;
      const long rowoff = (long)(qrow0 + qt * 16 + fr) * 512 + h * 64;
#pragma unroll
      for (int dt = 0; dt < 4; ++dt) {
        uint2* ptr = (uint2*)(gay + rowoff + dt * 16 + fq * 4);
        uint2 gv = *ptr;
        float g0 = __uint_as_float(gv.x << 16), g1 = __uint_as_float(gv.x & 0xFFFF0000u);
        float g2 = __uint_as_float(gv.y << 16), g3 = __uint_as_float(gv.y & 0xFFFF0000u);
        uint2 ov;
        ov.x = pack2(o[qt][dt][0] * inv * g0, o[qt][dt][1] * inv * g1);
        ov.y = pack2(o[qt][dt][2] * inv * g2, o[qt][dt][3] * inv * g3);
        *(uint2*)(dsty + rowoff + dt * 16 + fq * 4) = ov;
      }
    }
  }
}

#define XB_TMO      128
#define XB_XCNT(j)  (256  + 64 * (j))
#define XB_XSUB(j)  (1280 + 64 * (j))
#define XB_XGEN(j)  (2304 + 64 * (j))
#define XB_TOP      3328
#define XB_TOPGEN   3392
#define XCD_BAR_WORDS 3456
#define XB_SPIN_CAP (1u << 18)
#define LAS __attribute__((address_space(3)))

__device__ __forceinline__ unsigned xb_ld(unsigned* p)              { return __hip_atomic_load(p, __ATOMIC_RELAXED, __HIP_MEMORY_SCOPE_AGENT); }
__device__ __forceinline__ unsigned xb_add(unsigned* p, unsigned v) { return __hip_atomic_fetch_add(p, v, __ATOMIC_RELAXED, __HIP_MEMORY_SCOPE_AGENT); }
__device__ __forceinline__ unsigned xb_xcc_id() { return (unsigned)__builtin_amdgcn_s_getreg((3 << 11) | 20) & 0xFu; }
#define XB_SPIN(cond, bar) do { unsigned _sp = 0; while (cond) { __builtin_amdgcn_s_sleep(1); \
    if ((++_sp & 255u) == 0u) { if (xb_ld(&(bar)[XB_TMO])) break; if (_sp > XB_SPIN_CAP) { atomicAdd(&(bar)[XB_TMO], 1u); break; } } } } while (0)

struct XcdBarrier {
    unsigned* bar; unsigned x;
    volatile LAS unsigned* st;
};

__device__ __forceinline__ XcdBarrier xcd_barrier_post(unsigned* bar, volatile LAS unsigned* st) {
    XcdBarrier b; b.bar = bar; b.x = xb_xcc_id(); b.st = st;
    if (threadIdx.x == 0) (void)xb_add(&bar[XB_XCNT(b.x)], 1u);
    return b;
}
__device__ __forceinline__ void xcd_barrier_complete(unsigned* bar, unsigned x, unsigned& nloc, unsigned& nx) {
    const unsigned G = gridDim.x * gridDim.y * gridDim.z;
    unsigned sum, cnt, mine, sp = 0u;
    for (;;) {
        sum = 0u; cnt = 0u; mine = 0u;
#pragma unroll
        for (unsigned j = 0; j < 16; ++j) { const unsigned c = xb_ld(&bar[XB_XCNT(j)]); sum += c; cnt += (c > 0u) ? 1u : 0u; mine = (j == x) ? c : mine; }
        if (sum == G) break;
        __builtin_amdgcn_s_sleep(1);
        if ((++sp & 255u) == 0u) { if (xb_ld(&bar[XB_TMO])) break; if (sp > XB_SPIN_CAP) { atomicAdd(&bar[XB_TMO], 1u); break; } }
    }
    nloc = mine > 0u ? mine : 1u; nx = cnt > 0u ? cnt : 1u;
}

__device__ __forceinline__ void xcd_barrier(const XcdBarrier& b) {
    asm volatile("s_waitcnt vmcnt(0)" ::: "memory");
    __syncthreads();
    if (threadIdx.x == 0) {
        unsigned* bar = b.bar;
        __builtin_amdgcn_s_waitcnt(0);
        unsigned nloc = b.st[0], nx = b.st[1];
        if (nloc == 0u) { xcd_barrier_complete(bar, b.x, nloc, nx); b.st[0] = nloc; b.st[1] = nx; }
        const unsigned old = xb_add(&bar[XB_XSUB(b.x)], 1u);
        const unsigned gen = old / nloc;
        if (old + 1u == (gen + 1u) * nloc) {
            __builtin_amdgcn_fence(__ATOMIC_RELEASE, "agent");
            asm volatile("s_waitcnt vmcnt(0)" ::: "memory");
            const unsigned og = xb_add(&bar[XB_TOP], 1u);
            const unsigned tg = og / nx;
            if (og + 1u == (tg + 1u) * nx) xb_add(&bar[XB_TOPGEN], 1u);
            else XB_SPIN(xb_ld(&bar[XB_TOPGEN]) == tg, bar);
            __builtin_amdgcn_fence(__ATOMIC_ACQUIRE, "agent");
            xb_add(&bar[XB_XGEN(b.x)], 1u);
            asm volatile("s_waitcnt vmcnt(0)" ::: "memory");
        } else {
            XB_SPIN(xb_ld(&bar[XB_XGEN(b.x)]) == gen, bar);
            __builtin_amdgcn_fence(__ATOMIC_ACQUIRE, "agent");
            asm volatile("s_waitcnt vmcnt(0)" ::: "memory");
        }
    }
    __syncthreads();
}


DI int pop_block(int* ctr, int*) {
  __syncthreads();
  if (threadIdx.x == 0) sh_item = atomicAdd(ctr, 1);
  __syncthreads();
  return __builtin_amdgcn_readfirstlane(sh_item);
}

constexpr int N_KMAX = 20 * 8;
constexpr int N_SEL = 64 * 16 + 64 + 4;
constexpr int N_LRU1 = NB_P * NTILE_P * 8;
constexpr int N_POOL = NB_P * NTILE_P * 4 + NB_S * 4;
constexpr int N_LRU2 = NB_P * NTILE_P * 8 + NB_S * 8;
constexpr int N_ATT = 64 * 64 + 256 + 32;

DI void phase_b1(const Params& p, int layer, char*, int*) {
  int* ctr = (int*)(p.ws + W_CTR) + layer * 4 + 0;
  for (;;) {
    int it = pop_block(ctr, nullptr);
    if (it >= N_SEL + N_LRU1 + N_POOL + N_KMAX) break;
    if (it >= N_SEL + N_LRU1 + N_POOL) { int j = it - (N_SEL + N_LRU1 + N_POOL); kmax_item(p, j >> 3, j & 7, smem); }
    else if (it < N_SEL) {
      if (it < 1024) { int c = 64 - (it >> 4), b = (it & 15) >> 2, sub = it & 3; select_item(p, 1, b, c, sub, smem); }
      else if (it < 1088) { int j = it - 1024; select_item(p, 0, j >> 2, 0, j & 3, smem); }
      else select_item(p, 1, it - 1088, 0, 0, smem);
    } else if (it < N_SEL + N_LRU1) {
      int j = it - N_SEL;
      int sq = j / (NTILE_P * 8), rem = j % (NTILE_P * 8);
      lru_tile(p, layer, 1, sq, rem >> 3, rem & 7, 0, smem);
    } else {
      int j = it - N_SEL - N_LRU1;
      if (j < NB_P * NTILE_P * 4) { int sq = j / (NTILE_P * 4), rem = j % (NTILE_P * 4); pool_item(p, layer, 1, sq, rem >> 2, rem & 3, smem); }
      else { j -= NB_P * NTILE_P * 4; pool_item(p, layer, 0, j >> 2, 0, j & 3, smem); }
    }
  }
}

constexpr size_t W_DUMMY = W_END;
DI void probe_select(const Params& p, int layer) {
  int* ctr = (int*)(p.ws + W_CTR) + layer * 4 + 3;
  for (;;) {
    int it = pop_block(ctr, nullptr);
    if (it >= N_SEL) break;
    if (it < 1024) { int c = 64 - (it >> 4), b = (it & 15) >> 2, sub = it & 3; select_item(p, 1, b, c, sub, smem); }
    else if (it < 1088) { int j = it - 1024; select_item(p, 0, j >> 2, 0, j & 3, smem); }
    else select_item(p, 1, it - 1088, 0, 0, smem);
  }
}
DI void probe_attn(const Params& p, int layer) {
  int* ctr2 = (int*)(p.ws + W_CTR) + layer * 4 + 3;
  const int lane = get_tid() & 63;
  for (;;) {
    int u = 0;
    if (lane == 0) u = atomicAdd(ctr2, 1);
    u = __builtin_amdgcn_readfirstlane(u);
    if (u >= N_ATT) break;
    if (u < 4096) { int c = 64 - (u >> 6), r = u & 63; attn_unit(p, 1, r >> 4, c, (r >> 1) & 7, r & 1, W_DUMMY); }
    else if (u < 4096 + 256) { int r = u - 4096; attn_unit(p, 0, r >> 4, 0, (r >> 1) & 7, r & 1, W_DUMMY); }
    else { int r = u - 4352; attn_unit(p, 1, r >> 3, 0, r & 7, 0, W_DUMMY); }
  }
}

DI void phase_b2(const Params& p, int layer, char*, int*) {
  int* ctr = (int*)(p.ws + W_CTR) + layer * 4 + 1;
  for (;;) {
    int it = pop_block(ctr, nullptr);
    if (it >= N_LRU2) break;
    if (it < NB_P * NTILE_P * 8) { int sq = it / (NTILE_P * 8), rem = it % (NTILE_P * 8); lru_tile(p, layer, 1, sq, rem >> 3, rem & 7, 1, smem); }
    else { int j = it - NB_P * NTILE_P * 8; lru_tile(p, layer, 0, j >> 3, 0, j & 7, 1, smem); }
  }
  int* ctr2 = (int*)(p.ws + W_CTR) + layer * 4 + 2;
  const int lane = get_tid() & 63;
  for (;;) {
    int u = 0;
    if (lane == 0) u = atomicAdd(ctr2, 1);
    u = __builtin_amdgcn_readfirstlane(u);
    if (u >= N_ATT) break;
    if (u < 4096) { int c = 64 - (u >> 6), r = u & 63; attn_unit(p, 1, r >> 4, c, (r >> 1) & 7, r & 1); }
    else if (u < 4096 + 256) { int r = u - 4096; attn_unit(p, 0, r >> 4, 0, (r >> 1) & 7, r & 1); }
    else { int r = u - 4352; attn_unit(p, 1, r >> 3, 0, r & 7, 0); }
  }
}

DI Params fresh(const Params& p) {
  Params q = p;
  int z = 0;
  asm volatile("s_mov_b32 %0, 0" : "=s"(z));
  q.ws = p.ws + z;
  q.out = p.out + z;
  return q;
}
DI int fresh_i(int v) {
  asm volatile("" : "+s"(v));
  return v;
}

__shared__ uint4 xb_words;

__global__ void __launch_bounds__(256, 2) fwd_megakernel(Params p) {
  cg::grid_group grid = cg::this_grid();
  if (threadIdx.x == 0) xb_words = make_uint4(0u, 0u, 0u, 0u);
  __syncthreads();
  XcdBarrier xb = xcd_barrier_post((unsigned*)(p.ws + W_BAR), (volatile LAS unsigned*)&xb_words);
  prep_phase(fresh(p), smem);
  grid.sync();
#if PROBE == 6
#pragma unroll 1
  for (int i = 0; i < 10; ++i) xcd_barrier(xb);
#endif
#pragma unroll 1
  for (int layer = 0; layer < 2; ++layer) {
    phase_inproj(fresh(p), fresh_i(layer), smem);
    xcd_barrier(xb);
#if PROBE == 2
    probe_select(fresh(p), fresh_i(layer));
    xcd_barrier(xb);
#endif
    phase_b1(fresh(p), fresh_i(layer), smem, &sh_item);
    xcd_barrier(xb);
#if PROBE == 3
    probe_attn(fresh(p), fresh_i(layer));
    xcd_barrier(xb);
#endif
    phase_b2(fresh(p), fresh_i(layer), smem, &sh_item);
    xcd_barrier(xb);
    phase_merge(fresh(p), fresh_i(layer), smem);
    xcd_barrier(xb);
#if PROBE == 4
    phase_merge(fresh(p), fresh_i(layer), smem);
    xcd_barrier(xb);
#endif
    phase_out(fresh(p), fresh_i(layer), smem);
    xcd_barrier(xb);
    if (layer == 0) { convert_cache(fresh(p), 1, smem); norm_phase(fresh(p), 1); xcd_barrier(xb); }
    else norm_phase(fresh(p), 2);
  }
}

extern "C" void kernel_launch(void* const* d_in, const int* in_sizes, int n_in, void* d_out, int out_size, void* d_ws,
                              size_t ws_size, hipStream_t stream) {
  static int grid_blocks = 0;
  if (!grid_blocks) {
    int dev = 0, cus = 0, per_cu = 0;
    hipGetDevice(&dev);
    hipDeviceGetAttribute(&cus, hipDeviceAttributeMultiprocessorCount, dev);
    hipOccupancyMaxActiveBlocksPerMultiprocessor(&per_cu, fwd_megakernel, 256, 0);
    if (per_cu > 2) per_cu = 2;
    if (per_cu < 1) per_cu = 1;
    grid_blocks = cus * per_cu;
  }
  if (ws_size < W_END) { fprintf(stderr, "workspace too small: %zu < %zu\n", ws_size, (size_t)W_END); return; }
  Params p{};
  const float** f = (const float**)&p;
  for (int i = 0; i < 23; ++i) f[i] = (const float*)d_in[i];
  p.out = (float*)d_out;
  p.ws = (char*)d_ws;
  hipMemsetAsync(d_ws, 0, 32768, stream);
  void* args[] = {&p};
  hipError_t e = hipLaunchCooperativeKernel((void*)fwd_megakernel, dim3(grid_blocks), dim3(256), args, 0, stream);
  if (e != hipSuccess) fprintf(stderr, "cooperative launch failed: %s (grid %d)\n", hipGetErrorString(e), grid_blocks);
}
```

```cpp
#include <hip/hip_runtime.h>
#include <hip/hip_cooperative_groups.h>
#include <stdint.h>
#include <cstdio>
namespace cg = cooperative_groups;
#ifndef PROBE
#define PROBE 0
#endif

typedef unsigned short bfr;
typedef __attribute__((ext_vector_type(8))) short bf16x8;
typedef __attribute__((ext_vector_type(4))) float f32x4;
typedef __attribute__((ext_vector_type(2))) float f32x2;
typedef __attribute__((ext_vector_type(2))) __bf16 bf2_t;
#define DI __device__ __forceinline__
#define MFMA16(a, b, c) __builtin_amdgcn_mfma_f32_16x16x32_bf16((a), (b), (c), 0, 0, 0)

constexpr int DM = 1024;
constexpr int NB_P = 4, T_P = 4112, SEQ_P = 4096, NMETA = 16;
constexpr int NB_S = 16, T_S = 64, PAST = 2048, S_S = 2112;
constexpr int ROWS_P = NB_P * T_P;
constexpr int ROWS = ROWS_P + NB_S * T_S;
constexpr int MPAD = 17536;
constexpr int NIN = 7492, NPAD = 7552;
constexpr int KP_PAD = 4128;
constexpr int MW = 132;
constexpr int NTILE_P = 65;

constexpr int C_Q = 0, C_K = 512, C_V = 1024, C_GA = 1536, C_QI = 2048, C_KI = 2304, C_XB = 2368, C_GB = 2880,
              C_XC = 3392, C_GC = 3904, C_GM = 4416, C_WI = 7488;

constexpr long O_YP = 0;
constexpr long O_YS = O_YP + (long)NB_P * SEQ_P * DM;
constexpr long O_KP = O_YS + (long)NB_S * T_S * DM;
constexpr long O_VP = O_KP + 2L * NB_P * T_P * 512;
constexpr long O_KIP = O_VP + 2L * NB_P * T_P * 512;
constexpr long O_CONVP = O_KIP + 2L * NB_P * T_P * 64;
constexpr long O_LRUP = O_CONVP + 2L * NB_P * 3 * 512;
constexpr long O_POOLP = O_LRUP + 2L * NB_P * 512;
constexpr long O_KS = O_POOLP + 2L * NB_P * 15 * 512;
constexpr long O_VS = O_KS + 2L * NB_S * T_S * 512;
constexpr long O_KIS = O_VS + 2L * NB_S * T_S * 512;
constexpr long O_CONVS = O_KIS + 2L * NB_S * T_S * 64;
constexpr long O_LRUS = O_CONVS + 2L * NB_S * 3 * 512;
constexpr long O_POOLS = O_LRUS + 2L * NB_S * 512;

constexpr size_t al256(size_t x) { return (x + 255) & ~(size_t)255; }
constexpr size_t W_CTR = 0;
constexpr size_t W_BAR = 4096;
constexpr size_t W_ROPE = 32768;
constexpr size_t W_WINT = al256(W_ROPE + (size_t)T_P * 8 * 8);
constexpr size_t W_WBT = al256(W_WINT + 2ull * NPAD * 1024 * 2);
constexpr size_t W_WOT = al256(W_WBT + 2ull * 3 * 1024 * 512 * 2);
constexpr size_t W_WAT = al256(W_WOT + 2ull * 1024 * 1024 * 2);
constexpr size_t W_WXT = al256(W_WAT + 2ull * 8 * 64 * 64 * 2);
constexpr size_t W_PWT = al256(W_WXT + 2ull * 8 * 64 * 64 * 2);
constexpr size_t W_XRES = al256(W_PWT + 2ull * 4 * 128 * 128 * 2);
constexpr size_t W_HN = al256(W_XRES + (size_t)MPAD * 1024 * 4);
constexpr size_t W_QB = al256(W_HN + (size_t)MPAD * 1024 * 2);
constexpr size_t W_GA = al256(W_QB + (size_t)MPAD * 512 * 2);
constexpr size_t W_QIB = al256(W_GA + (size_t)MPAD * 512 * 2);
constexpr size_t W_WIB = al256(W_QIB + (size_t)MPAD * 256 * 2);
constexpr size_t W_XBB = al256(W_WIB + (size_t)MPAD * 4 * 4);
constexpr size_t W_GB = al256(W_XBB + (size_t)MPAD * 512 * 2);
constexpr size_t W_XCB = al256(W_GB + (size_t)MPAD * 512 * 2);
constexpr size_t W_GC = al256(W_XCB + (size_t)MPAD * 512 * 2);
constexpr size_t W_GM = al256(W_GC + (size_t)MPAD * 512 * 2);
constexpr size_t W_KBP = al256(W_GM + (size_t)MPAD * 3072 * 2);
constexpr size_t W_VTP = al256(W_KBP + (size_t)NB_P * KP_PAD * 512 * 2);
constexpr size_t W_KIBP = al256(W_VTP + (size_t)NB_P * 512 * KP_PAD * 2);
constexpr size_t W_KBS = al256(W_KIBP + (size_t)NB_P * KP_PAD * 64 * 2);
constexpr size_t W_VTS = al256(W_KBS + (size_t)NB_S * S_S * 512 * 2);
constexpr size_t W_KIBS = al256(W_VTS + (size_t)NB_S * 512 * S_S * 2);
constexpr size_t W_MASK = al256(W_KIBS + (size_t)NB_S * S_S * 64 * 2);
constexpr size_t W_AGG = al256(W_MASK + (size_t)ROWS * MW * 4);
constexpr size_t W_KMAX = al256(W_AGG + (size_t)NB_P * NTILE_P * 512 * 2 * 4);
constexpr size_t W_END = al256(W_KMAX + 1024);

struct Params {
  const float *x_prompt, *x_sample, *cache_k, *cache_v, *cache_kidx, *state_conv, *state_lru, *state_pool, *meta,
      *norm_g, *w_in, *conv_w, *conv_b, *lru_wa, *lru_ba, *lru_wx, *lru_bx, *lru_lambda, *pool_w, *pool_scale,
      *w_branch_out, *w_out, *final_g;
  float* out;
  char* ws;
};

__shared__ __attribute__((aligned(16))) char smem[62464];
__shared__ int sh_item;
__shared__ int sh_xinfo[4];

DI bfr f2bf(float x) {
  unsigned u = __float_as_uint(x);
  u += 0x7fffu + ((u >> 16) & 1u);
  return (bfr)(u >> 16);
}
DI float bf2f(bfr b) { return __uint_as_float(((unsigned)b) << 16); }
DI unsigned pack2(float a, float b) {
  f32x2 v = {a, b};
  bf2_t r = __builtin_convertvector(v, bf2_t);
  return __builtin_bit_cast(unsigned, r);
}
DI float sigm(float x) { return 1.f / (1.f + __expf(-x)); }
DI float silu(float x) { return x / (1.f + __expf(-x)); }
DI int get_tid() {
  int t = threadIdx.x;
  asm volatile("" : "+v"(t));
  return t;
}
DI unsigned sortable(float f) {
  unsigned u = __float_as_uint(f);
  return (u & 0x80000000u) ? ~u : (u | 0x80000000u);
}
DI void decode_row(int row, int& isP, int& sq, int& t) {
  if (row < ROWS_P) { isP = 1; sq = row / T_P; t = row - sq * T_P; }
  else { isP = 0; int r = row - ROWS_P; sq = r >> 6; t = r & 63; }
}

DI void tc_tile(const float* src, long sld, bfr* dst, long dld, int k0, int n0, float* tile, int mapmode) {
  const int tid = get_tid();
#pragma unroll 4
  for (int i = 0; i < 16; ++i) {
    int kk = i * 4 + (tid >> 6), nn = tid & 63;
    int n = n0 + nn, sn = n;
    if (mapmode) sn = n < 2368 ? n : (n < 7488 ? n + 4 : (n < 7492 ? 2368 + (n - 7488) : -1));
    tile[kk * 65 + nn] = sn >= 0 ? src[(long)(k0 + kk) * sld + sn] : 0.f;
  }
  __syncthreads();
#pragma unroll 4
  for (int i = 0; i < 16; ++i) {
    int nn = i * 4 + (tid >> 6), kk = tid & 63;
    dst[(long)(n0 + nn) * dld + k0 + kk] = f2bf(tile[kk * 65 + nn]);
  }
  __syncthreads();
}

DI void convert_cache(const Params& p, int layer, char*) {
  const int tid = get_tid();
  bfr* kbs = (bfr*)(p.ws + W_KBS);
  bfr* vts = (bfr*)(p.ws + W_VTS);
  bfr* kibs = (bfr*)(p.ws + W_KIBS);
  for (int it = blockIdx.x; it < NB_S * 32 * 8; it += gridDim.x) {
    int sb = it >> 8, r = it & 255, kt = r >> 3, nt = r & 7;
    tc_tile(p.cache_v + ((long)(layer * NB_S + sb) * PAST) * 512, 512, vts + (long)sb * 512 * S_S, S_S, kt * 64, nt * 64,
            (float*)smem, 0);
  }
  {
    const float4* src = (const float4*)(p.cache_k + (long)layer * NB_S * PAST * 512);
    const long n4 = (long)NB_S * PAST * 512 / 4;
    for (long i = (long)blockIdx.x * 256 + tid; i < n4; i += (long)gridDim.x * 256) {
      float4 v = src[i];
      long e = i * 4;
      int sb = (int)(e / ((long)PAST * 512));
      long rem = e - (long)sb * PAST * 512;
      uint2 o; o.x = pack2(v.x, v.y); o.y = pack2(v.z, v.w);
      *(uint2*)(kbs + (long)sb * S_S * 512 + rem) = o;
    }
  }
  {
    const float4* src = (const float4*)(p.cache_kidx + (long)layer * NB_S * PAST * 64);
    const long n4 = (long)NB_S * PAST * 64 / 4;
    for (long i = (long)blockIdx.x * 256 + tid; i < n4; i += (long)gridDim.x * 256) {
      float4 v = src[i];
      long e = i * 4;
      int sb = (int)(e / ((long)PAST * 64));
      long rem = e - (long)sb * PAST * 64;
      uint2 o; o.x = pack2(v.x, v.y); o.y = pack2(v.z, v.w);
      *(uint2*)(kibs + (long)sb * S_S * 64 + rem) = o;
    }
  }
}

DI void norm_phase(const Params& p, int mode) {
  const int tid = get_tid(), wid = __builtin_amdgcn_readfirstlane(tid >> 6), lane = tid & 63;
  float* xres = (float*)(p.ws + W_XRES);
  bfr* hn = (bfr*)(p.ws + W_HN);
  const float* g = mode == 0 ? p.norm_g : (mode == 1 ? p.norm_g + 1024 : p.final_g);
  for (int row = blockIdx.x * 4 + wid; row < ROWS; row += gridDim.x * 4) {
    int isP, sq, t;
    decode_row(row, isP, sq, t);
    const float* src;
    if (mode == 0) {
      if (isP) src = t < NMETA ? p.meta + (long)t * 1024 : p.x_prompt + ((long)sq * SEQ_P + t - NMETA) * 1024;
      else src = p.x_sample + (long)(row - ROWS_P) * 1024;
    } else src = xres + (long)row * 1024;
    float4 v[4];
    float ss = 0.f;
#pragma unroll
    for (int i = 0; i < 4; ++i) {
      v[i] = ((const float4*)src)[lane + i * 64];
      ss += v[i].x * v[i].x + v[i].y * v[i].y + v[i].z * v[i].z + v[i].w * v[i].w;
    }
#pragma unroll
    for (int o = 32; o >= 1; o >>= 1) ss += __shfl_xor(ss, o);
    const float inv = rsqrtf(ss * (1.f / 1024.f) + 1e-6f);
    float* dsty = nullptr;
    if (mode == 2) {
      if (isP) { if (t >= NMETA) dsty = p.out + O_YP + ((long)sq * SEQ_P + t - NMETA) * 1024; }
      else dsty = p.out + O_YS + (long)(row - ROWS_P) * 1024;
    }
#pragma unroll
    for (int i = 0; i < 4; ++i) {
      float4 gg = ((const float4*)g)[lane + i * 64];
      float4 y;
      y.x = v[i].x * inv * gg.x; y.y = v[i].y * inv * gg.y; y.z = v[i].z * inv * gg.z; y.w = v[i].w * inv * gg.w;
      if (mode == 0) ((float4*)(xres + (long)row * 1024))[lane + i * 64] = v[i];
      if (mode < 2) {
        uint2 o; o.x = pack2(y.x, y.y); o.y = pack2(y.z, y.w);
        *(uint2*)(hn + (long)row * 1024 + (lane + i * 64) * 4) = o;
      } else if (dsty) ((float4*)dsty)[lane + i * 64] = y;
    }
  }
}

DI void prep_phase(const Params& p, char*) {
  const int tid = get_tid();
  for (int it = blockIdx.x; it < 2 * 118 * 16; it += gridDim.x) {
    int l = it / (118 * 16), r = it % (118 * 16), nt = r / 16, kt = r % 16;
    tc_tile(p.w_in + (long)l * 1024 * NIN, NIN, (bfr*)(p.ws + W_WINT) + (long)l * NPAD * 1024, 1024, kt * 64, nt * 64,
            (float*)smem, 1);
  }
  for (int it = blockIdx.x; it < 6 * 16 * 8; it += gridDim.x) {
    int mtx = it / 128, r = it % 128, nt = r / 8, kt = r % 8;
    tc_tile(p.w_branch_out + (long)mtx * 512 * 1024, 1024, (bfr*)(p.ws + W_WBT) + (long)mtx * 1024 * 512, 512, kt * 64,
            nt * 64, (float*)smem, 0);
  }
  for (int it = blockIdx.x; it < 2 * 16 * 16; it += gridDim.x) {
    int l = it / 256, r = it % 256, nt = r / 16, kt = r % 16;
    tc_tile(p.w_out + (long)l * 1024 * 1024, 1024, (bfr*)(p.ws + W_WOT) + (long)l * 1024 * 1024, 1024, kt * 64, nt * 64,
            (float*)smem, 0);
  }
  for (int it = blockIdx.x; it < 32; it += gridDim.x) {
    int which = it >> 4, mtx = it & 15;
    tc_tile((which ? p.lru_wx : p.lru_wa) + (long)mtx * 4096, 64, (bfr*)(p.ws + (which ? W_WXT : W_WAT)) + (long)mtx * 4096,
            64, 0, 0, (float*)smem, 0);
  }
  for (int it = blockIdx.x; it < 32; it += gridDim.x) {
    int mtx = it >> 2, r = it & 3, nt = r >> 1, kt = r & 1;
    tc_tile(p.pool_w + (long)mtx * 16384, 128, (bfr*)(p.ws + W_PWT) + (long)mtx * 16384, 128, kt * 64, nt * 64,
            (float*)smem, 0);
  }
  {
    float2* rt = (float2*)(p.ws + W_ROPE);
    for (int e = blockIdx.x * 256 + tid; e < T_P * 8; e += gridDim.x * 256) {
      int pos = e >> 3, d = e & 7;
      float inv = powf(500000.f, -(float)d * 0.125f);
      float ang = (float)pos * inv;
      rt[e] = make_float2(cosf(ang), sinf(ang));
    }
  }
  convert_cache(p, 0, smem);
  norm_phase(p, 0);
}

template <int NF>
DI void gemm128(const bfr* A, int lda, const bfr* Bt, int ldb, int K, int brow, int bcol, char*, f32x4 (&acc)[4][NF]) {
  const int tid = get_tid(), wid = __builtin_amdgcn_readfirstlane(tid >> 6), lane = tid & 63, wr = wid >> 1, wc = wid & 1, fr = lane & 15, fq = lane >> 4;
  const int b0 = tid * 16, r0 = b0 >> 6, c0 = (b0 & 63) >> 1;
  const bfr* ga0 = A + (long)(brow + r0) * lda + c0;
  const bfr* ga1 = A + (long)(brow + r0 + 64) * lda + c0;
  const bfr* gb0 = Bt + (long)(bcol + r0) * ldb + c0;
  const bfr* gb1 = Bt + (long)(bcol + r0 + 64) * ldb + c0;
  const int nk = K / 32;
  auto stage = [&](int kt, int buf) {
    char* SA = smem + buf * 16384;
    char* SB = SA + 8192;
    __builtin_amdgcn_global_load_lds((const unsigned*)(ga0 + kt * 32), (unsigned*)(SA + b0), 16, 0, 0);
    __builtin_amdgcn_global_load_lds((const unsigned*)(ga1 + kt * 32), (unsigned*)(SA + b0 + 4096), 16, 0, 0);
    __builtin_amdgcn_global_load_lds((const unsigned*)(gb0 + kt * 32), (unsigned*)(SB + b0), 16, 0, 0);
    if (NF == 4) __builtin_amdgcn_global_load_lds((const unsigned*)(gb1 + kt * 32), (unsigned*)(SB + b0 + 4096), 16, 0, 0);
  };
  asm volatile("s_waitcnt vmcnt(0)" ::: "memory");
  __syncthreads();
  stage(0, 0);
  stage(1, 1);
  const unsigned lds0 = (unsigned)(size_t)smem;
  const unsigned aoff = lds0 + (wr * 64 + fr) * 64 + fq * 16;
  const unsigned boff = lds0 + 8192 + (wc * NF * 16 + fr) * 64 + fq * 16;
  int cur = 0;
  for (int kt = 0; kt < nk; ++kt) {
    if (kt + 1 < nk) {
      if (NF == 4) asm volatile("s_waitcnt vmcnt(4)" ::: "memory");
      else asm volatile("s_waitcnt vmcnt(3)" ::: "memory");
    } else asm volatile("s_waitcnt vmcnt(0)" ::: "memory");
    __builtin_amdgcn_s_barrier();
    if (kt + 2 < nk) { int nb = cur + 2; nb = nb >= 3 ? nb - 3 : nb; stage(kt + 2, nb); }
    const unsigned bo = cur * 16384;
    cur = cur == 2 ? 0 : cur + 1;
    bf16x8 af[4], bfg[4];
    if (NF == 4) {
      asm volatile(
          "ds_read_b128 %0, %8\n\tds_read_b128 %1, %8 offset:1024\n\tds_read_b128 %2, %8 offset:2048\n\tds_read_b128 %3, %8 offset:3072\n\t"
          "ds_read_b128 %4, %9\n\tds_read_b128 %5, %9 offset:1024\n\tds_read_b128 %6, %9 offset:2048\n\tds_read_b128 %7, %9 offset:3072\n\t"
          "s_waitcnt lgkmcnt(0)"
          : "=&v"(af[0]), "=&v"(af[1]), "=&v"(af[2]), "=&v"(af[3]), "=&v"(bfg[0]), "=&v"(bfg[1]), "=&v"(bfg[2]), "=&v"(bfg[3])
          : "v"(aoff + bo), "v"(boff + bo)
          : "memory");
    } else {
      asm volatile(
          "ds_read_b128 %0, %6\n\tds_read_b128 %1, %6 offset:1024\n\tds_read_b128 %2, %6 offset:2048\n\tds_read_b128 %3, %6 offset:3072\n\t"
          "ds_read_b128 %4, %7\n\tds_read_b128 %5, %7 offset:1024\n\t"
          "s_waitcnt lgkmcnt(0)"
          : "=&v"(af[0]), "=&v"(af[1]), "=&v"(af[2]), "=&v"(af[3]), "=&v"(bfg[0]), "=&v"(bfg[1])
          : "v"(aoff + bo), "v"(boff + bo)
          : "memory");
    }
#pragma unroll
    for (int m = 0; m < 4; ++m)
#pragma unroll
      for (int n = 0; n < NF; ++n) acc[m][n] = MFMA16(af[m], bfg[n], acc[m][n]);
  }
}

template <int REG>
DI void epi_region(const Params& p, int layer, f32x4 (&acc)[4][4], int rbase0, int rel, int fr, int fq) {
  const float2* rt = (const float2*)(p.ws + W_ROPE);
  constexpr bool doRope = (REG == 0 || REG == 1 || REG == 4 || REG == 5);
#pragma unroll
  for (int m = 0; m < 4; ++m) {
    const int rbase = rbase0 + m * 16 + fq * 4;
    const bool rowsValid = rbase < ROWS;
    int isP, sq, t0;
    decode_row(rowsValid ? rbase : 0, isP, sq, t0);
    if (doRope) {
      const int pos0 = isP ? t0 : PAST + t0;
#pragma unroll
      for (int j = 0; j < 4; ++j) {
        float v = acc[m][0][j];
        float pv = __shfl_xor(v, 8);
        float2 cs = rt[(pos0 + j) * 8 + (fr & 7)];
        acc[m][0][j] = (fr < 8) ? (v * cs.x - pv * cs.y) : (v * cs.x + pv * cs.y);
      }
    }
    if (rowsValid) {
#pragma unroll
      for (int n = 0; n < 4; ++n) {
        const int col = rel + n * 16 + fr;
        if (REG == 2) {
          uint2 pk; pk.x = pack2(acc[m][n][0], acc[m][n][1]); pk.y = pack2(acc[m][n][2], acc[m][n][3]);
          if (isP) *(uint2*)((bfr*)(p.ws + W_VTP) + ((long)sq * 512 + col) * KP_PAD + t0) = pk;
          else *(uint2*)((bfr*)(p.ws + W_VTS) + ((long)sq * 512 + col) * S_S + PAST + t0) = pk;
        }
#pragma unroll
        for (int j = 0; j < 4; ++j) {
          const float v = acc[m][n][j];
          const int row = rbase + j, t = t0 + j;
          if (REG == 0) ((bfr*)(p.ws + W_QB))[(long)row * 512 + col] = f2bf(v);
          if (REG == 1) {
            if (isP) { p.out[O_KP + ((long)(layer * NB_P + sq) * T_P + t) * 512 + col] = v; ((bfr*)(p.ws + W_KBP))[((long)sq * KP_PAD + t) * 512 + col] = f2bf(v); }
            else { p.out[O_KS + ((long)(layer * NB_S + sq) * T_S + t) * 512 + col] = v; ((bfr*)(p.ws + W_KBS))[((long)sq * S_S + PAST + t) * 512 + col] = f2bf(v); }
          }
          if (REG == 2) {
            if (isP) p.out[O_VP + ((long)(layer * NB_P + sq) * T_P + t) * 512 + col] = v;
            else p.out[O_VS + ((long)(layer * NB_S + sq) * T_S + t) * 512 + col] = v;
          }
          if (REG == 3) ((bfr*)(p.ws + W_GA))[(long)row * 512 + col] = f2bf(silu(v));
          if (REG == 4) ((bfr*)(p.ws + W_QIB))[(long)row * 256 + col] = f2bf(v);
          if (REG == 5) {
            if (isP) { p.out[O_KIP + ((long)(layer * NB_P + sq) * T_P + t) * 64 + col] = v; ((bfr*)(p.ws + W_KIBP))[((long)sq * KP_PAD + t) * 64 + col] = f2bf(v); }
            else { p.out[O_KIS + ((long)(layer * NB_S + sq) * T_S + t) * 64 + col] = v; ((bfr*)(p.ws + W_KIBS))[((long)sq * S_S + PAST + t) * 64 + col] = f2bf(v); }
          }
          if (REG == 6) {
            ((bfr*)(p.ws + W_XBB))[(long)row * 512 + col] = f2bf(v);
            if (isP) { if (t >= T_P - 3) p.out[O_CONVP + ((long)(layer * NB_P + sq) * 3 + (t - (T_P - 3))) * 512 + col] = v; }
            else { if (t >= T_S - 3) p.out[O_CONVS + ((long)(layer * NB_S + sq) * 3 + (t - (T_S - 3))) * 512 + col] = v; }
          }
          if (REG == 7) ((bfr*)(p.ws + W_GB))[(long)row * 512 + col] = f2bf(silu(v));
          if (REG == 8) {
            ((bfr*)(p.ws + W_XCB))[(long)row * 512 + col] = f2bf(v);
            if (isP) { if (t >= T_P - 15) p.out[O_POOLP + ((long)(layer * NB_P + sq) * 15 + (t - (T_P - 15))) * 512 + col] = v; }
            else { if (t >= T_S - 15) p.out[O_POOLS + ((long)(layer * NB_S + sq) * 15 + (t - (T_S - 15))) * 512 + col] = v; }
          }
          if (REG == 9) ((bfr*)(p.ws + W_GC))[(long)row * 512 + col] = f2bf(silu(v));
          if (REG == 10) ((bfr*)(p.ws + W_GM))[(long)row * 3072 + col] = f2bf(sigm(v));
          if (REG == 11) { if (col < 4) ((float*)(p.ws + W_WIB))[(long)row * 4 + col] = v; }
        }
      }
    }
  }
}

DI void epi_inproj(const Params& p, int layer, f32x4 (&acc)[4][4], int brow, int bcol) {
  const int tid = get_tid(), wid = __builtin_amdgcn_readfirstlane(tid >> 6), lane = tid & 63, wr = wid >> 1, wc = wid & 1, fr = lane & 15, fq = lane >> 4;
  const int c0 = bcol + wc * 64;
  const int rb = brow + wr * 64;
  if (c0 < C_K) epi_region<0>(p, layer, acc, rb, c0 - C_Q, fr, fq);
  else if (c0 < C_V) epi_region<1>(p, layer, acc, rb, c0 - C_K, fr, fq);
  else if (c0 < C_GA) epi_region<2>(p, layer, acc, rb, c0 - C_V, fr, fq);
  else if (c0 < C_QI) epi_region<3>(p, layer, acc, rb, c0 - C_GA, fr, fq);
  else if (c0 < C_KI) epi_region<4>(p, layer, acc, rb, c0 - C_QI, fr, fq);
  else if (c0 < C_XB) epi_region<5>(p, layer, acc, rb, c0 - C_KI, fr, fq);
  else if (c0 < C_GB) epi_region<6>(p, layer, acc, rb, c0 - C_XB, fr, fq);
  else if (c0 < C_XC) epi_region<7>(p, layer, acc, rb, c0 - C_GB, fr, fq);
  else if (c0 < C_GC) epi_region<8>(p, layer, acc, rb, c0 - C_XC, fr, fq);
  else if (c0 < C_GM) epi_region<9>(p, layer, acc, rb, c0 - C_GC, fr, fq);
  else if (c0 < C_WI) epi_region<10>(p, layer, acc, rb, c0 - C_GM, fr, fq);
  else epi_region<11>(p, layer, acc, rb, c0 - C_WI, fr, fq);
}

DI void phase_inproj(const Params& p, int layer, char*) {
  const bfr* A = (const bfr*)(p.ws + W_HN);
  const bfr* Bt = (const bfr*)(p.ws + W_WINT) + (long)layer * NPAD * 1024;
  constexpr int NTM = MPAD / 128, NTN = NPAD / 128;
  const int rank = sh_xinfo[0], nloc = sh_xinfo[1], ia = sh_xinfo[2], na = sh_xinfo[3];
  const int nbase = NTN / na, nrem = NTN % na;
  const int nn = nbase + (ia < nrem ? 1 : 0), n0 = ia * nbase + min(ia, nrem);
#if PROBE == 1
#pragma unroll 1
  for (int rep = 0; rep < 2; ++rep)
#endif
  for (int i = rank; i < NTM * nn; i += nloc) {
    const int tm = i / nn, tn = n0 + (i - tm * nn);
    f32x4 acc[4][4];
#pragma unroll
    for (int m = 0; m < 4; ++m)
#pragma unroll
      for (int n = 0; n < 4; ++n) acc[m][n] = f32x4{0.f, 0.f, 0.f, 0.f};
    gemm128<4>(A, 1024, Bt, 1024, 1024, tm * 128, tn * 128, smem, acc);
    epi_inproj(p, layer, acc, tm * 128, tn * 128);
  }
}

DI void phase_merge(const Params& p, int layer, char*) {
  const int tid = get_tid(), wid = __builtin_amdgcn_readfirstlane(tid >> 6), lane = tid & 63, wr = wid >> 1, wc = wid & 1, fr = lane & 15, fq = lane >> 4;
  const bfr* gmb = (const bfr*)(p.ws + W_GM);
  bfr* merged = (bfr*)(p.ws + W_HN);
  constexpr int NTM = MPAD / 128, NTN = 16;
  for (int tile = blockIdx.x; tile < NTM * NTN; tile += gridDim.x) {
    int tn = tile / NTM, tm = tile % NTM;
    const int brow = tm * 128, bcol = tn * 64;
    f32x4 tot[4][2];
#pragma unroll
    for (int m = 0; m < 4; ++m)
#pragma unroll
      for (int n = 0; n < 2; ++n) tot[m][n] = f32x4{0.f, 0.f, 0.f, 0.f};
#pragma unroll 1
    for (int br = 0; br < 3; ++br) {
      const bfr* A = (const bfr*)(p.ws + (br == 0 ? W_GA : (br == 1 ? W_GB : W_GC)));
      const bfr* Bt = (const bfr*)(p.ws + W_WBT) + (long)(layer * 3 + br) * 1024 * 512;
      f32x4 acc[4][2];
#pragma unroll
      for (int m = 0; m < 4; ++m)
#pragma unroll
        for (int n = 0; n < 2; ++n) acc[m][n] = f32x4{0.f, 0.f, 0.f, 0.f};
      gemm128<2>(A, 512, Bt, 512, 512, brow, bcol, smem, acc);
#pragma unroll
      for (int m = 0; m < 4; ++m)
#pragma unroll
        for (int j = 0; j < 4; ++j) {
          int row = brow + wr * 64 + m * 16 + fq * 4 + j;
          if (row < ROWS) {
#pragma unroll
            for (int n = 0; n < 2; ++n) {
              int col = bcol + wc * 32 + n * 16 + fr;
              float g = bf2f(gmb[(long)row * 3072 + br * 1024 + col]);
              tot[m][n][j] += g * acc[m][n][j];
            }
          }
        }
    }
#pragma unroll
    for (int m = 0; m < 4; ++m)
#pragma unroll
      for (int j = 0; j < 4; ++j) {
        int row = brow + wr * 64 + m * 16 + fq * 4 + j;
        if (row < ROWS) {
#pragma unroll
          for (int n = 0; n < 2; ++n) merged[(long)row * 1024 + bcol + wc * 32 + n * 16 + fr] = f2bf(tot[m][n][j]);
        }
      }
  }
}

DI void phase_out(const Params& p, int layer, char*) {
  const int tid = get_tid(), wid = __builtin_amdgcn_readfirstlane(tid >> 6), lane = tid & 63, wr = wid >> 1, wc = wid & 1, fr = lane & 15, fq = lane >> 4;
  const bfr* A = (const bfr*)(p.ws + W_HN);
  const bfr* Bt = (const bfr*)(p.ws + W_WOT) + (long)layer * 1024 * 1024;
  float* xres = (float*)(p.ws + W_XRES);
  constexpr int NTM = MPAD / 128, NTN = 8;
  for (int tile = blockIdx.x; tile < NTM * NTN; tile += gridDim.x) {
    int tn = tile / NTM, tm = tile % NTM;
    const int brow = tm * 128, bcol = tn * 128;
    f32x4 acc[4][4];
#pragma unroll
    for (int m = 0; m < 4; ++m)
#pragma unroll
      for (int n = 0; n < 4; ++n) acc[m][n] = f32x4{0.f, 0.f, 0.f, 0.f};
    gemm128<4>(A, 1024, Bt, 1024, 1024, brow, bcol, smem, acc);
#pragma unroll
    for (int m = 0; m < 4; ++m)
#pragma unroll
      for (int j = 0; j < 4; ++j) {
        int row = brow + wr * 64 + m * 16 + fq * 4 + j;
        if (row < ROWS) {
#pragma unroll
          for (int n = 0; n < 4; ++n) xres[(long)row * 1024 + bcol + wc * 64 + n * 16 + fr] += acc[m][n][j];
        }
      }
  }
}

constexpr int SEL_QS = 2120;
DI void select_item(const Params& p, int isP, int sq, int c, int sub, char*) {
  const int tid = get_tid(), wid = __builtin_amdgcn_readfirstlane(tid >> 6), lane = tid & 63, fr = lane & 15, fq = lane >> 4;
  int T0, nadm, rowbase;
  const bfr* kib;
  if (isP) {
    if (c == 0) { T0 = 0; nadm = 16; } else { T0 = 16 + 64 * (c - 1) + 16 * sub; nadm = 16 + 64 * c; }
    rowbase = sq * T_P;
    kib = (const bfr*)(p.ws + W_KIBP) + (long)sq * KP_PAD * 64;
  } else {
    T0 = 16 * sub; nadm = S_S; rowbase = ROWS_P + sq * 64;
    kib = (const bfr*)(p.ws + W_KIBS) + (long)sq * S_S * 64;
  }
  unsigned* maskg = (unsigned*)(p.ws + W_MASK);
  const int nsteps = (nadm + 31) >> 5;
  if (nadm <= 256) {
    for (int e = tid; e < 16 * nsteps; e += 256) {
      int q = e / nsteps, s = e - q * nsteps;
      unsigned w = (s * 32 + 32 <= nadm) ? 0xFFFFFFFFu : 0xFFFFu;
      maskg[(long)(rowbase + T0 + q) * MW + s] = w;
    }
    return;
  }
  const int nkt = nadm >> 4;
  const int nmine = (nkt - wid + 3) >> 2;
  const int nregs = (nadm + 63) >> 6;
  const bfr* qib = (const bfr*)(p.ws + W_QIB);
  const float* wib = (const float*)(p.ws + W_WIB);
  unsigned* S = (unsigned*)smem;
#pragma unroll 1
  for (int g = 0; g < 4; ++g) {
    const int qrow = rowbase + T0 + g * 4;
    int koff = (wid * 16 + fr) * 64 + fq * 8;
    asm volatile("" : "+v"(koff));
    const bfr* kbase = kib + koff;
    int nm = nmine;
    asm volatile("" : "+v"(nm));
    nm = __builtin_amdgcn_readfirstlane(nm);
    const bfr* qp = qib + (long)(qrow + (fr >> 2)) * 256 + (fr & 3) * 64 + fq * 8;
    const bf16x8 a0 = *(const bf16x8*)qp;
    const bf16x8 a1 = *(const bf16x8*)(qp + 32);
    const float4 w = *(const float4*)(wib + (long)(qrow + fq) * 4);
    unsigned sc[65];
#pragma unroll
    for (int ch = 0; ch < 5; ++ch) {
      if (ch * 13 < nm) {
        bf16x8 b0[13], b1[13];
#pragma unroll
        for (int u = 0; u < 13; ++u) {
          const int ic = min(ch * 13 + u, nm - 1);
          const bfr* kp = kbase + (long)ic * 4096;
          b0[u] = *(const bf16x8*)kp;
          b1[u] = *(const bf16x8*)(kp + 32);
        }
#pragma unroll
        for (int u = 0; u < 13; ++u) {
          const int i = ch * 13 + u;
          f32x4 a = {0.f, 0.f, 0.f, 0.f};
          a = MFMA16(a0, b0[u], a);
          a = MFMA16(a1, b1[u], a);
          float s = w.x * fmaxf(a[0], 0.f) + w.y * fmaxf(a[1], 0.f) + w.z * fmaxf(a[2], 0.f) + w.w * fmaxf(a[3], 0.f);
          sc[i] = (i < nm) ? sortable(s) : 0u;
        }
      } else {
#pragma unroll
        for (int u = 0; u < 13; ++u) sc[ch * 13 + u] = 0u;
      }
      __builtin_amdgcn_sched_barrier(0);
    }
    unsigned v[65];
    __syncthreads();
#pragma unroll
    for (int i = 0; i < 33; ++i) S[fq * SEL_QS + (i * 4 + wid) * 16 + fr] = sc[i];
    __syncthreads();
#pragma unroll
    for (int j = 0; j < 33; ++j) v[j] = S[wid * SEL_QS + j * 64 + lane];
    if (nregs > 33) {
      __syncthreads();
#pragma unroll
      for (int i = 33; i < 65; ++i) S[fq * SEL_QS + (i * 4 + wid - 132) * 16 + fr] = sc[i];
      __syncthreads();
#pragma unroll
      for (int j = 0; j < 32; ++j) v[33 + j] = S[wid * SEL_QS + j * 64 + lane];
    } else {
#pragma unroll
      for (int j = 0; j < 32; ++j) v[33 + j] = 0u;
    }
    int nr = nregs;
    asm volatile("" : "+v"(nr));
    nr = __builtin_amdgcn_readfirstlane(nr);
    unsigned vmax = 0u;
#pragma unroll
    for (int r = 0; r < 65; ++r) vmax = max(vmax, v[r]);
#pragma unroll
    for (int o = 32; o >= 1; o >>= 1) vmax = max(vmax, (unsigned)__shfl_xor((int)vmax, o));
    vmax = __builtin_amdgcn_readfirstlane(vmax);
    unsigned thr = 0u;
    int exact = 0;
#pragma unroll 1
    for (int bit = 31; bit >= 0; --bit) {
      const unsigned cand = thr | (1u << bit);
      if (cand > vmax) continue;
      int cnt = 0;
#pragma unroll
      for (int ch = 0; ch < 5; ++ch) {
        if (ch * 13 < nr) {
#pragma unroll
          for (int u = 0; u < 13; ++u) cnt += __popcll(__ballot(v[ch * 13 + u] >= cand));
        }
      }
      if (cnt >= 256) {
        thr = cand;
        if (cnt == 256) { exact = 1; break; }
      }
    }
    if (exact) {
      unsigned mn = 0xFFFFFFFFu;
#pragma unroll
      for (int r = 0; r < 65; ++r) mn = min(mn, v[r] >= thr ? v[r] : 0xFFFFFFFFu);
#pragma unroll
      for (int o = 32; o >= 1; o >>= 1) mn = min(mn, (unsigned)__shfl_xor((int)mn, o));
      thr = __builtin_amdgcn_readfirstlane(mn);
    }
    int gt = 0, eq = 0;
#pragma unroll
    for (int r = 0; r < 65; ++r) {
      gt += __popcll(__ballot(v[r] > thr));
      eq += __popcll(__ballot(v[r] == thr));
    }
    const int need = 256 - gt;
    int idxcut = 0x7fffffff;
    if (eq != need) {
      int run = 0;
      bool done = false;
#pragma unroll
      for (int r = 0; r < 65; ++r) {
        if (!done) {
          unsigned long long m = __ballot(v[r] == thr);
          int pc = __popcll(m);
          if (run + pc >= need) {
            const int k = need - run;
            for (int t = 1; t < k; ++t) m &= m - 1ull;
            idxcut = r * 64 + (__ffsll((long long)m) - 1);
            done = true;
          } else run += pc;
        }
      }
    }
    unsigned* mrowp = maskg + (long)(qrow + wid) * MW;
#pragma unroll
    for (int r = 0; r < 65; ++r) {
      if (r < nr) {
        const bool sel = (v[r] > thr) || (v[r] == thr && (r * 64 + lane) <= idxcut);
        const unsigned long long bal = __ballot(sel);
        if (lane == 0) *(uint2*)(mrowp + r * 2) = make_uint2((unsigned)bal, (unsigned)(bal >> 32));
      }
    }
  }
}

DI void lru_tile(const Params& p, int layer, int isP, int sq, int tile, int nb, int pass, char*) {
  const int tid = get_tid(), wid = __builtin_amdgcn_readfirstlane(tid >> 6), lane = tid & 63, fr = lane & 15, fq = lane >> 4;
  float* xbs = (float*)smem;
  float* as_ = xbs;
  float* xcs = xbs + 67 * 64;
  float* bs_ = xcs + 64 * 64;
  float* ab = bs_ + 64 * 64;
  bfr* xca = (bfr*)(ab + 512);
  const int T = isP ? T_P : T_S;
  const int rowbase = isP ? sq * T_P : ROWS_P + sq * 64;
  const int t0 = tile * 64, ch0 = nb * 64;
  const bfr* xbb = (const bfr*)(p.ws + W_XBB);
  bfr* gby = (bfr*)(p.ws + W_GB);
  float* agg = (float*)(p.ws + W_AGG);
  {
    const int c = tid & 63;
    for (int rr = tid >> 6; rr < 67; rr += 4) {
      int tt = t0 - 3 + rr;
      float v = 0.f;
      if (tt < 0) { if (!isP) v = p.state_conv[((long)(layer * NB_S + sq) * 3 + (3 + tt)) * 512 + ch0 + c]; }
      else if (tt < T) v = bf2f(xbb[(long)(rowbase + tt) * 512 + ch0 + c]);
      xbs[rr * 64 + c] = v;
    }
  }
  __syncthreads();
  {
    const int c = tid & 63;
    const float cb = p.conv_b[layer * 512 + ch0 + c];
    const float w0 = p.conv_w[(layer * 4 + 0) * 512 + ch0 + c], w1 = p.conv_w[(layer * 4 + 1) * 512 + ch0 + c],
                w2 = p.conv_w[(layer * 4 + 2) * 512 + ch0 + c], w3 = p.conv_w[(layer * 4 + 3) * 512 + ch0 + c];
    for (int t = tid >> 6; t < 64; t += 4) {
      float xc = cb + w0 * xbs[t * 64 + c] + w1 * xbs[(t + 1) * 64 + c] + w2 * xbs[(t + 2) * 64 + c] + w3 * xbs[(t + 3) * 64 + c];
      xcs[t * 64 + c] = xc;
      xca[t * 72 + c] = f2bf(xc);
    }
  }
  __syncthreads();
  {
    const bfr* WaT = (const bfr*)(p.ws + W_WAT) + (long)(layer * 8 + nb) * 4096;
    const bfr* WxT = (const bfr*)(p.ws + W_WXT) + (long)(layer * 8 + nb) * 4096;
    bf16x8 af0 = *(const bf16x8*)(xca + (wid * 16 + fr) * 72 + fq * 8);
    bf16x8 af1 = *(const bf16x8*)(xca + (wid * 16 + fr) * 72 + 32 + fq * 8);
#pragma unroll
    for (int nt = 0; nt < 4; ++nt) {
      const int d = nt * 16 + fr;
      bf16x8 ba0 = *(const bf16x8*)(WaT + d * 64 + fq * 8), ba1 = *(const bf16x8*)(WaT + d * 64 + 32 + fq * 8);
      bf16x8 bx0 = *(const bf16x8*)(WxT + d * 64 + fq * 8), bx1 = *(const bf16x8*)(WxT + d * 64 + 32 + fq * 8);
      f32x4 ar = {0.f, 0.f, 0.f, 0.f}, ai = {0.f, 0.f, 0.f, 0.f};
      ar = MFMA16(af0, ba0, ar); ar = MFMA16(af1, ba1, ar);
      ai = MFMA16(af0, bx0, ai); ai = MFMA16(af1, bx1, ai);
      const float bav = p.lru_ba[layer * 512 + ch0 + d], bxv = p.lru_bx[layer * 512 + ch0 + d];
      const float sp = log1pf(__expf(-p.lru_lambda[layer * 512 + ch0 + d]));
#pragma unroll
      for (int j = 0; j < 4; ++j) {
        const int t = wid * 16 + fq * 4 + j;
        float r = sigm(ar[j] + bav), ig = sigm(ai[j] + bxv);
        float la = -8.f * r * sp;
        float a = __expf(la);
        float b = sqrtf(1.f - __expf(2.f * la)) * (ig * xcs[t * 64 + d]);
        if (t0 + t >= T) { a = 1.f; b = 0.f; }
        as_[t * 64 + d] = a;
        bs_[t * 64 + d] = b;
      }
    }
  }
  __syncthreads();
  const int c = tid & 63;
  {
    float A = 1.f, B = 0.f;
#pragma unroll
    for (int tt = 0; tt < 16; ++tt) {
      float a = as_[(wid * 16 + tt) * 64 + c], b = bs_[(wid * 16 + tt) * 64 + c];
      A *= a; B = a * B + b;
    }
    ab[(wid * 64 + c) * 2] = A;
    ab[(wid * 64 + c) * 2 + 1] = B;
  }
  __syncthreads();
  if (pass == 0) {
    if (wid == 0) {
      float A = 1.f, B = 0.f;
#pragma unroll
      for (int w = 0; w < 4; ++w) { float a = ab[(w * 64 + c) * 2], b = ab[(w * 64 + c) * 2 + 1]; A *= a; B = a * B + b; }
      *(float2*)(agg + ((long)(sq * NTILE_P + tile) * 512 + ch0 + c) * 2) = make_float2(A, B);
    }
  } else {
    float h = isP ? 0.f : p.state_lru[(long)(layer * NB_S + sq) * 512 + ch0 + c];
    for (int i = 0; i < tile; ++i) {
      float2 e = *(const float2*)(agg + ((long)(sq * NTILE_P + i) * 512 + ch0 + c) * 2);
      h = e.x * h + e.y;
    }
    for (int w = 0; w < wid; ++w) h = ab[(w * 64 + c) * 2] * h + ab[(w * 64 + c) * 2 + 1];
#pragma unroll
    for (int tt = 0; tt < 16; ++tt) {
      const int t = wid * 16 + tt;
      h = as_[t * 64 + c] * h + bs_[t * 64 + c];
      if (t0 + t < T) {
        const long idx = (long)(rowbase + t0 + t) * 512 + ch0 + c;
        gby[idx] = f2bf(h * bf2f(gby[idx]));
        if (t0 + t == T - 1) {
          if (isP) p.out[O_LRUP + (long)(layer * NB_P + sq) * 512 + ch0 + c] = h;
          else p.out[O_LRUS + (long)(layer * NB_S + sq) * 512 + ch0 + c] = h;
        }
      }
    }
  }
}

DI void pool_item(const Params& p, int layer, int isP, int sq, int tile, int g, char*) {
  const int tid = get_tid(), wid = __builtin_amdgcn_readfirstlane(tid >> 6), lane = tid & 63, fr = lane & 15, fq = lane >> 4;
  float* xps = (float*)smem;
  bfr* pa = (bfr*)(xps + 79 * 128);
  const int T = isP ? T_P : T_S;
  const int rowbase = isP ? sq * T_P : ROWS_P + sq * 64;
  const int t0 = tile * 64, ch0 = g * 128;
  const bfr* xcb = (const bfr*)(p.ws + W_XCB);
  bfr* gcy = (bfr*)(p.ws + W_GC);
  {
    const int c = tid & 127;
    for (int rr = tid >> 7; rr < 79; rr += 2) {
      int tt = t0 - 15 + rr;
      float v = 0.f;
      if (tt < 0) { if (!isP) v = p.state_pool[((long)(layer * NB_S + sq) * 15 + (15 + tt)) * 512 + ch0 + c]; }
      else if (tt < T) v = bf2f(xcb[(long)(rowbase + tt) * 512 + ch0 + c]);
      xps[rr * 128 + c] = v;
    }
  }
  __syncthreads();
  {
    const int c = tid & 127;
    const int w = 2 << g;
    const int nh = isP ? 0 : PAST;
    for (int t = tid >> 7; t < 64; t += 2) {
      float s = 0.f;
      for (int i = 0; i < w; ++i) s += xps[(15 + t - i) * 128 + c];
      int cnt = min(w, t0 + t + 1 + nh);
      float v = s / (float)cnt - xps[(15 + t) * 128 + c];
      pa[t * 136 + c] = f2bf(v);
    }
  }
  __syncthreads();
  {
    const bfr* PwT = (const bfr*)(p.ws + W_PWT) + (long)(layer * 4 + g) * 16384;
    bf16x8 af[4];
#pragma unroll
    for (int ks = 0; ks < 4; ++ks) af[ks] = *(const bf16x8*)(pa + (wid * 16 + fr) * 136 + ks * 32 + fq * 8);
#pragma unroll
    for (int nt = 0; nt < 8; ++nt) {
      const int d = nt * 16 + fr;
      f32x4 acc = {0.f, 0.f, 0.f, 0.f};
#pragma unroll
      for (int ks = 0; ks < 4; ++ks) {
        bf16x8 bq = *(const bf16x8*)(PwT + d * 128 + ks * 32 + fq * 8);
        acc = MFMA16(af[ks], bq, acc);
      }
      const float scl = p.pool_scale[layer * 512 + ch0 + d];
#pragma unroll
      for (int j = 0; j < 4; ++j) {
        const int t = wid * 16 + fq * 4 + j;
        if (t0 + t < T) {
          const long idx = (long)(rowbase + t0 + t) * 512 + ch0 + d;
          gcy[idx] = f2bf(acc[j] * scl * bf2f(gcy[idx]));
        }
      }
    }
  }
}

DI void kmax_item(const Params& p, int seq, int h, char*) {
  const int tid = get_tid(), wid = __builtin_amdgcn_readfirstlane(tid >> 6), lane = tid & 63;
  const bfr* kb; int S;
  if (seq < NB_P) { kb = (const bfr*)(p.ws + W_KBP) + (long)seq * KP_PAD * 512; S = T_P; }
  else { kb = (const bfr*)(p.ws + W_KBS) + (long)(seq - NB_P) * S_S * 512; S = S_S; }
  float mx = 0.f;
  for (int key = tid; key < S; key += 256) {
    const uint4* r = (const uint4*)(kb + (long)key * 512 + h * 64);
    float ss = 0.f;
#pragma unroll
    for (int i = 0; i < 8; ++i) {
      uint4 v = r[i];
      unsigned u[4] = {v.x, v.y, v.z, v.w};
#pragma unroll
      for (int j = 0; j < 4; ++j) {
        float a = __uint_as_float(u[j] << 16), b = __uint_as_float(u[j] & 0xFFFF0000u);
        ss += a * a + b * b;
      }
    }
    mx = fmaxf(mx, ss);
  }
#pragma unroll
  for (int o = 32; o >= 1; o >>= 1) mx = fmaxf(mx, __shfl_xor(mx, o));
  float* red = (float*)smem;
  if (lane == 0) red[wid] = mx;
  __syncthreads();
  if (tid == 0) ((float*)(p.ws + W_KMAX))[seq * 8 + h] = fmaxf(fmaxf(red[0], red[1]), fmaxf(red[2], red[3]));
}

DI void attn_unit(const Params& p, int isP, int sq, int c, int h, int half, size_t dstoff = W_GA) {
  const int lane = get_tid() & 63, fr = lane & 15, fq = lane >> 4;
  int T0, nqt, nadm, rowbase, vld;
  const bfr *kb, *vt;
  if (isP) {
    if (c == 0) { T0 = 0; nqt = 1; nadm = 16; } else { T0 = 16 + 64 * (c - 1) + 32 * half; nqt = 2; nadm = 16 + 64 * c; }
    rowbase = sq * T_P;
    kb = (const bfr*)(p.ws + W_KBP) + (long)sq * KP_PAD * 512;
    vt = (const bfr*)(p.ws + W_VTP) + (long)sq * 512 * KP_PAD;
    vld = KP_PAD;
  } else {
    T0 = 32 * half; nqt = 2; nadm = S_S; rowbase = ROWS_P + sq * 64;
    kb = (const bfr*)(p.ws + W_KBS) + (long)sq * S_S * 512;
    vt = (const bfr*)(p.ws + W_VTS) + (long)sq * 512 * S_S;
    vld = S_S;
  }
  const int nsteps = (nadm + 31) >> 5;
  const int qrow0 = rowbase + T0;
  const bfr* qb = (const bfr*)(p.ws + W_QB);
  const unsigned* maskg = (const unsigned*)(p.ws + W_MASK);
  bf16x8 qf[2][2];
#pragma unroll
  for (int qt = 0; qt < 2; ++qt)
#pragma unroll
    for (int ks = 0; ks < 2; ++ks) {
      int r = qrow0 + (qt < nqt ? qt * 16 : 0) + fr;
      qf[qt][ks] = *(const bf16x8*)(qb + (long)r * 512 + h * 64 + ks * 32 + fq * 8);
    }
  f32x4 o[2][4];
#pragma unroll
  for (int qt = 0; qt < 2; ++qt)
#pragma unroll
    for (int dt = 0; dt < 4; ++dt) o[qt][dt] = f32x4{0.f, 0.f, 0.f, 0.f};
  const float sc2 = 0.125f * 1.4426950408889634f;
  const float kmax2 = ((const float*)(p.ws + W_KMAX))[(isP ? sq : NB_P + sq) * 8 + h];
  float mref[2], lsum[2] = {0.f, 0.f};
#pragma unroll
  for (int qt = 0; qt < 2; ++qt) {
    float ss = 0.f;
#pragma unroll
    for (int ks = 0; ks < 2; ++ks)
#pragma unroll
      for (int i = 0; i < 8; ++i) { float a = bf2f((bfr)qf[qt][ks][i]); ss += a * a; }
    ss += __shfl_xor(ss, 16);
    ss += __shfl_xor(ss, 32);
    mref[qt] = sqrtf(ss * kmax2) * sc2;
  }
  const unsigned* mrow0 = maskg + (long)(qrow0 + fr) * MW;
  const unsigned* mrow1 = maskg + (long)(qrow0 + (nqt > 1 ? 16 : 0) + fr) * MW;
  const int kofs = (fr >> 2) * 8 + (fr & 3);
  const bfr* kptr = kb + (long)kofs * 512 + h * 64 + fq * 8;
  const bfr* vptr = vt + (long)(h * 64 + fr) * vld + fq * 8;
  bf16x8 ka0 = *(const bf16x8*)kptr, ka1 = *(const bf16x8*)(kptr + 32);
  bf16x8 kb0 = *(const bf16x8*)(kptr + 4 * 512), kb1 = *(const bf16x8*)(kptr + 4 * 512 + 32);
  bf16x8 vf[4];
#pragma unroll
  for (int dt = 0; dt < 4; ++dt) vf[dt] = *(const bf16x8*)(vptr + (long)dt * 16 * vld);
  unsigned mw0 = mrow0[0], mw1 = mrow1[0];
  for (int s = 0; s < nsteps; ++s) {
    const int sn = min(s + 1, nsteps - 1);
    const bfr* pa = kptr + (long)sn * 32 * 512;
    const bf16x8 nka0 = *(const bf16x8*)pa, nka1 = *(const bf16x8*)(pa + 32);
    const bf16x8 nkb0 = *(const bf16x8*)(pa + 4 * 512), nkb1 = *(const bf16x8*)(pa + 4 * 512 + 32);
    bf16x8 nvf[4];
#pragma unroll
    for (int dt = 0; dt < 4; ++dt) nvf[dt] = *(const bf16x8*)(vptr + (long)dt * 16 * vld + sn * 32);
    const unsigned nmw0 = mrow0[sn], nmw1 = mrow1[sn];
#pragma unroll
    for (int qt = 0; qt < 2; ++qt) {
      if (qt < nqt) {
        f32x4 sa = {0.f, 0.f, 0.f, 0.f}, sb = {0.f, 0.f, 0.f, 0.f};
        sa = MFMA16(ka0, qf[qt][0], sa); sa = MFMA16(ka1, qf[qt][1], sa);
        sb = MFMA16(kb0, qf[qt][0], sb); sb = MFMA16(kb1, qf[qt][1], sb);
        const unsigned mb = ((qt == 0 ? mw0 : mw1) >> (fq * 8)) & 0xFFu;
        float pr[8];
#pragma unroll
        for (int i = 0; i < 4; ++i) {
          float pa_ = __builtin_amdgcn_exp2f(sa[i] * sc2 - mref[qt]);
          float pb_ = __builtin_amdgcn_exp2f(sb[i] * sc2 - mref[qt]);
          pr[i] = ((mb >> i) & 1u) ? pa_ : 0.f;
          pr[4 + i] = ((mb >> (4 + i)) & 1u) ? pb_ : 0.f;
        }
        lsum[qt] += ((pr[0] + pr[1]) + (pr[2] + pr[3])) + ((pr[4] + pr[5]) + (pr[6] + pr[7]));
        union { unsigned u[4]; bf16x8 v; } pk;
        pk.u[0] = pack2(pr[0], pr[1]); pk.u[1] = pack2(pr[2], pr[3]); pk.u[2] = pack2(pr[4], pr[5]); pk.u[3] = pack2(pr[6], pr[7]);
#pragma unroll
        for (int dt = 0; dt < 4; ++dt) o[qt][dt] = MFMA16(vf[dt], pk.v, o[qt][dt]);
      }
    }
    ka0 = nka0; ka1 = nka1; kb0 = nkb0; kb1 = nkb1;
#pragma unroll
    for (int dt = 0; dt < 4; ++dt) vf[dt] = nvf[dt];
    mw0 = nmw0; mw1 = nmw1;
  }
  bfr* gay = (bfr*)(p.ws + W_GA);
  bfr* dsty = (bfr*)(p.ws + dstoff);
#pragma unroll
  for (int qt = 0; qt < 2; ++qt) {
    if (qt < nqt) {
      float l = lsum[qt];
      l += __shfl_xor(l, 16);
      l += __shfl_xor(l, 32);
      const float inv = l > 0.f ? 1.f / l : 0.f;
      const long rowoff = (long)(qrow0 + qt * 16 + fr) * 512 + h * 64;
#pragma unroll
      for (int dt = 0; dt < 4; ++dt) {
        uint2* ptr = (uint2*)(gay + rowoff + dt * 16 + fq * 4);
        uint2 gv = *ptr;
        float g0 = __uint_as_float(gv.x << 16), g1 = __uint_as_float(gv.x & 0xFFFF0000u);
        float g2 = __uint_as_float(gv.y << 16), g3 = __uint_as_float(gv.y & 0xFFFF0000u);
        uint2 ov;
        ov.x = pack2(o[qt][dt][0] * inv * g0, o[qt][dt][1] * inv * g1);
        ov.y = pack2(o[qt][dt][2] * inv * g2, o[qt][dt][3] * inv * g3);
        *(uint2*)(dsty + rowoff + dt * 16 + fq * 4) = ov;
      }
    }
  }
}

#define XB_TMO      128
#define XB_XCNT(j)  (256  + 64 * (j))
#define XB_XSUB(j)  (1280 + 64 * (j))
#define XB_XGEN(j)  (2304 + 64 * (j))
#define XB_TOP      3328
#define XB_TOPGEN   3392
#define XCD_BAR_WORDS 3456
#define XB_SPIN_CAP (1u << 18)
#define LAS __attribute__((address_space(3)))

__device__ __forceinline__ unsigned xb_ld(unsigned* p)              { return __hip_atomic_load(p, __ATOMIC_RELAXED, __HIP_MEMORY_SCOPE_AGENT); }
__device__ __forceinline__ unsigned xb_add(unsigned* p, unsigned v) { return __hip_atomic_fetch_add(p, v, __ATOMIC_RELAXED, __HIP_MEMORY_SCOPE_AGENT); }
__device__ __forceinline__ unsigned xb_xcc_id() { return (unsigned)__builtin_amdgcn_s_getreg((3 << 11) | 20) & 0xFu; }
#define XB_SPIN(cond, bar) do { unsigned _sp = 0; while (cond) { __builtin_amdgcn_s_sleep(1); \
    if ((++_sp & 255u) == 0u) { if (xb_ld(&(bar)[XB_TMO])) break; if (_sp > XB_SPIN_CAP) { atomicAdd(&(bar)[XB_TMO], 1u); break; } } } } while (0)

struct XcdBarrier {
    unsigned* bar; unsigned x;
    volatile LAS unsigned* st;
};

__device__ __forceinline__ XcdBarrier xcd_barrier_post(unsigned* bar, volatile LAS unsigned* st) {
    XcdBarrier b; b.bar = bar; b.x = xb_xcc_id(); b.st = st;
    if (threadIdx.x == 0) (void)xb_add(&bar[XB_XCNT(b.x)], 1u);
    return b;
}
__device__ __forceinline__ void xcd_barrier_complete(unsigned* bar, unsigned x, unsigned& nloc, unsigned& nx) {
    const unsigned G = gridDim.x * gridDim.y * gridDim.z;
    unsigned sum, cnt, mine, sp = 0u;
    for (;;) {
        sum = 0u; cnt = 0u; mine = 0u;
#pragma unroll
        for (unsigned j = 0; j < 16; ++j) { const unsigned c = xb_ld(&bar[XB_XCNT(j)]); sum += c; cnt += (c > 0u) ? 1u : 0u; mine = (j == x) ? c : mine; }
        if (sum == G) break;
        __builtin_amdgcn_s_sleep(1);
        if ((++sp & 255u) == 0u) { if (xb_ld(&bar[XB_TMO])) break; if (sp > XB_SPIN_CAP) { atomicAdd(&bar[XB_TMO], 1u); break; } }
    }
    nloc = mine > 0u ? mine : 1u; nx = cnt > 0u ? cnt : 1u;
}

__device__ __forceinline__ void xcd_barrier(const XcdBarrier& b) {
    asm volatile("s_waitcnt vmcnt(0)" ::: "memory");
    __syncthreads();
    if (threadIdx.x == 0) {
        unsigned* bar = b.bar;
        __builtin_amdgcn_s_waitcnt(0);
        unsigned nloc = b.st[0], nx = b.st[1];
        if (nloc == 0u) { xcd_barrier_complete(bar, b.x, nloc, nx); b.st[0] = nloc; b.st[1] = nx; }
        const unsigned old = xb_add(&bar[XB_XSUB(b.x)], 1u);
        const unsigned gen = old / nloc;
        if (old + 1u == (gen + 1u) * nloc) {
            __builtin_amdgcn_fence(__ATOMIC_RELEASE, "agent");
            asm volatile("s_waitcnt vmcnt(0)" ::: "memory");
            const unsigned og = xb_add(&bar[XB_TOP], 1u);
            const unsigned tg = og / nx;
            if (og + 1u == (tg + 1u) * nx) xb_add(&bar[XB_TOPGEN], 1u);
            else XB_SPIN(xb_ld(&bar[XB_TOPGEN]) == tg, bar);
            __builtin_amdgcn_fence(__ATOMIC_ACQUIRE, "agent");
            xb_add(&bar[XB_XGEN(b.x)], 1u);
            asm volatile("s_waitcnt vmcnt(0)" ::: "memory");
        } else {
            XB_SPIN(xb_ld(&bar[XB_XGEN(b.x)]) == gen, bar);
            __builtin_amdgcn_fence(__ATOMIC_ACQUIRE, "agent");
            asm volatile("s_waitcnt vmcnt(0)" ::: "memory");
        }
    }
    __syncthreads();
}


DI int pop_block(int* ctr, int*) {
  __syncthreads();
  if (threadIdx.x == 0) sh_item = atomicAdd(ctr, 1);
  __syncthreads();
  return __builtin_amdgcn_readfirstlane(sh_item);
}

constexpr int N_KMAX = 20 * 8;
constexpr int N_SEL = 64 * 16 + 64 + 4;
constexpr int N_LRU1 = NB_P * NTILE_P * 8;
constexpr int N_POOL = NB_P * NTILE_P * 4 + NB_S * 4;
constexpr int N_LRU2 = NB_P * NTILE_P * 8 + NB_S * 8;
constexpr int N_ATT = 64 * 64 + 256 + 32;

DI void phase_b1(const Params& p, int layer, char*, int*) {
  int* ctr = (int*)(p.ws + W_CTR) + layer * 4 + 0;
  for (;;) {
    int it = pop_block(ctr, nullptr);
    if (it >= N_SEL + N_LRU1 + N_POOL + N_KMAX) break;
    if (it >= N_SEL + N_LRU1 + N_POOL) { int j = it - (N_SEL + N_LRU1 + N_POOL); kmax_item(p, j >> 3, j & 7, smem); }
    else if (it < N_SEL) {
      if (it < 1024) { int c = 64 - (it >> 4), b = (it & 15) >> 2, sub = it & 3; select_item(p, 1, b, c, sub, smem); }
      else if (it < 1088) { int j = it - 1024; select_item(p, 0, j >> 2, 0, j & 3, smem); }
      else select_item(p, 1, it - 1088, 0, 0, smem);
    } else if (it < N_SEL + N_LRU1) {
      int j = it - N_SEL;
      int sq = j / (NTILE_P * 8), rem = j % (NTILE_P * 8);
      lru_tile(p, layer, 1, sq, rem >> 3, rem & 7, 0, smem);
    } else {
      int j = it - N_SEL - N_LRU1;
      if (j < NB_P * NTILE_P * 4) { int sq = j / (NTILE_P * 4), rem = j % (NTILE_P * 4); pool_item(p, layer, 1, sq, rem >> 2, rem & 3, smem); }
      else { j -= NB_P * NTILE_P * 4; pool_item(p, layer, 0, j >> 2, 0, j & 3, smem); }
    }
  }
}

constexpr size_t W_DUMMY = W_END;
DI void probe_select(const Params& p, int layer) {
  int* ctr = (int*)(p.ws + W_CTR) + layer * 4 + 3;
  for (;;) {
    int it = pop_block(ctr, nullptr);
    if (it >= N_SEL) break;
    if (it < 1024) { int c = 64 - (it >> 4), b = (it & 15) >> 2, sub = it & 3; select_item(p, 1, b, c, sub, smem); }
    else if (it < 1088) { int j = it - 1024; select_item(p, 0, j >> 2, 0, j & 3, smem); }
    else select_item(p, 1, it - 1088, 0, 0, smem);
  }
}
DI void probe_attn(const Params& p, int layer) {
  int* ctr2 = (int*)(p.ws + W_CTR) + layer * 4 + 3;
  const int lane = get_tid() & 63;
  for (;;) {
    int u = 0;
    if (lane == 0) u = atomicAdd(ctr2, 1);
    u = __builtin_amdgcn_readfirstlane(u);
    if (u >= N_ATT) break;
    if (u < 4096) { int c = 64 - (u >> 6), r = u & 63; attn_unit(p, 1, r >> 4, c, (r >> 1) & 7, r & 1, W_DUMMY); }
    else if (u < 4096 + 256) { int r = u - 4096; attn_unit(p, 0, r >> 4, 0, (r >> 1) & 7, r & 1, W_DUMMY); }
    else { int r = u - 4352; attn_unit(p, 1, r >> 3, 0, r & 7, 0, W_DUMMY); }
  }
}

DI void phase_b2(const Params& p, int layer, char*, int*) {
  int* ctr = (int*)(p.ws + W_CTR) + layer * 4 + 1;
  for (;;) {
    int it = pop_block(ctr, nullptr);
    if (it >= N_LRU2) break;
    if (it < NB_P * NTILE_P * 8) { int sq = it / (NTILE_P * 8), rem = it % (NTILE_P * 8); lru_tile(p, layer, 1, sq, rem >> 3, rem & 7, 1, smem); }
    else { int j = it - NB_P * NTILE_P * 8; lru_tile(p, layer, 0, j >> 3, 0, j & 7, 1, smem); }
  }
  int* ctr2 = (int*)(p.ws + W_CTR) + layer * 4 + 2;
  const int lane = get_tid() & 63;
  for (;;) {
    int u = 0;
    if (lane == 0) u = atomicAdd(ctr2, 1);
    u = __builtin_amdgcn_readfirstlane(u);
    if (u >= N_ATT) break;
    if (u < 4096) { int c = 64 - (u >> 6), r = u & 63; attn_unit(p, 1, r >> 4, c, (r >> 1) & 7, r & 1); }
    else if (u < 4096 + 256) { int r = u - 4096; attn_unit(p, 0, r >> 4, 0, (r >> 1) & 7, r & 1); }
    else { int r = u - 4352; attn_unit(p, 1, r >> 3, 0, r & 7, 0); }
  }
}

DI Params fresh(const Params& p) {
  Params q = p;
  int z = 0;
  asm volatile("s_mov_b32 %0, 0" : "=s"(z));
  q.ws = p.ws + z;
  q.out = p.out + z;
  return q;
}
DI int fresh_i(int v) {
  asm volatile("" : "+s"(v));
  return v;
}

__shared__ uint4 xb_words;

__global__ void __launch_bounds__(256, 2) fwd_megakernel(Params p) {
  cg::grid_group grid = cg::this_grid();
  if (threadIdx.x == 0) xb_words = make_uint4(0u, 0u, 0u, 0u);
  __syncthreads();
  XcdBarrier xb = xcd_barrier_post((unsigned*)(p.ws + W_BAR), (volatile LAS unsigned*)&xb_words);
  if (threadIdx.x == 0) sh_xinfo[0] = (int)atomicAdd((unsigned*)(p.ws + W_CTR) + 128 + xb.x, 1u);
  prep_phase(fresh(p), smem);
  grid.sync();
  if (threadIdx.x == 0) {
    unsigned* bar = (unsigned*)(p.ws + W_BAR);
    int na = 0, ia = 0, nloc = 1;
    for (unsigned j = 0; j < 16; ++j) {
      const unsigned cj = xb_ld(&bar[XB_XCNT(j)]);
      if (cj > 0u) { if (j < xb.x) ++ia; ++na; }
      if (j == xb.x) nloc = (int)cj;
    }
    sh_xinfo[1] = nloc > 0 ? nloc : 1; sh_xinfo[2] = ia; sh_xinfo[3] = na > 0 ? na : 1;
  }
  __syncthreads();
#if PROBE == 6
#pragma unroll 1
  for (int i = 0; i < 10; ++i) xcd_barrier(xb);
#endif
#pragma unroll 1
  for (int layer = 0; layer < 2; ++layer) {
    phase_inproj(fresh(p), fresh_i(layer), smem);
    xcd_barrier(xb);
#if PROBE == 2
    probe_select(fresh(p), fresh_i(layer));
    xcd_barrier(xb);
#endif
    phase_b1(fresh(p), fresh_i(layer), smem, &sh_item);
    xcd_barrier(xb);
#if PROBE == 3
    probe_attn(fresh(p), fresh_i(layer));
    xcd_barrier(xb);
#endif
    phase_b2(fresh(p), fresh_i(layer), smem, &sh_item);
    xcd_barrier(xb);
    phase_merge(fresh(p), fresh_i(layer), smem);
    xcd_barrier(xb);
#if PROBE == 4
    phase_merge(fresh(p), fresh_i(layer), smem);
    xcd_barrier(xb);
#endif
    phase_out(fresh(p), fresh_i(layer), smem);
    xcd_barrier(xb);
    if (layer == 0) { convert_cache(fresh(p), 1, smem); norm_phase(fresh(p), 1); xcd_barrier(xb); }
    else norm_phase(fresh(p), 2);
  }
}

extern "C" void kernel_launch(void* const* d_in, const int* in_sizes, int n_in, void* d_out, int out_size, void* d_ws,
                              size_t ws_size, hipStream_t stream) {
  static int grid_blocks = 0;
  if (!grid_blocks) {
    int dev = 0, cus = 0, per_cu = 0;
    hipGetDevice(&dev);
    hipDeviceGetAttribute(&cus, hipDeviceAttributeMultiprocessorCount, dev);
    hipOccupancyMaxActiveBlocksPerMultiprocessor(&per_cu, fwd_megakernel, 256, 0);
    if (per_cu > 2) per_cu = 2;
    if (per_cu < 1) per_cu = 1;
    grid_blocks = cus * per_cu;
  }
  if (ws_size < W_END) { fprintf(stderr, "workspace too small: %zu < %zu\n", ws_size, (size_t)W_END); return; }
  Params p{};
  const float** f = (const float**)&p;
  for (int i = 0; i < 23; ++i) f[i] = (const float*)d_in[i];
  p.out = (float*)d_out;
  p.ws = (char*)d_ws;
  hipMemsetAsync(d_ws, 0, 32768, stream);
  void* args[] = {&p};
  hipError_t e = hipLaunchCooperativeKernel((void*)fwd_megakernel, dim3(grid_blocks), dim3(256), args, 0, stream);
  if (e != hipSuccess) fprintf(stderr, "cooperative launch failed: %s (grid %d)\n", hipGetErrorString(e), grid_blocks);
}
```

```cpp
#include <hip/hip_runtime.h>
#include <hip/hip_cooperative_groups.h>
#include <stdint.h>
#include <cstdio>
namespace cg = cooperative_groups;
#ifndef PROBE
#define PROBE 0
#endif

typedef unsigned short bfr;
typedef __attribute__((ext_vector_type(8))) short bf16x8;
typedef __attribute__((ext_vector_type(4))) float f32x4;
typedef __attribute__((ext_vector_type(2))) float f32x2;
typedef __attribute__((ext_vector_type(2))) __bf16 bf2_t;
#define DI __device__ __forceinline__
#define MFMA16(a, b, c) __builtin_amdgcn_mfma_f32_16x16x32_bf16((a), (b), (c), 0, 0, 0)

constexpr int DM = 1024;
constexpr int NB_P = 4, T_P = 4112, SEQ_P = 4096, NMETA = 16;
constexpr int NB_S = 16, T_S = 64, PAST = 2048, S_S = 2112;
constexpr int ROWS_P = NB_P * T_P;
constexpr int ROWS = ROWS_P + NB_S * T_S;
constexpr int MPAD = 17536;
constexpr int NIN = 7492, NPAD = 7552;
constexpr int KP_PAD = 4128;
constexpr int MW = 132;
constexpr int NTILE_P = 65;

constexpr int C_Q = 0, C_K = 512, C_V = 1024, C_GA = 1536, C_QI = 2048, C_KI = 2304, C_XB = 2368, C_GB = 2880,
              C_XC = 3392, C_GC = 3904, C_GM = 4416, C_WI = 7488;

constexpr long O_YP = 0;
constexpr long O_YS = O_YP + (long)NB_P * SEQ_P * DM;
constexpr long O_KP = O_YS + (long)NB_S * T_S * DM;
constexpr long O_VP = O_KP + 2L * NB_P * T_P * 512;
constexpr long O_KIP = O_VP + 2L * NB_P * T_P * 512;
constexpr long O_CONVP = O_KIP + 2L * NB_P * T_P * 64;
constexpr long O_LRUP = O_CONVP + 2L * NB_P * 3 * 512;
constexpr long O_POOLP = O_LRUP + 2L * NB_P * 512;
constexpr long O_KS = O_POOLP + 2L * NB_P * 15 * 512;
constexpr long O_VS = O_KS + 2L * NB_S * T_S * 512;
constexpr long O_KIS = O_VS + 2L * NB_S * T_S * 512;
constexpr long O_CONVS = O_KIS + 2L * NB_S * T_S * 64;
constexpr long O_LRUS = O_CONVS + 2L * NB_S * 3 * 512;
constexpr long O_POOLS = O_LRUS + 2L * NB_S * 512;

constexpr size_t al256(size_t x) { return (x + 255) & ~(size_t)255; }
constexpr size_t W_CTR = 0;
constexpr size_t W_BAR = 4096;
constexpr size_t W_ROPE = 32768;
constexpr size_t W_WINT = al256(W_ROPE + (size_t)T_P * 8 * 8);
constexpr size_t W_WBT = al256(W_WINT + 2ull * NPAD * 1024 * 2);
constexpr size_t W_WOT = al256(W_WBT + 2ull * 3 * 1024 * 512 * 2);
constexpr size_t W_WAT = al256(W_WOT + 2ull * 1024 * 1024 * 2);
constexpr size_t W_WXT = al256(W_WAT + 2ull * 8 * 64 * 64 * 2);
constexpr size_t W_PWT = al256(W_WXT + 2ull * 8 * 64 * 64 * 2);
constexpr size_t W_XRES = al256(W_PWT + 2ull * 4 * 128 * 128 * 2);
constexpr size_t W_HN = al256(W_XRES + (size_t)MPAD * 1024 * 4);
constexpr size_t W_QB = al256(W_HN + (size_t)MPAD * 1024 * 2);
constexpr size_t W_GA = al256(W_QB + (size_t)MPAD * 512 * 2);
constexpr size_t W_QIB = al256(W_GA + (size_t)MPAD * 512 * 2);
constexpr size_t W_WIB = al256(W_QIB + (size_t)MPAD * 256 * 2);
constexpr size_t W_XBB = al256(W_WIB + (size_t)MPAD * 4 * 4);
constexpr size_t W_GB = al256(W_XBB + (size_t)MPAD * 512 * 2);
constexpr size_t W_XCB = al256(W_GB + (size_t)MPAD * 512 * 2);
constexpr size_t W_GC = al256(W_XCB + (size_t)MPAD * 512 * 2);
constexpr size_t W_GM = al256(W_GC + (size_t)MPAD * 512 * 2);
constexpr size_t W_KBP = al256(W_GM + (size_t)MPAD * 3072 * 2);
constexpr size_t W_VTP = al256(W_KBP + (size_t)NB_P * KP_PAD * 512 * 2);
constexpr size_t W_KIBP = al256(W_VTP + (size_t)NB_P * 512 * KP_PAD * 2);
constexpr size_t W_KBS = al256(W_KIBP + (size_t)NB_P * KP_PAD * 64 * 2);
constexpr size_t W_VTS = al256(W_KBS + (size_t)NB_S * S_S * 512 * 2);
constexpr size_t W_KIBS = al256(W_VTS + (size_t)NB_S * 512 * S_S * 2);
constexpr size_t W_MASK = al256(W_KIBS + (size_t)NB_S * S_S * 64 * 2);
constexpr size_t W_AGG = al256(W_MASK + (size_t)ROWS * MW * 4);
constexpr size_t W_KMAX = al256(W_AGG + (size_t)NB_P * NTILE_P * 512 * 2 * 4);
constexpr size_t W_END = al256(W_KMAX + 1024);

struct Params {
  const float *x_prompt, *x_sample, *cache_k, *cache_v, *cache_kidx, *state_conv, *state_lru, *state_pool, *meta,
      *norm_g, *w_in, *conv_w, *conv_b, *lru_wa, *lru_ba, *lru_wx, *lru_bx, *lru_lambda, *pool_w, *pool_scale,
      *w_branch_out, *w_out, *final_g;
  float* out;
  char* ws;
};

extern __shared__ __attribute__((aligned(128))) char smem[];
__shared__ int sh_item;
__shared__ int sh_xinfo[4];

DI bfr f2bf(float x) {
  unsigned u = __float_as_uint(x);
  u += 0x7fffu + ((u >> 16) & 1u);
  return (bfr)(u >> 16);
}
DI float bf2f(bfr b) { return __uint_as_float(((unsigned)b) << 16); }
DI unsigned pack2(float a, float b) {
  f32x2 v = {a, b};
  bf2_t r = __builtin_convertvector(v, bf2_t);
  return __builtin_bit_cast(unsigned, r);
}
DI float sigm(float x) { return 1.f / (1.f + __expf(-x)); }
DI float silu(float x) { return x / (1.f + __expf(-x)); }
DI int get_tid() {
  int t = threadIdx.x;
  asm volatile("" : "+v"(t));
  return t;
}
DI unsigned sortable(float f) {
  unsigned u = __float_as_uint(f);
  return (u & 0x80000000u) ? ~u : (u | 0x80000000u);
}
DI void decode_row(int row, int& isP, int& sq, int& t) {
  if (row < ROWS_P) { isP = 1; sq = row / T_P; t = row - sq * T_P; }
  else { isP = 0; int r = row - ROWS_P; sq = r >> 6; t = r & 63; }
}

DI void tc_tile(const float* src, long sld, bfr* dst, long dld, int k0, int n0, float* tile, int mapmode) {
  const int tid = get_tid();
#pragma unroll 4
  for (int i = 0; i < 16; ++i) {
    int kk = i * 4 + (tid >> 6), nn = tid & 63;
    int n = n0 + nn, sn = n;
    if (mapmode) sn = n < 2368 ? n : (n < 7488 ? n + 4 : (n < 7492 ? 2368 + (n - 7488) : -1));
    tile[kk * 65 + nn] = sn >= 0 ? src[(long)(k0 + kk) * sld + sn] : 0.f;
  }
  __syncthreads();
#pragma unroll 4
  for (int i = 0; i < 16; ++i) {
    int nn = i * 4 + (tid >> 6), kk = tid & 63;
    dst[(long)(n0 + nn) * dld + k0 + kk] = f2bf(tile[kk * 65 + nn]);
  }
  __syncthreads();
}

DI void convert_cache(const Params& p, int layer, char*) {
  const int tid = get_tid();
  bfr* kbs = (bfr*)(p.ws + W_KBS);
  bfr* vts = (bfr*)(p.ws + W_VTS);
  bfr* kibs = (bfr*)(p.ws + W_KIBS);
  for (int it = blockIdx.x; it < NB_S * 32 * 8; it += gridDim.x) {
    int sb = it >> 8, r = it & 255, kt = r >> 3, nt = r & 7;
    tc_tile(p.cache_v + ((long)(layer * NB_S + sb) * PAST) * 512, 512, vts + (long)sb * 512 * S_S, S_S, kt * 64, nt * 64,
            (float*)smem, 0);
  }
  {
    const float4* src = (const float4*)(p.cache_k + (long)layer * NB_S * PAST * 512);
    const long n4 = (long)NB_S * PAST * 512 / 4;
    for (long i = (long)blockIdx.x * 256 + tid; i < n4; i += (long)gridDim.x * 256) {
      float4 v = src[i];
      long e = i * 4;
      int sb = (int)(e / ((long)PAST * 512));
      long rem = e - (long)sb * PAST * 512;
      uint2 o; o.x = pack2(v.x, v.y); o.y = pack2(v.z, v.w);
      *(uint2*)(kbs + (long)sb * S_S * 512 + rem) = o;
    }
  }
  {
    const float4* src = (const float4*)(p.cache_kidx + (long)layer * NB_S * PAST * 64);
    const long n4 = (long)NB_S * PAST * 64 / 4;
    for (long i = (long)blockIdx.x * 256 + tid; i < n4; i += (long)gridDim.x * 256) {
      float4 v = src[i];
      long e = i * 4;
      int sb = (int)(e / ((long)PAST * 64));
      long rem = e - (long)sb * PAST * 64;
      uint2 o; o.x = pack2(v.x, v.y); o.y = pack2(v.z, v.w);
      *(uint2*)(kibs + (long)sb * S_S * 64 + rem) = o;
    }
  }
}

DI void norm_phase(const Params& p, int mode) {
  const int tid = get_tid(), wid = __builtin_amdgcn_readfirstlane(tid >> 6), lane = tid & 63;
  float* xres = (float*)(p.ws + W_XRES);
  bfr* hn = (bfr*)(p.ws + W_HN);
  const float* g = mode == 0 ? p.norm_g : (mode == 1 ? p.norm_g + 1024 : p.final_g);
  for (int row = blockIdx.x * 4 + wid; row < ROWS; row += gridDim.x * 4) {
    int isP, sq, t;
    decode_row(row, isP, sq, t);
    const float* src;
    if (mode == 0) {
      if (isP) src = t < NMETA ? p.meta + (long)t * 1024 : p.x_prompt + ((long)sq * SEQ_P + t - NMETA) * 1024;
      else src = p.x_sample + (long)(row - ROWS_P) * 1024;
    } else src = xres + (long)row * 1024;
    float4 v[4];
    float ss = 0.f;
#pragma unroll
    for (int i = 0; i < 4; ++i) {
      v[i] = ((const float4*)src)[lane + i * 64];
      ss += v[i].x * v[i].x + v[i].y * v[i].y + v[i].z * v[i].z + v[i].w * v[i].w;
    }
#pragma unroll
    for (int o = 32; o >= 1; o >>= 1) ss += __shfl_xor(ss, o);
    const float inv = rsqrtf(ss * (1.f / 1024.f) + 1e-6f);
    float* dsty = nullptr;
    if (mode == 2) {
      if (isP) { if (t >= NMETA) dsty = p.out + O_YP + ((long)sq * SEQ_P + t - NMETA) * 1024; }
      else dsty = p.out + O_YS + (long)(row - ROWS_P) * 1024;
    }
#pragma unroll
    for (int i = 0; i < 4; ++i) {
      float4 gg = ((const float4*)g)[lane + i * 64];
      float4 y;
      y.x = v[i].x * inv * gg.x; y.y = v[i].y * inv * gg.y; y.z = v[i].z * inv * gg.z; y.w = v[i].w * inv * gg.w;
      if (mode == 0) ((float4*)(xres + (long)row * 1024))[lane + i * 64] = v[i];
      if (mode < 2) {
        uint2 o; o.x = pack2(y.x, y.y); o.y = pack2(y.z, y.w);
        *(uint2*)(hn + (long)row * 1024 + (lane + i * 64) * 4) = o;
      } else if (dsty) ((float4*)dsty)[lane + i * 64] = y;
    }
  }
}

DI void prep_phase(const Params& p, char*) {
  const int tid = get_tid();
  for (int it = blockIdx.x; it < 2 * 118 * 16; it += gridDim.x) {
    int l = it / (118 * 16), r = it % (118 * 16), nt = r / 16, kt = r % 16;
    tc_tile(p.w_in + (long)l * 1024 * NIN, NIN, (bfr*)(p.ws + W_WINT) + (long)l * NPAD * 1024, 1024, kt * 64, nt * 64,
            (float*)smem, 1);
  }
  for (int it = blockIdx.x; it < 6 * 16 * 8; it += gridDim.x) {
    int mtx = it / 128, r = it % 128, nt = r / 8, kt = r % 8;
    tc_tile(p.w_branch_out + (long)mtx * 512 * 1024, 1024, (bfr*)(p.ws + W_WBT) + (long)mtx * 1024 * 512, 512, kt * 64,
            nt * 64, (float*)smem, 0);
  }
  for (int it = blockIdx.x; it < 2 * 16 * 16; it += gridDim.x) {
    int l = it / 256, r = it % 256, nt = r / 16, kt = r % 16;
    tc_tile(p.w_out + (long)l * 1024 * 1024, 1024, (bfr*)(p.ws + W_WOT) + (long)l * 1024 * 1024, 1024, kt * 64, nt * 64,
            (float*)smem, 0);
  }
  for (int it = blockIdx.x; it < 32; it += gridDim.x) {
    int which = it >> 4, mtx = it & 15;
    tc_tile((which ? p.lru_wx : p.lru_wa) + (long)mtx * 4096, 64, (bfr*)(p.ws + (which ? W_WXT : W_WAT)) + (long)mtx * 4096,
            64, 0, 0, (float*)smem, 0);
  }
  for (int it = blockIdx.x; it < 32; it += gridDim.x) {
    int mtx = it >> 2, r = it & 3, nt = r >> 1, kt = r & 1;
    tc_tile(p.pool_w + (long)mtx * 16384, 128, (bfr*)(p.ws + W_PWT) + (long)mtx * 16384, 128, kt * 64, nt * 64,
            (float*)smem, 0);
  }
  {
    float2* rt = (float2*)(p.ws + W_ROPE);
    for (int e = blockIdx.x * 256 + tid; e < T_P * 8; e += gridDim.x * 256) {
      int pos = e >> 3, d = e & 7;
      float inv = powf(500000.f, -(float)d * 0.125f);
      float ang = (float)pos * inv;
      rt[e] = make_float2(cosf(ang), sinf(ang));
    }
  }
  convert_cache(p, 0, smem);
  norm_phase(p, 0);
}

template <int NF>
DI void gemm128(const bfr* A, int lda, const bfr* Bt, int ldb, int K, int brow, int bcol, char*, f32x4 (&acc)[4][NF]) {
  const int tid = get_tid(), wid = __builtin_amdgcn_readfirstlane(tid >> 6), lane = tid & 63, wr = wid >> 1, wc = wid & 1, fr = lane & 15, fq = lane >> 4;
  const int r0 = tid >> 3;
  const int cg = ((tid & 7) ^ (r0 & 7)) * 8;
  const bfr* ga = A + (long)(brow + r0) * lda + cg;
  const bfr* gb = Bt + (long)(bcol + r0) * ldb + cg;
  const long a32 = (long)32 * lda, b32 = (long)32 * ldb;
  const int nk = K / 64;
  auto stage = [&](int kt, int buf) {
    char* SA = smem + buf * 32768;
    char* SB = SA + 16384;
#pragma unroll
    for (int i = 0; i < 4; ++i)
      __builtin_amdgcn_global_load_lds((const unsigned*)(ga + i * a32 + kt * 64), (unsigned*)(SA + tid * 16 + i * 4096), 16, 0, 0);
#pragma unroll
    for (int i = 0; i < NF; ++i)
      __builtin_amdgcn_global_load_lds((const unsigned*)(gb + i * b32 + kt * 64), (unsigned*)(SB + tid * 16 + i * 4096), 16, 0, 0);
  };
  asm volatile("s_waitcnt vmcnt(0)" ::: "memory");
  __syncthreads();
  stage(0, 0);
  const unsigned lds0 = (unsigned)(size_t)smem;
  const unsigned sw0 = (unsigned)((fq ^ (fr & 7)) * 16), sw1 = (unsigned)(((4 + fq) ^ (fr & 7)) * 16);
  const unsigned arow = lds0 + (wr * 64 + fr) * 128, brw = lds0 + 16384 + (wc * NF * 16 + fr) * 128;
  for (int kt = 0; kt < nk; ++kt) {
    asm volatile("s_waitcnt vmcnt(0)" ::: "memory");
    __builtin_amdgcn_s_barrier();
    if (kt + 1 < nk) stage(kt + 1, (kt + 1) & 1);
    const unsigned bo = (kt & 1) * 32768;
    bf16x8 af[2][4], bfg[2][4];
    if (NF == 4) {
      asm volatile(
          "ds_read_b128 %0, %16\n\tds_read_b128 %1, %16 offset:2048\n\tds_read_b128 %2, %16 offset:4096\n\tds_read_b128 %3, %16 offset:6144\n\t"
          "ds_read_b128 %4, %17\n\tds_read_b128 %5, %17 offset:2048\n\tds_read_b128 %6, %17 offset:4096\n\tds_read_b128 %7, %17 offset:6144\n\t"
          "ds_read_b128 %8, %18\n\tds_read_b128 %9, %18 offset:2048\n\tds_read_b128 %10, %18 offset:4096\n\tds_read_b128 %11, %18 offset:6144\n\t"
          "ds_read_b128 %12, %19\n\tds_read_b128 %13, %19 offset:2048\n\tds_read_b128 %14, %19 offset:4096\n\tds_read_b128 %15, %19 offset:6144\n\t"
          "s_waitcnt lgkmcnt(0)"
          : "=&v"(af[0][0]), "=&v"(af[0][1]), "=&v"(af[0][2]), "=&v"(af[0][3]), "=&v"(bfg[0][0]), "=&v"(bfg[0][1]), "=&v"(bfg[0][2]), "=&v"(bfg[0][3]),
            "=&v"(af[1][0]), "=&v"(af[1][1]), "=&v"(af[1][2]), "=&v"(af[1][3]), "=&v"(bfg[1][0]), "=&v"(bfg[1][1]), "=&v"(bfg[1][2]), "=&v"(bfg[1][3])
          : "v"(arow + sw0 + bo), "v"(brw + sw0 + bo), "v"(arow + sw1 + bo), "v"(brw + sw1 + bo)
          : "memory");
    } else {
      asm volatile(
          "ds_read_b128 %0, %12\n\tds_read_b128 %1, %12 offset:2048\n\tds_read_b128 %2, %12 offset:4096\n\tds_read_b128 %3, %12 offset:6144\n\t"
          "ds_read_b128 %4, %13\n\tds_read_b128 %5, %13 offset:2048\n\t"
          "ds_read_b128 %6, %14\n\tds_read_b128 %7, %14 offset:2048\n\tds_read_b128 %8, %14 offset:4096\n\tds_read_b128 %9, %14 offset:6144\n\t"
          "ds_read_b128 %10, %15\n\tds_read_b128 %11, %15 offset:2048\n\t"
          "s_waitcnt lgkmcnt(0)"
          : "=&v"(af[0][0]), "=&v"(af[0][1]), "=&v"(af[0][2]), "=&v"(af[0][3]), "=&v"(bfg[0][0]), "=&v"(bfg[0][1]),
            "=&v"(af[1][0]), "=&v"(af[1][1]), "=&v"(af[1][2]), "=&v"(af[1][3]), "=&v"(bfg[1][0]), "=&v"(bfg[1][1])
          : "v"(arow + sw0 + bo), "v"(brw + sw0 + bo), "v"(arow + sw1 + bo), "v"(brw + sw1 + bo)
          : "memory");
    }
#pragma unroll
    for (int ks = 0; ks < 2; ++ks)
#pragma unroll
      for (int m = 0; m < 4; ++m)
#pragma unroll
        for (int n = 0; n < NF; ++n) acc[m][n] = MFMA16(af[ks][m], bfg[ks][n], acc[m][n]);
  }
}

template <int REG>
DI void epi_region(const Params& p, int layer, f32x4 (&acc)[4][4], int rbase0, int rel, int fr, int fq) {
  const float2* rt = (const float2*)(p.ws + W_ROPE);
  constexpr bool doRope = (REG == 0 || REG == 1 || REG == 4 || REG == 5);
#pragma unroll
  for (int m = 0; m < 4; ++m) {
    const int rbase = rbase0 + m * 16 + fq * 4;
    const bool rowsValid = rbase < ROWS;
    int isP, sq, t0;
    decode_row(rowsValid ? rbase : 0, isP, sq, t0);
    if (doRope) {
      const int pos0 = isP ? t0 : PAST + t0;
#pragma unroll
      for (int j = 0; j < 4; ++j) {
        float v = acc[m][0][j];
        float pv = __shfl_xor(v, 8);
        float2 cs = rt[(pos0 + j) * 8 + (fr & 7)];
        acc[m][0][j] = (fr < 8) ? (v * cs.x - pv * cs.y) : (v * cs.x + pv * cs.y);
      }
    }
    if (rowsValid) {
#pragma unroll
      for (int n = 0; n < 4; ++n) {
        const int col = rel + n * 16 + fr;
        if (REG == 2) {
          uint2 pk; pk.x = pack2(acc[m][n][0], acc[m][n][1]); pk.y = pack2(acc[m][n][2], acc[m][n][3]);
          if (isP) *(uint2*)((bfr*)(p.ws + W_VTP) + ((long)sq * 512 + col) * KP_PAD + t0) = pk;
          else *(uint2*)((bfr*)(p.ws + W_VTS) + ((long)sq * 512 + col) * S_S + PAST + t0) = pk;
        }
#pragma unroll
        for (int j = 0; j < 4; ++j) {
          const float v = acc[m][n][j];
          const int row = rbase + j, t = t0 + j;
          if (REG == 0) ((bfr*)(p.ws + W_QB))[(long)row * 512 + col] = f2bf(v);
          if (REG == 1) {
            if (isP) { p.out[O_KP + ((long)(layer * NB_P + sq) * T_P + t) * 512 + col] = v; ((bfr*)(p.ws + W_KBP))[((long)sq * KP_PAD + t) * 512 + col] = f2bf(v); }
            else { p.out[O_KS + ((long)(layer * NB_S + sq) * T_S + t) * 512 + col] = v; ((bfr*)(p.ws + W_KBS))[((long)sq * S_S + PAST + t) * 512 + col] = f2bf(v); }
          }
          if (REG == 2) {
            if (isP) p.out[O_VP + ((long)(layer * NB_P + sq) * T_P + t) * 512 + col] = v;
            else p.out[O_VS + ((long)(layer * NB_S + sq) * T_S + t) * 512 + col] = v;
          }
          if (REG == 3) ((bfr*)(p.ws + W_GA))[(long)row * 512 + col] = f2bf(silu(v));
          if (REG == 4) ((bfr*)(p.ws + W_QIB))[(long)row * 256 + col] = f2bf(v);
          if (REG == 5) {
            if (isP) { p.out[O_KIP + ((long)(layer * NB_P + sq) * T_P + t) * 64 + col] = v; ((bfr*)(p.ws + W_KIBP))[((long)sq * KP_PAD + t) * 64 + col] = f2bf(v); }
            else { p.out[O_KIS + ((long)(layer * NB_S + sq) * T_S + t) * 64 + col] = v; ((bfr*)(p.ws + W_KIBS))[((long)sq * S_S + PAST + t) * 64 + col] = f2bf(v); }
          }
          if (REG == 6) {
            ((bfr*)(p.ws + W_XBB))[(long)row * 512 + col] = f2bf(v);
            if (isP) { if (t >= T_P - 3) p.out[O_CONVP + ((long)(layer * NB_P + sq) * 3 + (t - (T_P - 3))) * 512 + col] = v; }
            else { if (t >= T_S - 3) p.out[O_CONVS + ((long)(layer * NB_S + sq) * 3 + (t - (T_S - 3))) * 512 + col] = v; }
          }
          if (REG == 7) ((bfr*)(p.ws + W_GB))[(long)row * 512 + col] = f2bf(silu(v));
          if (REG == 8) {
            ((bfr*)(p.ws + W_XCB))[(long)row * 512 + col] = f2bf(v);
            if (isP) { if (t >= T_P - 15) p.out[O_POOLP + ((long)(layer * NB_P + sq) * 15 + (t - (T_P - 15))) * 512 + col] = v; }
            else { if (t >= T_S - 15) p.out[O_POOLS + ((long)(layer * NB_S + sq) * 15 + (t - (T_S - 15))) * 512 + col] = v; }
          }
          if (REG == 9) ((bfr*)(p.ws + W_GC))[(long)row * 512 + col] = f2bf(silu(v));
          if (REG == 10) ((bfr*)(p.ws + W_GM))[(long)row * 3072 + col] = f2bf(sigm(v));
          if (REG == 11) { if (col < 4) ((float*)(p.ws + W_WIB))[(long)row * 4 + col] = v; }
        }
      }
    }
  }
}

DI void epi_inproj(const Params& p, int layer, f32x4 (&acc)[4][4], int brow, int bcol) {
  const int tid = get_tid(), wid = __builtin_amdgcn_readfirstlane(tid >> 6), lane = tid & 63, wr = wid >> 1, wc = wid & 1, fr = lane & 15, fq = lane >> 4;
  const int c0 = bcol + wc * 64;
  const int rb = brow + wr * 64;
  if (c0 < C_K) epi_region<0>(p, layer, acc, rb, c0 - C_Q, fr, fq);
  else if (c0 < C_V) epi_region<1>(p, layer, acc, rb, c0 - C_K, fr, fq);
  else if (c0 < C_GA) epi_region<2>(p, layer, acc, rb, c0 - C_V, fr, fq);
  else if (c0 < C_QI) epi_region<3>(p, layer, acc, rb, c0 - C_GA, fr, fq);
  else if (c0 < C_KI) epi_region<4>(p, layer, acc, rb, c0 - C_QI, fr, fq);
  else if (c0 < C_XB) epi_region<5>(p, layer, acc, rb, c0 - C_KI, fr, fq);
  else if (c0 < C_GB) epi_region<6>(p, layer, acc, rb, c0 - C_XB, fr, fq);
  else if (c0 < C_XC) epi_region<7>(p, layer, acc, rb, c0 - C_GB, fr, fq);
  else if (c0 < C_GC) epi_region<8>(p, layer, acc, rb, c0 - C_XC, fr, fq);
  else if (c0 < C_GM) epi_region<9>(p, layer, acc, rb, c0 - C_GC, fr, fq);
  else if (c0 < C_WI) epi_region<10>(p, layer, acc, rb, c0 - C_GM, fr, fq);
  else epi_region<11>(p, layer, acc, rb, c0 - C_WI, fr, fq);
}

DI void phase_inproj(const Params& p, int layer, char*) {
  const bfr* A = (const bfr*)(p.ws + W_HN);
  const bfr* Bt = (const bfr*)(p.ws + W_WINT) + (long)layer * NPAD * 1024;
  constexpr int NTM = MPAD / 128, NTN = NPAD / 128;
  const int rank = sh_xinfo[0], nloc = sh_xinfo[1], ia = sh_xinfo[2], na = sh_xinfo[3];
  const int nbase = NTN / na, nrem = NTN % na;
  const int nn = nbase + (ia < nrem ? 1 : 0), n0 = ia * nbase + min(ia, nrem);
#if PROBE == 1
#pragma unroll 1
  for (int rep = 0; rep < 2; ++rep)
#endif
  for (int i = rank; i < NTM * nn; i += nloc) {
    const int tm = i / nn, tn = n0 + (i - tm * nn);
    f32x4 acc[4][4];
#pragma unroll
    for (int m = 0; m < 4; ++m)
#pragma unroll
      for (int n = 0; n < 4; ++n) acc[m][n] = f32x4{0.f, 0.f, 0.f, 0.f};
    gemm128<4>(A, 1024, Bt, 1024, 1024, tm * 128, tn * 128, smem, acc);
    epi_inproj(p, layer, acc, tm * 128, tn * 128);
  }
}

DI void phase_merge(const Params& p, int layer, char*) {
  const int tid = get_tid(), wid = __builtin_amdgcn_readfirstlane(tid >> 6), lane = tid & 63, wr = wid >> 1, wc = wid & 1, fr = lane & 15, fq = lane >> 4;
  const bfr* gmb = (const bfr*)(p.ws + W_GM);
  bfr* merged = (bfr*)(p.ws + W_HN);
  constexpr int NTM = MPAD / 128, NTN = 16;
  for (int tile = blockIdx.x; tile < NTM * NTN; tile += gridDim.x) {
    int tn = tile / NTM, tm = tile % NTM;
    const int brow = tm * 128, bcol = tn * 64;
    f32x4 tot[4][2];
#pragma unroll
    for (int m = 0; m < 4; ++m)
#pragma unroll
      for (int n = 0; n < 2; ++n) tot[m][n] = f32x4{0.f, 0.f, 0.f, 0.f};
#pragma unroll 1
    for (int br = 0; br < 3; ++br) {
      const bfr* A = (const bfr*)(p.ws + (br == 0 ? W_GA : (br == 1 ? W_GB : W_GC)));
      const bfr* Bt = (const bfr*)(p.ws + W_WBT) + (long)(layer * 3 + br) * 1024 * 512;
      f32x4 acc[4][2];
#pragma unroll
      for (int m = 0; m < 4; ++m)
#pragma unroll
        for (int n = 0; n < 2; ++n) acc[m][n] = f32x4{0.f, 0.f, 0.f, 0.f};
      gemm128<2>(A, 512, Bt, 512, 512, brow, bcol, smem, acc);
#pragma unroll
      for (int m = 0; m < 4; ++m)
#pragma unroll
        for (int j = 0; j < 4; ++j) {
          int row = brow + wr * 64 + m * 16 + fq * 4 + j;
          if (row < ROWS) {
#pragma unroll
            for (int n = 0; n < 2; ++n) {
              int col = bcol + wc * 32 + n * 16 + fr;
              float g = bf2f(gmb[(long)row * 3072 + br * 1024 + col]);
              tot[m][n][j] += g * acc[m][n][j];
            }
          }
        }
    }
#pragma unroll
    for (int m = 0; m < 4; ++m)
#pragma unroll
      for (int j = 0; j < 4; ++j) {
        int row = brow + wr * 64 + m * 16 + fq * 4 + j;
        if (row < ROWS) {
#pragma unroll
          for (int n = 0; n < 2; ++n) merged[(long)row * 1024 + bcol + wc * 32 + n * 16 + fr] = f2bf(tot[m][n][j]);
        }
      }
  }
}

DI void phase_out(const Params& p, int layer, char*) {
  const int tid = get_tid(), wid = __builtin_amdgcn_readfirstlane(tid >> 6), lane = tid & 63, wr = wid >> 1, wc = wid & 1, fr = lane & 15, fq = lane >> 4;
  const bfr* A = (const bfr*)(p.ws + W_HN);
  const bfr* Bt = (const bfr*)(p.ws + W_WOT) + (long)layer * 1024 * 1024;
  float* xres = (float*)(p.ws + W_XRES);
  constexpr int NTM = MPAD / 128, NTN = 8;
  for (int tile = blockIdx.x; tile < NTM * NTN; tile += gridDim.x) {
    int tn = tile / NTM, tm = tile % NTM;
    const int brow = tm * 128, bcol = tn * 128;
    f32x4 acc[4][4];
#pragma unroll
    for (int m = 0; m < 4; ++m)
#pragma unroll
      for (int n = 0; n < 4; ++n) acc[m][n] = f32x4{0.f, 0.f, 0.f, 0.f};
    gemm128<4>(A, 1024, Bt, 1024, 1024, brow, bcol, smem, acc);
#pragma unroll
    for (int m = 0; m < 4; ++m)
#pragma unroll
      for (int j = 0; j < 4; ++j) {
        int row = brow + wr * 64 + m * 16 + fq * 4 + j;
        if (row < ROWS) {
#pragma unroll
          for (int n = 0; n < 4; ++n) xres[(long)row * 1024 + bcol + wc * 64 + n * 16 + fr] += acc[m][n][j];
        }
      }
  }
}

constexpr int SEL_QS = 2120;
DI void select_item(const Params& p, int isP, int sq, int c, int sub, char*) {
  const int tid = get_tid(), wid = __builtin_amdgcn_readfirstlane(tid >> 6), lane = tid & 63, fr = lane & 15, fq = lane >> 4;
  int T0, nadm, rowbase;
  const bfr* kib;
  if (isP) {
    if (c == 0) { T0 = 0; nadm = 16; } else { T0 = 16 + 64 * (c - 1) + 16 * sub; nadm = 16 + 64 * c; }
    rowbase = sq * T_P;
    kib = (const bfr*)(p.ws + W_KIBP) + (long)sq * KP_PAD * 64;
  } else {
    T0 = 16 * sub; nadm = S_S; rowbase = ROWS_P + sq * 64;
    kib = (const bfr*)(p.ws + W_KIBS) + (long)sq * S_S * 64;
  }
  unsigned* maskg = (unsigned*)(p.ws + W_MASK);
  const int nsteps = (nadm + 31) >> 5;
  if (nadm <= 256) {
    for (int e = tid; e < 16 * nsteps; e += 256) {
      int q = e / nsteps, s = e - q * nsteps;
      unsigned w = (s * 32 + 32 <= nadm) ? 0xFFFFFFFFu : 0xFFFFu;
      maskg[(long)(rowbase + T0 + q) * MW + s] = w;
    }
    return;
  }
  const int nkt = nadm >> 4;
  const int nmine = (nkt - wid + 3) >> 2;
  const int nregs = (nadm + 63) >> 6;
  const bfr* qib = (const bfr*)(p.ws + W_QIB);
  const float* wib = (const float*)(p.ws + W_WIB);
  unsigned* S = (unsigned*)smem;
#pragma unroll 1
  for (int g = 0; g < 4; ++g) {
    const int qrow = rowbase + T0 + g * 4;
    int koff = (wid * 16 + fr) * 64 + fq * 8;
    asm volatile("" : "+v"(koff));
    const bfr* kbase = kib + koff;
    int nm = nmine;
    asm volatile("" : "+v"(nm));
    nm = __builtin_amdgcn_readfirstlane(nm);
    const bfr* qp = qib + (long)(qrow + (fr >> 2)) * 256 + (fr & 3) * 64 + fq * 8;
    const bf16x8 a0 = *(const bf16x8*)qp;
    const bf16x8 a1 = *(const bf16x8*)(qp + 32);
    const float4 w = *(const float4*)(wib + (long)(qrow + fq) * 4);
    unsigned sc[65];
#pragma unroll
    for (int ch = 0; ch < 5; ++ch) {
      if (ch * 13 < nm) {
        bf16x8 b0[13], b1[13];
#pragma unroll
        for (int u = 0; u < 13; ++u) {
          const int ic = min(ch * 13 + u, nm - 1);
          const bfr* kp = kbase + (long)ic * 4096;
          b0[u] = *(const bf16x8*)kp;
          b1[u] = *(const bf16x8*)(kp + 32);
        }
#pragma unroll
        for (int u = 0; u < 13; ++u) {
          const int i = ch * 13 + u;
          f32x4 a = {0.f, 0.f, 0.f, 0.f};
          a = MFMA16(a0, b0[u], a);
          a = MFMA16(a1, b1[u], a);
          float s = w.x * fmaxf(a[0], 0.f) + w.y * fmaxf(a[1], 0.f) + w.z * fmaxf(a[2], 0.f) + w.w * fmaxf(a[3], 0.f);
          sc[i] = (i < nm) ? sortable(s) : 0u;
        }
      } else {
#pragma unroll
        for (int u = 0; u < 13; ++u) sc[ch * 13 + u] = 0u;
      }
      __builtin_amdgcn_sched_barrier(0);
    }
    unsigned v[65];
    __syncthreads();
#pragma unroll
    for (int i = 0; i < 33; ++i) S[fq * SEL_QS + (i * 4 + wid) * 16 + fr] = sc[i];
    __syncthreads();
#pragma unroll
    for (int j = 0; j < 33; ++j) v[j] = S[wid * SEL_QS + j * 64 + lane];
    if (nregs > 33) {
      __syncthreads();
#pragma unroll
      for (int i = 33; i < 65; ++i) S[fq * SEL_QS + (i * 4 + wid - 132) * 16 + fr] = sc[i];
      __syncthreads();
#pragma unroll
      for (int j = 0; j < 32; ++j) v[33 + j] = S[wid * SEL_QS + j * 64 + lane];
    } else {
#pragma unroll
      for (int j = 0; j < 32; ++j) v[33 + j] = 0u;
    }
    int nr = nregs;
    asm volatile("" : "+v"(nr));
    nr = __builtin_amdgcn_readfirstlane(nr);
    unsigned vmax = 0u;
#pragma unroll
    for (int r = 0; r < 65; ++r) vmax = max(vmax, v[r]);
#pragma unroll
    for (int o = 32; o >= 1; o >>= 1) vmax = max(vmax, (unsigned)__shfl_xor((int)vmax, o));
    vmax = __builtin_amdgcn_readfirstlane(vmax);
    unsigned thr = 0u;
    int exact = 0;
#pragma unroll 1
    for (int bit = 31; bit >= 0; --bit) {
      const unsigned cand = thr | (1u << bit);
      if (cand > vmax) continue;
      int cnt = 0;
#pragma unroll
      for (int ch = 0; ch < 5; ++ch) {
        if (ch * 13 < nr) {
#pragma unroll
          for (int u = 0; u < 13; ++u) cnt += __popcll(__ballot(v[ch * 13 + u] >= cand));
        }
      }
      if (cnt >= 256) {
        thr = cand;
        if (cnt == 256) { exact = 1; break; }
      }
    }
    if (exact) {
      unsigned mn = 0xFFFFFFFFu;
#pragma unroll
      for (int r = 0; r < 65; ++r) mn = min(mn, v[r] >= thr ? v[r] : 0xFFFFFFFFu);
#pragma unroll
      for (int o = 32; o >= 1; o >>= 1) mn = min(mn, (unsigned)__shfl_xor((int)mn, o));
      thr = __builtin_amdgcn_readfirstlane(mn);
    }
    int gt = 0, eq = 0;
#pragma unroll
    for (int r = 0; r < 65; ++r) {
      gt += __popcll(__ballot(v[r] > thr));
      eq += __popcll(__ballot(v[r] == thr));
    }
    const int need = 256 - gt;
    int idxcut = 0x7fffffff;
    if (eq != need) {
      int run = 0;
      bool done = false;
#pragma unroll
      for (int r = 0; r < 65; ++r) {
        if (!done) {
          unsigned long long m = __ballot(v[r] == thr);
          int pc = __popcll(m);
          if (run + pc >= need) {
            const int k = need - run;
            for (int t = 1; t < k; ++t) m &= m - 1ull;
            idxcut = r * 64 + (__ffsll((long long)m) - 1);
            done = true;
          } else run += pc;
        }
      }
    }
    unsigned* mrowp = maskg + (long)(qrow + wid) * MW;
#pragma unroll
    for (int r = 0; r < 65; ++r) {
      if (r < nr) {
        const bool sel = (v[r] > thr) || (v[r] == thr && (r * 64 + lane) <= idxcut);
        const unsigned long long bal = __ballot(sel);
        if (lane == 0) *(uint2*)(mrowp + r * 2) = make_uint2((unsigned)bal, (unsigned)(bal >> 32));
      }
    }
  }
}

DI void lru_tile(const Params& p, int layer, int isP, int sq, int tile, int nb, int pass, char*) {
  const int tid = get_tid(), wid = __builtin_amdgcn_readfirstlane(tid >> 6), lane = tid & 63, fr = lane & 15, fq = lane >> 4;
  float* xbs = (float*)smem;
  float* as_ = xbs;
  float* xcs = xbs + 67 * 64;
  float* bs_ = xcs + 64 * 64;
  float* ab = bs_ + 64 * 64;
  bfr* xca = (bfr*)(ab + 512);
  const int T = isP ? T_P : T_S;
  const int rowbase = isP ? sq * T_P : ROWS_P + sq * 64;
  const int t0 = tile * 64, ch0 = nb * 64;
  const bfr* xbb = (const bfr*)(p.ws + W_XBB);
  bfr* gby = (bfr*)(p.ws + W_GB);
  float* agg = (float*)(p.ws + W_AGG);
  {
    const int c = tid & 63;
    for (int rr = tid >> 6; rr < 67; rr += 4) {
      int tt = t0 - 3 + rr;
      float v = 0.f;
      if (tt < 0) { if (!isP) v = p.state_conv[((long)(layer * NB_S + sq) * 3 + (3 + tt)) * 512 + ch0 + c]; }
      else if (tt < T) v = bf2f(xbb[(long)(rowbase + tt) * 512 + ch0 + c]);
      xbs[rr * 64 + c] = v;
    }
  }
  __syncthreads();
  {
    const int c = tid & 63;
    const float cb = p.conv_b[layer * 512 + ch0 + c];
    const float w0 = p.conv_w[(layer * 4 + 0) * 512 + ch0 + c], w1 = p.conv_w[(layer * 4 + 1) * 512 + ch0 + c],
                w2 = p.conv_w[(layer * 4 + 2) * 512 + ch0 + c], w3 = p.conv_w[(layer * 4 + 3) * 512 + ch0 + c];
    for (int t = tid >> 6; t < 64; t += 4) {
      float xc = cb + w0 * xbs[t * 64 + c] + w1 * xbs[(t + 1) * 64 + c] + w2 * xbs[(t + 2) * 64 + c] + w3 * xbs[(t + 3) * 64 + c];
      xcs[t * 64 + c] = xc;
      xca[t * 72 + c] = f2bf(xc);
    }
  }
  __syncthreads();
  {
    const bfr* WaT = (const bfr*)(p.ws + W_WAT) + (long)(layer * 8 + nb) * 4096;
    const bfr* WxT = (const bfr*)(p.ws + W_WXT) + (long)(layer * 8 + nb) * 4096;
    bf16x8 af0 = *(const bf16x8*)(xca + (wid * 16 + fr) * 72 + fq * 8);
    bf16x8 af1 = *(const bf16x8*)(xca + (wid * 16 + fr) * 72 + 32 + fq * 8);
#pragma unroll
    for (int nt = 0; nt < 4; ++nt) {
      const int d = nt * 16 + fr;
      bf16x8 ba0 = *(const bf16x8*)(WaT + d * 64 + fq * 8), ba1 = *(const bf16x8*)(WaT + d * 64 + 32 + fq * 8);
      bf16x8 bx0 = *(const bf16x8*)(WxT + d * 64 + fq * 8), bx1 = *(const bf16x8*)(WxT + d * 64 + 32 + fq * 8);
      f32x4 ar = {0.f, 0.f, 0.f, 0.f}, ai = {0.f, 0.f, 0.f, 0.f};
      ar = MFMA16(af0, ba0, ar); ar = MFMA16(af1, ba1, ar);
      ai = MFMA16(af0, bx0, ai); ai = MFMA16(af1, bx1, ai);
      const float bav = p.lru_ba[layer * 512 + ch0 + d], bxv = p.lru_bx[layer * 512 + ch0 + d];
      const float sp = log1pf(__expf(-p.lru_lambda[layer * 512 + ch0 + d]));
#pragma unroll
      for (int j = 0; j < 4; ++j) {
        const int t = wid * 16 + fq * 4 + j;
        float r = sigm(ar[j] + bav), ig = sigm(ai[j] + bxv);
        float la = -8.f * r * sp;
        float a = __expf(la);
        float b = sqrtf(1.f - __expf(2.f * la)) * (ig * xcs[t * 64 + d]);
        if (t0 + t >= T) { a = 1.f; b = 0.f; }
        as_[t * 64 + d] = a;
        bs_[t * 64 + d] = b;
      }
    }
  }
  __syncthreads();
  const int c = tid & 63;
  {
    float A = 1.f, B = 0.f;
#pragma unroll
    for (int tt = 0; tt < 16; ++tt) {
      float a = as_[(wid * 16 + tt) * 64 + c], b = bs_[(wid * 16 + tt) * 64 + c];
      A *= a; B = a * B + b;
    }
    ab[(wid * 64 + c) * 2] = A;
    ab[(wid * 64 + c) * 2 + 1] = B;
  }
  __syncthreads();
  if (pass == 0) {
    if (wid == 0) {
      float A = 1.f, B = 0.f;
#pragma unroll
      for (int w = 0; w < 4; ++w) { float a = ab[(w * 64 + c) * 2], b = ab[(w * 64 + c) * 2 + 1]; A *= a; B = a * B + b; }
      *(float2*)(agg + ((long)(sq * NTILE_P + tile) * 512 + ch0 + c) * 2) = make_float2(A, B);
    }
  } else {
    float h = isP ? 0.f : p.state_lru[(long)(layer * NB_S + sq) * 512 + ch0 + c];
    for (int i = 0; i < tile; ++i) {
      float2 e = *(const float2*)(agg + ((long)(sq * NTILE_P + i) * 512 + ch0 + c) * 2);
      h = e.x * h + e.y;
    }
    for (int w = 0; w < wid; ++w) h = ab[(w * 64 + c) * 2] * h + ab[(w * 64 + c) * 2 + 1];
#pragma unroll
    for (int tt = 0; tt < 16; ++tt) {
      const int t = wid * 16 + tt;
      h = as_[t * 64 + c] * h + bs_[t * 64 + c];
      if (t0 + t < T) {
        const long idx = (long)(rowbase + t0 + t) * 512 + ch0 + c;
        gby[idx] = f2bf(h * bf2f(gby[idx]));
        if (t0 + t == T - 1) {
          if (isP) p.out[O_LRUP + (long)(layer * NB_P + sq) * 512 + ch0 + c] = h;
          else p.out[O_LRUS + (long)(layer * NB_S + sq) * 512 + ch0 + c] = h;
        }
      }
    }
  }
}

DI void pool_item(const Params& p, int layer, int isP, int sq, int tile, int g, char*) {
  const int tid = get_tid(), wid = __builtin_amdgcn_readfirstlane(tid >> 6), lane = tid & 63, fr = lane & 15, fq = lane >> 4;
  float* xps = (float*)smem;
  bfr* pa = (bfr*)(xps + 79 * 128);
  const int T = isP ? T_P : T_S;
  const int rowbase = isP ? sq * T_P : ROWS_P + sq * 64;
  const int t0 = tile * 64, ch0 = g * 128;
  const bfr* xcb = (const bfr*)(p.ws + W_XCB);
  bfr* gcy = (bfr*)(p.ws + W_GC);
  {
    const int c = tid & 127;
    for (int rr = tid >> 7; rr < 79; rr += 2) {
      int tt = t0 - 15 + rr;
      float v = 0.f;
      if (tt < 0) { if (!isP) v = p.state_pool[((long)(layer * NB_S + sq) * 15 + (15 + tt)) * 512 + ch0 + c]; }
      else if (tt < T) v = bf2f(xcb[(long)(rowbase + tt) * 512 + ch0 + c]);
      xps[rr * 128 + c] = v;
    }
  }
  __syncthreads();
  {
    const int c = tid & 127;
    const int w = 2 << g;
    const int nh = isP ? 0 : PAST;
    for (int t = tid >> 7; t < 64; t += 2) {
      float s = 0.f;
      for (int i = 0; i < w; ++i) s += xps[(15 + t - i) * 128 + c];
      int cnt = min(w, t0 + t + 1 + nh);
      float v = s / (float)cnt - xps[(15 + t) * 128 + c];
      pa[t * 136 + c] = f2bf(v);
    }
  }
  __syncthreads();
  {
    const bfr* PwT = (const bfr*)(p.ws + W_PWT) + (long)(layer * 4 + g) * 16384;
    bf16x8 af[4];
#pragma unroll
    for (int ks = 0; ks < 4; ++ks) af[ks] = *(const bf16x8*)(pa + (wid * 16 + fr) * 136 + ks * 32 + fq * 8);
#pragma unroll
    for (int nt = 0; nt < 8; ++nt) {
      const int d = nt * 16 + fr;
      f32x4 acc = {0.f, 0.f, 0.f, 0.f};
#pragma unroll
      for (int ks = 0; ks < 4; ++ks) {
        bf16x8 bq = *(const bf16x8*)(PwT + d * 128 + ks * 32 + fq * 8);
        acc = MFMA16(af[ks], bq, acc);
      }
      const float scl = p.pool_scale[layer * 512 + ch0 + d];
#pragma unroll
      for (int j = 0; j < 4; ++j) {
        const int t = wid * 16 + fq * 4 + j;
        if (t0 + t < T) {
          const long idx = (long)(rowbase + t0 + t) * 512 + ch0 + d;
          gcy[idx] = f2bf(acc[j] * scl * bf2f(gcy[idx]));
        }
      }
    }
  }
}

DI void kmax_item(const Params& p, int seq, int h, char*) {
  const int tid = get_tid(), wid = __builtin_amdgcn_readfirstlane(tid >> 6), lane = tid & 63;
  const bfr* kb; int S;
  if (seq < NB_P) { kb = (const bfr*)(p.ws + W_KBP) + (long)seq * KP_PAD * 512; S = T_P; }
  else { kb = (const bfr*)(p.ws + W_KBS) + (long)(seq - NB_P) * S_S * 512; S = S_S; }
  float mx = 0.f;
  for (int key = tid; key < S; key += 256) {
    const uint4* r = (const uint4*)(kb + (long)key * 512 + h * 64);
    float ss = 0.f;
#pragma unroll
    for (int i = 0; i < 8; ++i) {
      uint4 v = r[i];
      unsigned u[4] = {v.x, v.y, v.z, v.w};
#pragma unroll
      for (int j = 0; j < 4; ++j) {
        float a = __uint_as_float(u[j] << 16), b = __uint_as_float(u[j] & 0xFFFF0000u);
        ss += a * a + b * b;
      }
    }
    mx = fmaxf(mx, ss);
  }
#pragma unroll
  for (int o = 32; o >= 1; o >>= 1) mx = fmaxf(mx, __shfl_xor(mx, o));
  float* red = (float*)smem;
  if (lane == 0) red[wid] = mx;
  __syncthreads();
  if (tid == 0) ((float*)(p.ws + W_KMAX))[seq * 8 + h] = fmaxf(fmaxf(red[0], red[1]), fmaxf(red[2], red[3]));
}

DI void attn_unit(const Params& p, int isP, int sq, int c, int h, int half, size_t dstoff = W_GA) {
  const int lane = get_tid() & 63, fr = lane & 15, fq = lane >> 4;
  int T0, nqt, nadm, rowbase, vld;
  const bfr *kb, *vt;
  if (isP) {
    if (c == 0) { T0 = 0; nqt = 1; nadm = 16; } else { T0 = 16 + 64 * (c - 1) + 32 * half; nqt = 2; nadm = 16 + 64 * c; }
    rowbase = sq * T_P;
    kb = (const bfr*)(p.ws + W_KBP) + (long)sq * KP_PAD * 512;
    vt = (const bfr*)(p.ws + W_VTP) + (long)sq * 512 * KP_PAD;
    vld = KP_PAD;
  } else {
    T0 = 32 * half; nqt = 2; nadm = S_S; rowbase = ROWS_P + sq * 64;
    kb = (const bfr*)(p.ws + W_KBS) + (long)sq * S_S * 512;
    vt = (const bfr*)(p.ws + W_VTS) + (long)sq * 512 * S_S;
    vld = S_S;
  }
  const int nsteps = (nadm + 31) >> 5;
  const int qrow0 = rowbase + T0;
  const bfr* qb = (const bfr*)(p.ws + W_QB);
  const unsigned* maskg = (const unsigned*)(p.ws + W_MASK);
  bf16x8 qf[2][2];
#pragma unroll
  for (int qt = 0; qt < 2; ++qt)
#pragma unroll
    for (int ks = 0; ks < 2; ++ks) {
      int r = qrow0 + (qt < nqt ? qt * 16 : 0) + fr;
      qf[qt][ks] = *(const bf16x8*)(qb + (long)r * 512 + h * 64 + ks * 32 + fq * 8);
    }
  f32x4 o[2][4];
#pragma unroll
  for (int qt = 0; qt < 2; ++qt)
#pragma unroll
    for (int dt = 0; dt < 4; ++dt) o[qt][dt] = f32x4{0.f, 0.f, 0.f, 0.f};
  const float sc2 = 0.125f * 1.4426950408889634f;
  const float kmax2 = ((const float*)(p.ws + W_KMAX))[(isP ? sq : NB_P + sq) * 8 + h];
  float mref[2], lsum[2] = {0.f, 0.f};
#pragma unroll
  for (int qt = 0; qt < 2; ++qt) {
    float ss = 0.f;
#pragma unroll
    for (int ks = 0; ks < 2; ++ks)
#pragma unroll
      for (int i = 0; i < 8; ++i) { float a = bf2f((bfr)qf[qt][ks][i]); ss += a * a; }
    ss += __shfl_xor(ss, 16);
    ss += __shfl_xor(ss, 32);
    mref[qt] = sqrtf(ss * kmax2) * sc2;
  }
  const unsigned* mrow0 = maskg + (long)(qrow0 + fr) * MW;
  const unsigned* mrow1 = maskg + (long)(qrow0 + (nqt > 1 ? 16 : 0) + fr) * MW;
  const int kofs = (fr >> 2) * 8 + (fr & 3);
  const bfr* kptr = kb + (long)kofs * 512 + h * 64 + fq * 8;
  const bfr* vptr = vt + (long)(h * 64 + fr) * vld + fq * 8;
  bf16x8 ka0 = *(const bf16x8*)kptr, ka1 = *(const bf16x8*)(kptr + 32);
  bf16x8 kb0 = *(const bf16x8*)(kptr + 4 * 512), kb1 = *(const bf16x8*)(kptr + 4 * 512 + 32);
  bf16x8 vf[4];
#pragma unroll
  for (int dt = 0; dt < 4; ++dt) vf[dt] = *(const bf16x8*)(vptr + (long)dt * 16 * vld);
  unsigned mw0 = mrow0[0], mw1 = mrow1[0];
  for (int s = 0; s < nsteps; ++s) {
    const int sn = min(s + 1, nsteps - 1);
    const bfr* pa = kptr + (long)sn * 32 * 512;
    const bf16x8 nka0 = *(const bf16x8*)pa, nka1 = *(const bf16x8*)(pa + 32);
    const bf16x8 nkb0 = *(const bf16x8*)(pa + 4 * 512), nkb1 = *(const bf16x8*)(pa + 4 * 512 + 32);
    bf16x8 nvf[4];
#pragma unroll
    for (int dt = 0; dt < 4; ++dt) nvf[dt] = *(const bf16x8*)(vptr + (long)dt * 16 * vld + sn * 32);
    const unsigned nmw0 = mrow0[sn], nmw1 = mrow1[sn];
#pragma unroll
    for (int qt = 0; qt < 2; ++qt) {
      if (qt < nqt) {
        f32x4 sa = {0.f, 0.f, 0.f, 0.f}, sb = {0.f, 0.f, 0.f, 0.f};
        sa = MFMA16(ka0, qf[qt][0], sa); sa = MFMA16(ka1, qf[qt][1], sa);
        sb = MFMA16(kb0, qf[qt][0], sb); sb = MFMA16(kb1, qf[qt][1], sb);
        const unsigned mb = ((qt == 0 ? mw0 : mw1) >> (fq * 8)) & 0xFFu;
        float pr[8];
#pragma unroll
        for (int i = 0; i < 4; ++i) {
          float pa_ = __builtin_amdgcn_exp2f(sa[i] * sc2 - mref[qt]);
          float pb_ = __builtin_amdgcn_exp2f(sb[i] * sc2 - mref[qt]);
          pr[i] = ((mb >> i) & 1u) ? pa_ : 0.f;
          pr[4 + i] = ((mb >> (4 + i)) & 1u) ? pb_ : 0.f;
        }
        lsum[qt] += ((pr[0] + pr[1]) + (pr[2] + pr[3])) + ((pr[4] + pr[5]) + (pr[6] + pr[7]));
        union { unsigned u[4]; bf16x8 v; } pk;
        pk.u[0] = pack2(pr[0], pr[1]); pk.u[1] = pack2(pr[2], pr[3]); pk.u[2] = pack2(pr[4], pr[5]); pk.u[3] = pack2(pr[6], pr[7]);
#pragma unroll
        for (int dt = 0; dt < 4; ++dt) o[qt][dt] = MFMA16(vf[dt], pk.v, o[qt][dt]);
      }
    }
    ka0 = nka0; ka1 = nka1; kb0 = nkb0; kb1 = nkb1;
#pragma unroll
    for (int dt = 0; dt < 4; ++dt) vf[dt] = nvf[dt];
    mw0 = nmw0; mw1 = nmw1;
  }
  bfr* gay = (bfr*)(p.ws + W_GA);
  bfr* dsty = (bfr*)(p.ws + dstoff);
#pragma unroll
  for (int qt = 0; qt < 2; ++qt) {
    if (qt < nqt) {
      float l = lsum[qt];
      l += __shfl_xor(l, 16);
      l += __shfl_xor(l, 32);
      const float inv = l > 0.f ? 1.f / l : 0.f;
      const long rowoff = (long)(qrow0 + qt * 16 + fr) * 512 + h * 64;
#pragma unroll
      for (int dt = 0; dt < 4; ++dt) {
        uint2* ptr = (uint2*)(gay + rowoff + dt * 16 + fq * 4);
        uint2 gv = *ptr;
        float g0 = __uint_as_float(gv.x << 16), g1 = __uint_as_float(gv.x & 0xFFFF0000u);
        float g2 = __uint_as_float(gv.y << 16), g3 = __uint_as_float(gv.y & 0xFFFF0000u);
        uint2 ov;
        ov.x = pack2(o[qt][dt][0] * inv * g0, o[qt][dt][1] * inv * g1);
        ov.y = pack2(o[qt][dt][2] * inv * g2, o[qt][dt][3] * inv * g3);
        *(uint2*)(dsty + rowoff + dt * 16 + fq * 4) = ov;
      }
    }
  }
}

#define XB_TMO      128
#define XB_XCNT(j)  (256  + 64 * (j))
#define XB_XSUB(j)  (1280 + 64 * (j))
#define XB_XGEN(j)  (2304 + 64 * (j))
#define XB_TOP      3328
#define XB_TOPGEN   3392
#define XCD_BAR_WORDS 3456
#define XB_SPIN_CAP (1u << 18)
#define LAS __attribute__((address_space(3)))

__device__ __forceinline__ unsigned xb_ld(unsigned* p)              { return __hip_atomic_load(p, __ATOMIC_RELAXED, __HIP_MEMORY_SCOPE_AGENT); }
__device__ __forceinline__ unsigned xb_add(unsigned* p, unsigned v) { return __hip_atomic_fetch_add(p, v, __ATOMIC_RELAXED, __HIP_MEMORY_SCOPE_AGENT); }
__device__ __forceinline__ unsigned xb_xcc_id() { return (unsigned)__builtin_amdgcn_s_getreg((3 << 11) | 20) & 0xFu; }
#define XB_SPIN(cond, bar) do { unsigned _sp = 0; while (cond) { __builtin_amdgcn_s_sleep(1); \
    if ((++_sp & 255u) == 0u) { if (xb_ld(&(bar)[XB_TMO])) break; if (_sp > XB_SPIN_CAP) { atomicAdd(&(bar)[XB_TMO], 1u); break; } } } } while (0)

struct XcdBarrier {
    unsigned* bar; unsigned x;
    volatile LAS unsigned* st;
};

__device__ __forceinline__ XcdBarrier xcd_barrier_post(unsigned* bar, volatile LAS unsigned* st) {
    XcdBarrier b; b.bar = bar; b.x = xb_xcc_id(); b.st = st;
    if (threadIdx.x == 0) (void)xb_add(&bar[XB_XCNT(b.x)], 1u);
    return b;
}
__device__ __forceinline__ void xcd_barrier_complete(unsigned* bar, unsigned x, unsigned& nloc, unsigned& nx) {
    const unsigned G = gridDim.x * gridDim.y * gridDim.z;
    unsigned sum, cnt, mine, sp = 0u;
    for (;;) {
        sum = 0u; cnt = 0u; mine = 0u;
#pragma unroll
        for (unsigned j = 0; j < 16; ++j) { const unsigned c = xb_ld(&bar[XB_XCNT(j)]); sum += c; cnt += (c > 0u) ? 1u : 0u; mine = (j == x) ? c : mine; }
        if (sum == G) break;
        __builtin_amdgcn_s_sleep(1);
        if ((++sp & 255u) == 0u) { if (xb_ld(&bar[XB_TMO])) break; if (sp > XB_SPIN_CAP) { atomicAdd(&bar[XB_TMO], 1u); break; } }
    }
    nloc = mine > 0u ? mine : 1u; nx = cnt > 0u ? cnt : 1u;
}

__device__ __forceinline__ void xcd_barrier(const XcdBarrier& b) {
    asm volatile("s_waitcnt vmcnt(0)" ::: "memory");
    __syncthreads();
    if (threadIdx.x == 0) {
        unsigned* bar = b.bar;
        __builtin_amdgcn_s_waitcnt(0);
        unsigned nloc = b.st[0], nx = b.st[1];
        if (nloc == 0u) { xcd_barrier_complete(bar, b.x, nloc, nx); b.st[0] = nloc; b.st[1] = nx; }
        const unsigned old = xb_add(&bar[XB_XSUB(b.x)], 1u);
        const unsigned gen = old / nloc;
        if (old + 1u == (gen + 1u) * nloc) {
            __builtin_amdgcn_fence(__ATOMIC_RELEASE, "agent");
            asm volatile("s_waitcnt vmcnt(0)" ::: "memory");
            const unsigned og = xb_add(&bar[XB_TOP], 1u);
            const unsigned tg = og / nx;
            if (og + 1u == (tg + 1u) * nx) xb_add(&bar[XB_TOPGEN], 1u);
            else XB_SPIN(xb_ld(&bar[XB_TOPGEN]) == tg, bar);
            __builtin_amdgcn_fence(__ATOMIC_ACQUIRE, "agent");
            xb_add(&bar[XB_XGEN(b.x)], 1u);
            asm volatile("s_waitcnt vmcnt(0)" ::: "memory");
        } else {
            XB_SPIN(xb_ld(&bar[XB_XGEN(b.x)]) == gen, bar);
            __builtin_amdgcn_fence(__ATOMIC_ACQUIRE, "agent");
            asm volatile("s_waitcnt vmcnt(0)" ::: "memory");
        }
    }
    __syncthreads();
}


DI void attn_block(const Params& p, int isP, int sq, int c, int h) {
  const int tid = get_tid(), wid = __builtin_amdgcn_readfirstlane(tid >> 6), lane = tid & 63, fr = lane & 15, fq = lane >> 4;
  int T0, nqt, nadm, rowbase, vld;
  const bfr *kb, *vt;
  if (isP) {
    if (c == 0) { T0 = 0; nqt = 1; nadm = 16; } else { T0 = 16 + 64 * (c - 1); nqt = 4; nadm = 16 + 64 * c; }
    rowbase = sq * T_P;
    kb = (const bfr*)(p.ws + W_KBP) + (long)sq * KP_PAD * 512;
    vt = (const bfr*)(p.ws + W_VTP) + (long)sq * 512 * KP_PAD;
    vld = KP_PAD;
  } else {
    T0 = 0; nqt = 4; nadm = S_S; rowbase = ROWS_P + sq * 64;
    kb = (const bfr*)(p.ws + W_KBS) + (long)sq * S_S * 512;
    vt = (const bfr*)(p.ws + W_VTS) + (long)sq * 512 * S_S;
    vld = S_S;
  }
  const int nsteps = (nadm + 31) >> 5;
  const int qrow0 = rowbase + T0;
  const bfr* qb = (const bfr*)(p.ws + W_QB);
  const unsigned* maskg = (const unsigned*)(p.ws + W_MASK);
  bf16x8 qf[4][2];
#pragma unroll
  for (int qt = 0; qt < 4; ++qt)
#pragma unroll
    for (int ks = 0; ks < 2; ++ks) {
      int r = qrow0 + (qt < nqt ? qt * 16 : 0) + fr;
      qf[qt][ks] = *(const bf16x8*)(qb + (long)r * 512 + h * 64 + ks * 32 + fq * 8);
    }
  f32x4 o[4][4];
#pragma unroll
  for (int qt = 0; qt < 4; ++qt)
#pragma unroll
    for (int dt = 0; dt < 4; ++dt) o[qt][dt] = f32x4{0.f, 0.f, 0.f, 0.f};
  const float sc2 = 0.125f * 1.4426950408889634f;
  const float kmax2 = ((const float*)(p.ws + W_KMAX))[(isP ? sq : NB_P + sq) * 8 + h];
  float mref[4], lsum[4] = {0.f, 0.f, 0.f, 0.f};
  const unsigned* mrow[4];
#pragma unroll
  for (int qt = 0; qt < 4; ++qt) {
    float ss = 0.f;
#pragma unroll
    for (int ks = 0; ks < 2; ++ks)
#pragma unroll
      for (int i = 0; i < 8; ++i) { float a = bf2f((bfr)qf[qt][ks][i]); ss += a * a; }
    ss += __shfl_xor(ss, 16);
    ss += __shfl_xor(ss, 32);
    mref[qt] = sqrtf(ss * kmax2) * sc2;
    mrow[qt] = maskg + (long)(qrow0 + (qt < nqt ? qt * 16 : 0) + fr) * MW;
  }
  const int kofs = (fr >> 2) * 8 + (fr & 3);
  const bfr* kptr = kb + (long)kofs * 512 + h * 64 + fq * 8;
  const bfr* vptr = vt + (long)(h * 64 + fr) * vld + fq * 8;
  if (wid < nsteps) {
    int s = wid;
    const bfr* pa0 = kptr + (long)s * 32 * 512;
    bf16x8 ka0 = *(const bf16x8*)pa0, ka1 = *(const bf16x8*)(pa0 + 32);
    bf16x8 kb0 = *(const bf16x8*)(pa0 + 4 * 512), kb1 = *(const bf16x8*)(pa0 + 4 * 512 + 32);
    bf16x8 vf[4];
#pragma unroll
    for (int dt = 0; dt < 4; ++dt) vf[dt] = *(const bf16x8*)(vptr + (long)dt * 16 * vld + s * 32);
    unsigned mw[4];
#pragma unroll
    for (int qt = 0; qt < 4; ++qt) mw[qt] = mrow[qt][s];
    for (; s < nsteps; s += 4) {
      const int sn = (s + 4 < nsteps) ? s + 4 : s;
      const bfr* pa = kptr + (long)sn * 32 * 512;
      const bf16x8 nka0 = *(const bf16x8*)pa, nka1 = *(const bf16x8*)(pa + 32);
      const bf16x8 nkb0 = *(const bf16x8*)(pa + 4 * 512), nkb1 = *(const bf16x8*)(pa + 4 * 512 + 32);
      bf16x8 nvf[4];
#pragma unroll
      for (int dt = 0; dt < 4; ++dt) nvf[dt] = *(const bf16x8*)(vptr + (long)dt * 16 * vld + sn * 32);
      unsigned nmw[4];
#pragma unroll
      for (int qt = 0; qt < 4; ++qt) nmw[qt] = mrow[qt][sn];
#pragma unroll
      for (int qt = 0; qt < 4; ++qt) {
        if (qt < nqt) {
          f32x4 sa = {0.f, 0.f, 0.f, 0.f}, sb = {0.f, 0.f, 0.f, 0.f};
          sa = MFMA16(ka0, qf[qt][0], sa); sa = MFMA16(ka1, qf[qt][1], sa);
          sb = MFMA16(kb0, qf[qt][0], sb); sb = MFMA16(kb1, qf[qt][1], sb);
          const unsigned mb = (mw[qt] >> (fq * 8)) & 0xFFu;
          float pr[8];
#pragma unroll
          for (int i = 0; i < 4; ++i) {
            float pa_ = __builtin_amdgcn_exp2f(sa[i] * sc2 - mref[qt]);
            float pb_ = __builtin_amdgcn_exp2f(sb[i] * sc2 - mref[qt]);
            pr[i] = ((mb >> i) & 1u) ? pa_ : 0.f;
            pr[4 + i] = ((mb >> (4 + i)) & 1u) ? pb_ : 0.f;
          }
          lsum[qt] += ((pr[0] + pr[1]) + (pr[2] + pr[3])) + ((pr[4] + pr[5]) + (pr[6] + pr[7]));
          union { unsigned u[4]; bf16x8 v; } pk;
          pk.u[0] = pack2(pr[0], pr[1]); pk.u[1] = pack2(pr[2], pr[3]); pk.u[2] = pack2(pr[4], pr[5]); pk.u[3] = pack2(pr[6], pr[7]);
#pragma unroll
          for (int dt = 0; dt < 4; ++dt) o[qt][dt] = MFMA16(vf[dt], pk.v, o[qt][dt]);
        }
      }
      ka0 = nka0; ka1 = nka1; kb0 = nkb0; kb1 = nkb1;
#pragma unroll
      for (int dt = 0; dt < 4; ++dt) vf[dt] = nvf[dt];
#pragma unroll
      for (int qt = 0; qt < 4; ++qt) mw[qt] = nmw[qt];
    }
  }
  float* OS = (float*)smem;
  float* LS = OS + 4 * 2048;
  bfr* gay = (bfr*)(p.ws + W_GA);
#pragma unroll
  for (int rd = 0; rd < 2; ++rd) {
    __syncthreads();
#pragma unroll
    for (int q2 = 0; q2 < 2; ++q2) {
      const int qt = rd * 2 + q2;
      float l = lsum[qt];
      l += __shfl_xor(l, 16);
      l += __shfl_xor(l, 32);
      LS[(wid * 2 + q2) * 64 + lane] = l;
#pragma unroll
      for (int dt = 0; dt < 4; ++dt)
#pragma unroll
        for (int j = 0; j < 4; ++j) OS[((wid * 2 + q2) * 16 + dt * 4 + j) * 64 + lane] = o[qt][dt][j];
    }
    __syncthreads();
    const int q2 = wid >> 1, qt = rd * 2 + q2;
    if (qt < nqt) {
      float l = 0.f;
#pragma unroll
      for (int w = 0; w < 4; ++w) l += LS[(w * 2 + q2) * 64 + lane];
      const float inv = l > 0.f ? 1.f / l : 0.f;
      const long rowoff = (long)(qrow0 + qt * 16 + fr) * 512 + h * 64;
#pragma unroll
      for (int d2 = 0; d2 < 2; ++d2) {
        const int dt = (wid & 1) * 2 + d2;
        float acc4[4];
#pragma unroll
        for (int j = 0; j < 4; ++j) {
          float a = 0.f;
#pragma unroll
          for (int w = 0; w < 4; ++w) a += OS[((w * 2 + q2) * 16 + dt * 4 + j) * 64 + lane];
          acc4[j] = a * inv;
        }
        uint2* ptr = (uint2*)(gay + rowoff + dt * 16 + fq * 4);
        uint2 gv = *ptr;
        float g0 = __uint_as_float(gv.x << 16), g1 = __uint_as_float(gv.x & 0xFFFF0000u);
        float g2 = __uint_as_float(gv.y << 16), g3 = __uint_as_float(gv.y & 0xFFFF0000u);
        uint2 ov;
        ov.x = pack2(acc4[0] * g0, acc4[1] * g1);
        ov.y = pack2(acc4[2] * g2, acc4[3] * g3);
        *ptr = ov;
      }
    }
  }
}

DI int pop_block(int* ctr, int*) {
  __syncthreads();
  if (threadIdx.x == 0) sh_item = atomicAdd(ctr, 1);
  __syncthreads();
  return __builtin_amdgcn_readfirstlane(sh_item);
}

constexpr int N_KMAX = 20 * 8;
constexpr int N_SEL = 64 * 16 + 64 + 4;
constexpr int N_LRU1 = NB_P * NTILE_P * 8;
constexpr int N_POOL = NB_P * NTILE_P * 4 + NB_S * 4;
constexpr int N_LRU2 = NB_P * NTILE_P * 8 + NB_S * 8;
constexpr int N_ATT = 64 * 64 + 256 + 32;

DI void phase_b1(const Params& p, int layer, char*, int*) {
  int* ctr = (int*)(p.ws + W_CTR) + layer * 4 + 0;
  for (;;) {
    int it = pop_block(ctr, nullptr);
    if (it >= N_SEL + N_LRU1 + N_POOL + N_KMAX) break;
    if (it >= N_SEL + N_LRU1 + N_POOL) { int j = it - (N_SEL + N_LRU1 + N_POOL); kmax_item(p, j >> 3, j & 7, smem); }
    else if (it < N_SEL) {
      if (it < 1024) { int c = 64 - (it >> 4), b = (it & 15) >> 2, sub = it & 3; select_item(p, 1, b, c, sub, smem); }
      else if (it < 1088) { int j = it - 1024; select_item(p, 0, j >> 2, 0, j & 3, smem); }
      else select_item(p, 1, it - 1088, 0, 0, smem);
    } else if (it < N_SEL + N_LRU1) {
      int j = it - N_SEL;
      int sq = j / (NTILE_P * 8), rem = j % (NTILE_P * 8);
      lru_tile(p, layer, 1, sq, rem >> 3, rem & 7, 0, smem);
    } else {
      int j = it - N_SEL - N_LRU1;
      if (j < NB_P * NTILE_P * 4) { int sq = j / (NTILE_P * 4), rem = j % (NTILE_P * 4); pool_item(p, layer, 1, sq, rem >> 2, rem & 3, smem); }
      else { j -= NB_P * NTILE_P * 4; pool_item(p, layer, 0, j >> 2, 0, j & 3, smem); }
    }
  }
}

constexpr size_t W_DUMMY = W_END;
DI void probe_select(const Params& p, int layer) {
  int* ctr = (int*)(p.ws + W_CTR) + layer * 4 + 3;
  for (;;) {
    int it = pop_block(ctr, nullptr);
    if (it >= N_SEL) break;
    if (it < 1024) { int c = 64 - (it >> 4), b = (it & 15) >> 2, sub = it & 3; select_item(p, 1, b, c, sub, smem); }
    else if (it < 1088) { int j = it - 1024; select_item(p, 0, j >> 2, 0, j & 3, smem); }
    else select_item(p, 1, it - 1088, 0, 0, smem);
  }
}
DI void probe_attn(const Params& p, int layer) {
  int* ctr2 = (int*)(p.ws + W_CTR) + layer * 4 + 3;
  const int lane = get_tid() & 63;
  for (;;) {
    int u = 0;
    if (lane == 0) u = atomicAdd(ctr2, 1);
    u = __builtin_amdgcn_readfirstlane(u);
    if (u >= N_ATT) break;
    if (u < 4096) { int c = 64 - (u >> 6), r = u & 63; attn_unit(p, 1, r >> 4, c, (r >> 1) & 7, r & 1, W_DUMMY); }
    else if (u < 4096 + 256) { int r = u - 4096; attn_unit(p, 0, r >> 4, 0, (r >> 1) & 7, r & 1, W_DUMMY); }
    else { int r = u - 4352; attn_unit(p, 1, r >> 3, 0, r & 7, 0, W_DUMMY); }
  }
}

DI void phase_b2(const Params& p, int layer, char*, int*) {
  int* ctr = (int*)(p.ws + W_CTR) + layer * 4 + 1;
  for (;;) {
    int it = pop_block(ctr, nullptr);
    if (it >= N_LRU2) break;
    if (it < NB_P * NTILE_P * 8) { int sq = it / (NTILE_P * 8), rem = it % (NTILE_P * 8); lru_tile(p, layer, 1, sq, rem >> 3, rem & 7, 1, smem); }
    else { int j = it - NB_P * NTILE_P * 8; lru_tile(p, layer, 0, j >> 3, 0, j & 7, 1, smem); }
  }
  int* ctr2 = (int*)(p.ws + W_CTR) + layer * 4 + 2;
  for (;;) {
    int it = pop_block(ctr2, nullptr);
    if (it >= 2208) break;
    if (it < 2048) { const int c = 64 - (it >> 5), pair = it & 31; attn_block(p, 1, pair >> 3, c, pair & 7); }
    else if (it < 2176) { const int r = it - 2048; attn_block(p, 0, r >> 3, 0, r & 7); }
    else { const int pair = it - 2176; attn_block(p, 1, pair >> 3, 0, pair & 7); }
  }
}

DI Params fresh(const Params& p) {
  Params q = p;
  int z = 0;
  asm volatile("s_mov_b32 %0, 0" : "=s"(z));
  q.ws = p.ws + z;
  q.out = p.out + z;
  return q;
}
DI int fresh_i(int v) {
  asm volatile("" : "+s"(v));
  return v;
}

__shared__ uint4 xb_words;

__global__ void __launch_bounds__(256, 2) fwd_megakernel(Params p) {
  cg::grid_group grid = cg::this_grid();
  if (threadIdx.x == 0) xb_words = make_uint4(0u, 0u, 0u, 0u);
  __syncthreads();
  XcdBarrier xb = xcd_barrier_post((unsigned*)(p.ws + W_BAR), (volatile LAS unsigned*)&xb_words);
  if (threadIdx.x == 0) sh_xinfo[0] = (int)atomicAdd((unsigned*)(p.ws + W_CTR) + 128 + xb.x, 1u);
  prep_phase(fresh(p), smem);
  grid.sync();
  if (threadIdx.x == 0) {
    unsigned* bar = (unsigned*)(p.ws + W_BAR);
    int na = 0, ia = 0, nloc = 1;
    for (unsigned j = 0; j < 16; ++j) {
      const unsigned cj = xb_ld(&bar[XB_XCNT(j)]);
      if (cj > 0u) { if (j < xb.x) ++ia; ++na; }
      if (j == xb.x) nloc = (int)cj;
    }
    sh_xinfo[1] = nloc > 0 ? nloc : 1; sh_xinfo[2] = ia; sh_xinfo[3] = na > 0 ? na : 1;
  }
  __syncthreads();
#if PROBE == 6
#pragma unroll 1
  for (int i = 0; i < 10; ++i) xcd_barrier(xb);
#endif
#pragma unroll 1
  for (int layer = 0; layer < 2; ++layer) {
    phase_inproj(fresh(p), fresh_i(layer), smem);
    xcd_barrier(xb);
#if PROBE == 2
    probe_select(fresh(p), fresh_i(layer));
    xcd_barrier(xb);
#endif
    phase_b1(fresh(p), fresh_i(layer), smem, &sh_item);
    xcd_barrier(xb);
#if PROBE == 3
    probe_attn(fresh(p), fresh_i(layer));
    xcd_barrier(xb);
#endif
    phase_b2(fresh(p), fresh_i(layer), smem, &sh_item);
    xcd_barrier(xb);
    phase_merge(fresh(p), fresh_i(layer), smem);
    xcd_barrier(xb);
#if PROBE == 4
    phase_merge(fresh(p), fresh_i(layer), smem);
    xcd_barrier(xb);
#endif
    phase_out(fresh(p), fresh_i(layer), smem);
    xcd_barrier(xb);
    if (layer == 0) { convert_cache(fresh(p), 1, smem); norm_phase(fresh(p), 1); xcd_barrier(xb); }
    else norm_phase(fresh(p), 2);
  }
}

extern "C" void kernel_launch(void* const* d_in, const int* in_sizes, int n_in, void* d_out, int out_size, void* d_ws,
                              size_t ws_size, hipStream_t stream) {
  constexpr int kDynLds = 65536;
  static int grid_blocks = 0;
  if (!grid_blocks) {
    int dev = 0, cus = 0, per_cu = 0;
    hipGetDevice(&dev);
    hipDeviceGetAttribute(&cus, hipDeviceAttributeMultiprocessorCount, dev);
    hipFuncSetAttribute((const void*)fwd_megakernel, hipFuncAttributeMaxDynamicSharedMemorySize, kDynLds);
    hipOccupancyMaxActiveBlocksPerMultiprocessor(&per_cu, fwd_megakernel, 256, kDynLds);
    if (per_cu > 2) per_cu = 2;
    if (per_cu < 1) per_cu = 1;
    grid_blocks = cus * per_cu;
  }
  if (ws_size < W_END) { fprintf(stderr, "workspace too small: %zu < %zu\n", ws_size, (size_t)W_END); return; }
  Params p{};
  const float** f = (const float**)&p;
  for (int i = 0; i < 23; ++i) f[i] = (const float*)d_in[i];
  p.out = (float*)d_out;
  p.ws = (char*)d_ws;
  hipMemsetAsync(d_ws, 0, 32768, stream);
  void* args[] = {&p};
  hipError_t e = hipLaunchCooperativeKernel((void*)fwd_megakernel, dim3(grid_blocks), dim3(256), args, kDynLds, stream);
  if (e != hipSuccess) fprintf(stderr, "cooperative launch failed: %s (grid %d)\n", hipGetErrorString(e), grid_blocks);
}
```

```cpp
#include <hip/hip_runtime.h>
#include <hip/hip_cooperative_groups.h>
#include <stdint.h>
#include <cstdio>
namespace cg = cooperative_groups;
#ifndef PROBE
#define PROBE 0
#endif

typedef unsigned short bfr;
typedef __attribute__((ext_vector_type(8))) short bf16x8;
typedef __attribute__((ext_vector_type(4))) float f32x4;
typedef __attribute__((ext_vector_type(2))) float f32x2;
typedef __attribute__((ext_vector_type(2))) __bf16 bf2_t;
#define DI __device__ __forceinline__
#define MFMA16(a, b, c) __builtin_amdgcn_mfma_f32_16x16x32_bf16((a), (b), (c), 0, 0, 0)

constexpr int DM = 1024;
constexpr int NB_P = 4, T_P = 4112, SEQ_P = 4096, NMETA = 16;
constexpr int NB_S = 16, T_S = 64, PAST = 2048, S_S = 2112;
constexpr int ROWS_P = NB_P * T_P;
constexpr int ROWS = ROWS_P + NB_S * T_S;
constexpr int MPAD = 17536;
constexpr int NIN = 7492, NPAD = 7552;
constexpr int KP_PAD = 4128;
constexpr int MW = 132;
constexpr int NTILE_P = 65;

constexpr int C_Q = 0, C_K = 512, C_V = 1024, C_GA = 1536, C_QI = 2048, C_KI = 2304, C_XB = 2368, C_GB = 2880,
              C_XC = 3392, C_GC = 3904, C_GM = 4416, C_WI = 7488;

constexpr long O_YP = 0;
constexpr long O_YS = O_YP + (long)NB_P * SEQ_P * DM;
constexpr long O_KP = O_YS + (long)NB_S * T_S * DM;
constexpr long O_VP = O_KP + 2L * NB_P * T_P * 512;
constexpr long O_KIP = O_VP + 2L * NB_P * T_P * 512;
constexpr long O_CONVP = O_KIP + 2L * NB_P * T_P * 64;
constexpr long O_LRUP = O_CONVP + 2L * NB_P * 3 * 512;
constexpr long O_POOLP = O_LRUP + 2L * NB_P * 512;
constexpr long O_KS = O_POOLP + 2L * NB_P * 15 * 512;
constexpr long O_VS = O_KS + 2L * NB_S * T_S * 512;
constexpr long O_KIS = O_VS + 2L * NB_S * T_S * 512;
constexpr long O_CONVS = O_KIS + 2L * NB_S * T_S * 64;
constexpr long O_LRUS = O_CONVS + 2L * NB_S * 3 * 512;
constexpr long O_POOLS = O_LRUS + 2L * NB_S * 512;

constexpr size_t al256(size_t x) { return (x + 255) & ~(size_t)255; }
constexpr size_t W_CTR = 0;
constexpr size_t W_BAR = 4096;
constexpr size_t W_ROPE = 32768;
constexpr size_t W_WINT = al256(W_ROPE + (size_t)T_P * 8 * 8);
constexpr size_t W_WBT = al256(W_WINT + 2ull * NPAD * 1024 * 2);
constexpr size_t W_WOT = al256(W_WBT + 2ull * 3 * 1024 * 512 * 2);
constexpr size_t W_WAT = al256(W_WOT + 2ull * 1024 * 1024 * 2);
constexpr size_t W_WXT = al256(W_WAT + 2ull * 8 * 64 * 64 * 2);
constexpr size_t W_PWT = al256(W_WXT + 2ull * 8 * 64 * 64 * 2);
constexpr size_t W_XRES = al256(W_PWT + 2ull * 4 * 128 * 128 * 2);
constexpr size_t W_HN = al256(W_XRES + (size_t)MPAD * 1024 * 4);
constexpr size_t W_QB = al256(W_HN + (size_t)MPAD * 1024 * 2);
constexpr size_t W_GA = al256(W_QB + (size_t)MPAD * 512 * 2);
constexpr size_t W_QIB = al256(W_GA + (size_t)MPAD * 512 * 2);
constexpr size_t W_WIB = al256(W_QIB + (size_t)MPAD * 256 * 2);
constexpr size_t W_XBB = al256(W_WIB + (size_t)MPAD * 4 * 4);
constexpr size_t W_GB = al256(W_XBB + (size_t)MPAD * 512 * 2);
constexpr size_t W_XCB = al256(W_GB + (size_t)MPAD * 512 * 2);
constexpr size_t W_GC = al256(W_XCB + (size_t)MPAD * 512 * 2);
constexpr size_t W_GM = al256(W_GC + (size_t)MPAD * 512 * 2);
constexpr size_t W_KBP = al256(W_GM + (size_t)MPAD * 3072 * 2);
constexpr size_t W_VTP = al256(W_KBP + (size_t)NB_P * KP_PAD * 512 * 2);
constexpr size_t W_KIBP = al256(W_VTP + (size_t)NB_P * 512 * KP_PAD * 2);
constexpr size_t W_KBS = al256(W_KIBP + (size_t)NB_P * KP_PAD * 64 * 2);
constexpr size_t W_VTS = al256(W_KBS + (size_t)NB_S * S_S * 512 * 2);
constexpr size_t W_KIBS = al256(W_VTS + (size_t)NB_S * 512 * S_S * 2);
constexpr size_t W_MASK = al256(W_KIBS + (size_t)NB_S * S_S * 64 * 2);
constexpr size_t W_AGG = al256(W_MASK + (size_t)ROWS * MW * 4);
constexpr size_t W_KMAX = al256(W_AGG + (size_t)NB_P * NTILE_P * 512 * 2 * 4);
constexpr size_t W_END = al256(W_KMAX + 1024);

struct Params {
  const float *x_prompt, *x_sample, *cache_k, *cache_v, *cache_kidx, *state_conv, *state_lru, *state_pool, *meta,
      *norm_g, *w_in, *conv_w, *conv_b, *lru_wa, *lru_ba, *lru_wx, *lru_bx, *lru_lambda, *pool_w, *pool_scale,
      *w_branch_out, *w_out, *final_g;
  float* out;
  char* ws;
};

extern __shared__ __attribute__((aligned(128))) char smem[];
__shared__ int sh_item;
__shared__ int sh_xinfo[4];

DI float bf2f(bfr b) { return __uint_as_float(((unsigned)b) << 16); }
DI unsigned pack2(float a, float b) {
  f32x2 v = {a, b};
  bf2_t r = __builtin_convertvector(v, bf2_t);
  return __builtin_bit_cast(unsigned, r);
}
DI bfr f2bf(float x) { return (bfr)(pack2(x, 0.f) & 0xFFFFu); }
DI float sigm(float x) { return __builtin_amdgcn_rcpf(1.f + __expf(-x)); }
DI float silu(float x) { return x * __builtin_amdgcn_rcpf(1.f + __expf(-x)); }
DI int get_tid() {
  int t = threadIdx.x;
  asm volatile("" : "+v"(t));
  return t;
}
DI unsigned sortable(float f) {
  unsigned u = __float_as_uint(f);
  return (u & 0x80000000u) ? ~u : (u | 0x80000000u);
}
DI void decode_row(int row, int& isP, int& sq, int& t) {
  if (row < ROWS_P) { isP = 1; sq = row / T_P; t = row - sq * T_P; }
  else { isP = 0; int r = row - ROWS_P; sq = r >> 6; t = r & 63; }
}

DI void tc_tile(const float* src, long sld, bfr* dst, long dld, int k0, int n0, float* tile, int mapmode) {
  const int tid = get_tid();
  const int nn = tid & 63, kk0 = tid >> 6;
  int n = n0 + nn, sn = n;
  if (mapmode) sn = n < 2368 ? n : (n < 7488 ? n + 4 : (n < 7492 ? 2368 + (n - 7488) : -1));
  float v[16];
#pragma unroll
  for (int i = 0; i < 16; ++i) v[i] = sn >= 0 ? src[(long)(k0 + i * 4 + kk0) * sld + sn] : 0.f;
#pragma unroll
  for (int i = 0; i < 16; ++i) tile[(i * 4 + kk0) * 65 + nn] = v[i];
  __syncthreads();
#pragma unroll
  for (int i = 0; i < 16; ++i) {
    int nn2 = i * 4 + (tid >> 6), kk = tid & 63;
    dst[(long)(n0 + nn2) * dld + k0 + kk] = f2bf(tile[kk * 65 + nn2]);
  }
  __syncthreads();
}

DI void convert_cache(const Params& p, int layer, char*) {
  const int tid = get_tid();
  bfr* kbs = (bfr*)(p.ws + W_KBS);
  bfr* vts = (bfr*)(p.ws + W_VTS);
  bfr* kibs = (bfr*)(p.ws + W_KIBS);
  for (int it = blockIdx.x; it < NB_S * 32 * 8; it += gridDim.x) {
    int sb = it >> 8, r = it & 255, kt = r >> 3, nt = r & 7;
    tc_tile(p.cache_v + ((long)(layer * NB_S + sb) * PAST) * 512, 512, vts + (long)sb * 512 * S_S, S_S, kt * 64, nt * 64,
            (float*)smem, 0);
  }
  {
    const float4* src = (const float4*)(p.cache_k + (long)layer * NB_S * PAST * 512);
    const long n4 = (long)NB_S * PAST * 512 / 4;
    const long stride = (long)gridDim.x * 256;
    for (long i = (long)blockIdx.x * 256 + tid; i < n4; i += 4 * stride) {
      float4 v[4];
#pragma unroll
      for (int u = 0; u < 4; ++u) { const long ii = i + u * stride; v[u] = ii < n4 ? src[ii] : make_float4(0.f, 0.f, 0.f, 0.f); }
#pragma unroll
      for (int u = 0; u < 4; ++u) {
        const long ii = i + u * stride;
        if (ii < n4) {
          const long e = ii * 4;
          const int sb = (int)(e / ((long)PAST * 512));
          const long rem = e - (long)sb * PAST * 512;
          uint2 o; o.x = pack2(v[u].x, v[u].y); o.y = pack2(v[u].z, v[u].w);
          *(uint2*)(kbs + (long)sb * S_S * 512 + rem) = o;
        }
      }
    }
  }
  {
    const float4* src = (const float4*)(p.cache_kidx + (long)layer * NB_S * PAST * 64);
    const long n4 = (long)NB_S * PAST * 64 / 4;
    const long stride = (long)gridDim.x * 256;
    for (long i = (long)blockIdx.x * 256 + tid; i < n4; i += 4 * stride) {
      float4 v[4];
#pragma unroll
      for (int u = 0; u < 4; ++u) { const long ii = i + u * stride; v[u] = ii < n4 ? src[ii] : make_float4(0.f, 0.f, 0.f, 0.f); }
#pragma unroll
      for (int u = 0; u < 4; ++u) {
        const long ii = i + u * stride;
        if (ii < n4) {
          const long e = ii * 4;
          const int sb = (int)(e / ((long)PAST * 64));
          const long rem = e - (long)sb * PAST * 64;
          uint2 o; o.x = pack2(v[u].x, v[u].y); o.y = pack2(v[u].z, v[u].w);
          *(uint2*)(kibs + (long)sb * S_S * 64 + rem) = o;
        }
      }
    }
  }
}

DI void norm_phase(const Params& p, int mode) {
  const int tid = get_tid(), wid = __builtin_amdgcn_readfirstlane(tid >> 6), lane = tid & 63;
  float* xres = (float*)(p.ws + W_XRES);
  bfr* hn = (bfr*)(p.ws + W_HN);
  const float* g = mode == 0 ? p.norm_g : (mode == 1 ? p.norm_g + 1024 : p.final_g);
  for (int row = blockIdx.x * 4 + wid; row < ROWS; row += gridDim.x * 4) {
    int isP, sq, t;
    decode_row(row, isP, sq, t);
    const float* src;
    if (mode == 0) {
      if (isP) src = t < NMETA ? p.meta + (long)t * 1024 : p.x_prompt + ((long)sq * SEQ_P + t - NMETA) * 1024;
      else src = p.x_sample + (long)(row - ROWS_P) * 1024;
    } else src = xres + (long)row * 1024;
    float4 v[4];
    float ss = 0.f;
#pragma unroll
    for (int i = 0; i < 4; ++i) {
      v[i] = ((const float4*)src)[lane + i * 64];
      ss += v[i].x * v[i].x + v[i].y * v[i].y + v[i].z * v[i].z + v[i].w * v[i].w;
    }
#pragma unroll
    for (int o = 32; o >= 1; o >>= 1) ss += __shfl_xor(ss, o);
    const float inv = rsqrtf(ss * (1.f / 1024.f) + 1e-6f);
    float* dsty = nullptr;
    if (mode == 2) {
      if (isP) { if (t >= NMETA) dsty = p.out + O_YP + ((long)sq * SEQ_P + t - NMETA) * 1024; }
      else dsty = p.out + O_YS + (long)(row - ROWS_P) * 1024;
    }
#pragma unroll
    for (int i = 0; i < 4; ++i) {
      float4 gg = ((const float4*)g)[lane + i * 64];
      float4 y;
      y.x = v[i].x * inv * gg.x; y.y = v[i].y * inv * gg.y; y.z = v[i].z * inv * gg.z; y.w = v[i].w * inv * gg.w;
      if (mode == 0) ((float4*)(xres + (long)row * 1024))[lane + i * 64] = v[i];
      if (mode < 2) {
        uint2 o; o.x = pack2(y.x, y.y); o.y = pack2(y.z, y.w);
        *(uint2*)(hn + (long)row * 1024 + (lane + i * 64) * 4) = o;
      } else if (dsty) ((float4*)dsty)[lane + i * 64] = y;
    }
  }
}

DI void prep_phase(const Params& p, char*) {
  const int tid = get_tid();
  for (int it = blockIdx.x; it < 2 * 118 * 16; it += gridDim.x) {
    int l = it / (118 * 16), r = it % (118 * 16), nt = r / 16, kt = r % 16;
    tc_tile(p.w_in + (long)l * 1024 * NIN, NIN, (bfr*)(p.ws + W_WINT) + (long)l * NPAD * 1024, 1024, kt * 64, nt * 64,
            (float*)smem, 1);
  }
  for (int it = blockIdx.x; it < 6 * 16 * 8; it += gridDim.x) {
    int mtx = it / 128, r = it % 128, nt = r / 8, kt = r % 8;
    tc_tile(p.w_branch_out + (long)mtx * 512 * 1024, 1024, (bfr*)(p.ws + W_WBT) + (long)mtx * 1024 * 512, 512, kt * 64,
            nt * 64, (float*)smem, 0);
  }
  for (int it = blockIdx.x; it < 2 * 16 * 16; it += gridDim.x) {
    int l = it / 256, r = it % 256, nt = r / 16, kt = r % 16;
    tc_tile(p.w_out + (long)l * 1024 * 1024, 1024, (bfr*)(p.ws + W_WOT) + (long)l * 1024 * 1024, 1024, kt * 64, nt * 64,
            (float*)smem, 0);
  }
  for (int it = blockIdx.x; it < 32; it += gridDim.x) {
    int which = it >> 4, mtx = it & 15;
    tc_tile((which ? p.lru_wx : p.lru_wa) + (long)mtx * 4096, 64, (bfr*)(p.ws + (which ? W_WXT : W_WAT)) + (long)mtx * 4096,
            64, 0, 0, (float*)smem, 0);
  }
  for (int it = blockIdx.x; it < 32; it += gridDim.x) {
    int mtx = it >> 2, r = it & 3, nt = r >> 1, kt = r & 1;
    tc_tile(p.pool_w + (long)mtx * 16384, 128, (bfr*)(p.ws + W_PWT) + (long)mtx * 16384, 128, kt * 64, nt * 64,
            (float*)smem, 0);
  }
  {
    float2* rt = (float2*)(p.ws + W_ROPE);
    for (int e = blockIdx.x * 256 + tid; e < T_P * 8; e += gridDim.x * 256) {
      int pos = e >> 3, d = e & 7;
      float inv = powf(500000.f, -(float)d * 0.125f);
      float ang = (float)pos * inv;
      rt[e] = make_float2(cosf(ang), sinf(ang));
    }
  }
  convert_cache(p, 0, smem);
  norm_phase(p, 0);
}

template <int NF>
DI void gemm128(const bfr* A, int lda, const bfr* Bt, int ldb, int K, int brow, int bcol, char*, f32x4 (&acc)[4][NF]) {
  const int tid = get_tid(), wid = __builtin_amdgcn_readfirstlane(tid >> 6), lane = tid & 63, wr = wid >> 1, wc = wid & 1, fr = lane & 15, fq = lane >> 4;
  const int r0 = tid >> 3;
  const int cg = ((tid & 7) ^ (r0 & 7)) * 8;
  const bfr* ga = A + (long)(brow + r0) * lda + cg;
  const bfr* gb = Bt + (long)(bcol + r0) * ldb + cg;
  const long a32 = (long)32 * lda, b32 = (long)32 * ldb;
  const int nk = K / 64;
  auto stage = [&](int kt, int buf) {
    char* SA = smem + buf * 32768;
    char* SB = SA + 16384;
#pragma unroll
    for (int i = 0; i < 4; ++i)
      __builtin_amdgcn_global_load_lds((const unsigned*)(ga + i * a32 + kt * 64), (unsigned*)(SA + tid * 16 + i * 4096), 16, 0, 0);
#pragma unroll
    for (int i = 0; i < NF; ++i)
      __builtin_amdgcn_global_load_lds((const unsigned*)(gb + i * b32 + kt * 64), (unsigned*)(SB + tid * 16 + i * 4096), 16, 0, 0);
  };
  asm volatile("s_waitcnt vmcnt(0)" ::: "memory");
  __syncthreads();
  stage(0, 0);
  const unsigned lds0 = (unsigned)(size_t)smem;
  const unsigned sw0 = (unsigned)((fq ^ (fr & 7)) * 16), sw1 = (unsigned)(((4 + fq) ^ (fr & 7)) * 16);
  const unsigned arow = lds0 + (wr * 64 + fr) * 128, brw = lds0 + 16384 + (wc * NF * 16 + fr) * 128;
  for (int kt = 0; kt < nk; ++kt) {
    asm volatile("s_waitcnt vmcnt(0)" ::: "memory");
    __builtin_amdgcn_s_barrier();
    if (kt + 1 < nk) stage(kt + 1, (kt + 1) & 1);
    const unsigned bo = (kt & 1) * 32768;
    bf16x8 af[2][4], bfg[2][4];
    if (NF == 4) {
      asm volatile(
          "ds_read_b128 %0, %16\n\tds_read_b128 %1, %16 offset:2048\n\tds_read_b128 %2, %16 offset:4096\n\tds_read_b128 %3, %16 offset:6144\n\t"
          "ds_read_b128 %4, %17\n\tds_read_b128 %5, %17 offset:2048\n\tds_read_b128 %6, %17 offset:4096\n\tds_read_b128 %7, %17 offset:6144\n\t"
          "ds_read_b128 %8, %18\n\tds_read_b128 %9, %18 offset:2048\n\tds_read_b128 %10, %18 offset:4096\n\tds_read_b128 %11, %18 offset:6144\n\t"
          "ds_read_b128 %12, %19\n\tds_read_b128 %13, %19 offset:2048\n\tds_read_b128 %14, %19 offset:4096\n\tds_read_b128 %15, %19 offset:6144\n\t"
          "s_waitcnt lgkmcnt(0)"
          : "=&v"(af[0][0]), "=&v"(af[0][1]), "=&v"(af[0][2]), "=&v"(af[0][3]), "=&v"(bfg[0][0]), "=&v"(bfg[0][1]), "=&v"(bfg[0][2]), "=&v"(bfg[0][3]),
            "=&v"(af[1][0]), "=&v"(af[1][1]), "=&v"(af[1][2]), "=&v"(af[1][3]), "=&v"(bfg[1][0]), "=&v"(bfg[1][1]), "=&v"(bfg[1][2]), "=&v"(bfg[1][3])
          : "v"(arow + sw0 + bo), "v"(brw + sw0 + bo), "v"(arow + sw1 + bo), "v"(brw + sw1 + bo)
          : "memory");
    } else {
      asm volatile(
          "ds_read_b128 %0, %12\n\tds_read_b128 %1, %12 offset:2048\n\tds_read_b128 %2, %12 offset:4096\n\tds_read_b128 %3, %12 offset:6144\n\t"
          "ds_read_b128 %4, %13\n\tds_read_b128 %5, %13 offset:2048\n\t"
          "ds_read_b128 %6, %14\n\tds_read_b128 %7, %14 offset:2048\n\tds_read_b128 %8, %14 offset:4096\n\tds_read_b128 %9, %14 offset:6144\n\t"
          "ds_read_b128 %10, %15\n\tds_read_b128 %11, %15 offset:2048\n\t"
          "s_waitcnt lgkmcnt(0)"
          : "=&v"(af[0][0]), "=&v"(af[0][1]), "=&v"(af[0][2]), "=&v"(af[0][3]), "=&v"(bfg[0][0]), "=&v"(bfg[0][1]),
            "=&v"(af[1][0]), "=&v"(af[1][1]), "=&v"(af[1][2]), "=&v"(af[1][3]), "=&v"(bfg[1][0]), "=&v"(bfg[1][1])
          : "v"(arow + sw0 + bo), "v"(brw + sw0 + bo), "v"(arow + sw1 + bo), "v"(brw + sw1 + bo)
          : "memory");
    }
#pragma unroll
    for (int ks = 0; ks < 2; ++ks)
#pragma unroll
      for (int m = 0; m < 4; ++m)
#pragma unroll
        for (int n = 0; n < NF; ++n) acc[m][n] = MFMA16(af[ks][m], bfg[ks][n], acc[m][n]);
  }
}

constexpr int EPI_PITCH = 72;
template <int REG>
DI void epi_region(const Params& p, int layer, f32x4 (&acc)[4][4], int rbase0, int rel, int lane, int wid) {
  const int fr = lane & 15, fq = lane >> 4;
  const float2* rt = (const float2*)(p.ws + W_ROPE);
  constexpr bool doRope = (REG == 0 || REG == 1 || REG == 4 || REG == 5);
  constexpr bool staged = (REG != 2 && REG != 11);
  bfr* img = (bfr*)(smem + wid * (64 * EPI_PITCH * 2));
#pragma unroll
  for (int m = 0; m < 4; ++m) {
    const int rbase = rbase0 + m * 16 + fq * 4;
    const bool rowsValid = rbase < ROWS;
    int isP, sq, t0;
    decode_row(rowsValid ? rbase : 0, isP, sq, t0);
    if (doRope) {
      const int pos0 = isP ? t0 : PAST + t0;
#pragma unroll
      for (int j = 0; j < 4; ++j) {
        float v = acc[m][0][j];
        float pv = __shfl_xor(v, 8);
        float2 cs = rt[(pos0 + j) * 8 + (fr & 7)];
        acc[m][0][j] = (fr < 8) ? (v * cs.x - pv * cs.y) : (v * cs.x + pv * cs.y);
      }
    }
#pragma unroll
    for (int n = 0; n < 4; ++n) {
      const int col = rel + n * 16 + fr;
      if (REG == 2 && rowsValid) {
        uint2 pk; pk.x = pack2(acc[m][n][0], acc[m][n][1]); pk.y = pack2(acc[m][n][2], acc[m][n][3]);
        if (isP) *(uint2*)((bfr*)(p.ws + W_VTP) + ((long)sq * 512 + col) * KP_PAD + t0) = pk;
        else *(uint2*)((bfr*)(p.ws + W_VTS) + ((long)sq * 512 + col) * S_S + PAST + t0) = pk;
      }
#pragma unroll
      for (int j = 0; j < 4; ++j) {
        const float v = acc[m][n][j];
        const int row = rbase + j, t = t0 + j;
        if (rowsValid) {
          if (REG == 1) { if (isP) p.out[O_KP + ((long)(layer * NB_P + sq) * T_P + t) * 512 + col] = v; else p.out[O_KS + ((long)(layer * NB_S + sq) * T_S + t) * 512 + col] = v; }
          if (REG == 2) { if (isP) p.out[O_VP + ((long)(layer * NB_P + sq) * T_P + t) * 512 + col] = v; else p.out[O_VS + ((long)(layer * NB_S + sq) * T_S + t) * 512 + col] = v; }
          if (REG == 5) { if (isP) p.out[O_KIP + ((long)(layer * NB_P + sq) * T_P + t) * 64 + col] = v; else p.out[O_KIS + ((long)(layer * NB_S + sq) * T_S + t) * 64 + col] = v; }
          if (REG == 6) {
            if (isP) { if (t >= T_P - 3) p.out[O_CONVP + ((long)(layer * NB_P + sq) * 3 + (t - (T_P - 3))) * 512 + col] = v; }
            else { if (t >= T_S - 3) p.out[O_CONVS + ((long)(layer * NB_S + sq) * 3 + (t - (T_S - 3))) * 512 + col] = v; }
          }
          if (REG == 8) {
            if (isP) { if (t >= T_P - 15) p.out[O_POOLP + ((long)(layer * NB_P + sq) * 15 + (t - (T_P - 15))) * 512 + col] = v; }
            else { if (t >= T_S - 15) p.out[O_POOLS + ((long)(layer * NB_S + sq) * 15 + (t - (T_S - 15))) * 512 + col] = v; }
          }
          if (REG == 11) { if (col < 4) ((float*)(p.ws + W_WIB))[(long)row * 4 + col] = v; }
        }
        if (staged) {
          float y = v;
          if (REG == 3 || REG == 7 || REG == 9) y = silu(v);
          if (REG == 10) y = sigm(v);
          img[(m * 16 + fq * 4 + j) * EPI_PITCH + n * 16 + fr] = f2bf(y);
        }
      }
    }
  }
  if (staged) {
    asm volatile("s_waitcnt lgkmcnt(0)" ::: "memory");
#pragma unroll
    for (int it = 0; it < 8; ++it) {
      const int r = it * 8 + (lane >> 3), ch = lane & 7;
      const int row = rbase0 + r;
      if (row < ROWS) {
        int isP, sq, t;
        decode_row(row, isP, sq, t);
        bfr* dst;
        if (REG == 0) dst = (bfr*)(p.ws + W_QB) + (long)row * 512;
        else if (REG == 1) dst = isP ? (bfr*)(p.ws + W_KBP) + ((long)sq * KP_PAD + t) * 512 : (bfr*)(p.ws + W_KBS) + ((long)sq * S_S + PAST + t) * 512;
        else if (REG == 3) dst = (bfr*)(p.ws + W_GA) + (long)row * 512;
        else if (REG == 4) dst = (bfr*)(p.ws + W_QIB) + (long)row * 256;
        else if (REG == 5) dst = isP ? (bfr*)(p.ws + W_KIBP) + ((long)sq * KP_PAD + t) * 64 : (bfr*)(p.ws + W_KIBS) + ((long)sq * S_S + PAST + t) * 64;
        else if (REG == 6) dst = (bfr*)(p.ws + W_XBB) + (long)row * 512;
        else if (REG == 7) dst = (bfr*)(p.ws + W_GB) + (long)row * 512;
        else if (REG == 8) dst = (bfr*)(p.ws + W_XCB) + (long)row * 512;
        else if (REG == 9) dst = (bfr*)(p.ws + W_GC) + (long)row * 512;
        else dst = (bfr*)(p.ws + W_GM) + (long)row * 3072;
        const uint4 val = *(const uint4*)(img + r * EPI_PITCH + ch * 8);
        *(uint4*)(dst + rel + ch * 8) = val;
      }
    }
  }
}

DI void epi_inproj(const Params& p, int layer, f32x4 (&acc)[4][4], int brow, int bcol) {
  const int tid = get_tid(), wid = __builtin_amdgcn_readfirstlane(tid >> 6), lane = tid & 63, wr = wid >> 1, wc = wid & 1;
  const int c0 = bcol + wc * 64;
  const int rb = brow + wr * 64;
  __syncthreads();
  if (c0 < C_K) epi_region<0>(p, layer, acc, rb, c0 - C_Q, lane, wid);
  else if (c0 < C_V) epi_region<1>(p, layer, acc, rb, c0 - C_K, lane, wid);
  else if (c0 < C_GA) epi_region<2>(p, layer, acc, rb, c0 - C_V, lane, wid);
  else if (c0 < C_QI) epi_region<3>(p, layer, acc, rb, c0 - C_GA, lane, wid);
  else if (c0 < C_KI) epi_region<4>(p, layer, acc, rb, c0 - C_QI, lane, wid);
  else if (c0 < C_XB) epi_region<5>(p, layer, acc, rb, c0 - C_KI, lane, wid);
  else if (c0 < C_GB) epi_region<6>(p, layer, acc, rb, c0 - C_XB, lane, wid);
  else if (c0 < C_XC) epi_region<7>(p, layer, acc, rb, c0 - C_GB, lane, wid);
  else if (c0 < C_GC) epi_region<8>(p, layer, acc, rb, c0 - C_XC, lane, wid);
  else if (c0 < C_GM) epi_region<9>(p, layer, acc, rb, c0 - C_GC, lane, wid);
  else if (c0 < C_WI) epi_region<10>(p, layer, acc, rb, c0 - C_GM, lane, wid);
  else epi_region<11>(p, layer, acc, rb, c0 - C_WI, lane, wid);
}

DI void phase_inproj(const Params& p, int layer, char*) {
  const bfr* A = (const bfr*)(p.ws + W_HN);
  const bfr* Bt = (const bfr*)(p.ws + W_WINT) + (long)layer * NPAD * 1024;
  constexpr int NTM = MPAD / 128, NTN = NPAD / 128;
  const int rank = sh_xinfo[0], nloc = sh_xinfo[1], ia = sh_xinfo[2], na = sh_xinfo[3];
  const int nbase = NTN / na, nrem = NTN % na;
  const int nn = nbase + (ia < nrem ? 1 : 0), n0 = ia * nbase + min(ia, nrem);
#if PROBE == 1
#pragma unroll 1
  for (int rep = 0; rep < 2; ++rep)
#endif
  for (int i = rank; i < NTM * nn; i += nloc) {
    const int tm = i / nn, tn = n0 + (i - tm * nn);
    f32x4 acc[4][4];
#pragma unroll
    for (int m = 0; m < 4; ++m)
#pragma unroll
      for (int n = 0; n < 4; ++n) acc[m][n] = f32x4{0.f, 0.f, 0.f, 0.f};
    gemm128<4>(A, 1024, Bt, 1024, 1024, tm * 128, tn * 128, smem, acc);
    epi_inproj(p, layer, acc, tm * 128, tn * 128);
  }
}

DI void phase_merge(const Params& p, int layer, char*) {
  const int tid = get_tid(), wid = __builtin_amdgcn_readfirstlane(tid >> 6), lane = tid & 63, wr = wid >> 1, wc = wid & 1, fr = lane & 15, fq = lane >> 4;
  const bfr* gmb = (const bfr*)(p.ws + W_GM);
  bfr* merged = (bfr*)(p.ws + W_HN);
  constexpr int NTM = MPAD / 128, NTN = 8;
  for (int tile = blockIdx.x; tile < NTM * NTN; tile += gridDim.x) {
    int tn = tile / NTM, tm = tile % NTM;
    const int brow = tm * 128, bcol = tn * 128;
    unsigned tot[4][4][2];
#pragma unroll
    for (int m = 0; m < 4; ++m)
#pragma unroll
      for (int n = 0; n < 4; ++n) { tot[m][n][0] = 0u; tot[m][n][1] = 0u; }
#pragma unroll 1
    for (int br = 0; br < 3; ++br) {
      const bfr* A = (const bfr*)(p.ws + (br == 0 ? W_GA : (br == 1 ? W_GB : W_GC)));
      const bfr* Bt = (const bfr*)(p.ws + W_WBT) + (long)(layer * 3 + br) * 1024 * 512;
      f32x4 acc[4][4];
#pragma unroll
      for (int m = 0; m < 4; ++m)
#pragma unroll
        for (int n = 0; n < 4; ++n) acc[m][n] = f32x4{0.f, 0.f, 0.f, 0.f};
      gemm128<4>(A, 512, Bt, 512, 512, brow, bcol, smem, acc);
#pragma unroll
      for (int m = 0; m < 4; ++m) {
        const int row0 = brow + wr * 64 + m * 16 + fq * 4;
        if (row0 < ROWS) {
#pragma unroll
          for (int n = 0; n < 4; ++n) {
            const int col = bcol + wc * 64 + n * 16 + fr;
            const bfr* gp = gmb + (long)row0 * 3072 + br * 1024 + col;
            const float g0 = bf2f(gp[0]), g1 = bf2f(gp[3072]), g2 = bf2f(gp[2 * 3072]), g3 = bf2f(gp[3 * 3072]);
            const unsigned t0 = tot[m][n][0], t1 = tot[m][n][1];
            tot[m][n][0] = pack2(__uint_as_float(t0 << 16) + g0 * acc[m][n][0], __uint_as_float(t0 & 0xFFFF0000u) + g1 * acc[m][n][1]);
            tot[m][n][1] = pack2(__uint_as_float(t1 << 16) + g2 * acc[m][n][2], __uint_as_float(t1 & 0xFFFF0000u) + g3 * acc[m][n][3]);
          }
        }
      }
    }
#pragma unroll
    for (int m = 0; m < 4; ++m) {
      const int row0 = brow + wr * 64 + m * 16 + fq * 4;
      if (row0 < ROWS) {
#pragma unroll
        for (int n = 0; n < 4; ++n) {
          bfr* mp = merged + (long)row0 * 1024 + bcol + wc * 64 + n * 16 + fr;
          mp[0] = (bfr)(tot[m][n][0] & 0xFFFFu); mp[1024] = (bfr)(tot[m][n][0] >> 16);
          mp[2048] = (bfr)(tot[m][n][1] & 0xFFFFu); mp[3072] = (bfr)(tot[m][n][1] >> 16);
        }
      }
    }
  }
}

DI void phase_out(const Params& p, int layer, char*) {
  const int tid = get_tid(), wid = __builtin_amdgcn_readfirstlane(tid >> 6), lane = tid & 63, wr = wid >> 1, wc = wid & 1, fr = lane & 15, fq = lane >> 4;
  const bfr* A = (const bfr*)(p.ws + W_HN);
  const bfr* Bt = (const bfr*)(p.ws + W_WOT) + (long)layer * 1024 * 1024;
  float* xres = (float*)(p.ws + W_XRES);
  constexpr int NTM = MPAD / 128, NTN = 8;
  for (int tile = blockIdx.x; tile < NTM * NTN; tile += gridDim.x) {
    int tn = tile / NTM, tm = tile % NTM;
    const int brow = tm * 128, bcol = tn * 128;
    f32x4 acc[4][4];
#pragma unroll
    for (int m = 0; m < 4; ++m)
#pragma unroll
      for (int n = 0; n < 4; ++n) acc[m][n] = f32x4{0.f, 0.f, 0.f, 0.f};
    gemm128<4>(A, 1024, Bt, 1024, 1024, brow, bcol, smem, acc);
#pragma unroll
    for (int m = 0; m < 4; ++m)
#pragma unroll
      for (int j = 0; j < 4; ++j) {
        int row = brow + wr * 64 + m * 16 + fq * 4 + j;
        if (row < ROWS) {
#pragma unroll
          for (int n = 0; n < 4; ++n) xres[(long)row * 1024 + bcol + wc * 64 + n * 16 + fr] += acc[m][n][j];
        }
      }
  }
}

constexpr int SEL_QS = 2120;
DI void select_item(const Params& p, int isP, int sq, int c, int sub, char*) {
  const int tid = get_tid(), wid = __builtin_amdgcn_readfirstlane(tid >> 6), lane = tid & 63, fr = lane & 15, fq = lane >> 4;
  int T0, nadm, rowbase;
  const bfr* kib;
  if (isP) {
    if (c == 0) { T0 = 0; nadm = 16; } else { T0 = 16 + 64 * (c - 1) + 16 * sub; nadm = 16 + 64 * c; }
    rowbase = sq * T_P;
    kib = (const bfr*)(p.ws + W_KIBP) + (long)sq * KP_PAD * 64;
  } else {
    T0 = 16 * sub; nadm = S_S; rowbase = ROWS_P + sq * 64;
    kib = (const bfr*)(p.ws + W_KIBS) + (long)sq * S_S * 64;
  }
  unsigned* maskg = (unsigned*)(p.ws + W_MASK);
  const int nsteps = (nadm + 31) >> 5;
  if (nadm <= 256) {
    for (int e = tid; e < 16 * nsteps; e += 256) {
      int q = e / nsteps, s = e - q * nsteps;
      unsigned w = (s * 32 + 32 <= nadm) ? 0xFFFFFFFFu : 0xFFFFu;
      maskg[(long)(rowbase + T0 + q) * MW + s] = w;
    }
    return;
  }
  const int nkt = nadm >> 4;
  const int nmine = (nkt - wid + 3) >> 2;
  const int nregs = (nadm + 63) >> 6;
  const bfr* qib = (const bfr*)(p.ws + W_QIB);
  const float* wib = (const float*)(p.ws + W_WIB);
  unsigned* S = (unsigned*)smem;
#pragma unroll 1
  for (int g = 0; g < 4; ++g) {
    const int qrow = rowbase + T0 + g * 4;
    int koff = (wid * 16 + fr) * 64 + fq * 8;
    asm volatile("" : "+v"(koff));
    const bfr* kbase = kib + koff;
    int nm = nmine;
    asm volatile("" : "+v"(nm));
    nm = __builtin_amdgcn_readfirstlane(nm);
    const bfr* qp = qib + (long)(qrow + (fr >> 2)) * 256 + (fr & 3) * 64 + fq * 8;
    const bf16x8 a0 = *(const bf16x8*)qp;
    const bf16x8 a1 = *(const bf16x8*)(qp + 32);
    const float4 w = *(const float4*)(wib + (long)(qrow + fq) * 4);
    unsigned sc[65];
#pragma unroll
    for (int ch = 0; ch < 5; ++ch) {
      if (ch * 13 < nm) {
        bf16x8 b0[13], b1[13];
#pragma unroll
        for (int u = 0; u < 13; ++u) {
          const int ic = min(ch * 13 + u, nm - 1);
          const bfr* kp = kbase + (long)ic * 4096;
          b0[u] = *(const bf16x8*)kp;
          b1[u] = *(const bf16x8*)(kp + 32);
        }
#pragma unroll
        for (int u = 0; u < 13; ++u) {
          const int i = ch * 13 + u;
          f32x4 a = {0.f, 0.f, 0.f, 0.f};
          a = MFMA16(a0, b0[u], a);
          a = MFMA16(a1, b1[u], a);
          float s = w.x * fmaxf(a[0], 0.f) + w.y * fmaxf(a[1], 0.f) + w.z * fmaxf(a[2], 0.f) + w.w * fmaxf(a[3], 0.f);
          sc[i] = (i < nm) ? sortable(s) : 0u;
        }
      } else {
#pragma unroll
        for (int u = 0; u < 13; ++u) sc[ch * 13 + u] = 0u;
      }
      __builtin_amdgcn_sched_barrier(0);
    }
    unsigned v[65];
    __syncthreads();
#pragma unroll
    for (int i = 0; i < 33; ++i) S[fq * SEL_QS + (i * 4 + wid) * 16 + fr] = sc[i];
    __syncthreads();
#pragma unroll
    for (int j = 0; j < 33; ++j) v[j] = S[wid * SEL_QS + j * 64 + lane];
    if (nregs > 33) {
      __syncthreads();
#pragma unroll
      for (int i = 33; i < 65; ++i) S[fq * SEL_QS + (i * 4 + wid - 132) * 16 + fr] = sc[i];
      __syncthreads();
#pragma unroll
      for (int j = 0; j < 32; ++j) v[33 + j] = S[wid * SEL_QS + j * 64 + lane];
    } else {
#pragma unroll
      for (int j = 0; j < 32; ++j) v[33 + j] = 0u;
    }
    int nr = nregs;
    asm volatile("" : "+v"(nr));
    nr = __builtin_amdgcn_readfirstlane(nr);
    unsigned vmax = 0u;
#pragma unroll
    for (int r = 0; r < 65; ++r) vmax = max(vmax, v[r]);
#pragma unroll
    for (int o = 32; o >= 1; o >>= 1) vmax = max(vmax, (unsigned)__shfl_xor((int)vmax, o));
    vmax = __builtin_amdgcn_readfirstlane(vmax);
    unsigned thr = 0u;
    int exact = 0;
#pragma unroll 1
    for (int bit = 31; bit >= 0; --bit) {
      const unsigned cand = thr | (1u << bit);
      if (cand > vmax) continue;
      int cnt = 0;
#pragma unroll
      for (int ch = 0; ch < 5; ++ch) {
        if (ch * 13 < nr) {
#pragma unroll
          for (int u = 0; u < 13; ++u) cnt += __popcll(__ballot(v[ch * 13 + u] >= cand));
        }
      }
      if (cnt >= 256) {
        thr = cand;
        if (cnt == 256) { exact = 1; break; }
      }
    }
    if (exact) {
      unsigned mn = 0xFFFFFFFFu;
#pragma unroll
      for (int r = 0; r < 65; ++r) mn = min(mn, v[r] >= thr ? v[r] : 0xFFFFFFFFu);
#pragma unroll
      for (int o = 32; o >= 1; o >>= 1) mn = min(mn, (unsigned)__shfl_xor((int)mn, o));
      thr = __builtin_amdgcn_readfirstlane(mn);
    }
    int gt = 0, eq = 0;
#pragma unroll
    for (int r = 0; r < 65; ++r) {
      gt += __popcll(__ballot(v[r] > thr));
      eq += __popcll(__ballot(v[r] == thr));
    }
    const int need = 256 - gt;
    int idxcut = 0x7fffffff;
    if (eq != need) {
      int run = 0;
      bool done = false;
#pragma unroll
      for (int r = 0; r < 65; ++r) {
        if (!done) {
          unsigned long long m = __ballot(v[r] == thr);
          int pc = __popcll(m);
          if (run + pc >= need) {
            const int k = need - run;
            for (int t = 1; t < k; ++t) m &= m - 1ull;
            idxcut = r * 64 + (__ffsll((long long)m) - 1);
            done = true;
          } else run += pc;
        }
      }
    }
    unsigned* mrowp = maskg + (long)(qrow + wid) * MW;
#pragma unroll
    for (int r = 0; r < 65; ++r) {
      if (r < nr) {
        const bool sel = (v[r] > thr) || (v[r] == thr && (r * 64 + lane) <= idxcut);
        const unsigned long long bal = __ballot(sel);
        if (lane == 0) *(uint2*)(mrowp + r * 2) = make_uint2((unsigned)bal, (unsigned)(bal >> 32));
      }
    }
  }
}

DI void lru_tile(const Params& p, int layer, int isP, int sq, int tile, int nb, int pass, char*) {
  const int tid = get_tid(), wid = __builtin_amdgcn_readfirstlane(tid >> 6), lane = tid & 63, fr = lane & 15, fq = lane >> 4;
  float* xbs = (float*)smem;
  float* as_ = xbs;
  float* xcs = xbs + 67 * 64;
  float* bs_ = xcs + 64 * 64;
  float* ab = bs_ + 64 * 64;
  bfr* xca = (bfr*)(ab + 512);
  const int T = isP ? T_P : T_S;
  const int rowbase = isP ? sq * T_P : ROWS_P + sq * 64;
  const int t0 = tile * 64, ch0 = nb * 64;
  const bfr* xbb = (const bfr*)(p.ws + W_XBB);
  bfr* gby = (bfr*)(p.ws + W_GB);
  float* agg = (float*)(p.ws + W_AGG);
  {
    const int c = tid & 63;
    float vv[17];
#pragma unroll
    for (int i = 0; i < 17; ++i) {
      const int rr = i * 4 + (tid >> 6);
      const int tt = t0 - 3 + rr;
      float v = 0.f;
      if (rr < 67) {
        if (tt < 0) { if (!isP) v = p.state_conv[((long)(layer * NB_S + sq) * 3 + (3 + tt)) * 512 + ch0 + c]; }
        else if (tt < T) v = bf2f(xbb[(long)(rowbase + tt) * 512 + ch0 + c]);
      }
      vv[i] = v;
    }
#pragma unroll
    for (int i = 0; i < 17; ++i) { const int rr = i * 4 + (tid >> 6); if (rr < 67) xbs[rr * 64 + c] = vv[i]; }
  }
  __syncthreads();
  {
    const int c = tid & 63;
    const float cb = p.conv_b[layer * 512 + ch0 + c];
    const float w0 = p.conv_w[(layer * 4 + 0) * 512 + ch0 + c], w1 = p.conv_w[(layer * 4 + 1) * 512 + ch0 + c],
                w2 = p.conv_w[(layer * 4 + 2) * 512 + ch0 + c], w3 = p.conv_w[(layer * 4 + 3) * 512 + ch0 + c];
    for (int t = tid >> 6; t < 64; t += 4) {
      float xc = cb + w0 * xbs[t * 64 + c] + w1 * xbs[(t + 1) * 64 + c] + w2 * xbs[(t + 2) * 64 + c] + w3 * xbs[(t + 3) * 64 + c];
      xcs[t * 64 + c] = xc;
      xca[t * 72 + c] = f2bf(xc);
    }
  }
  __syncthreads();
  {
    const bfr* WaT = (const bfr*)(p.ws + W_WAT) + (long)(layer * 8 + nb) * 4096;
    const bfr* WxT = (const bfr*)(p.ws + W_WXT) + (long)(layer * 8 + nb) * 4096;
    bf16x8 af0 = *(const bf16x8*)(xca + (wid * 16 + fr) * 72 + fq * 8);
    bf16x8 af1 = *(const bf16x8*)(xca + (wid * 16 + fr) * 72 + 32 + fq * 8);
#pragma unroll
    for (int nt = 0; nt < 4; ++nt) {
      const int d = nt * 16 + fr;
      bf16x8 ba0 = *(const bf16x8*)(WaT + d * 64 + fq * 8), ba1 = *(const bf16x8*)(WaT + d * 64 + 32 + fq * 8);
      bf16x8 bx0 = *(const bf16x8*)(WxT + d * 64 + fq * 8), bx1 = *(const bf16x8*)(WxT + d * 64 + 32 + fq * 8);
      f32x4 ar = {0.f, 0.f, 0.f, 0.f}, ai = {0.f, 0.f, 0.f, 0.f};
      ar = MFMA16(af0, ba0, ar); ar = MFMA16(af1, ba1, ar);
      ai = MFMA16(af0, bx0, ai); ai = MFMA16(af1, bx1, ai);
      const float bav = p.lru_ba[layer * 512 + ch0 + d], bxv = p.lru_bx[layer * 512 + ch0 + d];
      const float sp = log1pf(__expf(-p.lru_lambda[layer * 512 + ch0 + d]));
#pragma unroll
      for (int j = 0; j < 4; ++j) {
        const int t = wid * 16 + fq * 4 + j;
        float r = sigm(ar[j] + bav), ig = sigm(ai[j] + bxv);
        float la = -8.f * r * sp;
        float a = __expf(la);
        float b = sqrtf(1.f - __expf(2.f * la)) * (ig * xcs[t * 64 + d]);
        if (t0 + t >= T) { a = 1.f; b = 0.f; }
        as_[t * 64 + d] = a;
        bs_[t * 64 + d] = b;
      }
    }
  }
  __syncthreads();
  const int c = tid & 63;
  {
    float A = 1.f, B = 0.f;
#pragma unroll
    for (int tt = 0; tt < 16; ++tt) {
      float a = as_[(wid * 16 + tt) * 64 + c], b = bs_[(wid * 16 + tt) * 64 + c];
      A *= a; B = a * B + b;
    }
    ab[(wid * 64 + c) * 2] = A;
    ab[(wid * 64 + c) * 2 + 1] = B;
  }
  __syncthreads();
  if (pass == 0) {
    if (wid == 0) {
      float A = 1.f, B = 0.f;
#pragma unroll
      for (int w = 0; w < 4; ++w) { float a = ab[(w * 64 + c) * 2], b = ab[(w * 64 + c) * 2 + 1]; A *= a; B = a * B + b; }
      *(float2*)(agg + ((long)(sq * NTILE_P + tile) * 512 + ch0 + c) * 2) = make_float2(A, B);
    }
  } else {
    float h = isP ? 0.f : p.state_lru[(long)(layer * NB_S + sq) * 512 + ch0 + c];
    for (int i0 = 0; i0 < tile; i0 += 16) {
      float2 e[16];
#pragma unroll
      for (int u = 0; u < 16; ++u)
        e[u] = (i0 + u < tile) ? *(const float2*)(agg + ((long)(sq * NTILE_P + i0 + u) * 512 + ch0 + c) * 2) : make_float2(1.f, 0.f);
#pragma unroll
      for (int u = 0; u < 16; ++u) h = e[u].x * h + e[u].y;
    }
    for (int w = 0; w < wid; ++w) h = ab[(w * 64 + c) * 2] * h + ab[(w * 64 + c) * 2 + 1];
#pragma unroll
    for (int tt = 0; tt < 16; ++tt) {
      const int t = wid * 16 + tt;
      h = as_[t * 64 + c] * h + bs_[t * 64 + c];
      if (t0 + t < T) {
        const long idx = (long)(rowbase + t0 + t) * 512 + ch0 + c;
        gby[idx] = f2bf(h * bf2f(gby[idx]));
        if (t0 + t == T - 1) {
          if (isP) p.out[O_LRUP + (long)(layer * NB_P + sq) * 512 + ch0 + c] = h;
          else p.out[O_LRUS + (long)(layer * NB_S + sq) * 512 + ch0 + c] = h;
        }
      }
    }
  }
}

DI void pool_item(const Params& p, int layer, int isP, int sq, int tile, int g, char*) {
  const int tid = get_tid(), wid = __builtin_amdgcn_readfirstlane(tid >> 6), lane = tid & 63, fr = lane & 15, fq = lane >> 4;
  float* xps = (float*)smem;
  bfr* pa = (bfr*)(xps + 79 * 128);
  const int T = isP ? T_P : T_S;
  const int rowbase = isP ? sq * T_P : ROWS_P + sq * 64;
  const int t0 = tile * 64, ch0 = g * 128;
  const bfr* xcb = (const bfr*)(p.ws + W_XCB);
  bfr* gcy = (bfr*)(p.ws + W_GC);
  {
    const int c = tid & 127;
#pragma unroll
    for (int b8 = 0; b8 < 5; ++b8) {
      float vv[8];
#pragma unroll
      for (int u = 0; u < 8; ++u) {
        const int rr = (b8 * 8 + u) * 2 + (tid >> 7);
        const int tt = t0 - 15 + rr;
        float v = 0.f;
        if (rr < 79) {
          if (tt < 0) { if (!isP) v = p.state_pool[((long)(layer * NB_S + sq) * 15 + (15 + tt)) * 512 + ch0 + c]; }
          else if (tt < T) v = bf2f(xcb[(long)(rowbase + tt) * 512 + ch0 + c]);
        }
        vv[u] = v;
      }
#pragma unroll
      for (int u = 0; u < 8; ++u) { const int rr = (b8 * 8 + u) * 2 + (tid >> 7); if (rr < 79) xps[rr * 128 + c] = vv[u]; }
    }
  }
  __syncthreads();
  {
    const int c = tid & 127;
    const int w = 2 << g;
    const int nh = isP ? 0 : PAST;
    for (int t = tid >> 7; t < 64; t += 2) {
      float s = 0.f;
      for (int i = 0; i < w; ++i) s += xps[(15 + t - i) * 128 + c];
      int cnt = min(w, t0 + t + 1 + nh);
      float v = s / (float)cnt - xps[(15 + t) * 128 + c];
      pa[t * 136 + c] = f2bf(v);
    }
  }
  __syncthreads();
  {
    const bfr* PwT = (const bfr*)(p.ws + W_PWT) + (long)(layer * 4 + g) * 16384;
    bf16x8 af[4];
#pragma unroll
    for (int ks = 0; ks < 4; ++ks) af[ks] = *(const bf16x8*)(pa + (wid * 16 + fr) * 136 + ks * 32 + fq * 8);
#pragma unroll
    for (int nt = 0; nt < 8; ++nt) {
      const int d = nt * 16 + fr;
      f32x4 acc = {0.f, 0.f, 0.f, 0.f};
#pragma unroll
      for (int ks = 0; ks < 4; ++ks) {
        bf16x8 bq = *(const bf16x8*)(PwT + d * 128 + ks * 32 + fq * 8);
        acc = MFMA16(af[ks], bq, acc);
      }
      const float scl = p.pool_scale[layer * 512 + ch0 + d];
#pragma unroll
      for (int j = 0; j < 4; ++j) {
        const int t = wid * 16 + fq * 4 + j;
        if (t0 + t < T) {
          const long idx = (long)(rowbase + t0 + t) * 512 + ch0 + d;
          gcy[idx] = f2bf(acc[j] * scl * bf2f(gcy[idx]));
        }
      }
    }
  }
}

DI void kmax_item(const Params& p, int seq, int h, char*) {
  const int tid = get_tid(), wid = __builtin_amdgcn_readfirstlane(tid >> 6), lane = tid & 63;
  const bfr* kb; int S;
  if (seq < NB_P) { kb = (const bfr*)(p.ws + W_KBP) + (long)seq * KP_PAD * 512; S = T_P; }
  else { kb = (const bfr*)(p.ws + W_KBS) + (long)(seq - NB_P) * S_S * 512; S = S_S; }
  float mx = 0.f;
  for (int key = tid; key < S; key += 256) {
    const uint4* r = (const uint4*)(kb + (long)key * 512 + h * 64);
    float ss = 0.f;
#pragma unroll
    for (int i = 0; i < 8; ++i) {
      uint4 v = r[i];
      unsigned u[4] = {v.x, v.y, v.z, v.w};
#pragma unroll
      for (int j = 0; j < 4; ++j) {
        float a = __uint_as_float(u[j] << 16), b = __uint_as_float(u[j] & 0xFFFF0000u);
        ss += a * a + b * b;
      }
    }
    mx = fmaxf(mx, ss);
  }
#pragma unroll
  for (int o = 32; o >= 1; o >>= 1) mx = fmaxf(mx, __shfl_xor(mx, o));
  float* red = (float*)smem;
  if (lane == 0) red[wid] = mx;
  __syncthreads();
  if (tid == 0) ((float*)(p.ws + W_KMAX))[seq * 8 + h] = fmaxf(fmaxf(red[0], red[1]), fmaxf(red[2], red[3]));
}

DI void attn_unit(const Params& p, int isP, int sq, int c, int h, int half, size_t dstoff = W_GA) {
  const int lane = get_tid() & 63, fr = lane & 15, fq = lane >> 4;
  int T0, nqt, nadm, rowbase, vld;
  const bfr *kb, *vt;
  if (isP) {
    if (c == 0) { T0 = 0; nqt = 1; nadm = 16; } else { T0 = 16 + 64 * (c - 1) + 32 * half; nqt = 2; nadm = 16 + 64 * c; }
    rowbase = sq * T_P;
    kb = (const bfr*)(p.ws + W_KBP) + (long)sq * KP_PAD * 512;
    vt = (const bfr*)(p.ws + W_VTP) + (long)sq * 512 * KP_PAD;
    vld = KP_PAD;
  } else {
    T0 = 32 * half; nqt = 2; nadm = S_S; rowbase = ROWS_P + sq * 64;
    kb = (const bfr*)(p.ws + W_KBS) + (long)sq * S_S * 512;
    vt = (const bfr*)(p.ws + W_VTS) + (long)sq * 512 * S_S;
    vld = S_S;
  }
  const int nsteps = (nadm + 31) >> 5;
  const int qrow0 = rowbase + T0;
  const bfr* qb = (const bfr*)(p.ws + W_QB);
  const unsigned* maskg = (const unsigned*)(p.ws + W_MASK);
  bf16x8 qf[2][2];
#pragma unroll
  for (int qt = 0; qt < 2; ++qt)
#pragma unroll
    for (int ks = 0; ks < 2; ++ks) {
      int r = qrow0 + (qt < nqt ? qt * 16 : 0) + fr;
      qf[qt][ks] = *(const bf16x8*)(qb + (long)r * 512 + h * 64 + ks * 32 + fq * 8);
    }
  f32x4 o[2][4];
#pragma unroll
  for (int qt = 0; qt < 2; ++qt)
#pragma unroll
    for (int dt = 0; dt < 4; ++dt) o[qt][dt] = f32x4{0.f, 0.f, 0.f, 0.f};
  const float sc2 = 0.125f * 1.4426950408889634f;
  const float kmax2 = ((const float*)(p.ws + W_KMAX))[(isP ? sq : NB_P + sq) * 8 + h];
  float mref[2], lsum[2] = {0.f, 0.f};
#pragma unroll
  for (int qt = 0; qt < 2; ++qt) {
    float ss = 0.f;
#pragma unroll
    for (int ks = 0; ks < 2; ++ks)
#pragma unroll
      for (int i = 0; i < 8; ++i) { float a = bf2f((bfr)qf[qt][ks][i]); ss += a * a; }
    ss += __shfl_xor(ss, 16);
    ss += __shfl_xor(ss, 32);
    mref[qt] = sqrtf(ss * kmax2) * sc2;
  }
  const unsigned* mrow0 = maskg + (long)(qrow0 + fr) * MW;
  const unsigned* mrow1 = maskg + (long)(qrow0 + (nqt > 1 ? 16 : 0) + fr) * MW;
  const int kofs = (fr >> 2) * 8 + (fr & 3);
  const bfr* kptr = kb + (long)kofs * 512 + h * 64 + fq * 8;
  const bfr* vptr = vt + (long)(h * 64 + fr) * vld + fq * 8;
  bf16x8 ka0 = *(const bf16x8*)kptr, ka1 = *(const bf16x8*)(kptr + 32);
  bf16x8 kb0 = *(const bf16x8*)(kptr + 4 * 512), kb1 = *(const bf16x8*)(kptr + 4 * 512 + 32);
  bf16x8 vf[4];
#pragma unroll
  for (int dt = 0; dt < 4; ++dt) vf[dt] = *(const bf16x8*)(vptr + (long)dt * 16 * vld);
  unsigned mw0 = mrow0[0], mw1 = mrow1[0];
  for (int s = 0; s < nsteps; ++s) {
    const int sn = min(s + 1, nsteps - 1);
    const bfr* pa = kptr + (long)sn * 32 * 512;
    const bf16x8 nka0 = *(const bf16x8*)pa, nka1 = *(const bf16x8*)(pa + 32);
    const bf16x8 nkb0 = *(const bf16x8*)(pa + 4 * 512), nkb1 = *(const bf16x8*)(pa + 4 * 512 + 32);
    bf16x8 nvf[4];
#pragma unroll
    for (int dt = 0; dt < 4; ++dt) nvf[dt] = *(const bf16x8*)(vptr + (long)dt * 16 * vld + sn * 32);
    const unsigned nmw0 = mrow0[sn], nmw1 = mrow1[sn];
#pragma unroll
    for (int qt = 0; qt < 2; ++qt) {
      if (qt < nqt) {
        f32x4 sa = {0.f, 0.f, 0.f, 0.f}, sb = {0.f, 0.f, 0.f, 0.f};
        sa = MFMA16(ka0, qf[qt][0], sa); sa = MFMA16(ka1, qf[qt][1], sa);
        sb = MFMA16(kb0, qf[qt][0], sb); sb = MFMA16(kb1, qf[qt][1], sb);
        const unsigned mb = ((qt == 0 ? mw0 : mw1) >> (fq * 8)) & 0xFFu;
        float pr[8];
#pragma unroll
        for (int i = 0; i < 4; ++i) {
          float pa_ = __builtin_amdgcn_exp2f(sa[i] * sc2 - mref[qt]);
          float pb_ = __builtin_amdgcn_exp2f(sb[i] * sc2 - mref[qt]);
          pr[i] = ((mb >> i) & 1u) ? pa_ : 0.f;
          pr[4 + i] = ((mb >> (4 + i)) & 1u) ? pb_ : 0.f;
        }
        lsum[qt] += ((pr[0] + pr[1]) + (pr[2] + pr[3])) + ((pr[4] + pr[5]) + (pr[6] + pr[7]));
        union { unsigned u[4]; bf16x8 v; } pk;
        pk.u[0] = pack2(pr[0], pr[1]); pk.u[1] = pack2(pr[2], pr[3]); pk.u[2] = pack2(pr[4], pr[5]); pk.u[3] = pack2(pr[6], pr[7]);
#pragma unroll
        for (int dt = 0; dt < 4; ++dt) o[qt][dt] = MFMA16(vf[dt], pk.v, o[qt][dt]);
      }
    }
    ka0 = nka0; ka1 = nka1; kb0 = nkb0; kb1 = nkb1;
#pragma unroll
    for (int dt = 0; dt < 4; ++dt) vf[dt] = nvf[dt];
    mw0 = nmw0; mw1 = nmw1;
  }
  bfr* gay = (bfr*)(p.ws + W_GA);
  bfr* dsty = (bfr*)(p.ws + dstoff);
#pragma unroll
  for (int qt = 0; qt < 2; ++qt) {
    if (qt < nqt) {
      float l = lsum[qt];
      l += __shfl_xor(l, 16);
      l += __shfl_xor(l, 32);
      const float inv = l > 0.f ? 1.f / l : 0.f;
      const long rowoff = (long)(qrow0 + qt * 16 + fr) * 512 + h * 64;
#pragma unroll
      for (int dt = 0; dt < 4; ++dt) {
        uint2* ptr = (uint2*)(gay + rowoff + dt * 16 + fq * 4);
        uint2 gv = *ptr;
        float g0 = __uint_as_float(gv.x << 16), g1 = __uint_as_float(gv.x & 0xFFFF0000u);
        float g2 = __uint_as_float(gv.y << 16), g3 = __uint_as_float(gv.y & 0xFFFF0000u);
        uint2 ov;
        ov.x = pack2(o[qt][dt][0] * inv * g0, o[qt][dt][1] * inv * g1);
        ov.y = pack2(o[qt][dt][2] * inv * g2, o[qt][dt][3] * inv * g3);
        *(uint2*)(dsty + rowoff + dt * 16 + fq * 4) = ov;
      }
    }
  }
}

#define XB_TMO      128
#define XB_XCNT(j)  (256  + 64 * (j))
#define XB_XSUB(j)  (1280 + 64 * (j))
#define XB_XGEN(j)  (2304 + 64 * (j))
#define XB_TOP      3328
#define XB_TOPGEN   3392
#define XCD_BAR_WORDS 3456
#define XB_SPIN_CAP (1u << 18)
#define LAS __attribute__((address_space(3)))

__device__ __forceinline__ unsigned xb_ld(unsigned* p)              { return __hip_atomic_load(p, __ATOMIC_RELAXED, __HIP_MEMORY_SCOPE_AGENT); }
__device__ __forceinline__ unsigned xb_add(unsigned* p, unsigned v) { return __hip_atomic_fetch_add(p, v, __ATOMIC_RELAXED, __HIP_MEMORY_SCOPE_AGENT); }
__device__ __forceinline__ unsigned xb_xcc_id() { return (unsigned)__builtin_amdgcn_s_getreg((3 << 11) | 20) & 0xFu; }
#define XB_SPIN(cond, bar) do { unsigned _sp = 0; while (cond) { __builtin_amdgcn_s_sleep(1); \
    if ((++_sp & 255u) == 0u) { if (xb_ld(&(bar)[XB_TMO])) break; if (_sp > XB_SPIN_CAP) { atomicAdd(&(bar)[XB_TMO], 1u); break; } } } } while (0)

struct XcdBarrier {
    unsigned* bar; unsigned x;
    volatile LAS unsigned* st;
};

__device__ __forceinline__ XcdBarrier xcd_barrier_post(unsigned* bar, volatile LAS unsigned* st) {
    XcdBarrier b; b.bar = bar; b.x = xb_xcc_id(); b.st = st;
    if (threadIdx.x == 0) (void)xb_add(&bar[XB_XCNT(b.x)], 1u);
    return b;
}
__device__ __forceinline__ void xcd_barrier_complete(unsigned* bar, unsigned x, unsigned& nloc, unsigned& nx) {
    const unsigned G = gridDim.x * gridDim.y * gridDim.z;
    unsigned sum, cnt, mine, sp = 0u;
    for (;;) {
        sum = 0u; cnt = 0u; mine = 0u;
#pragma unroll
        for (unsigned j = 0; j < 16; ++j) { const unsigned c = xb_ld(&bar[XB_XCNT(j)]); sum += c; cnt += (c > 0u) ? 1u : 0u; mine = (j == x) ? c : mine; }
        if (sum == G) break;
        __builtin_amdgcn_s_sleep(1);
        if ((++sp & 255u) == 0u) { if (xb_ld(&bar[XB_TMO])) break; if (sp > XB_SPIN_CAP) { atomicAdd(&bar[XB_TMO], 1u); break; } }
    }
    nloc = mine > 0u ? mine : 1u; nx = cnt > 0u ? cnt : 1u;
}

__device__ __forceinline__ void xcd_barrier(const XcdBarrier& b) {
    asm volatile("s_waitcnt vmcnt(0)" ::: "memory");
    __syncthreads();
    if (threadIdx.x == 0) {
        unsigned* bar = b.bar;
        __builtin_amdgcn_s_waitcnt(0);
        unsigned nloc = b.st[0], nx = b.st[1];
        if (nloc == 0u) { xcd_barrier_complete(bar, b.x, nloc, nx); b.st[0] = nloc; b.st[1] = nx; }
        const unsigned old = xb_add(&bar[XB_XSUB(b.x)], 1u);
        const unsigned gen = old / nloc;
        if (old + 1u == (gen + 1u) * nloc) {
            __builtin_amdgcn_fence(__ATOMIC_RELEASE, "agent");
            asm volatile("s_waitcnt vmcnt(0)" ::: "memory");
            const unsigned og = xb_add(&bar[XB_TOP], 1u);
            const unsigned tg = og / nx;
            if (og + 1u == (tg + 1u) * nx) xb_add(&bar[XB_TOPGEN], 1u);
            else XB_SPIN(xb_ld(&bar[XB_TOPGEN]) == tg, bar);
            __builtin_amdgcn_fence(__ATOMIC_ACQUIRE, "agent");
            xb_add(&bar[XB_XGEN(b.x)], 1u);
            asm volatile("s_waitcnt vmcnt(0)" ::: "memory");
        } else {
            XB_SPIN(xb_ld(&bar[XB_XGEN(b.x)]) == gen, bar);
            __builtin_amdgcn_fence(__ATOMIC_ACQUIRE, "agent");
            asm volatile("s_waitcnt vmcnt(0)" ::: "memory");
        }
    }
    __syncthreads();
}


DI void attn_block(const Params& p, int isP, int sq, int c, int h) {
  const int tid = get_tid(), wid = __builtin_amdgcn_readfirstlane(tid >> 6), lane = tid & 63, fr = lane & 15, fq = lane >> 4;
  int T0, nqt, nadm, rowbase, vld;
  const bfr *kb, *vt;
  if (isP) {
    if (c == 0) { T0 = 0; nqt = 1; nadm = 16; } else { T0 = 16 + 64 * (c - 1); nqt = 4; nadm = 16 + 64 * c; }
    rowbase = sq * T_P;
    kb = (const bfr*)(p.ws + W_KBP) + (long)sq * KP_PAD * 512;
    vt = (const bfr*)(p.ws + W_VTP) + (long)sq * 512 * KP_PAD;
    vld = KP_PAD;
  } else {
    T0 = 0; nqt = 4; nadm = S_S; rowbase = ROWS_P + sq * 64;
    kb = (const bfr*)(p.ws + W_KBS) + (long)sq * S_S * 512;
    vt = (const bfr*)(p.ws + W_VTS) + (long)sq * 512 * S_S;
    vld = S_S;
  }
  const int nsteps = (nadm + 31) >> 5;
  const int qrow0 = rowbase + T0;
  const bfr* qb = (const bfr*)(p.ws + W_QB);
  const unsigned* maskg = (const unsigned*)(p.ws + W_MASK);
  bf16x8 qf[4][2];
#pragma unroll
  for (int qt = 0; qt < 4; ++qt)
#pragma unroll
    for (int ks = 0; ks < 2; ++ks) {
      int r = qrow0 + (qt < nqt ? qt * 16 : 0) + fr;
      qf[qt][ks] = *(const bf16x8*)(qb + (long)r * 512 + h * 64 + ks * 32 + fq * 8);
    }
  f32x4 o[4][4];
#pragma unroll
  for (int qt = 0; qt < 4; ++qt)
#pragma unroll
    for (int dt = 0; dt < 4; ++dt) o[qt][dt] = f32x4{0.f, 0.f, 0.f, 0.f};
  const float sc2 = 0.125f * 1.4426950408889634f;
  const float kmax2 = ((const float*)(p.ws + W_KMAX))[(isP ? sq : NB_P + sq) * 8 + h];
  float mref[4], lsum[4] = {0.f, 0.f, 0.f, 0.f};
  const unsigned* mrow[4];
#pragma unroll
  for (int qt = 0; qt < 4; ++qt) {
    float ss = 0.f;
#pragma unroll
    for (int ks = 0; ks < 2; ++ks)
#pragma unroll
      for (int i = 0; i < 8; ++i) { float a = bf2f((bfr)qf[qt][ks][i]); ss += a * a; }
    ss += __shfl_xor(ss, 16);
    ss += __shfl_xor(ss, 32);
    mref[qt] = sqrtf(ss * kmax2) * sc2;
    mrow[qt] = maskg + (long)(qrow0 + (qt < nqt ? qt * 16 : 0) + fr) * MW;
  }
  const int kofs = (fr >> 2) * 8 + (fr & 3);
  const bfr* kptr = kb + (long)kofs * 512 + h * 64 + fq * 8;
  const bfr* vptr = vt + (long)(h * 64 + fr) * vld + fq * 8;
  if (wid < nsteps) {
    int s = wid;
    const bfr* pa0 = kptr + (long)s * 32 * 512;
    bf16x8 ka0 = *(const bf16x8*)pa0, ka1 = *(const bf16x8*)(pa0 + 32);
    bf16x8 kb0 = *(const bf16x8*)(pa0 + 4 * 512), kb1 = *(const bf16x8*)(pa0 + 4 * 512 + 32);
    bf16x8 vf[4];
#pragma unroll
    for (int dt = 0; dt < 4; ++dt) vf[dt] = *(const bf16x8*)(vptr + (long)dt * 16 * vld + s * 32);
    unsigned mw[4];
#pragma unroll
    for (int qt = 0; qt < 4; ++qt) mw[qt] = mrow[qt][s];
    for (; s < nsteps; s += 4) {
      const int sn = (s + 4 < nsteps) ? s + 4 : s;
      const bfr* pa = kptr + (long)sn * 32 * 512;
      const bf16x8 nka0 = *(const bf16x8*)pa, nka1 = *(const bf16x8*)(pa + 32);
      const bf16x8 nkb0 = *(const bf16x8*)(pa + 4 * 512), nkb1 = *(const bf16x8*)(pa + 4 * 512 + 32);
      bf16x8 nvf[4];
#pragma unroll
      for (int dt = 0; dt < 4; ++dt) nvf[dt] = *(const bf16x8*)(vptr + (long)dt * 16 * vld + sn * 32);
      unsigned nmw[4];
#pragma unroll
      for (int qt = 0; qt < 4; ++qt) nmw[qt] = mrow[qt][sn];
#pragma unroll
      for (int qt = 0; qt < 4; ++qt) {
        if (qt < nqt) {
          f32x4 sa = {0.f, 0.f, 0.f, 0.f}, sb = {0.f, 0.f, 0.f, 0.f};
          sa = MFMA16(ka0, qf[qt][0], sa); sa = MFMA16(ka1, qf[qt][1], sa);
          sb = MFMA16(kb0, qf[qt][0], sb); sb = MFMA16(kb1, qf[qt][1], sb);
          const unsigned mb = (mw[qt] >> (fq * 8)) & 0xFFu;
          float pr[8];
#pragma unroll
          for (int i = 0; i < 4; ++i) {
            float pa_ = __builtin_amdgcn_exp2f(sa[i] * sc2 - mref[qt]);
            float pb_ = __builtin_amdgcn_exp2f(sb[i] * sc2 - mref[qt]);
            pr[i] = ((mb >> i) & 1u) ? pa_ : 0.f;
            pr[4 + i] = ((mb >> (4 + i)) & 1u) ? pb_ : 0.f;
          }
          lsum[qt] += ((pr[0] + pr[1]) + (pr[2] + pr[3])) + ((pr[4] + pr[5]) + (pr[6] + pr[7]));
          union { unsigned u[4]; bf16x8 v; } pk;
          pk.u[0] = pack2(pr[0], pr[1]); pk.u[1] = pack2(pr[2], pr[3]); pk.u[2] = pack2(pr[4], pr[5]); pk.u[3] = pack2(pr[6], pr[7]);
#pragma unroll
          for (int dt = 0; dt < 4; ++dt) o[qt][dt] = MFMA16(vf[dt], pk.v, o[qt][dt]);
        }
      }
      ka0 = nka0; ka1 = nka1; kb0 = nkb0; kb1 = nkb1;
#pragma unroll
      for (int dt = 0; dt < 4; ++dt) vf[dt] = nvf[dt];
#pragma unroll
      for (int qt = 0; qt < 4; ++qt) mw[qt] = nmw[qt];
    }
  }
  float* OS = (float*)smem;
  float* LS = OS + 4 * 2048;
  bfr* gay = (bfr*)(p.ws + W_GA);
#pragma unroll
  for (int rd = 0; rd < 2; ++rd) {
    __syncthreads();
#pragma unroll
    for (int q2 = 0; q2 < 2; ++q2) {
      const int qt = rd * 2 + q2;
      float l = lsum[qt];
      l += __shfl_xor(l, 16);
      l += __shfl_xor(l, 32);
      LS[(wid * 2 + q2) * 64 + lane] = l;
#pragma unroll
      for (int dt = 0; dt < 4; ++dt)
#pragma unroll
        for (int j = 0; j < 4; ++j) OS[((wid * 2 + q2) * 16 + dt * 4 + j) * 64 + lane] = o[qt][dt][j];
    }
    __syncthreads();
    const int q2 = wid >> 1, qt = rd * 2 + q2;
    if (qt < nqt) {
      float l = 0.f;
#pragma unroll
      for (int w = 0; w < 4; ++w) l += LS[(w * 2 + q2) * 64 + lane];
      const float inv = l > 0.f ? 1.f / l : 0.f;
      const long rowoff = (long)(qrow0 + qt * 16 + fr) * 512 + h * 64;
#pragma unroll
      for (int d2 = 0; d2 < 2; ++d2) {
        const int dt = (wid & 1) * 2 + d2;
        float acc4[4];
#pragma unroll
        for (int j = 0; j < 4; ++j) {
          float a = 0.f;
#pragma unroll
          for (int w = 0; w < 4; ++w) a += OS[((w * 2 + q2) * 16 + dt * 4 + j) * 64 + lane];
          acc4[j] = a * inv;
        }
        uint2* ptr = (uint2*)(gay + rowoff + dt * 16 + fq * 4);
        uint2 gv = *ptr;
        float g0 = __uint_as_float(gv.x << 16), g1 = __uint_as_float(gv.x & 0xFFFF0000u);
        float g2 = __uint_as_float(gv.y << 16), g3 = __uint_as_float(gv.y & 0xFFFF0000u);
        uint2 ov;
        ov.x = pack2(acc4[0] * g0, acc4[1] * g1);
        ov.y = pack2(acc4[2] * g2, acc4[3] * g3);
        *ptr = ov;
      }
    }
  }
}

DI int pop_block(int* ctr, int*) {
  __syncthreads();
  if (threadIdx.x == 0) sh_item = atomicAdd(ctr, 1);
  __syncthreads();
  return __builtin_amdgcn_readfirstlane(sh_item);
}

constexpr int N_KMAX = 20 * 8;
constexpr int N_SEL = 64 * 16 + 64 + 4;
constexpr int N_LRU1 = NB_P * NTILE_P * 8;
constexpr int N_POOL = NB_P * NTILE_P * 4 + NB_S * 4;
constexpr int N_LRU2 = NB_P * NTILE_P * 8 + NB_S * 8;
constexpr int N_ATT = 64 * 64 + 256 + 32;

DI void phase_b1(const Params& p, int layer, char*, int*) {
  int* ctr = (int*)(p.ws + W_CTR) + layer * 4 + 0;
  for (;;) {
    int it = pop_block(ctr, nullptr);
    if (it >= N_SEL + N_LRU1 + N_POOL + N_KMAX) break;
    if (it >= N_SEL + N_LRU1 + N_POOL) { int j = it - (N_SEL + N_LRU1 + N_POOL); kmax_item(p, j >> 3, j & 7, smem); }
    else if (it < N_SEL) {
      if (it < 1024) { int c = 64 - (it >> 4), b = (it & 15) >> 2, sub = it & 3; select_item(p, 1, b, c, sub, smem); }
      else if (it < 1088) { int j = it - 1024; select_item(p, 0, j >> 2, 0, j & 3, smem); }
      else select_item(p, 1, it - 1088, 0, 0, smem);
    } else if (it < N_SEL + N_LRU1) {
      int j = it - N_SEL;
      int sq = j / (NTILE_P * 8), rem = j % (NTILE_P * 8);
      lru_tile(p, layer, 1, sq, rem >> 3, rem & 7, 0, smem);
    } else {
      int j = it - N_SEL - N_LRU1;
      if (j < NB_P * NTILE_P * 4) { int sq = j / (NTILE_P * 4), rem = j % (NTILE_P * 4); pool_item(p, layer, 1, sq, rem >> 2, rem & 3, smem); }
      else { j -= NB_P * NTILE_P * 4; pool_item(p, layer, 0, j >> 2, 0, j & 3, smem); }
    }
  }
}

constexpr size_t W_DUMMY = W_END;
DI void probe_select(const Params& p, int layer) {
  int* ctr = (int*)(p.ws + W_CTR) + layer * 4 + 3;
  for (;;) {
    int it = pop_block(ctr, nullptr);
    if (it >= N_SEL) break;
    if (it < 1024) { int c = 64 - (it >> 4), b = (it & 15) >> 2, sub = it & 3; select_item(p, 1, b, c, sub, smem); }
    else if (it < 1088) { int j = it - 1024; select_item(p, 0, j >> 2, 0, j & 3, smem); }
    else select_item(p, 1, it - 1088, 0, 0, smem);
  }
}
DI void probe_attn(const Params& p, int layer) {
  int* ctr2 = (int*)(p.ws + W_CTR) + layer * 4 + 3;
  const int lane = get_tid() & 63;
  for (;;) {
    int u = 0;
    if (lane == 0) u = atomicAdd(ctr2, 1);
    u = __builtin_amdgcn_readfirstlane(u);
    if (u >= N_ATT) break;
    if (u < 4096) { int c = 64 - (u >> 6), r = u & 63; attn_unit(p, 1, r >> 4, c, (r >> 1) & 7, r & 1, W_DUMMY); }
    else if (u < 4096 + 256) { int r = u - 4096; attn_unit(p, 0, r >> 4, 0, (r >> 1) & 7, r & 1, W_DUMMY); }
    else { int r = u - 4352; attn_unit(p, 1, r >> 3, 0, r & 7, 0, W_DUMMY); }
  }
}

DI void phase_b2(const Params& p, int layer, char*, int*) {
  int* ctr = (int*)(p.ws + W_CTR) + layer * 4 + 1;
  for (;;) {
    int it = pop_block(ctr, nullptr);
    if (it >= N_LRU2) break;
    if (it < NB_P * NTILE_P * 8) { int sq = it / (NTILE_P * 8), rem = it % (NTILE_P * 8); lru_tile(p, layer, 1, sq, rem >> 3, rem & 7, 1, smem); }
    else { int j = it - NB_P * NTILE_P * 8; lru_tile(p, layer, 0, j >> 3, 0, j & 7, 1, smem); }
  }
  int* ctr2 = (int*)(p.ws + W_CTR) + layer * 4 + 2;
  for (;;) {
    int it = pop_block(ctr2, nullptr);
    if (it >= 2208) break;
    if (it < 2048) { const int c = 64 - (it >> 5), pair = it & 31; attn_block(p, 1, pair >> 3, c, pair & 7); }
    else if (it < 2176) { const int r = it - 2048; attn_block(p, 0, r >> 3, 0, r & 7); }
    else { const int pair = it - 2176; attn_block(p, 1, pair >> 3, 0, pair & 7); }
  }
}

DI Params fresh(const Params& p) {
  Params q = p;
  int z = 0;
  asm volatile("s_mov_b32 %0, 0" : "=s"(z));
  q.ws = p.ws + z;
  q.out = p.out + z;
  return q;
}
DI int fresh_i(int v) {
  asm volatile("" : "+s"(v));
  return v;
}

__shared__ uint4 xb_words;

__global__ void __launch_bounds__(256, 2) fwd_megakernel(Params p) {
  cg::grid_group grid = cg::this_grid();
  if (threadIdx.x == 0) xb_words = make_uint4(0u, 0u, 0u, 0u);
  __syncthreads();
  XcdBarrier xb = xcd_barrier_post((unsigned*)(p.ws + W_BAR), (volatile LAS unsigned*)&xb_words);
  if (threadIdx.x == 0) sh_xinfo[0] = (int)atomicAdd((unsigned*)(p.ws + W_CTR) + 128 + xb.x, 1u);
  prep_phase(fresh(p), smem);
  grid.sync();
  if (threadIdx.x == 0) {
    unsigned* bar = (unsigned*)(p.ws + W_BAR);
    int na = 0, ia = 0, nloc = 1;
    for (unsigned j = 0; j < 16; ++j) {
      const unsigned cj = xb_ld(&bar[XB_XCNT(j)]);
      if (cj > 0u) { if (j < xb.x) ++ia; ++na; }
      if (j == xb.x) nloc = (int)cj;
    }
    sh_xinfo[1] = nloc > 0 ? nloc : 1; sh_xinfo[2] = ia; sh_xinfo[3] = na > 0 ? na : 1;
  }
  __syncthreads();
#if PROBE == 6
#pragma unroll 1
  for (int i = 0; i < 10; ++i) xcd_barrier(xb);
#endif
#pragma unroll 1
  for (int layer = 0; layer < 2; ++layer) {
    phase_inproj(fresh(p), fresh_i(layer), smem);
    xcd_barrier(xb);
#if PROBE == 2
    probe_select(fresh(p), fresh_i(layer));
    xcd_barrier(xb);
#endif
    phase_b1(fresh(p), fresh_i(layer), smem, &sh_item);
    xcd_barrier(xb);
#if PROBE == 3
    probe_attn(fresh(p), fresh_i(layer));
    xcd_barrier(xb);
#endif
    phase_b2(fresh(p), fresh_i(layer), smem, &sh_item);
    xcd_barrier(xb);
    phase_merge(fresh(p), fresh_i(layer), smem);
    xcd_barrier(xb);
#if PROBE == 4
    phase_merge(fresh(p), fresh_i(layer), smem);
    xcd_barrier(xb);
#endif
    phase_out(fresh(p), fresh_i(layer), smem);
    xcd_barrier(xb);
    if (layer == 0) { convert_cache(fresh(p), 1, smem); norm_phase(fresh(p), 1); xcd_barrier(xb); }
    else norm_phase(fresh(p), 2);
  }
}

extern "C" void kernel_launch(void* const* d_in, const int* in_sizes, int n_in, void* d_out, int out_size, void* d_ws,
                              size_t ws_size, hipStream_t stream) {
  constexpr int kDynLds = 65536;
  static int grid_blocks = 0;
  if (!grid_blocks) {
    int dev = 0, cus = 0, per_cu = 0;
    hipGetDevice(&dev);
    hipDeviceGetAttribute(&cus, hipDeviceAttributeMultiprocessorCount, dev);
    hipFuncSetAttribute((const void*)fwd_megakernel, hipFuncAttributeMaxDynamicSharedMemorySize, kDynLds);
    hipOccupancyMaxActiveBlocksPerMultiprocessor(&per_cu, fwd_megakernel, 256, kDynLds);
    if (per_cu > 2) per_cu = 2;
    if (per_cu < 1) per_cu = 1;
    grid_blocks = cus * per_cu;
  }
  if (ws_size < W_END) { fprintf(stderr, "workspace too small: %zu < %zu\n", ws_size, (size_t)W_END); return; }
  Params p{};
  const float** f = (const float**)&p;
  for (int i = 0; i < 23; ++i) f[i] = (const float*)d_in[i];
  p.out = (float*)d_out;
  p.ws = (char*)d_ws;
  hipMemsetAsync(d_ws, 0, 32768, stream);
  void* args[] = {&p};
  hipError_t e = hipLaunchCooperativeKernel((void*)fwd_megakernel, dim3(grid_blocks), dim3(256), args, kDynLds, stream);
  if (e != hipSuccess) fprintf(stderr, "cooperative launch failed: %s (grid %d)\n", hipGetErrorString(e), grid_blocks);
}
```

```cpp
#include <hip/hip_runtime.h>
#include <hip/hip_cooperative_groups.h>
#include <stdint.h>
#include <cstdio>
namespace cg = cooperative_groups;
#ifndef PROBE
#define PROBE 0
#endif

typedef unsigned short bfr;
typedef __attribute__((ext_vector_type(8))) short bf16x8;
typedef __attribute__((ext_vector_type(4))) float f32x4;
typedef __attribute__((ext_vector_type(2))) float f32x2;
typedef __attribute__((ext_vector_type(2))) __bf16 bf2_t;
#define DI __device__ __forceinline__
#define MFMA16(a, b, c) __builtin_amdgcn_mfma_f32_16x16x32_bf16((a), (b), (c), 0, 0, 0)

constexpr int DM = 1024;
constexpr int NB_P = 4, T_P = 4112, SEQ_P = 4096, NMETA = 16;
constexpr int NB_S = 16, T_S = 64, PAST = 2048, S_S = 2112;
constexpr int ROWS_P = NB_P * T_P;
constexpr int ROWS = ROWS_P + NB_S * T_S;
constexpr int MPAD = 17536;
constexpr int NIN = 7492, NPAD = 7552;
constexpr int KP_PAD = 4128;
constexpr int MW = 132;
constexpr int NTILE_P = 65;

constexpr int C_Q = 0, C_K = 512, C_V = 1024, C_GA = 1536, C_QI = 2048, C_KI = 2304, C_XB = 2368, C_GB = 2880,
              C_XC = 3392, C_GC = 3904, C_GM = 4416, C_WI = 7488;

constexpr long O_YP = 0;
constexpr long O_YS = O_YP + (long)NB_P * SEQ_P * DM;
constexpr long O_KP = O_YS + (long)NB_S * T_S * DM;
constexpr long O_VP = O_KP + 2L * NB_P * T_P * 512;
constexpr long O_KIP = O_VP + 2L * NB_P * T_P * 512;
constexpr long O_CONVP = O_KIP + 2L * NB_P * T_P * 64;
constexpr long O_LRUP = O_CONVP + 2L * NB_P * 3 * 512;
constexpr long O_POOLP = O_LRUP + 2L * NB_P * 512;
constexpr long O_KS = O_POOLP + 2L * NB_P * 15 * 512;
constexpr long O_VS = O_KS + 2L * NB_S * T_S * 512;
constexpr long O_KIS = O_VS + 2L * NB_S * T_S * 512;
constexpr long O_CONVS = O_KIS + 2L * NB_S * T_S * 64;
constexpr long O_LRUS = O_CONVS + 2L * NB_S * 3 * 512;
constexpr long O_POOLS = O_LRUS + 2L * NB_S * 512;

constexpr size_t al256(size_t x) { return (x + 255) & ~(size_t)255; }
constexpr size_t W_CTR = 0;
constexpr size_t W_BAR = 4096;
constexpr size_t W_ROPE = 32768;
constexpr size_t W_WINT = al256(W_ROPE + (size_t)T_P * 8 * 8);
constexpr size_t W_WBT = al256(W_WINT + 2ull * NPAD * 1024 * 2);
constexpr size_t W_WOT = al256(W_WBT + 2ull * 3 * 1024 * 512 * 2);
constexpr size_t W_WAT = al256(W_WOT + 2ull * 1024 * 1024 * 2);
constexpr size_t W_WXT = al256(W_WAT + 2ull * 8 * 64 * 64 * 2);
constexpr size_t W_PWT = al256(W_WXT + 2ull * 8 * 64 * 64 * 2);
constexpr size_t W_XRES = al256(W_PWT + 2ull * 4 * 128 * 128 * 2);
constexpr size_t W_HN = al256(W_XRES + (size_t)MPAD * 1024 * 4);
constexpr size_t W_QB = al256(W_HN + (size_t)MPAD * 1024 * 2);
constexpr size_t W_GA = al256(W_QB + (size_t)MPAD * 512 * 2);
constexpr size_t W_QIB = al256(W_GA + (size_t)MPAD * 512 * 2);
constexpr size_t W_WIB = al256(W_QIB + (size_t)MPAD * 256 * 2);
constexpr size_t W_XBB = al256(W_WIB + (size_t)MPAD * 4 * 4);
constexpr size_t W_GB = al256(W_XBB + (size_t)MPAD * 512 * 2);
constexpr size_t W_XCB = al256(W_GB + (size_t)MPAD * 512 * 2);
constexpr size_t W_GC = al256(W_XCB + (size_t)MPAD * 512 * 2);
constexpr size_t W_GM = al256(W_GC + (size_t)MPAD * 512 * 2);
constexpr size_t W_KBP = al256(W_GM + (size_t)MPAD * 3072 * 2);
constexpr size_t W_VTP = al256(W_KBP + (size_t)NB_P * KP_PAD * 512 * 2);
constexpr size_t W_KIBP = al256(W_VTP + (size_t)NB_P * 512 * KP_PAD * 2);
constexpr size_t W_KBS = al256(W_KIBP + (size_t)NB_P * KP_PAD * 64 * 2);
constexpr size_t W_VTS = al256(W_KBS + (size_t)NB_S * S_S * 512 * 2);
constexpr size_t W_KIBS = al256(W_VTS + (size_t)NB_S * 512 * S_S * 2);
constexpr size_t W_MASK = al256(W_KIBS + (size_t)NB_S * S_S * 64 * 2);
constexpr size_t W_AGG = al256(W_MASK + (size_t)ROWS * MW * 4);
constexpr size_t W_KMAX = al256(W_AGG + (size_t)NB_P * NTILE_P * 512 * 2 * 4);
constexpr size_t W_END = al256(W_KMAX + 1024);

struct Params {
  const float *x_prompt, *x_sample, *cache_k, *cache_v, *cache_kidx, *state_conv, *state_lru, *state_pool, *meta,
      *norm_g, *w_in, *conv_w, *conv_b, *lru_wa, *lru_ba, *lru_wx, *lru_bx, *lru_lambda, *pool_w, *pool_scale,
      *w_branch_out, *w_out, *final_g;
  float* out;
  char* ws;
};

extern __shared__ __attribute__((aligned(128))) char smem[];
__shared__ int sh_item;
__shared__ int sh_xinfo[4];

DI float bf2f(bfr b) { return __uint_as_float(((unsigned)b) << 16); }
DI unsigned pack2(float a, float b) {
  f32x2 v = {a, b};
  bf2_t r = __builtin_convertvector(v, bf2_t);
  return __builtin_bit_cast(unsigned, r);
}
DI bfr f2bf(float x) { return (bfr)(pack2(x, 0.f) & 0xFFFFu); }
DI float sigm(float x) { return __builtin_amdgcn_rcpf(1.f + __expf(-x)); }
DI float silu(float x) { return x * __builtin_amdgcn_rcpf(1.f + __expf(-x)); }
DI int get_tid() {
  int t = threadIdx.x;
  asm volatile("" : "+v"(t));
  return t;
}
DI unsigned sortable(float f) {
  unsigned u = __float_as_uint(f);
  return (u & 0x80000000u) ? ~u : (u | 0x80000000u);
}
DI void decode_row(int row, int& isP, int& sq, int& t) {
  if (row < ROWS_P) { isP = 1; sq = row / T_P; t = row - sq * T_P; }
  else { isP = 0; int r = row - ROWS_P; sq = r >> 6; t = r & 63; }
}

DI void tc_tile(const float* src, long sld, bfr* dst, long dld, int k0, int n0, float* tile, int mapmode) {
  const int tid = get_tid();
  const int nn = tid & 63, kk0 = tid >> 6;
  int n = n0 + nn, sn = n;
  if (mapmode) sn = n < 2368 ? n : (n < 7488 ? n + 4 : (n < 7492 ? 2368 + (n - 7488) : -1));
  float v[16];
#pragma unroll
  for (int i = 0; i < 16; ++i) v[i] = sn >= 0 ? src[(long)(k0 + i * 4 + kk0) * sld + sn] : 0.f;
#pragma unroll
  for (int i = 0; i < 16; ++i) tile[(i * 4 + kk0) * 65 + nn] = v[i];
  __syncthreads();
#pragma unroll
  for (int i = 0; i < 16; ++i) {
    int nn2 = i * 4 + (tid >> 6), kk = tid & 63;
    dst[(long)(n0 + nn2) * dld + k0 + kk] = f2bf(tile[kk * 65 + nn2]);
  }
  __syncthreads();
}

DI void convert_cache(const Params& p, int layer, char*) {
  const int tid = get_tid();
  bfr* kbs = (bfr*)(p.ws + W_KBS);
  bfr* vts = (bfr*)(p.ws + W_VTS);
  bfr* kibs = (bfr*)(p.ws + W_KIBS);
  for (int it = blockIdx.x; it < NB_S * 32 * 8; it += gridDim.x) {
    int sb = it >> 8, r = it & 255, kt = r >> 3, nt = r & 7;
    tc_tile(p.cache_v + ((long)(layer * NB_S + sb) * PAST) * 512, 512, vts + (long)sb * 512 * S_S, S_S, kt * 64, nt * 64,
            (float*)smem, 0);
  }
  {
    const float4* src = (const float4*)(p.cache_k + (long)layer * NB_S * PAST * 512);
    const long n4 = (long)NB_S * PAST * 512 / 4;
    const long stride = (long)gridDim.x * 256;
    for (long i = (long)blockIdx.x * 256 + tid; i < n4; i += 4 * stride) {
      float4 v[4];
#pragma unroll
      for (int u = 0; u < 4; ++u) { const long ii = i + u * stride; v[u] = ii < n4 ? src[ii] : make_float4(0.f, 0.f, 0.f, 0.f); }
#pragma unroll
      for (int u = 0; u < 4; ++u) {
        const long ii = i + u * stride;
        if (ii < n4) {
          const long e = ii * 4;
          const int sb = (int)(e / ((long)PAST * 512));
          const long rem = e - (long)sb * PAST * 512;
          uint2 o; o.x = pack2(v[u].x, v[u].y); o.y = pack2(v[u].z, v[u].w);
          *(uint2*)(kbs + (long)sb * S_S * 512 + rem) = o;
        }
      }
    }
  }
  {
    const float4* src = (const float4*)(p.cache_kidx + (long)layer * NB_S * PAST * 64);
    const long n4 = (long)NB_S * PAST * 64 / 4;
    const long stride = (long)gridDim.x * 256;
    for (long i = (long)blockIdx.x * 256 + tid; i < n4; i += 4 * stride) {
      float4 v[4];
#pragma unroll
      for (int u = 0; u < 4; ++u) { const long ii = i + u * stride; v[u] = ii < n4 ? src[ii] : make_float4(0.f, 0.f, 0.f, 0.f); }
#pragma unroll
      for (int u = 0; u < 4; ++u) {
        const long ii = i + u * stride;
        if (ii < n4) {
          const long e = ii * 4;
          const int sb = (int)(e / ((long)PAST * 64));
          const long rem = e - (long)sb * PAST * 64;
          uint2 o; o.x = pack2(v[u].x, v[u].y); o.y = pack2(v[u].z, v[u].w);
          *(uint2*)(kibs + (long)sb * S_S * 64 + rem) = o;
        }
      }
    }
  }
}

DI void norm_phase(const Params& p, int mode) {
  const int tid = get_tid(), wid = __builtin_amdgcn_readfirstlane(tid >> 6), lane = tid & 63;
  float* xres = (float*)(p.ws + W_XRES);
  bfr* hn = (bfr*)(p.ws + W_HN);
  const float* g = mode == 0 ? p.norm_g : (mode == 1 ? p.norm_g + 1024 : p.final_g);
  for (int row = blockIdx.x * 4 + wid; row < ROWS; row += gridDim.x * 4) {
    int isP, sq, t;
    decode_row(row, isP, sq, t);
    const float* src;
    if (mode == 0) {
      if (isP) src = t < NMETA ? p.meta + (long)t * 1024 : p.x_prompt + ((long)sq * SEQ_P + t - NMETA) * 1024;
      else src = p.x_sample + (long)(row - ROWS_P) * 1024;
    } else src = xres + (long)row * 1024;
    float4 v[4];
    float ss = 0.f;
#pragma unroll
    for (int i = 0; i < 4; ++i) {
      v[i] = ((const float4*)src)[lane + i * 64];
      ss += v[i].x * v[i].x + v[i].y * v[i].y + v[i].z * v[i].z + v[i].w * v[i].w;
    }
#pragma unroll
    for (int o = 32; o >= 1; o >>= 1) ss += __shfl_xor(ss, o);
    const float inv = rsqrtf(ss * (1.f / 1024.f) + 1e-6f);
    float* dsty = nullptr;
    if (mode == 2) {
      if (isP) { if (t >= NMETA) dsty = p.out + O_YP + ((long)sq * SEQ_P + t - NMETA) * 1024; }
      else dsty = p.out + O_YS + (long)(row - ROWS_P) * 1024;
    }
#pragma unroll
    for (int i = 0; i < 4; ++i) {
      float4 gg = ((const float4*)g)[lane + i * 64];
      float4 y;
      y.x = v[i].x * inv * gg.x; y.y = v[i].y * inv * gg.y; y.z = v[i].z * inv * gg.z; y.w = v[i].w * inv * gg.w;
      if (mode == 0) ((float4*)(xres + (long)row * 1024))[lane + i * 64] = v[i];
      if (mode < 2) {
        uint2 o; o.x = pack2(y.x, y.y); o.y = pack2(y.z, y.w);
        *(uint2*)(hn + (long)row * 1024 + (lane + i * 64) * 4) = o;
      } else if (dsty) ((float4*)dsty)[lane + i * 64] = y;
    }
  }
}

DI void prep_phase(const Params& p, char*) {
  const int tid = get_tid();
  for (int it = blockIdx.x; it < 2 * 118 * 16; it += gridDim.x) {
    int l = it / (118 * 16), r = it % (118 * 16), nt = r / 16, kt = r % 16;
    tc_tile(p.w_in + (long)l * 1024 * NIN, NIN, (bfr*)(p.ws + W_WINT) + (long)l * NPAD * 1024, 1024, kt * 64, nt * 64,
            (float*)smem, 1);
  }
  for (int it = blockIdx.x; it < 6 * 16 * 8; it += gridDim.x) {
    int mtx = it / 128, r = it % 128, nt = r / 8, kt = r % 8;
    tc_tile(p.w_branch_out + (long)mtx * 512 * 1024, 1024, (bfr*)(p.ws + W_WBT) + (long)mtx * 1024 * 512, 512, kt * 64,
            nt * 64, (float*)smem, 0);
  }
  for (int it = blockIdx.x; it < 2 * 16 * 16; it += gridDim.x) {
    int l = it / 256, r = it % 256, nt = r / 16, kt = r % 16;
    tc_tile(p.w_out + (long)l * 1024 * 1024, 1024, (bfr*)(p.ws + W_WOT) + (long)l * 1024 * 1024, 1024, kt * 64, nt * 64,
            (float*)smem, 0);
  }
  for (int it = blockIdx.x; it < 32; it += gridDim.x) {
    int which = it >> 4, mtx = it & 15;
    tc_tile((which ? p.lru_wx : p.lru_wa) + (long)mtx * 4096, 64, (bfr*)(p.ws + (which ? W_WXT : W_WAT)) + (long)mtx * 4096,
            64, 0, 0, (float*)smem, 0);
  }
  for (int it = blockIdx.x; it < 32; it += gridDim.x) {
    int mtx = it >> 2, r = it & 3, nt = r >> 1, kt = r & 1;
    tc_tile(p.pool_w + (long)mtx * 16384, 128, (bfr*)(p.ws + W_PWT) + (long)mtx * 16384, 128, kt * 64, nt * 64,
            (float*)smem, 0);
  }
  {
    float2* rt = (float2*)(p.ws + W_ROPE);
    for (int e = blockIdx.x * 256 + tid; e < T_P * 8; e += gridDim.x * 256) {
      int pos = e >> 3, d = e & 7;
      float inv = powf(500000.f, -(float)d * 0.125f);
      float ang = (float)pos * inv;
      rt[e] = make_float2(cosf(ang), sinf(ang));
    }
  }
  convert_cache(p, 0, smem);
  norm_phase(p, 0);
}

template <int NF>
DI void gemm128(const bfr* A, int lda, const bfr* Bt, int ldb, int K, int brow, int bcol, char*, f32x4 (&acc)[4][NF],
             bool chained = false, bool first = true, int nbrow = -1, int nbcol = 0) {
  const int tid = get_tid(), wid = __builtin_amdgcn_readfirstlane(tid >> 6), lane = tid & 63, wr = wid >> 1, wc = wid & 1, fr = lane & 15, fq = lane >> 4;
  const int r0 = tid >> 3;
  const int cg = ((tid & 7) ^ (r0 & 7)) * 8;
  const bfr* ga = A + (long)(brow + r0) * lda + cg;
  const bfr* gb = Bt + (long)(bcol + r0) * ldb + cg;
  const long a32 = (long)32 * lda, b32 = (long)32 * ldb;
  const int nk = K / 64;
  auto stage = [&](int kt, int buf) {
    char* SA = smem + buf * 32768;
    char* SB = SA + 16384;
#pragma unroll
    for (int i = 0; i < 4; ++i)
      __builtin_amdgcn_global_load_lds((const unsigned*)(ga + i * a32 + kt * 64), (unsigned*)(SA + tid * 16 + i * 4096), 16, 0, 0);
#pragma unroll
    for (int i = 0; i < NF; ++i)
      __builtin_amdgcn_global_load_lds((const unsigned*)(gb + i * b32 + kt * 64), (unsigned*)(SB + tid * 16 + i * 4096), 16, 0, 0);
  };
  if (!chained || first) {
    asm volatile("s_waitcnt vmcnt(0)" ::: "memory");
    __syncthreads();
    stage(0, 0);
  }
  const unsigned lds0 = (unsigned)(size_t)smem;
  const unsigned sw0 = (unsigned)((fq ^ (fr & 7)) * 16), sw1 = (unsigned)(((4 + fq) ^ (fr & 7)) * 16);
  const unsigned arow = lds0 + (wr * 64 + fr) * 128, brw = lds0 + 16384 + (wc * NF * 16 + fr) * 128;
  for (int kt = 0; kt < nk; ++kt) {
    asm volatile("s_waitcnt vmcnt(0)" ::: "memory");
    __builtin_amdgcn_s_barrier();
    if (kt + 1 < nk) stage(kt + 1, (kt + 1) & 1);
    else if (chained && nbrow >= 0) {
      const bfr* na = A + (long)(nbrow + r0) * lda + cg;
      const bfr* nb = Bt + (long)(nbcol + r0) * ldb + cg;
#pragma unroll
      for (int i = 0; i < 4; ++i)
        __builtin_amdgcn_global_load_lds((const unsigned*)(na + i * a32), (unsigned*)(smem + tid * 16 + i * 4096), 16, 0, 0);
#pragma unroll
      for (int i = 0; i < NF; ++i)
        __builtin_amdgcn_global_load_lds((const unsigned*)(nb + i * b32), (unsigned*)(smem + 16384 + tid * 16 + i * 4096), 16, 0, 0);
    }
    const unsigned bo = (kt & 1) * 32768;
    bf16x8 af[2][4], bfg[2][4];
    if (NF == 4) {
      asm volatile(
          "ds_read_b128 %0, %16\n\tds_read_b128 %1, %16 offset:2048\n\tds_read_b128 %2, %16 offset:4096\n\tds_read_b128 %3, %16 offset:6144\n\t"
          "ds_read_b128 %4, %17\n\tds_read_b128 %5, %17 offset:2048\n\tds_read_b128 %6, %17 offset:4096\n\tds_read_b128 %7, %17 offset:6144\n\t"
          "ds_read_b128 %8, %18\n\tds_read_b128 %9, %18 offset:2048\n\tds_read_b128 %10, %18 offset:4096\n\tds_read_b128 %11, %18 offset:6144\n\t"
          "ds_read_b128 %12, %19\n\tds_read_b128 %13, %19 offset:2048\n\tds_read_b128 %14, %19 offset:4096\n\tds_read_b128 %15, %19 offset:6144\n\t"
          "s_waitcnt lgkmcnt(0)"
          : "=&v"(af[0][0]), "=&v"(af[0][1]), "=&v"(af[0][2]), "=&v"(af[0][3]), "=&v"(bfg[0][0]), "=&v"(bfg[0][1]), "=&v"(bfg[0][2]), "=&v"(bfg[0][3]),
            "=&v"(af[1][0]), "=&v"(af[1][1]), "=&v"(af[1][2]), "=&v"(af[1][3]), "=&v"(bfg[1][0]), "=&v"(bfg[1][1]), "=&v"(bfg[1][2]), "=&v"(bfg[1][3])
          : "v"(arow + sw0 + bo), "v"(brw + sw0 + bo), "v"(arow + sw1 + bo), "v"(brw + sw1 + bo)
          : "memory");
    } else {
      asm volatile(
          "ds_read_b128 %0, %12\n\tds_read_b128 %1, %12 offset:2048\n\tds_read_b128 %2, %12 offset:4096\n\tds_read_b128 %3, %12 offset:6144\n\t"
          "ds_read_b128 %4, %13\n\tds_read_b128 %5, %13 offset:2048\n\t"
          "ds_read_b128 %6, %14\n\tds_read_b128 %7, %14 offset:2048\n\tds_read_b128 %8, %14 offset:4096\n\tds_read_b128 %9, %14 offset:6144\n\t"
          "ds_read_b128 %10, %15\n\tds_read_b128 %11, %15 offset:2048\n\t"
          "s_waitcnt lgkmcnt(0)"
          : "=&v"(af[0][0]), "=&v"(af[0][1]), "=&v"(af[0][2]), "=&v"(af[0][3]), "=&v"(bfg[0][0]), "=&v"(bfg[0][1]),
            "=&v"(af[1][0]), "=&v"(af[1][1]), "=&v"(af[1][2]), "=&v"(af[1][3]), "=&v"(bfg[1][0]), "=&v"(bfg[1][1])
          : "v"(arow + sw0 + bo), "v"(brw + sw0 + bo), "v"(arow + sw1 + bo), "v"(brw + sw1 + bo)
          : "memory");
    }
#pragma unroll
    for (int ks = 0; ks < 2; ++ks)
#pragma unroll
      for (int m = 0; m < 4; ++m)
#pragma unroll
        for (int n = 0; n < NF; ++n) acc[m][n] = MFMA16(af[ks][m], bfg[ks][n], acc[m][n]);
  }
}

constexpr int EPI_PITCH = 64;
template <int REG>
DI void epi_region(const Params& p, int layer, f32x4 (&acc)[4][4], int rbase0, int rel, int lane, int wid) {
  const int fr = lane & 15, fq = lane >> 4;
  const float2* rt = (const float2*)(p.ws + W_ROPE);
  constexpr bool doRope = (REG == 0 || REG == 1 || REG == 4 || REG == 5);
  constexpr bool staged = (REG != 2 && REG != 11);
  bfr* img = (bfr*)(smem + 32768 + wid * (64 * EPI_PITCH * 2));
#pragma unroll
  for (int m = 0; m < 4; ++m) {
    const int rbase = rbase0 + m * 16 + fq * 4;
    const bool rowsValid = rbase < ROWS;
    int isP, sq, t0;
    decode_row(rowsValid ? rbase : 0, isP, sq, t0);
    if (doRope) {
      const int pos0 = isP ? t0 : PAST + t0;
#pragma unroll
      for (int j = 0; j < 4; ++j) {
        float v = acc[m][0][j];
        float pv = __shfl_xor(v, 8);
        float2 cs = rt[(pos0 + j) * 8 + (fr & 7)];
        acc[m][0][j] = (fr < 8) ? (v * cs.x - pv * cs.y) : (v * cs.x + pv * cs.y);
      }
    }
#pragma unroll
    for (int n = 0; n < 4; ++n) {
      const int col = rel + n * 16 + fr;
      if (REG == 2 && rowsValid) {
        uint2 pk; pk.x = pack2(acc[m][n][0], acc[m][n][1]); pk.y = pack2(acc[m][n][2], acc[m][n][3]);
        if (isP) *(uint2*)((bfr*)(p.ws + W_VTP) + ((long)sq * 512 + col) * KP_PAD + t0) = pk;
        else *(uint2*)((bfr*)(p.ws + W_VTS) + ((long)sq * 512 + col) * S_S + PAST + t0) = pk;
      }
#pragma unroll
      for (int j = 0; j < 4; ++j) {
        const float v = acc[m][n][j];
        const int row = rbase + j, t = t0 + j;
        if (rowsValid) {
          if (REG == 1) { if (isP) p.out[O_KP + ((long)(layer * NB_P + sq) * T_P + t) * 512 + col] = v; else p.out[O_KS + ((long)(layer * NB_S + sq) * T_S + t) * 512 + col] = v; }
          if (REG == 2) { if (isP) p.out[O_VP + ((long)(layer * NB_P + sq) * T_P + t) * 512 + col] = v; else p.out[O_VS + ((long)(layer * NB_S + sq) * T_S + t) * 512 + col] = v; }
          if (REG == 5) { if (isP) p.out[O_KIP + ((long)(layer * NB_P + sq) * T_P + t) * 64 + col] = v; else p.out[O_KIS + ((long)(layer * NB_S + sq) * T_S + t) * 64 + col] = v; }
          if (REG == 6) {
            if (isP) { if (t >= T_P - 3) p.out[O_CONVP + ((long)(layer * NB_P + sq) * 3 + (t - (T_P - 3))) * 512 + col] = v; }
            else { if (t >= T_S - 3) p.out[O_CONVS + ((long)(layer * NB_S + sq) * 3 + (t - (T_S - 3))) * 512 + col] = v; }
          }
          if (REG == 8) {
            if (isP) { if (t >= T_P - 15) p.out[O_POOLP + ((long)(layer * NB_P + sq) * 15 + (t - (T_P - 15))) * 512 + col] = v; }
            else { if (t >= T_S - 15) p.out[O_POOLS + ((long)(layer * NB_S + sq) * 15 + (t - (T_S - 15))) * 512 + col] = v; }
          }
          if (REG == 11) { if (col < 4) ((float*)(p.ws + W_WIB))[(long)row * 4 + col] = v; }
        }
        if (staged) {
          float y = v;
          if (REG == 3 || REG == 7 || REG == 9) y = silu(v);
          if (REG == 10) y = sigm(v);
          img[(m * 16 + fq * 4 + j) * EPI_PITCH + n * 16 + fr] = f2bf(y);
        }
      }
    }
  }
  if (staged) {
    asm volatile("s_waitcnt lgkmcnt(0)" ::: "memory");
#pragma unroll
    for (int it = 0; it < 8; ++it) {
      const int r = it * 8 + (lane >> 3), ch = lane & 7;
      const int row = rbase0 + r;
      if (row < ROWS) {
        int isP, sq, t;
        decode_row(row, isP, sq, t);
        bfr* dst;
        if (REG == 0) dst = (bfr*)(p.ws + W_QB) + (long)row * 512;
        else if (REG == 1) dst = isP ? (bfr*)(p.ws + W_KBP) + ((long)sq * KP_PAD + t) * 512 : (bfr*)(p.ws + W_KBS) + ((long)sq * S_S + PAST + t) * 512;
        else if (REG == 3) dst = (bfr*)(p.ws + W_GA) + (long)row * 512;
        else if (REG == 4) dst = (bfr*)(p.ws + W_QIB) + (long)row * 256;
        else if (REG == 5) dst = isP ? (bfr*)(p.ws + W_KIBP) + ((long)sq * KP_PAD + t) * 64 : (bfr*)(p.ws + W_KIBS) + ((long)sq * S_S + PAST + t) * 64;
        else if (REG == 6) dst = (bfr*)(p.ws + W_XBB) + (long)row * 512;
        else if (REG == 7) dst = (bfr*)(p.ws + W_GB) + (long)row * 512;
        else if (REG == 8) dst = (bfr*)(p.ws + W_XCB) + (long)row * 512;
        else if (REG == 9) dst = (bfr*)(p.ws + W_GC) + (long)row * 512;
        else dst = (bfr*)(p.ws + W_GM) + (long)row * 3072;
        const uint4 val = *(const uint4*)(img + r * EPI_PITCH + ch * 8);
        *(uint4*)(dst + rel + ch * 8) = val;
      }
    }
  }
}

DI void epi_inproj(const Params& p, int layer, f32x4 (&acc)[4][4], int brow, int bcol) {
  const int tid = get_tid(), wid = __builtin_amdgcn_readfirstlane(tid >> 6), lane = tid & 63, wr = wid >> 1, wc = wid & 1;
  const int c0 = bcol + wc * 64;
  const int rb = brow + wr * 64;
  asm volatile("s_waitcnt lgkmcnt(0)" ::: "memory");
  __builtin_amdgcn_s_barrier();
  if (c0 < C_K) epi_region<0>(p, layer, acc, rb, c0 - C_Q, lane, wid);
  else if (c0 < C_V) epi_region<1>(p, layer, acc, rb, c0 - C_K, lane, wid);
  else if (c0 < C_GA) epi_region<2>(p, layer, acc, rb, c0 - C_V, lane, wid);
  else if (c0 < C_QI) epi_region<3>(p, layer, acc, rb, c0 - C_GA, lane, wid);
  else if (c0 < C_KI) epi_region<4>(p, layer, acc, rb, c0 - C_QI, lane, wid);
  else if (c0 < C_XB) epi_region<5>(p, layer, acc, rb, c0 - C_KI, lane, wid);
  else if (c0 < C_GB) epi_region<6>(p, layer, acc, rb, c0 - C_XB, lane, wid);
  else if (c0 < C_XC) epi_region<7>(p, layer, acc, rb, c0 - C_GB, lane, wid);
  else if (c0 < C_GC) epi_region<8>(p, layer, acc, rb, c0 - C_XC, lane, wid);
  else if (c0 < C_GM) epi_region<9>(p, layer, acc, rb, c0 - C_GC, lane, wid);
  else if (c0 < C_WI) epi_region<10>(p, layer, acc, rb, c0 - C_GM, lane, wid);
  else epi_region<11>(p, layer, acc, rb, c0 - C_WI, lane, wid);
}

DI void phase_inproj(const Params& p, int layer, char*) {
  const bfr* A = (const bfr*)(p.ws + W_HN);
  const bfr* Bt = (const bfr*)(p.ws + W_WINT) + (long)layer * NPAD * 1024;
  constexpr int NTM = MPAD / 128, NTN = NPAD / 128;
  const int rank = sh_xinfo[0], nloc = sh_xinfo[1], ia = sh_xinfo[2], na = sh_xinfo[3];
  const int nbase = NTN / na, nrem = NTN % na;
  const int nn = nbase + (ia < nrem ? 1 : 0), n0 = ia * nbase + min(ia, nrem);
#if PROBE == 1
#pragma unroll 1
  for (int rep = 0; rep < 2; ++rep)
#endif
  bool first = true;
  for (int i = rank; i < NTM * nn; i += nloc) {
    const int tm = i / nn, tn = n0 + (i - tm * nn);
    const int inx = i + nloc;
    int nbr = -1, nbc = 0;
    if (inx < NTM * nn) { const int tm2 = inx / nn; nbr = tm2 * 128; nbc = (n0 + (inx - tm2 * nn)) * 128; }
    f32x4 acc[4][4];
#pragma unroll
    for (int m = 0; m < 4; ++m)
#pragma unroll
      for (int n = 0; n < 4; ++n) acc[m][n] = f32x4{0.f, 0.f, 0.f, 0.f};
    gemm128<4>(A, 1024, Bt, 1024, 1024, tm * 128, tn * 128, smem, acc, true, first, nbr, nbc);
    first = false;
    epi_inproj(p, layer, acc, tm * 128, tn * 128);
  }
}

DI void phase_merge(const Params& p, int layer, char*) {
  const int tid = get_tid(), wid = __builtin_amdgcn_readfirstlane(tid >> 6), lane = tid & 63, wr = wid >> 1, wc = wid & 1, fr = lane & 15, fq = lane >> 4;
  const bfr* gmb = (const bfr*)(p.ws + W_GM);
  bfr* merged = (bfr*)(p.ws + W_HN);
  constexpr int NTM = MPAD / 128, NTN = 8;
  for (int tile = blockIdx.x; tile < NTM * NTN; tile += gridDim.x) {
    int tn = tile / NTM, tm = tile % NTM;
    const int brow = tm * 128, bcol = tn * 128;
    unsigned tot[4][4][2];
#pragma unroll
    for (int m = 0; m < 4; ++m)
#pragma unroll
      for (int n = 0; n < 4; ++n) { tot[m][n][0] = 0u; tot[m][n][1] = 0u; }
#pragma unroll 1
    for (int br = 0; br < 3; ++br) {
      const bfr* A = (const bfr*)(p.ws + (br == 0 ? W_GA : (br == 1 ? W_GB : W_GC)));
      const bfr* Bt = (const bfr*)(p.ws + W_WBT) + (long)(layer * 3 + br) * 1024 * 512;
      f32x4 acc[4][4];
#pragma unroll
      for (int m = 0; m < 4; ++m)
#pragma unroll
        for (int n = 0; n < 4; ++n) acc[m][n] = f32x4{0.f, 0.f, 0.f, 0.f};
      gemm128<4>(A, 512, Bt, 512, 512, brow, bcol, smem, acc);
#pragma unroll
      for (int m = 0; m < 4; ++m) {
        const int row0 = brow + wr * 64 + m * 16 + fq * 4;
        if (row0 < ROWS) {
#pragma unroll
          for (int n = 0; n < 4; ++n) {
            const int col = bcol + wc * 64 + n * 16 + fr;
            const bfr* gp = gmb + (long)row0 * 3072 + br * 1024 + col;
            const float g0 = bf2f(gp[0]), g1 = bf2f(gp[3072]), g2 = bf2f(gp[2 * 3072]), g3 = bf2f(gp[3 * 3072]);
            const unsigned t0 = tot[m][n][0], t1 = tot[m][n][1];
            tot[m][n][0] = pack2(__uint_as_float(t0 << 16) + g0 * acc[m][n][0], __uint_as_float(t0 & 0xFFFF0000u) + g1 * acc[m][n][1]);
            tot[m][n][1] = pack2(__uint_as_float(t1 << 16) + g2 * acc[m][n][2], __uint_as_float(t1 & 0xFFFF0000u) + g3 * acc[m][n][3]);
          }
        }
      }
    }
#pragma unroll
    for (int m = 0; m < 4; ++m) {
      const int row0 = brow + wr * 64 + m * 16 + fq * 4;
      if (row0 < ROWS) {
#pragma unroll
        for (int n = 0; n < 4; ++n) {
          bfr* mp = merged + (long)row0 * 1024 + bcol + wc * 64 + n * 16 + fr;
          mp[0] = (bfr)(tot[m][n][0] & 0xFFFFu); mp[1024] = (bfr)(tot[m][n][0] >> 16);
          mp[2048] = (bfr)(tot[m][n][1] & 0xFFFFu); mp[3072] = (bfr)(tot[m][n][1] >> 16);
        }
      }
    }
  }
}

DI void phase_out(const Params& p, int layer, char*) {
  const int tid = get_tid(), wid = __builtin_amdgcn_readfirstlane(tid >> 6), lane = tid & 63, wr = wid >> 1, wc = wid & 1, fr = lane & 15, fq = lane >> 4;
  const bfr* A = (const bfr*)(p.ws + W_HN);
  const bfr* Bt = (const bfr*)(p.ws + W_WOT) + (long)layer * 1024 * 1024;
  float* xres = (float*)(p.ws + W_XRES);
  constexpr int NTM = MPAD / 128, NTN = 8;
  for (int tile = blockIdx.x; tile < NTM * NTN; tile += gridDim.x) {
    int tn = tile / NTM, tm = tile % NTM;
    const int brow = tm * 128, bcol = tn * 128;
    f32x4 acc[4][4];
#pragma unroll
    for (int m = 0; m < 4; ++m)
#pragma unroll
      for (int n = 0; n < 4; ++n) acc[m][n] = f32x4{0.f, 0.f, 0.f, 0.f};
    gemm128<4>(A, 1024, Bt, 1024, 1024, brow, bcol, smem, acc);
#pragma unroll
    for (int m = 0; m < 4; ++m)
#pragma unroll
      for (int j = 0; j < 4; ++j) {
        int row = brow + wr * 64 + m * 16 + fq * 4 + j;
        if (row < ROWS) {
#pragma unroll
          for (int n = 0; n < 4; ++n) xres[(long)row * 1024 + bcol + wc * 64 + n * 16 + fr] += acc[m][n][j];
        }
      }
  }
}

constexpr int SEL_QS = 2120;
DI void select_item(const Params& p, int isP, int sq, int c, int sub, char*) {
  const int tid = get_tid(), wid = __builtin_amdgcn_readfirstlane(tid >> 6), lane = tid & 63, fr = lane & 15, fq = lane >> 4;
  int T0, nadm, rowbase;
  const bfr* kib;
  if (isP) {
    if (c == 0) { T0 = 0; nadm = 16; } else { T0 = 16 + 64 * (c - 1) + 16 * sub; nadm = 16 + 64 * c; }
    rowbase = sq * T_P;
    kib = (const bfr*)(p.ws + W_KIBP) + (long)sq * KP_PAD * 64;
  } else {
    T0 = 16 * sub; nadm = S_S; rowbase = ROWS_P + sq * 64;
    kib = (const bfr*)(p.ws + W_KIBS) + (long)sq * S_S * 64;
  }
  unsigned* maskg = (unsigned*)(p.ws + W_MASK);
  const int nsteps = (nadm + 31) >> 5;
  if (nadm <= 256) {
    for (int e = tid; e < 16 * nsteps; e += 256) {
      int q = e / nsteps, s = e - q * nsteps;
      unsigned w = (s * 32 + 32 <= nadm) ? 0xFFFFFFFFu : 0xFFFFu;
      maskg[(long)(rowbase + T0 + q) * MW + s] = w;
    }
    return;
  }
  const int nkt = nadm >> 4;
  const int nmine = (nkt - wid + 3) >> 2;
  const int nregs = (nadm + 63) >> 6;
  const bfr* qib = (const bfr*)(p.ws + W_QIB);
  const float* wib = (const float*)(p.ws + W_WIB);
  unsigned* S = (unsigned*)smem;
#pragma unroll 1
  for (int g = 0; g < 4; ++g) {
    const int qrow = rowbase + T0 + g * 4;
    int koff = (wid * 16 + fr) * 64 + fq * 8;
    asm volatile("" : "+v"(koff));
    const bfr* kbase = kib + koff;
    int nm = nmine;
    asm volatile("" : "+v"(nm));
    nm = __builtin_amdgcn_readfirstlane(nm);
    const bfr* qp = qib + (long)(qrow + (fr >> 2)) * 256 + (fr & 3) * 64 + fq * 8;
    const bf16x8 a0 = *(const bf16x8*)qp;
    const bf16x8 a1 = *(const bf16x8*)(qp + 32);
    const float4 w = *(const float4*)(wib + (long)(qrow + fq) * 4);
    unsigned sc[65];
#pragma unroll
    for (int ch = 0; ch < 5; ++ch) {
      if (ch * 13 < nm) {
        bf16x8 b0[13], b1[13];
#pragma unroll
        for (int u = 0; u < 13; ++u) {
          const int ic = min(ch * 13 + u, nm - 1);
          const bfr* kp = kbase + (long)ic * 4096;
          b0[u] = *(const bf16x8*)kp;
          b1[u] = *(const bf16x8*)(kp + 32);
        }
#pragma unroll
        for (int u = 0; u < 13; ++u) {
          const int i = ch * 13 + u;
          f32x4 a = {0.f, 0.f, 0.f, 0.f};
          a = MFMA16(a0, b0[u], a);
          a = MFMA16(a1, b1[u], a);
          float s = w.x * fmaxf(a[0], 0.f) + w.y * fmaxf(a[1], 0.f) + w.z * fmaxf(a[2], 0.f) + w.w * fmaxf(a[3], 0.f);
          sc[i] = (i < nm) ? sortable(s) : 0u;
        }
      } else {
#pragma unroll
        for (int u = 0; u < 13; ++u) sc[ch * 13 + u] = 0u;
      }
      __builtin_amdgcn_sched_barrier(0);
    }
    unsigned v[65];
    __syncthreads();
#pragma unroll
    for (int i = 0; i < 33; ++i) S[fq * SEL_QS + (i * 4 + wid) * 16 + fr] = sc[i];
    __syncthreads();
#pragma unroll
    for (int j = 0; j < 33; ++j) v[j] = S[wid * SEL_QS + j * 64 + lane];
    if (nregs > 33) {
      __syncthreads();
#pragma unroll
      for (int i = 33; i < 65; ++i) S[fq * SEL_QS + (i * 4 + wid - 132) * 16 + fr] = sc[i];
      __syncthreads();
#pragma unroll
      for (int j = 0; j < 32; ++j) v[33 + j] = S[wid * SEL_QS + j * 64 + lane];
    } else {
#pragma unroll
      for (int j = 0; j < 32; ++j) v[33 + j] = 0u;
    }
    int nr = nregs;
    asm volatile("" : "+v"(nr));
    nr = __builtin_amdgcn_readfirstlane(nr);
    unsigned vmax = 0u;
#pragma unroll
    for (int r = 0; r < 65; ++r) vmax = max(vmax, v[r]);
#pragma unroll
    for (int o = 32; o >= 1; o >>= 1) vmax = max(vmax, (unsigned)__shfl_xor((int)vmax, o));
    vmax = __builtin_amdgcn_readfirstlane(vmax);
    unsigned thr = 0u;
    int exact = 0;
#pragma unroll 1
    for (int bit = 31; bit >= 0; --bit) {
      const unsigned cand = thr | (1u << bit);
      if (cand > vmax) continue;
      int cnt = 0;
#pragma unroll
      for (int ch = 0; ch < 5; ++ch) {
        if (ch * 13 < nr) {
#pragma unroll
          for (int u = 0; u < 13; ++u) cnt += __popcll(__ballot(v[ch * 13 + u] >= cand));
        }
      }
      if (cnt >= 256) {
        thr = cand;
        if (cnt == 256) { exact = 1; break; }
      }
    }
    if (exact) {
      unsigned mn = 0xFFFFFFFFu;
#pragma unroll
      for (int r = 0; r < 65; ++r) mn = min(mn, v[r] >= thr ? v[r] : 0xFFFFFFFFu);
#pragma unroll
      for (int o = 32; o >= 1; o >>= 1) mn = min(mn, (unsigned)__shfl_xor((int)mn, o));
      thr = __builtin_amdgcn_readfirstlane(mn);
    }
    int gt = 0, eq = 0;
#pragma unroll
    for (int r = 0; r < 65; ++r) {
      gt += __popcll(__ballot(v[r] > thr));
      eq += __popcll(__ballot(v[r] == thr));
    }
    const int need = 256 - gt;
    int idxcut = 0x7fffffff;
    if (eq != need) {
      int run = 0;
      bool done = false;
#pragma unroll
      for (int r = 0; r < 65; ++r) {
        if (!done) {
          unsigned long long m = __ballot(v[r] == thr);
          int pc = __popcll(m);
          if (run + pc >= need) {
            const int k = need - run;
            for (int t = 1; t < k; ++t) m &= m - 1ull;
            idxcut = r * 64 + (__ffsll((long long)m) - 1);
            done = true;
          } else run += pc;
        }
      }
    }
    unsigned* mrowp = maskg + (long)(qrow + wid) * MW;
#pragma unroll
    for (int r = 0; r < 65; ++r) {
      if (r < nr) {
        const bool sel = (v[r] > thr) || (v[r] == thr && (r * 64 + lane) <= idxcut);
        const unsigned long long bal = __ballot(sel);
        if (lane == 0) *(uint2*)(mrowp + r * 2) = make_uint2((unsigned)bal, (unsigned)(bal >> 32));
      }
    }
  }
}

DI void lru_tile(const Params& p, int layer, int isP, int sq, int tile, int nb, int pass, char*) {
  const int tid = get_tid(), wid = __builtin_amdgcn_readfirstlane(tid >> 6), lane = tid & 63, fr = lane & 15, fq = lane >> 4;
  float* xbs = (float*)smem;
  float* as_ = xbs;
  float* xcs = xbs + 67 * 64;
  float* bs_ = xcs + 64 * 64;
  float* ab = bs_ + 64 * 64;
  bfr* xca = (bfr*)(ab + 512);
  const int T = isP ? T_P : T_S;
  const int rowbase = isP ? sq * T_P : ROWS_P + sq * 64;
  const int t0 = tile * 64, ch0 = nb * 64;
  const bfr* xbb = (const bfr*)(p.ws + W_XBB);
  bfr* gby = (bfr*)(p.ws + W_GB);
  float* agg = (float*)(p.ws + W_AGG);
  {
    const int c = tid & 63;
    float vv[17];
#pragma unroll
    for (int i = 0; i < 17; ++i) {
      const int rr = i * 4 + (tid >> 6);
      const int tt = t0 - 3 + rr;
      float v = 0.f;
      if (rr < 67) {
        if (tt < 0) { if (!isP) v = p.state_conv[((long)(layer * NB_S + sq) * 3 + (3 + tt)) * 512 + ch0 + c]; }
        else if (tt < T) v = bf2f(xbb[(long)(rowbase + tt) * 512 + ch0 + c]);
      }
      vv[i] = v;
    }
#pragma unroll
    for (int i = 0; i < 17; ++i) { const int rr = i * 4 + (tid >> 6); if (rr < 67) xbs[rr * 64 + c] = vv[i]; }
  }
  __syncthreads();
  {
    const int c = tid & 63;
    const float cb = p.conv_b[layer * 512 + ch0 + c];
    const float w0 = p.conv_w[(layer * 4 + 0) * 512 + ch0 + c], w1 = p.conv_w[(layer * 4 + 1) * 512 + ch0 + c],
                w2 = p.conv_w[(layer * 4 + 2) * 512 + ch0 + c], w3 = p.conv_w[(layer * 4 + 3) * 512 + ch0 + c];
    for (int t = tid >> 6; t < 64; t += 4) {
      float xc = cb + w0 * xbs[t * 64 + c] + w1 * xbs[(t + 1) * 64 + c] + w2 * xbs[(t + 2) * 64 + c] + w3 * xbs[(t + 3) * 64 + c];
      xcs[t * 64 + c] = xc;
      xca[t * 72 + c] = f2bf(xc);
    }
  }
  __syncthreads();
  {
    const bfr* WaT = (const bfr*)(p.ws + W_WAT) + (long)(layer * 8 + nb) * 4096;
    const bfr* WxT = (const bfr*)(p.ws + W_WXT) + (long)(layer * 8 + nb) * 4096;
    bf16x8 af0 = *(const bf16x8*)(xca + (wid * 16 + fr) * 72 + fq * 8);
    bf16x8 af1 = *(const bf16x8*)(xca + (wid * 16 + fr) * 72 + 32 + fq * 8);
#pragma unroll
    for (int nt = 0; nt < 4; ++nt) {
      const int d = nt * 16 + fr;
      bf16x8 ba0 = *(const bf16x8*)(WaT + d * 64 + fq * 8), ba1 = *(const bf16x8*)(WaT + d * 64 + 32 + fq * 8);
      bf16x8 bx0 = *(const bf16x8*)(WxT + d * 64 + fq * 8), bx1 = *(const bf16x8*)(WxT + d * 64 + 32 + fq * 8);
      f32x4 ar = {0.f, 0.f, 0.f, 0.f}, ai = {0.f, 0.f, 0.f, 0.f};
      ar = MFMA16(af0, ba0, ar); ar = MFMA16(af1, ba1, ar);
      ai = MFMA16(af0, bx0, ai); ai = MFMA16(af1, bx1, ai);
      const float bav = p.lru_ba[layer * 512 + ch0 + d], bxv = p.lru_bx[layer * 512 + ch0 + d];
      const float sp = log1pf(__expf(-p.lru_lambda[layer * 512 + ch0 + d]));
#pragma unroll
      for (int j = 0; j < 4; ++j) {
        const int t = wid * 16 + fq * 4 + j;
        float r = sigm(ar[j] + bav), ig = sigm(ai[j] + bxv);
        float la = -8.f * r * sp;
        float a = __expf(la);
        float b = sqrtf(1.f - __expf(2.f * la)) * (ig * xcs[t * 64 + d]);
        if (t0 + t >= T) { a = 1.f; b = 0.f; }
        as_[t * 64 + d] = a;
        bs_[t * 64 + d] = b;
      }
    }
  }
  __syncthreads();
  const int c = tid & 63;
  {
    float A = 1.f, B = 0.f;
#pragma unroll
    for (int tt = 0; tt < 16; ++tt) {
      float a = as_[(wid * 16 + tt) * 64 + c], b = bs_[(wid * 16 + tt) * 64 + c];
      A *= a; B = a * B + b;
    }
    ab[(wid * 64 + c) * 2] = A;
    ab[(wid * 64 + c) * 2 + 1] = B;
  }
  __syncthreads();
  if (pass == 0) {
    if (wid == 0) {
      float A = 1.f, B = 0.f;
#pragma unroll
      for (int w = 0; w < 4; ++w) { float a = ab[(w * 64 + c) * 2], b = ab[(w * 64 + c) * 2 + 1]; A *= a; B = a * B + b; }
      *(float2*)(agg + ((long)(sq * NTILE_P + tile) * 512 + ch0 + c) * 2) = make_float2(A, B);
    }
  } else {
    float h = isP ? 0.f : p.state_lru[(long)(layer * NB_S + sq) * 512 + ch0 + c];
    for (int i0 = 0; i0 < tile; i0 += 16) {
      float2 e[16];
#pragma unroll
      for (int u = 0; u < 16; ++u)
        e[u] = (i0 + u < tile) ? *(const float2*)(agg + ((long)(sq * NTILE_P + i0 + u) * 512 + ch0 + c) * 2) : make_float2(1.f, 0.f);
#pragma unroll
      for (int u = 0; u < 16; ++u) h = e[u].x * h + e[u].y;
    }
    for (int w = 0; w < wid; ++w) h = ab[(w * 64 + c) * 2] * h + ab[(w * 64 + c) * 2 + 1];
#pragma unroll
    for (int tt = 0; tt < 16; ++tt) {
      const int t = wid * 16 + tt;
      h = as_[t * 64 + c] * h + bs_[t * 64 + c];
      if (t0 + t < T) {
        const long idx = (long)(rowbase + t0 + t) * 512 + ch0 + c;
        gby[idx] = f2bf(h * bf2f(gby[idx]));
        if (t0 + t == T - 1) {
          if (isP) p.out[O_LRUP + (long)(layer * NB_P + sq) * 512 + ch0 + c] = h;
          else p.out[O_LRUS + (long)(layer * NB_S + sq) * 512 + ch0 + c] = h;
        }
      }
    }
  }
}

DI void pool_item(const Params& p, int layer, int isP, int sq, int tile, int g, char*) {
  const int tid = get_tid(), wid = __builtin_amdgcn_readfirstlane(tid >> 6), lane = tid & 63, fr = lane & 15, fq = lane >> 4;
  float* xps = (float*)smem;
  bfr* pa = (bfr*)(xps + 79 * 128);
  const int T = isP ? T_P : T_S;
  const int rowbase = isP ? sq * T_P : ROWS_P + sq * 64;
  const int t0 = tile * 64, ch0 = g * 128;
  const bfr* xcb = (const bfr*)(p.ws + W_XCB);
  bfr* gcy = (bfr*)(p.ws + W_GC);
  {
    const int c = tid & 127;
#pragma unroll
    for (int b8 = 0; b8 < 5; ++b8) {
      float vv[8];
#pragma unroll
      for (int u = 0; u < 8; ++u) {
        const int rr = (b8 * 8 + u) * 2 + (tid >> 7);
        const int tt = t0 - 15 + rr;
        float v = 0.f;
        if (rr < 79) {
          if (tt < 0) { if (!isP) v = p.state_pool[((long)(layer * NB_S + sq) * 15 + (15 + tt)) * 512 + ch0 + c]; }
          else if (tt < T) v = bf2f(xcb[(long)(rowbase + tt) * 512 + ch0 + c]);
        }
        vv[u] = v;
      }
#pragma unroll
      for (int u = 0; u < 8; ++u) { const int rr = (b8 * 8 + u) * 2 + (tid >> 7); if (rr < 79) xps[rr * 128 + c] = vv[u]; }
    }
  }
  __syncthreads();
  {
    const int c = tid & 127;
    const int w = 2 << g;
    const int nh = isP ? 0 : PAST;
    for (int t = tid >> 7; t < 64; t += 2) {
      float s = 0.f;
      for (int i = 0; i < w; ++i) s += xps[(15 + t - i) * 128 + c];
      int cnt = min(w, t0 + t + 1 + nh);
      float v = s / (float)cnt - xps[(15 + t) * 128 + c];
      pa[t * 136 + c] = f2bf(v);
    }
  }
  __syncthreads();
  {
    const bfr* PwT = (const bfr*)(p.ws + W_PWT) + (long)(layer * 4 + g) * 16384;
    bf16x8 af[4];
#pragma unroll
    for (int ks = 0; ks < 4; ++ks) af[ks] = *(const bf16x8*)(pa + (wid * 16 + fr) * 136 + ks * 32 + fq * 8);
#pragma unroll
    for (int nt = 0; nt < 8; ++nt) {
      const int d = nt * 16 + fr;
      f32x4 acc = {0.f, 0.f, 0.f, 0.f};
#pragma unroll
      for (int ks = 0; ks < 4; ++ks) {
        bf16x8 bq = *(const bf16x8*)(PwT + d * 128 + ks * 32 + fq * 8);
        acc = MFMA16(af[ks], bq, acc);
      }
      const float scl = p.pool_scale[layer * 512 + ch0 + d];
#pragma unroll
      for (int j = 0; j < 4; ++j) {
        const int t = wid * 16 + fq * 4 + j;
        if (t0 + t < T) {
          const long idx = (long)(rowbase + t0 + t) * 512 + ch0 + d;
          gcy[idx] = f2bf(acc[j] * scl * bf2f(gcy[idx]));
        }
      }
    }
  }
}

DI void kmax_item(const Params& p, int seq, int h, char*) {
  const int tid = get_tid(), wid = __builtin_amdgcn_readfirstlane(tid >> 6), lane = tid & 63;
  const bfr* kb; int S;
  if (seq < NB_P) { kb = (const bfr*)(p.ws + W_KBP) + (long)seq * KP_PAD * 512; S = T_P; }
  else { kb = (const bfr*)(p.ws + W_KBS) + (long)(seq - NB_P) * S_S * 512; S = S_S; }
  float mx = 0.f;
  for (int key = tid; key < S; key += 256) {
    const uint4* r = (const uint4*)(kb + (long)key * 512 + h * 64);
    float ss = 0.f;
#pragma unroll
    for (int i = 0; i < 8; ++i) {
      uint4 v = r[i];
      unsigned u[4] = {v.x, v.y, v.z, v.w};
#pragma unroll
      for (int j = 0; j < 4; ++j) {
        float a = __uint_as_float(u[j] << 16), b = __uint_as_float(u[j] & 0xFFFF0000u);
        ss += a * a + b * b;
      }
    }
    mx = fmaxf(mx, ss);
  }
#pragma unroll
  for (int o = 32; o >= 1; o >>= 1) mx = fmaxf(mx, __shfl_xor(mx, o));
  float* red = (float*)smem;
  if (lane == 0) red[wid] = mx;
  __syncthreads();
  if (tid == 0) ((float*)(p.ws + W_KMAX))[seq * 8 + h] = fmaxf(fmaxf(red[0], red[1]), fmaxf(red[2], red[3]));
}

DI void attn_unit(const Params& p, int isP, int sq, int c, int h, int half, size_t dstoff = W_GA) {
  const int lane = get_tid() & 63, fr = lane & 15, fq = lane >> 4;
  int T0, nqt, nadm, rowbase, vld;
  const bfr *kb, *vt;
  if (isP) {
    if (c == 0) { T0 = 0; nqt = 1; nadm = 16; } else { T0 = 16 + 64 * (c - 1) + 32 * half; nqt = 2; nadm = 16 + 64 * c; }
    rowbase = sq * T_P;
    kb = (const bfr*)(p.ws + W_KBP) + (long)sq * KP_PAD * 512;
    vt = (const bfr*)(p.ws + W_VTP) + (long)sq * 512 * KP_PAD;
    vld = KP_PAD;
  } else {
    T0 = 32 * half; nqt = 2; nadm = S_S; rowbase = ROWS_P + sq * 64;
    kb = (const bfr*)(p.ws + W_KBS) + (long)sq * S_S * 512;
    vt = (const bfr*)(p.ws + W_VTS) + (long)sq * 512 * S_S;
    vld = S_S;
  }
  const int nsteps = (nadm + 31) >> 5;
  const int qrow0 = rowbase + T0;
  const bfr* qb = (const bfr*)(p.ws + W_QB);
  const unsigned* maskg = (const unsigned*)(p.ws + W_MASK);
  bf16x8 qf[2][2];
#pragma unroll
  for (int qt = 0; qt < 2; ++qt)
#pragma unroll
    for (int ks = 0; ks < 2; ++ks) {
      int r = qrow0 + (qt < nqt ? qt * 16 : 0) + fr;
      qf[qt][ks] = *(const bf16x8*)(qb + (long)r * 512 + h * 64 + ks * 32 + fq * 8);
    }
  f32x4 o[2][4];
#pragma unroll
  for (int qt = 0; qt < 2; ++qt)
#pragma unroll
    for (int dt = 0; dt < 4; ++dt) o[qt][dt] = f32x4{0.f, 0.f, 0.f, 0.f};
  const float sc2 = 0.125f * 1.4426950408889634f;
  const float kmax2 = ((const float*)(p.ws + W_KMAX))[(isP ? sq : NB_P + sq) * 8 + h];
  float mref[2], lsum[2] = {0.f, 0.f};
#pragma unroll
  for (int qt = 0; qt < 2; ++qt) {
    float ss = 0.f;
#pragma unroll
    for (int ks = 0; ks < 2; ++ks)
#pragma unroll
      for (int i = 0; i < 8; ++i) { float a = bf2f((bfr)qf[qt][ks][i]); ss += a * a; }
    ss += __shfl_xor(ss, 16);
    ss += __shfl_xor(ss, 32);
    mref[qt] = sqrtf(ss * kmax2) * sc2;
  }
  const unsigned* mrow0 = maskg + (long)(qrow0 + fr) * MW;
  const unsigned* mrow1 = maskg + (long)(qrow0 + (nqt > 1 ? 16 : 0) + fr) * MW;
  const int kofs = (fr >> 2) * 8 + (fr & 3);
  const bfr* kptr = kb + (long)kofs * 512 + h * 64 + fq * 8;
  const bfr* vptr = vt + (long)(h * 64 + fr) * vld + fq * 8;
  bf16x8 ka0 = *(const bf16x8*)kptr, ka1 = *(const bf16x8*)(kptr + 32);
  bf16x8 kb0 = *(const bf16x8*)(kptr + 4 * 512), kb1 = *(const bf16x8*)(kptr + 4 * 512 + 32);
  bf16x8 vf[4];
#pragma unroll
  for (int dt = 0; dt < 4; ++dt) vf[dt] = *(const bf16x8*)(vptr + (long)dt * 16 * vld);
  unsigned mw0 = mrow0[0], mw1 = mrow1[0];
  for (int s = 0; s < nsteps; ++s) {
    const int sn = min(s + 1, nsteps - 1);
    const bfr* pa = kptr + (long)sn * 32 * 512;
    const bf16x8 nka0 = *(const bf16x8*)pa, nka1 = *(const bf16x8*)(pa + 32);
    const bf16x8 nkb0 = *(const bf16x8*)(pa + 4 * 512), nkb1 = *(const bf16x8*)(pa + 4 * 512 + 32);
    bf16x8 nvf[4];
#pragma unroll
    for (int dt = 0; dt < 4; ++dt) nvf[dt] = *(const bf16x8*)(vptr + (long)dt * 16 * vld + sn * 32);
    const unsigned nmw0 = mrow0[sn], nmw1 = mrow1[sn];
#pragma unroll
    for (int qt = 0; qt < 2; ++qt) {
      if (qt < nqt) {
        f32x4 sa = {0.f, 0.f, 0.f, 0.f}, sb = {0.f, 0.f, 0.f, 0.f};
        sa = MFMA16(ka0, qf[qt][0], sa); sa = MFMA16(ka1, qf[qt][1], sa);
        sb = MFMA16(kb0, qf[qt][0], sb); sb = MFMA16(kb1, qf[qt][1], sb);
        const unsigned mb = ((qt == 0 ? mw0 : mw1) >> (fq * 8)) & 0xFFu;
        float pr[8];
#pragma unroll
        for (int i = 0; i < 4; ++i) {
          float pa_ = __builtin_amdgcn_exp2f(sa[i] * sc2 - mref[qt]);
          float pb_ = __builtin_amdgcn_exp2f(sb[i] * sc2 - mref[qt]);
          pr[i] = ((mb >> i) & 1u) ? pa_ : 0.f;
          pr[4 + i] = ((mb >> (4 + i)) & 1u) ? pb_ : 0.f;
        }
        lsum[qt] += ((pr[0] + pr[1]) + (pr[2] + pr[3])) + ((pr[4] + pr[5]) + (pr[6] + pr[7]));
        union { unsigned u[4]; bf16x8 v; } pk;
        pk.u[0] = pack2(pr[0], pr[1]); pk.u[1] = pack2(pr[2], pr[3]); pk.u[2] = pack2(pr[4], pr[5]); pk.u[3] = pack2(pr[6], pr[7]);
#pragma unroll
        for (int dt = 0; dt < 4; ++dt) o[qt][dt] = MFMA16(vf[dt], pk.v, o[qt][dt]);
      }
    }
    ka0 = nka0; ka1 = nka1; kb0 = nkb0; kb1 = nkb1;
#pragma unroll
    for (int dt = 0; dt < 4; ++dt) vf[dt] = nvf[dt];
    mw0 = nmw0; mw1 = nmw1;
  }
  bfr* gay = (bfr*)(p.ws + W_GA);
  bfr* dsty = (bfr*)(p.ws + dstoff);
#pragma unroll
  for (int qt = 0; qt < 2; ++qt) {
    if (qt < nqt) {
      float l = lsum[qt];
      l += __shfl_xor(l, 16);
      l += __shfl_xor(l, 32);
      const float inv = l > 0.f ? 1.f / l : 0.f;
      const long rowoff = (long)(qrow0 + qt * 16 + fr) * 512 + h * 64;
#pragma unroll
      for (int dt = 0; dt < 4; ++dt) {
        uint2* ptr = (uint2*)(gay + rowoff + dt * 16 + fq * 4);
        uint2 gv = *ptr;
        float g0 = __uint_as_float(gv.x << 16), g1 = __uint_as_float(gv.x & 0xFFFF0000u);
        float g2 = __uint_as_float(gv.y << 16), g3 = __uint_as_float(gv.y & 0xFFFF0000u);
        uint2 ov;
        ov.x = pack2(o[qt][dt][0] * inv * g0, o[qt][dt][1] * inv * g1);
        ov.y = pack2(o[qt][dt][2] * inv * g2, o[qt][dt][3] * inv * g3);
        *(uint2*)(dsty + rowoff + dt * 16 + fq * 4) = ov;
      }
    }
  }
}

#define XB_TMO      128
#define XB_XCNT(j)  (256  + 64 * (j))
#define XB_XSUB(j)  (1280 + 64 * (j))
#define XB_XGEN(j)  (2304 + 64 * (j))
#define XB_TOP      3328
#define XB_TOPGEN   3392
#define XCD_BAR_WORDS 3456
#define XB_SPIN_CAP (1u << 18)
#define LAS __attribute__((address_space(3)))

__device__ __forceinline__ unsigned xb_ld(unsigned* p)              { return __hip_atomic_load(p, __ATOMIC_RELAXED, __HIP_MEMORY_SCOPE_AGENT); }
__device__ __forceinline__ unsigned xb_add(unsigned* p, unsigned v) { return __hip_atomic_fetch_add(p, v, __ATOMIC_RELAXED, __HIP_MEMORY_SCOPE_AGENT); }
__device__ __forceinline__ unsigned xb_xcc_id() { return (unsigned)__builtin_amdgcn_s_getreg((3 << 11) | 20) & 0xFu; }
#define XB_SPIN(cond, bar) do { unsigned _sp = 0; while (cond) { __builtin_amdgcn_s_sleep(1); \
    if ((++_sp & 255u) == 0u) { if (xb_ld(&(bar)[XB_TMO])) break; if (_sp > XB_SPIN_CAP) { atomicAdd(&(bar)[XB_TMO], 1u); break; } } } } while (0)

struct XcdBarrier {
    unsigned* bar; unsigned x;
    volatile LAS unsigned* st;
};

__device__ __forceinline__ XcdBarrier xcd_barrier_post(unsigned* bar, volatile LAS unsigned* st) {
    XcdBarrier b; b.bar = bar; b.x = xb_xcc_id(); b.st = st;
    if (threadIdx.x == 0) (void)xb_add(&bar[XB_XCNT(b.x)], 1u);
    return b;
}
__device__ __forceinline__ void xcd_barrier_complete(unsigned* bar, unsigned x, unsigned& nloc, unsigned& nx) {
    const unsigned G = gridDim.x * gridDim.y * gridDim.z;
    unsigned sum, cnt, mine, sp = 0u;
    for (;;) {
        sum = 0u; cnt = 0u; mine = 0u;
#pragma unroll
        for (unsigned j = 0; j < 16; ++j) { const unsigned c = xb_ld(&bar[XB_XCNT(j)]); sum += c; cnt += (c > 0u) ? 1u : 0u; mine = (j == x) ? c : mine; }
        if (sum == G) break;
        __builtin_amdgcn_s_sleep(1);
        if ((++sp & 255u) == 0u) { if (xb_ld(&bar[XB_TMO])) break; if (sp > XB_SPIN_CAP) { atomicAdd(&bar[XB_TMO], 1u); break; } }
    }
    nloc = mine > 0u ? mine : 1u; nx = cnt > 0u ? cnt : 1u;
}

__device__ __forceinline__ void xcd_barrier(const XcdBarrier& b) {
    asm volatile("s_waitcnt vmcnt(0)" ::: "memory");
    __syncthreads();
    if (threadIdx.x == 0) {
        unsigned* bar = b.bar;
        __builtin_amdgcn_s_waitcnt(0);
        unsigned nloc = b.st[0], nx = b.st[1];
        if (nloc == 0u) { xcd_barrier_complete(bar, b.x, nloc, nx); b.st[0] = nloc; b.st[1] = nx; }
        const unsigned old = xb_add(&bar[XB_XSUB(b.x)], 1u);
        const unsigned gen = old / nloc;
        if (old + 1u == (gen + 1u) * nloc) {
            __builtin_amdgcn_fence(__ATOMIC_RELEASE, "agent");
            asm volatile("s_waitcnt vmcnt(0)" ::: "memory");
            const unsigned og = xb_add(&bar[XB_TOP], 1u);
            const unsigned tg = og / nx;
            if (og + 1u == (tg + 1u) * nx) xb_add(&bar[XB_TOPGEN], 1u);
            else XB_SPIN(xb_ld(&bar[XB_TOPGEN]) == tg, bar);
            __builtin_amdgcn_fence(__ATOMIC_ACQUIRE, "agent");
            xb_add(&bar[XB_XGEN(b.x)], 1u);
            asm volatile("s_waitcnt vmcnt(0)" ::: "memory");
        } else {
            XB_SPIN(xb_ld(&bar[XB_XGEN(b.x)]) == gen, bar);
            __builtin_amdgcn_fence(__ATOMIC_ACQUIRE, "agent");
            asm volatile("s_waitcnt vmcnt(0)" ::: "memory");
        }
    }
    __syncthreads();
}


DI void attn_block(const Params& p, int isP, int sq, int c, int h) {
  const int tid = get_tid(), wid = __builtin_amdgcn_readfirstlane(tid >> 6), lane = tid & 63, fr = lane & 15, fq = lane >> 4;
  int T0, nqt, nadm, rowbase, vld;
  const bfr *kb, *vt;
  if (isP) {
    if (c == 0) { T0 = 0; nqt = 1; nadm = 16; } else { T0 = 16 + 64 * (c - 1); nqt = 4; nadm = 16 + 64 * c; }
    rowbase = sq * T_P;
    kb = (const bfr*)(p.ws + W_KBP) + (long)sq * KP_PAD * 512;
    vt = (const bfr*)(p.ws + W_VTP) + (long)sq * 512 * KP_PAD;
    vld = KP_PAD;
  } else {
    T0 = 0; nqt = 4; nadm = S_S; rowbase = ROWS_P + sq * 64;
    kb = (const bfr*)(p.ws + W_KBS) + (long)sq * S_S * 512;
    vt = (const bfr*)(p.ws + W_VTS) + (long)sq * 512 * S_S;
    vld = S_S;
  }
  const int nsteps = (nadm + 31) >> 5;
  const int qrow0 = rowbase + T0;
  const bfr* qb = (const bfr*)(p.ws + W_QB);
  const unsigned* maskg = (const unsigned*)(p.ws + W_MASK);
  bf16x8 qf[4][2];
#pragma unroll
  for (int qt = 0; qt < 4; ++qt)
#pragma unroll
    for (int ks = 0; ks < 2; ++ks) {
      int r = qrow0 + (qt < nqt ? qt * 16 : 0) + fr;
      qf[qt][ks] = *(const bf16x8*)(qb + (long)r * 512 + h * 64 + ks * 32 + fq * 8);
    }
  f32x4 o[4][4];
#pragma unroll
  for (int qt = 0; qt < 4; ++qt)
#pragma unroll
    for (int dt = 0; dt < 4; ++dt) o[qt][dt] = f32x4{0.f, 0.f, 0.f, 0.f};
  const float sc2 = 0.125f * 1.4426950408889634f;
  const float kmax2 = ((const float*)(p.ws + W_KMAX))[(isP ? sq : NB_P + sq) * 8 + h];
  float mref[4], lsum[4] = {0.f, 0.f, 0.f, 0.f};
  const unsigned* mrow[4];
#pragma unroll
  for (int qt = 0; qt < 4; ++qt) {
    float ss = 0.f;
#pragma unroll
    for (int ks = 0; ks < 2; ++ks)
#pragma unroll
      for (int i = 0; i < 8; ++i) { float a = bf2f((bfr)qf[qt][ks][i]); ss += a * a; }
    ss += __shfl_xor(ss, 16);
    ss += __shfl_xor(ss, 32);
    mref[qt] = sqrtf(ss * kmax2) * sc2;
    mrow[qt] = maskg + (long)(qrow0 + (qt < nqt ? qt * 16 : 0) + fr) * MW;
  }
  const int kofs = (fr >> 2) * 8 + (fr & 3);
  const bfr* kptr = kb + (long)kofs * 512 + h * 64 + fq * 8;
  const bfr* vptr = vt + (long)(h * 64 + fr) * vld + fq * 8;
  if (wid < nsteps) {
    int s = wid;
    const bfr* pa0 = kptr + (long)s * 32 * 512;
    bf16x8 ka0 = *(const bf16x8*)pa0, ka1 = *(const bf16x8*)(pa0 + 32);
    bf16x8 kb0 = *(const bf16x8*)(pa0 + 4 * 512), kb1 = *(const bf16x8*)(pa0 + 4 * 512 + 32);
    bf16x8 vf[4];
#pragma unroll
    for (int dt = 0; dt < 4; ++dt) vf[dt] = *(const bf16x8*)(vptr + (long)dt * 16 * vld + s * 32);
    unsigned mw[4];
#pragma unroll
    for (int qt = 0; qt < 4; ++qt) mw[qt] = mrow[qt][s];
    for (; s < nsteps; s += 4) {
      const int sn = (s + 4 < nsteps) ? s + 4 : s;
      const bfr* pa = kptr + (long)sn * 32 * 512;
      const bf16x8 nka0 = *(const bf16x8*)pa, nka1 = *(const bf16x8*)(pa + 32);
      const bf16x8 nkb0 = *(const bf16x8*)(pa + 4 * 512), nkb1 = *(const bf16x8*)(pa + 4 * 512 + 32);
      bf16x8 nvf[4];
#pragma unroll
      for (int dt = 0; dt < 4; ++dt) nvf[dt] = *(const bf16x8*)(vptr + (long)dt * 16 * vld + sn * 32);
      unsigned nmw[4];
#pragma unroll
      for (int qt = 0; qt < 4; ++qt) nmw[qt] = mrow[qt][sn];
#pragma unroll
      for (int qt = 0; qt < 4; ++qt) {
        if (qt < nqt) {
          f32x4 sa = {0.f, 0.f, 0.f, 0.f}, sb = {0.f, 0.f, 0.f, 0.f};
          sa = MFMA16(ka0, qf[qt][0], sa); sa = MFMA16(ka1, qf[qt][1], sa);
          sb = MFMA16(kb0, qf[qt][0], sb); sb = MFMA16(kb1, qf[qt][1], sb);
          const unsigned mb = (mw[qt] >> (fq * 8)) & 0xFFu;
          float pr[8];
#pragma unroll
          for (int i = 0; i < 4; ++i) {
            float pa_ = __builtin_amdgcn_exp2f(sa[i] * sc2 - mref[qt]);
            float pb_ = __builtin_amdgcn_exp2f(sb[i] * sc2 - mref[qt]);
            pr[i] = ((mb >> i) & 1u) ? pa_ : 0.f;
            pr[4 + i] = ((mb >> (4 + i)) & 1u) ? pb_ : 0.f;
          }
          lsum[qt] += ((pr[0] + pr[1]) + (pr[2] + pr[3])) + ((pr[4] + pr[5]) + (pr[6] + pr[7]));
          union { unsigned u[4]; bf16x8 v; } pk;
          pk.u[0] = pack2(pr[0], pr[1]); pk.u[1] = pack2(pr[2], pr[3]); pk.u[2] = pack2(pr[4], pr[5]); pk.u[3] = pack2(pr[6], pr[7]);
#pragma unroll
          for (int dt = 0; dt < 4; ++dt) o[qt][dt] = MFMA16(vf[dt], pk.v, o[qt][dt]);
        }
      }
      ka0 = nka0; ka1 = nka1; kb0 = nkb0; kb1 = nkb1;
#pragma unroll
      for (int dt = 0; dt < 4; ++dt) vf[dt] = nvf[dt];
#pragma unroll
      for (int qt = 0; qt < 4; ++qt) mw[qt] = nmw[qt];
    }
  }
  float* OS = (float*)smem;
  float* LS = OS + 4 * 2048;
  bfr* gay = (bfr*)(p.ws + W_GA);
#pragma unroll
  for (int rd = 0; rd < 2; ++rd) {
    __syncthreads();
#pragma unroll
    for (int q2 = 0; q2 < 2; ++q2) {
      const int qt = rd * 2 + q2;
      float l = lsum[qt];
      l += __shfl_xor(l, 16);
      l += __shfl_xor(l, 32);
      LS[(wid * 2 + q2) * 64 + lane] = l;
#pragma unroll
      for (int dt = 0; dt < 4; ++dt)
#pragma unroll
        for (int j = 0; j < 4; ++j) OS[((wid * 2 + q2) * 16 + dt * 4 + j) * 64 + lane] = o[qt][dt][j];
    }
    __syncthreads();
    const int q2 = wid >> 1, qt = rd * 2 + q2;
    if (qt < nqt) {
      float l = 0.f;
#pragma unroll
      for (int w = 0; w < 4; ++w) l += LS[(w * 2 + q2) * 64 + lane];
      const float inv = l > 0.f ? 1.f / l : 0.f;
      const long rowoff = (long)(qrow0 + qt * 16 + fr) * 512 + h * 64;
#pragma unroll
      for (int d2 = 0; d2 < 2; ++d2) {
        const int dt = (wid & 1) * 2 + d2;
        float acc4[4];
#pragma unroll
        for (int j = 0; j < 4; ++j) {
          float a = 0.f;
#pragma unroll
          for (int w = 0; w < 4; ++w) a += OS[((w * 2 + q2) * 16 + dt * 4 + j) * 64 + lane];
          acc4[j] = a * inv;
        }
        uint2* ptr = (uint2*)(gay + rowoff + dt * 16 + fq * 4);
        uint2 gv = *ptr;
        float g0 = __uint_as_float(gv.x << 16), g1 = __uint_as_float(gv.x & 0xFFFF0000u);
        float g2 = __uint_as_float(gv.y << 16), g3 = __uint_as_float(gv.y & 0xFFFF0000u);
        uint2 ov;
        ov.x = pack2(acc4[0] * g0, acc4[1] * g1);
        ov.y = pack2(acc4[2] * g2, acc4[3] * g3);
        *ptr = ov;
      }
    }
  }
}

DI int pop_block(int* ctr, int*) {
  __syncthreads();
  if (threadIdx.x == 0) sh_item = atomicAdd(ctr, 1);
  __syncthreads();
  return __builtin_amdgcn_readfirstlane(sh_item);
}

constexpr int N_KMAX = 20 * 8;
constexpr int N_SEL = 64 * 16 + 64 + 4;
constexpr int N_LRU1 = NB_P * NTILE_P * 8;
constexpr int N_POOL = NB_P * NTILE_P * 4 + NB_S * 4;
constexpr int N_LRU2 = NB_P * NTILE_P * 8 + NB_S * 8;
constexpr int N_ATT = 64 * 64 + 256 + 32;

DI void phase_b1(const Params& p, int layer, char*, int*) {
  int* ctr = (int*)(p.ws + W_CTR) + layer * 4 + 0;
  for (;;) {
    int it = pop_block(ctr, nullptr);
    if (it >= N_SEL + N_LRU1 + N_POOL + N_KMAX) break;
    if (it >= N_SEL + N_LRU1 + N_POOL) { int j = it - (N_SEL + N_LRU1 + N_POOL); kmax_item(p, j >> 3, j & 7, smem); }
    else if (it < N_SEL) {
      if (it < 1024) { int c = 64 - (it >> 4), b = (it & 15) >> 2, sub = it & 3; select_item(p, 1, b, c, sub, smem); }
      else if (it < 1088) { int j = it - 1024; select_item(p, 0, j >> 2, 0, j & 3, smem); }
      else select_item(p, 1, it - 1088, 0, 0, smem);
    } else if (it < N_SEL + N_LRU1) {
      int j = it - N_SEL;
      int sq = j / (NTILE_P * 8), rem = j % (NTILE_P * 8);
      lru_tile(p, layer, 1, sq, rem >> 3, rem & 7, 0, smem);
    } else {
      int j = it - N_SEL - N_LRU1;
      if (j < NB_P * NTILE_P * 4) { int sq = j / (NTILE_P * 4), rem = j % (NTILE_P * 4); pool_item(p, layer, 1, sq, rem >> 2, rem & 3, smem); }
      else { j -= NB_P * NTILE_P * 4; pool_item(p, layer, 0, j >> 2, 0, j & 3, smem); }
    }
  }
}

constexpr size_t W_DUMMY = W_END;
DI void probe_select(const Params& p, int layer) {
  int* ctr = (int*)(p.ws + W_CTR) + layer * 4 + 3;
  for (;;) {
    int it = pop_block(ctr, nullptr);
    if (it >= N_SEL) break;
    if (it < 1024) { int c = 64 - (it >> 4), b = (it & 15) >> 2, sub = it & 3; select_item(p, 1, b, c, sub, smem); }
    else if (it < 1088) { int j = it - 1024; select_item(p, 0, j >> 2, 0, j & 3, smem); }
    else select_item(p, 1, it - 1088, 0, 0, smem);
  }
}
DI void probe_attn(const Params& p, int layer) {
  int* ctr2 = (int*)(p.ws + W_CTR) + layer * 4 + 3;
  const int lane = get_tid() & 63;
  for (;;) {
    int u = 0;
    if (lane == 0) u = atomicAdd(ctr2, 1);
    u = __builtin_amdgcn_readfirstlane(u);
    if (u >= N_ATT) break;
    if (u < 4096) { int c = 64 - (u >> 6), r = u & 63; attn_unit(p, 1, r >> 4, c, (r >> 1) & 7, r & 1, W_DUMMY); }
    else if (u < 4096 + 256) { int r = u - 4096; attn_unit(p, 0, r >> 4, 0, (r >> 1) & 7, r & 1, W_DUMMY); }
    else { int r = u - 4352; attn_unit(p, 1, r >> 3, 0, r & 7, 0, W_DUMMY); }
  }
}

DI void phase_b2(const Params& p, int layer, char*, int*) {
  int* ctr = (int*)(p.ws + W_CTR) + layer * 4 + 1;
  for (;;) {
    int it = pop_block(ctr, nullptr);
    if (it >= N_LRU2) break;
    if (it < NB_P * NTILE_P * 8) { int sq = it / (NTILE_P * 8), rem = it % (NTILE_P * 8); lru_tile(p, layer, 1, sq, rem >> 3, rem & 7, 1, smem); }
    else { int j = it - NB_P * NTILE_P * 8; lru_tile(p, layer, 0, j >> 3, 0, j & 7, 1, smem); }
  }
  int* ctr2 = (int*)(p.ws + W_CTR) + layer * 4 + 2;
  for (;;) {
    int it = pop_block(ctr2, nullptr);
    if (it >= 2208) break;
    if (it < 2048) { const int c = 64 - (it >> 5), pair = it & 31; attn_block(p, 1, pair >> 3, c, pair & 7); }
    else if (it < 2176) { const int r = it - 2048; attn_block(p, 0, r >> 3, 0, r & 7); }
    else { const int pair = it - 2176; attn_block(p, 1, pair >> 3, 0, pair & 7); }
  }
}

DI Params fresh(const Params& p) {
  Params q = p;
  int z = 0;
  asm volatile("s_mov_b32 %0, 0" : "=s"(z));
  q.ws = p.ws + z;
  q.out = p.out + z;
  return q;
}
DI int fresh_i(int v) {
  asm volatile("" : "+s"(v));
  return v;
}

__shared__ uint4 xb_words;

__global__ void __launch_bounds__(256, 2) fwd_megakernel(Params p) {
  cg::grid_group grid = cg::this_grid();
  if (threadIdx.x == 0) xb_words = make_uint4(0u, 0u, 0u, 0u);
  __syncthreads();
  XcdBarrier xb = xcd_barrier_post((unsigned*)(p.ws + W_BAR), (volatile LAS unsigned*)&xb_words);
  if (threadIdx.x == 0) sh_xinfo[0] = (int)atomicAdd((unsigned*)(p.ws + W_CTR) + 128 + xb.x, 1u);
  prep_phase(fresh(p), smem);
  grid.sync();
  if (threadIdx.x == 0) {
    unsigned* bar = (unsigned*)(p.ws + W_BAR);
    int na = 0, ia = 0, nloc = 1;
    for (unsigned j = 0; j < 16; ++j) {
      const unsigned cj = xb_ld(&bar[XB_XCNT(j)]);
      if (cj > 0u) { if (j < xb.x) ++ia; ++na; }
      if (j == xb.x) nloc = (int)cj;
    }
    sh_xinfo[1] = nloc > 0 ? nloc : 1; sh_xinfo[2] = ia; sh_xinfo[3] = na > 0 ? na : 1;
  }
  __syncthreads();
#if PROBE == 6
#pragma unroll 1
  for (int i = 0; i < 10; ++i) xcd_barrier(xb);
#endif
#pragma unroll 1
  for (int layer = 0; layer < 2; ++layer) {
    phase_inproj(fresh(p), fresh_i(layer), smem);
    xcd_barrier(xb);
#if PROBE == 2
    probe_select(fresh(p), fresh_i(layer));
    xcd_barrier(xb);
#endif
    phase_b1(fresh(p), fresh_i(layer), smem, &sh_item);
    xcd_barrier(xb);
#if PROBE == 3
    probe_attn(fresh(p), fresh_i(layer));
    xcd_barrier(xb);
#endif
    phase_b2(fresh(p), fresh_i(layer), smem, &sh_item);
    xcd_barrier(xb);
    phase_merge(fresh(p), fresh_i(layer), smem);
    xcd_barrier(xb);
#if PROBE == 4
    phase_merge(fresh(p), fresh_i(layer), smem);
    xcd_barrier(xb);
#endif
    phase_out(fresh(p), fresh_i(layer), smem);
    xcd_barrier(xb);
    if (layer == 0) { convert_cache(fresh(p), 1, smem); norm_phase(fresh(p), 1); xcd_barrier(xb); }
    else norm_phase(fresh(p), 2);
  }
}

extern "C" void kernel_launch(void* const* d_in, const int* in_sizes, int n_in, void* d_out, int out_size, void* d_ws,
                              size_t ws_size, hipStream_t stream) {
  constexpr int kDynLds = 65536;
  static int grid_blocks = 0;
  if (!grid_blocks) {
    int dev = 0, cus = 0, per_cu = 0;
    hipGetDevice(&dev);
    hipDeviceGetAttribute(&cus, hipDeviceAttributeMultiprocessorCount, dev);
    hipFuncSetAttribute((const void*)fwd_megakernel, hipFuncAttributeMaxDynamicSharedMemorySize, kDynLds);
    hipOccupancyMaxActiveBlocksPerMultiprocessor(&per_cu, fwd_megakernel, 256, kDynLds);
    if (per_cu > 2) per_cu = 2;
    if (per_cu < 1) per_cu = 1;
    grid_blocks = cus * per_cu;
  }
  if (ws_size < W_END) { fprintf(stderr, "workspace too small: %zu < %zu\n", ws_size, (size_t)W_END); return; }
  Params p{};
  const float** f = (const float**)&p;
  for (int i = 0; i < 23; ++i) f[i] = (const float*)d_in[i];
  p.out = (float*)d_out;
  p.ws = (char*)d_ws;
  hipMemsetAsync(d_ws, 0, 32768, stream);
  void* args[] = {&p};
  hipError_t e = hipLaunchCooperativeKernel((void*)fwd_megakernel, dim3(grid_blocks), dim3(256), args, kDynLds, stream);
  if (e != hipSuccess) fprintf(stderr, "cooperative launch failed: %s (grid %d)\n", hipGetErrorString(e), grid_blocks);
}
```

```cpp
#include <hip/hip_runtime.h>
#include <hip/hip_cooperative_groups.h>
#include <stdint.h>
#include <cstdio>
namespace cg = cooperative_groups;
#ifndef PROBE
#define PROBE 0
#endif

typedef unsigned short bfr;
typedef __attribute__((ext_vector_type(8))) short bf16x8;
typedef __attribute__((ext_vector_type(4))) float f32x4;
typedef __attribute__((ext_vector_type(2))) float f32x2;
typedef __attribute__((ext_vector_type(2))) __bf16 bf2_t;
#define DI __device__ __forceinline__
#define MFMA16(a, b, c) __builtin_amdgcn_mfma_f32_16x16x32_bf16((a), (b), (c), 0, 0, 0)

constexpr int DM = 1024;
constexpr int NB_P = 4, T_P = 4112, SEQ_P = 4096, NMETA = 16;
constexpr int NB_S = 16, T_S = 64, PAST = 2048, S_S = 2112;
constexpr int ROWS_P = NB_P * T_P;
constexpr int ROWS = ROWS_P + NB_S * T_S;
constexpr int MPAD = 17536;
constexpr int NIN = 7492, NPAD = 7552;
constexpr int KP_PAD = 4128;
constexpr int MW = 132;
constexpr int NTILE_P = 65;

constexpr int C_Q = 0, C_K = 512, C_V = 1024, C_GA = 1536, C_QI = 2048, C_KI = 2304, C_XB = 2368, C_GB = 2880,
              C_XC = 3392, C_GC = 3904, C_GM = 4416, C_WI = 7488;

constexpr long O_YP = 0;
constexpr long O_YS = O_YP + (long)NB_P * SEQ_P * DM;
constexpr long O_KP = O_YS + (long)NB_S * T_S * DM;
constexpr long O_VP = O_KP + 2L * NB_P * T_P * 512;
constexpr long O_KIP = O_VP + 2L * NB_P * T_P * 512;
constexpr long O_CONVP = O_KIP + 2L * NB_P * T_P * 64;
constexpr long O_LRUP = O_CONVP + 2L * NB_P * 3 * 512;
constexpr long O_POOLP = O_LRUP + 2L * NB_P * 512;
constexpr long O_KS = O_POOLP + 2L * NB_P * 15 * 512;
constexpr long O_VS = O_KS + 2L * NB_S * T_S * 512;
constexpr long O_KIS = O_VS + 2L * NB_S * T_S * 512;
constexpr long O_CONVS = O_KIS + 2L * NB_S * T_S * 64;
constexpr long O_LRUS = O_CONVS + 2L * NB_S * 3 * 512;
constexpr long O_POOLS = O_LRUS + 2L * NB_S * 512;

constexpr size_t al256(size_t x) { return (x + 255) & ~(size_t)255; }
constexpr size_t W_CTR = 0;
constexpr size_t W_BAR = 4096;
constexpr size_t W_ROPE = 32768;
constexpr size_t W_WINT = al256(W_ROPE + (size_t)T_P * 8 * 8);
constexpr size_t W_WBT = al256(W_WINT + 2ull * NPAD * 1024 * 2);
constexpr size_t W_WOT = al256(W_WBT + 2ull * 3 * 1024 * 512 * 2);
constexpr size_t W_WAT = al256(W_WOT + 2ull * 1024 * 1024 * 2);
constexpr size_t W_WXT = al256(W_WAT + 2ull * 8 * 64 * 64 * 2);
constexpr size_t W_PWT = al256(W_WXT + 2ull * 8 * 64 * 64 * 2);
constexpr size_t W_XRES = al256(W_PWT + 2ull * 4 * 128 * 128 * 2);
constexpr size_t W_HN = al256(W_XRES + (size_t)MPAD * 1024 * 4);
constexpr size_t W_QB = al256(W_HN + (size_t)MPAD * 1024 * 2);
constexpr size_t W_GA = al256(W_QB + (size_t)MPAD * 512 * 2);
constexpr size_t W_QIB = al256(W_GA + (size_t)MPAD * 512 * 2);
constexpr size_t W_WIB = al256(W_QIB + (size_t)MPAD * 256 * 2);
constexpr size_t W_XBB = al256(W_WIB + (size_t)MPAD * 4 * 4);
constexpr size_t W_GB = al256(W_XBB + (size_t)MPAD * 512 * 2);
constexpr size_t W_XCB = al256(W_GB + (size_t)MPAD * 512 * 2);
constexpr size_t W_GC = al256(W_XCB + (size_t)MPAD * 512 * 2);
constexpr size_t W_GM = al256(W_GC + (size_t)MPAD * 512 * 2);
constexpr size_t W_KBP = al256(W_GM + (size_t)MPAD * 3072 * 2);
constexpr size_t W_VTP = al256(W_KBP + (size_t)NB_P * KP_PAD * 512 * 2);
constexpr size_t W_KIBP = al256(W_VTP + (size_t)NB_P * 512 * KP_PAD * 2);
constexpr size_t W_KBS = al256(W_KIBP + (size_t)NB_P * KP_PAD * 64 * 2);
constexpr size_t W_VTS = al256(W_KBS + (size_t)NB_S * S_S * 512 * 2);
constexpr size_t W_KIBS = al256(W_VTS + (size_t)NB_S * 512 * S_S * 2);
constexpr size_t W_MASK = al256(W_KIBS + (size_t)NB_S * S_S * 64 * 2);
constexpr size_t W_AGG = al256(W_MASK + (size_t)ROWS * MW * 4);
constexpr size_t W_KMAX = al256(W_AGG + (size_t)NB_P * NTILE_P * 512 * 2 * 4);
constexpr size_t W_END = al256(W_KMAX + 1024);

struct Params {
  const float *x_prompt, *x_sample, *cache_k, *cache_v, *cache_kidx, *state_conv, *state_lru, *state_pool, *meta,
      *norm_g, *w_in, *conv_w, *conv_b, *lru_wa, *lru_ba, *lru_wx, *lru_bx, *lru_lambda, *pool_w, *pool_scale,
      *w_branch_out, *w_out, *final_g;
  float* out;
  char* ws;
};

extern __shared__ __attribute__((aligned(128))) char smem[];
__shared__ int sh_item;
__shared__ int sh_xinfo[4];

DI float bf2f(bfr b) { return __uint_as_float(((unsigned)b) << 16); }
DI unsigned pack2(float a, float b) {
  f32x2 v = {a, b};
  bf2_t r = __builtin_convertvector(v, bf2_t);
  return __builtin_bit_cast(unsigned, r);
}
DI bfr f2bf(float x) { return (bfr)(pack2(x, 0.f) & 0xFFFFu); }
DI float sigm(float x) { return __builtin_amdgcn_rcpf(1.f + __expf(-x)); }
DI float silu(float x) { return x * __builtin_amdgcn_rcpf(1.f + __expf(-x)); }
DI int get_tid() {
  int t = threadIdx.x;
  asm volatile("" : "+v"(t));
  return t;
}
DI unsigned sortable(float f) {
  unsigned u = __float_as_uint(f);
  return (u & 0x80000000u) ? ~u : (u | 0x80000000u);
}
DI void decode_row(int row, int& isP, int& sq, int& t) {
  if (row < ROWS_P) { isP = 1; sq = row / T_P; t = row - sq * T_P; }
  else { isP = 0; int r = row - ROWS_P; sq = r >> 6; t = r & 63; }
}

DI void tc_tile(const float* src, long sld, bfr* dst, long dld, int k0, int n0, float* tile, int mapmode) {
  const int tid = get_tid();
  const int nn = tid & 63, kk0 = tid >> 6;
  int n = n0 + nn, sn = n;
  if (mapmode) sn = n < 2368 ? n : (n < 7488 ? n + 4 : (n < 7492 ? 2368 + (n - 7488) : -1));
  float v[16];
#pragma unroll
  for (int i = 0; i < 16; ++i) v[i] = sn >= 0 ? src[(long)(k0 + i * 4 + kk0) * sld + sn] : 0.f;
#pragma unroll
  for (int i = 0; i < 16; ++i) tile[(i * 4 + kk0) * 65 + nn] = v[i];
  __syncthreads();
#pragma unroll
  for (int i = 0; i < 16; ++i) {
    int nn2 = i * 4 + (tid >> 6), kk = tid & 63;
    dst[(long)(n0 + nn2) * dld + k0 + kk] = f2bf(tile[kk * 65 + nn2]);
  }
  __syncthreads();
}

DI void convert_cache(const Params& p, int layer, char*) {
  const int tid = get_tid();
  bfr* kbs = (bfr*)(p.ws + W_KBS);
  bfr* vts = (bfr*)(p.ws + W_VTS);
  bfr* kibs = (bfr*)(p.ws + W_KIBS);
  for (int it = blockIdx.x; it < NB_S * 32 * 8; it += gridDim.x) {
    int sb = it >> 8, r = it & 255, kt = r >> 3, nt = r & 7;
    tc_tile(p.cache_v + ((long)(layer * NB_S + sb) * PAST) * 512, 512, vts + (long)sb * 512 * S_S, S_S, kt * 64, nt * 64,
            (float*)smem, 0);
  }
  {
    const float4* src = (const float4*)(p.cache_k + (long)layer * NB_S * PAST * 512);
    const long n4 = (long)NB_S * PAST * 512 / 4;
    const long stride = (long)gridDim.x * 256;
    for (long i = (long)blockIdx.x * 256 + tid; i < n4; i += 4 * stride) {
      float4 v[4];
#pragma unroll
      for (int u = 0; u < 4; ++u) { const long ii = i + u * stride; v[u] = ii < n4 ? src[ii] : make_float4(0.f, 0.f, 0.f, 0.f); }
#pragma unroll
      for (int u = 0; u < 4; ++u) {
        const long ii = i + u * stride;
        if (ii < n4) {
          const long e = ii * 4;
          const int sb = (int)(e / ((long)PAST * 512));
          const long rem = e - (long)sb * PAST * 512;
          uint2 o; o.x = pack2(v[u].x, v[u].y); o.y = pack2(v[u].z, v[u].w);
          *(uint2*)(kbs + (long)sb * S_S * 512 + rem) = o;
        }
      }
    }
  }
  {
    const float4* src = (const float4*)(p.cache_kidx + (long)layer * NB_S * PAST * 64);
    const long n4 = (long)NB_S * PAST * 64 / 4;
    const long stride = (long)gridDim.x * 256;
    for (long i = (long)blockIdx.x * 256 + tid; i < n4; i += 4 * stride) {
      float4 v[4];
#pragma unroll
      for (int u = 0; u < 4; ++u) { const long ii = i + u * stride; v[u] = ii < n4 ? src[ii] : make_float4(0.f, 0.f, 0.f, 0.f); }
#pragma unroll
      for (int u = 0; u < 4; ++u) {
        const long ii = i + u * stride;
        if (ii < n4) {
          const long e = ii * 4;
          const int sb = (int)(e / ((long)PAST * 64));
          const long rem = e - (long)sb * PAST * 64;
          uint2 o; o.x = pack2(v[u].x, v[u].y); o.y = pack2(v[u].z, v[u].w);
          *(uint2*)(kibs + (long)sb * S_S * 64 + rem) = o;
        }
      }
    }
  }
}

DI void norm_phase(const Params& p, int mode) {
  const int tid = get_tid(), wid = __builtin_amdgcn_readfirstlane(tid >> 6), lane = tid & 63;
  float* xres = (float*)(p.ws + W_XRES);
  bfr* hn = (bfr*)(p.ws + W_HN);
  const float* g = mode == 0 ? p.norm_g : (mode == 1 ? p.norm_g + 1024 : p.final_g);
  for (int row = blockIdx.x * 4 + wid; row < ROWS; row += gridDim.x * 4) {
    int isP, sq, t;
    decode_row(row, isP, sq, t);
    const float* src;
    if (mode == 0) {
      if (isP) src = t < NMETA ? p.meta + (long)t * 1024 : p.x_prompt + ((long)sq * SEQ_P + t - NMETA) * 1024;
      else src = p.x_sample + (long)(row - ROWS_P) * 1024;
    } else src = xres + (long)row * 1024;
    float4 v[4];
    float ss = 0.f;
#pragma unroll
    for (int i = 0; i < 4; ++i) {
      v[i] = ((const float4*)src)[lane + i * 64];
      ss += v[i].x * v[i].x + v[i].y * v[i].y + v[i].z * v[i].z + v[i].w * v[i].w;
    }
#pragma unroll
    for (int o = 32; o >= 1; o >>= 1) ss += __shfl_xor(ss, o);
    const float inv = rsqrtf(ss * (1.f / 1024.f) + 1e-6f);
    float* dsty = nullptr;
    if (mode == 2) {
      if (isP) { if (t >= NMETA) dsty = p.out + O_YP + ((long)sq * SEQ_P + t - NMETA) * 1024; }
      else dsty = p.out + O_YS + (long)(row - ROWS_P) * 1024;
    }
#pragma unroll
    for (int i = 0; i < 4; ++i) {
      float4 gg = ((const float4*)g)[lane + i * 64];
      float4 y;
      y.x = v[i].x * inv * gg.x; y.y = v[i].y * inv * gg.y; y.z = v[i].z * inv * gg.z; y.w = v[i].w * inv * gg.w;
      if (mode == 0) ((float4*)(xres + (long)row * 1024))[lane + i * 64] = v[i];
      if (mode < 2) {
        uint2 o; o.x = pack2(y.x, y.y); o.y = pack2(y.z, y.w);
        *(uint2*)(hn + (long)row * 1024 + (lane + i * 64) * 4) = o;
      } else if (dsty) ((float4*)dsty)[lane + i * 64] = y;
    }
  }
}

DI void prep_phase(const Params& p, char*) {
  const int tid = get_tid();
  for (int it = blockIdx.x; it < 2 * 118 * 16; it += gridDim.x) {
    int l = it / (118 * 16), r = it % (118 * 16), nt = r / 16, kt = r % 16;
    tc_tile(p.w_in + (long)l * 1024 * NIN, NIN, (bfr*)(p.ws + W_WINT) + (long)l * NPAD * 1024, 1024, kt * 64, nt * 64,
            (float*)smem, 1);
  }
  for (int it = blockIdx.x; it < 6 * 16 * 8; it += gridDim.x) {
    int mtx = it / 128, r = it % 128, nt = r / 8, kt = r % 8;
    tc_tile(p.w_branch_out + (long)mtx * 512 * 1024, 1024, (bfr*)(p.ws + W_WBT) + (long)mtx * 1024 * 512, 512, kt * 64,
            nt * 64, (float*)smem, 0);
  }
  for (int it = blockIdx.x; it < 2 * 16 * 16; it += gridDim.x) {
    int l = it / 256, r = it % 256, nt = r / 16, kt = r % 16;
    tc_tile(p.w_out + (long)l * 1024 * 1024, 1024, (bfr*)(p.ws + W_WOT) + (long)l * 1024 * 1024, 1024, kt * 64, nt * 64,
            (float*)smem, 0);
  }
  for (int it = blockIdx.x; it < 32; it += gridDim.x) {
    int which = it >> 4, mtx = it & 15;
    tc_tile((which ? p.lru_wx : p.lru_wa) + (long)mtx * 4096, 64, (bfr*)(p.ws + (which ? W_WXT : W_WAT)) + (long)mtx * 4096,
            64, 0, 0, (float*)smem, 0);
  }
  for (int it = blockIdx.x; it < 32; it += gridDim.x) {
    int mtx = it >> 2, r = it & 3, nt = r >> 1, kt = r & 1;
    tc_tile(p.pool_w + (long)mtx * 16384, 128, (bfr*)(p.ws + W_PWT) + (long)mtx * 16384, 128, kt * 64, nt * 64,
            (float*)smem, 0);
  }
  {
    float2* rt = (float2*)(p.ws + W_ROPE);
    for (int e = blockIdx.x * 256 + tid; e < T_P * 8; e += gridDim.x * 256) {
      int pos = e >> 3, d = e & 7;
      float inv = powf(500000.f, -(float)d * 0.125f);
      float ang = (float)pos * inv;
      rt[e] = make_float2(cosf(ang), sinf(ang));
    }
  }
  convert_cache(p, 0, smem);
  norm_phase(p, 0);
}

template <int NF>
DI void gemm128(const bfr* A, int lda, const bfr* Bt, int ldb, int K, int brow, int bcol, char*, f32x4 (&acc)[4][NF],
             bool chained = false, bool first = true, int nbrow = -1, int nbcol = 0) {
  const int tid = get_tid(), wid = __builtin_amdgcn_readfirstlane(tid >> 6), lane = tid & 63, wr = wid >> 1, wc = wid & 1, fr = lane & 15, fq = lane >> 4;
  const int r0 = tid >> 3;
  const int cg = ((tid & 7) ^ (r0 & 7)) * 8;
  const bfr* ga = A + (long)(brow + r0) * lda + cg;
  const bfr* gb = Bt + (long)(bcol + r0) * ldb + cg;
  const long a32 = (long)32 * lda, b32 = (long)32 * ldb;
  const int nk = K / 64;
  auto stage = [&](int kt, int buf) {
    char* SA = smem + buf * 32768;
    char* SB = SA + 16384;
#pragma unroll
    for (int i = 0; i < 4; ++i)
      __builtin_amdgcn_global_load_lds((const unsigned*)(ga + i * a32 + kt * 64), (unsigned*)(SA + tid * 16 + i * 4096), 16, 0, 0);
#pragma unroll
    for (int i = 0; i < NF; ++i)
      __builtin_amdgcn_global_load_lds((const unsigned*)(gb + i * b32 + kt * 64), (unsigned*)(SB + tid * 16 + i * 4096), 16, 0, 0);
  };
  if (!chained || first) {
    asm volatile("s_waitcnt vmcnt(0)" ::: "memory");
    __syncthreads();
    stage(0, 0);
  }
  const unsigned lds0 = (unsigned)(size_t)smem;
  const unsigned sw0 = (unsigned)((fq ^ (fr & 7)) * 16), sw1 = (unsigned)(((4 + fq) ^ (fr & 7)) * 16);
  const unsigned arow = lds0 + (wr * 64 + fr) * 128, brw = lds0 + 16384 + (wc * NF * 16 + fr) * 128;
  for (int kt = 0; kt < nk; ++kt) {
    asm volatile("s_waitcnt vmcnt(0)" ::: "memory");
    __builtin_amdgcn_s_barrier();
    if (kt + 1 < nk) stage(kt + 1, (kt + 1) & 1);
    else if (chained && nbrow >= 0) {
      const bfr* na = A + (long)(nbrow + r0) * lda + cg;
      const bfr* nb = Bt + (long)(nbcol + r0) * ldb + cg;
#pragma unroll
      for (int i = 0; i < 4; ++i)
        __builtin_amdgcn_global_load_lds((const unsigned*)(na + i * a32), (unsigned*)(smem + tid * 16 + i * 4096), 16, 0, 0);
#pragma unroll
      for (int i = 0; i < NF; ++i)
        __builtin_amdgcn_global_load_lds((const unsigned*)(nb + i * b32), (unsigned*)(smem + 16384 + tid * 16 + i * 4096), 16, 0, 0);
    }
    const unsigned bo = (kt & 1) * 32768;
    bf16x8 af[2][4], bfg[2][4];
    if (NF == 4) {
      asm volatile(
          "ds_read_b128 %0, %16\n\tds_read_b128 %1, %16 offset:2048\n\tds_read_b128 %2, %16 offset:4096\n\tds_read_b128 %3, %16 offset:6144\n\t"
          "ds_read_b128 %4, %17\n\tds_read_b128 %5, %17 offset:2048\n\tds_read_b128 %6, %17 offset:4096\n\tds_read_b128 %7, %17 offset:6144\n\t"
          "ds_read_b128 %8, %18\n\tds_read_b128 %9, %18 offset:2048\n\tds_read_b128 %10, %18 offset:4096\n\tds_read_b128 %11, %18 offset:6144\n\t"
          "ds_read_b128 %12, %19\n\tds_read_b128 %13, %19 offset:2048\n\tds_read_b128 %14, %19 offset:4096\n\tds_read_b128 %15, %19 offset:6144\n\t"
          "s_waitcnt lgkmcnt(0)"
          : "=&v"(af[0][0]), "=&v"(af[0][1]), "=&v"(af[0][2]), "=&v"(af[0][3]), "=&v"(bfg[0][0]), "=&v"(bfg[0][1]), "=&v"(bfg[0][2]), "=&v"(bfg[0][3]),
            "=&v"(af[1][0]), "=&v"(af[1][1]), "=&v"(af[1][2]), "=&v"(af[1][3]), "=&v"(bfg[1][0]), "=&v"(bfg[1][1]), "=&v"(bfg[1][2]), "=&v"(bfg[1][3])
          : "v"(arow + sw0 + bo), "v"(brw + sw0 + bo), "v"(arow + sw1 + bo), "v"(brw + sw1 + bo)
          : "memory");
    } else {
      asm volatile(
          "ds_read_b128 %0, %12\n\tds_read_b128 %1, %12 offset:2048\n\tds_read_b128 %2, %12 offset:4096\n\tds_read_b128 %3, %12 offset:6144\n\t"
          "ds_read_b128 %4, %13\n\tds_read_b128 %5, %13 offset:2048\n\t"
          "ds_read_b128 %6, %14\n\tds_read_b128 %7, %14 offset:2048\n\tds_read_b128 %8, %14 offset:4096\n\tds_read_b128 %9, %14 offset:6144\n\t"
          "ds_read_b128 %10, %15\n\tds_read_b128 %11, %15 offset:2048\n\t"
          "s_waitcnt lgkmcnt(0)"
          : "=&v"(af[0][0]), "=&v"(af[0][1]), "=&v"(af[0][2]), "=&v"(af[0][3]), "=&v"(bfg[0][0]), "=&v"(bfg[0][1]),
            "=&v"(af[1][0]), "=&v"(af[1][1]), "=&v"(af[1][2]), "=&v"(af[1][3]), "=&v"(bfg[1][0]), "=&v"(bfg[1][1])
          : "v"(arow + sw0 + bo), "v"(brw + sw0 + bo), "v"(arow + sw1 + bo), "v"(brw + sw1 + bo)
          : "memory");
    }
#pragma unroll
    for (int ks = 0; ks < 2; ++ks)
#pragma unroll
      for (int m = 0; m < 4; ++m)
#pragma unroll
        for (int n = 0; n < NF; ++n) acc[m][n] = MFMA16(af[ks][m], bfg[ks][n], acc[m][n]);
  }
}

constexpr int EPI_PITCH = 64;
template <int REG>
DI void epi_region(const Params& p, int layer, f32x4 (&acc)[4][4], int rbase0, int rel, int lane, int wid) {
  const int fr = lane & 15, fq = lane >> 4;
  const float2* rt = (const float2*)(p.ws + W_ROPE);
  constexpr bool doRope = (REG == 0 || REG == 1 || REG == 4 || REG == 5);
  constexpr bool staged = (REG != 2 && REG != 11);
  bfr* img = (bfr*)(smem + 32768 + wid * (64 * EPI_PITCH * 2));
#pragma unroll
  for (int m = 0; m < 4; ++m) {
    const int rbase = rbase0 + m * 16 + fq * 4;
    const bool rowsValid = rbase < ROWS;
    int isP, sq, t0;
    decode_row(rowsValid ? rbase : 0, isP, sq, t0);
    if (doRope) {
      const int pos0 = isP ? t0 : PAST + t0;
#pragma unroll
      for (int j = 0; j < 4; ++j) {
        float v = acc[m][0][j];
        float pv = __shfl_xor(v, 8);
        float2 cs = rt[(pos0 + j) * 8 + (fr & 7)];
        acc[m][0][j] = (fr < 8) ? (v * cs.x - pv * cs.y) : (v * cs.x + pv * cs.y);
      }
    }
#pragma unroll
    for (int n = 0; n < 4; ++n) {
      const int col = rel + n * 16 + fr;
      if (REG == 2 && rowsValid) {
        uint2 pk; pk.x = pack2(acc[m][n][0], acc[m][n][1]); pk.y = pack2(acc[m][n][2], acc[m][n][3]);
        if (isP) *(uint2*)((bfr*)(p.ws + W_VTP) + ((long)sq * 512 + col) * KP_PAD + t0) = pk;
        else *(uint2*)((bfr*)(p.ws + W_VTS) + ((long)sq * 512 + col) * S_S + PAST + t0) = pk;
      }
#pragma unroll
      for (int j = 0; j < 4; ++j) {
        const float v = acc[m][n][j];
        const int row = rbase + j, t = t0 + j;
        if (rowsValid) {
          if (REG == 1) { if (isP) p.out[O_KP + ((long)(layer * NB_P + sq) * T_P + t) * 512 + col] = v; else p.out[O_KS + ((long)(layer * NB_S + sq) * T_S + t) * 512 + col] = v; }
          if (REG == 2) { if (isP) p.out[O_VP + ((long)(layer * NB_P + sq) * T_P + t) * 512 + col] = v; else p.out[O_VS + ((long)(layer * NB_S + sq) * T_S + t) * 512 + col] = v; }
          if (REG == 5) { if (isP) p.out[O_KIP + ((long)(layer * NB_P + sq) * T_P + t) * 64 + col] = v; else p.out[O_KIS + ((long)(layer * NB_S + sq) * T_S + t) * 64 + col] = v; }
          if (REG == 6) {
            if (isP) { if (t >= T_P - 3) p.out[O_CONVP + ((long)(layer * NB_P + sq) * 3 + (t - (T_P - 3))) * 512 + col] = v; }
            else { if (t >= T_S - 3) p.out[O_CONVS + ((long)(layer * NB_S + sq) * 3 + (t - (T_S - 3))) * 512 + col] = v; }
          }
          if (REG == 8) {
            if (isP) { if (t >= T_P - 15) p.out[O_POOLP + ((long)(layer * NB_P + sq) * 15 + (t - (T_P - 15))) * 512 + col] = v; }
            else { if (t >= T_S - 15) p.out[O_POOLS + ((long)(layer * NB_S + sq) * 15 + (t - (T_S - 15))) * 512 + col] = v; }
          }
          if (REG == 11) { if (col < 4) ((float*)(p.ws + W_WIB))[(long)row * 4 + col] = v; }
        }
        if (staged) {
          float y = v;
          if (REG == 3 || REG == 7 || REG == 9) y = silu(v);
          if (REG == 10) y = sigm(v);
          img[(m * 16 + fq * 4 + j) * EPI_PITCH + n * 16 + fr] = f2bf(y);
        }
      }
    }
  }
  if (staged) {
    asm volatile("s_waitcnt lgkmcnt(0)" ::: "memory");
#pragma unroll
    for (int it = 0; it < 8; ++it) {
      const int r = it * 8 + (lane >> 3), ch = lane & 7;
      const int row = rbase0 + r;
      if (row < ROWS) {
        int isP, sq, t;
        decode_row(row, isP, sq, t);
        bfr* dst;
        if (REG == 0) dst = (bfr*)(p.ws + W_QB) + (long)row * 512;
        else if (REG == 1) dst = isP ? (bfr*)(p.ws + W_KBP) + ((long)sq * KP_PAD + t) * 512 : (bfr*)(p.ws + W_KBS) + ((long)sq * S_S + PAST + t) * 512;
        else if (REG == 3) dst = (bfr*)(p.ws + W_GA) + (long)row * 512;
        else if (REG == 4) dst = (bfr*)(p.ws + W_QIB) + (long)row * 256;
        else if (REG == 5) dst = isP ? (bfr*)(p.ws + W_KIBP) + ((long)sq * KP_PAD + t) * 64 : (bfr*)(p.ws + W_KIBS) + ((long)sq * S_S + PAST + t) * 64;
        else if (REG == 6) dst = (bfr*)(p.ws + W_XBB) + (long)row * 512;
        else if (REG == 7) dst = (bfr*)(p.ws + W_GB) + (long)row * 512;
        else if (REG == 8) dst = (bfr*)(p.ws + W_XCB) + (long)row * 512;
        else if (REG == 9) dst = (bfr*)(p.ws + W_GC) + (long)row * 512;
        else dst = (bfr*)(p.ws + W_GM) + (long)row * 3072;
        const uint4 val = *(const uint4*)(img + r * EPI_PITCH + ch * 8);
        *(uint4*)(dst + rel + ch * 8) = val;
      }
    }
  }
}

DI void epi_inproj(const Params& p, int layer, f32x4 (&acc)[4][4], int brow, int bcol) {
  const int tid = get_tid(), wid = __builtin_amdgcn_readfirstlane(tid >> 6), lane = tid & 63, wr = wid >> 1, wc = wid & 1;
  const int c0 = bcol + wc * 64;
  const int rb = brow + wr * 64;
  asm volatile("s_waitcnt lgkmcnt(0)" ::: "memory");
  __builtin_amdgcn_s_barrier();
  if (c0 < C_K) epi_region<0>(p, layer, acc, rb, c0 - C_Q, lane, wid);
  else if (c0 < C_V) epi_region<1>(p, layer, acc, rb, c0 - C_K, lane, wid);
  else if (c0 < C_GA) epi_region<2>(p, layer, acc, rb, c0 - C_V, lane, wid);
  else if (c0 < C_QI) epi_region<3>(p, layer, acc, rb, c0 - C_GA, lane, wid);
  else if (c0 < C_KI) epi_region<4>(p, layer, acc, rb, c0 - C_QI, lane, wid);
  else if (c0 < C_XB) epi_region<5>(p, layer, acc, rb, c0 - C_KI, lane, wid);
  else if (c0 < C_GB) epi_region<6>(p, layer, acc, rb, c0 - C_XB, lane, wid);
  else if (c0 < C_XC) epi_region<7>(p, layer, acc, rb, c0 - C_GB, lane, wid);
  else if (c0 < C_GC) epi_region<8>(p, layer, acc, rb, c0 - C_XC, lane, wid);
  else if (c0 < C_GM) epi_region<9>(p, layer, acc, rb, c0 - C_GC, lane, wid);
  else if (c0 < C_WI) epi_region<10>(p, layer, acc, rb, c0 - C_GM, lane, wid);
  else epi_region<11>(p, layer, acc, rb, c0 - C_WI, lane, wid);
}

DI void phase_inproj(const Params& p, int layer, char*) {
  const bfr* A = (const bfr*)(p.ws + W_HN);
  const bfr* Bt = (const bfr*)(p.ws + W_WINT) + (long)layer * NPAD * 1024;
  constexpr int NTM = MPAD / 128, NTN = NPAD / 128;
  const int rank = sh_xinfo[0], nloc = sh_xinfo[1], ia = sh_xinfo[2], na = sh_xinfo[3];
  const int nbase = NTN / na, nrem = NTN % na;
  const int nn = nbase + (ia < nrem ? 1 : 0), n0 = ia * nbase + min(ia, nrem);
  const int target = (NTM * NTN + na - 1) / na;
  const int keep = min(NTM * nn, target);
  int poff = 0, stot = 0;
  for (int a = 0; a < na; ++a) {
    const int o = NTM * (nbase + (a < nrem ? 1 : 0)), kp = min(o, target);
    if (a < ia) poff += target - kp;
    stot += o - kp;
  }
  const int dend = min(poff + (target - keep), stot);
  const int kown = rank < keep ? (keep - rank + nloc - 1) / nloc : 0;
  auto get_tile = [&](int k, int& tm_, int& tn_) -> bool {
    if (k < kown) { const int i = rank + k * nloc; tm_ = i / nn; tn_ = n0 + (i - tm_ * nn); return true; }
    const int e = poff + rank + (k - kown) * nloc;
    if (e >= dend) return false;
    int accs = 0;
    for (int a = 0; a < na; ++a) {
      const int nna = nbase + (a < nrem ? 1 : 0), o = NTM * nna, kp = min(o, target), sp = o - kp;
      if (e < accs + sp) {
        const int i = kp + (e - accs);
        tm_ = i / nna;
        tn_ = a * nbase + min(a, nrem) + (i - tm_ * nna);
        return true;
      }
      accs += sp;
    }
    return false;
  };
  bool first = true;
  int tm = 0, tn = 0;
  bool have = get_tile(0, tm, tn);
#pragma unroll 1
  for (int k = 0; have; ++k) {
    int tm2 = 0, tn2 = 0;
    const bool nxt = get_tile(k + 1, tm2, tn2);
    const int nbr = nxt ? tm2 * 128 : -1, nbc = tn2 * 128;
    f32x4 acc[4][4];
#pragma unroll
    for (int m = 0; m < 4; ++m)
#pragma unroll
      for (int n = 0; n < 4; ++n) acc[m][n] = f32x4{0.f, 0.f, 0.f, 0.f};
    gemm128<4>(A, 1024, Bt, 1024, 1024, tm * 128, tn * 128, smem, acc, true, first, nbr, nbc);
    first = false;
    epi_inproj(p, layer, acc, tm * 128, tn * 128);
    tm = tm2; tn = tn2; have = nxt;
  }
}

DI void phase_merge(const Params& p, int layer, char*) {
  const int tid = get_tid(), wid = __builtin_amdgcn_readfirstlane(tid >> 6), lane = tid & 63, wr = wid >> 1, wc = wid & 1, fr = lane & 15, fq = lane >> 4;
  const bfr* gmb = (const bfr*)(p.ws + W_GM);
  bfr* merged = (bfr*)(p.ws + W_HN);
  constexpr int NTM = MPAD / 128, NTN = 8;
  for (int tile = blockIdx.x; tile < NTM * NTN; tile += gridDim.x) {
    int tn = tile / NTM, tm = tile % NTM;
    const int brow = tm * 128, bcol = tn * 128;
    unsigned tot[4][4][2];
#pragma unroll
    for (int m = 0; m < 4; ++m)
#pragma unroll
      for (int n = 0; n < 4; ++n) { tot[m][n][0] = 0u; tot[m][n][1] = 0u; }
#pragma unroll 1
    for (int br = 0; br < 3; ++br) {
      const bfr* A = (const bfr*)(p.ws + (br == 0 ? W_GA : (br == 1 ? W_GB : W_GC)));
      const bfr* Bt = (const bfr*)(p.ws + W_WBT) + (long)(layer * 3 + br) * 1024 * 512;
      f32x4 acc[4][4];
#pragma unroll
      for (int m = 0; m < 4; ++m)
#pragma unroll
        for (int n = 0; n < 4; ++n) acc[m][n] = f32x4{0.f, 0.f, 0.f, 0.f};
      gemm128<4>(A, 512, Bt, 512, 512, brow, bcol, smem, acc);
#pragma unroll
      for (int m = 0; m < 4; ++m) {
        const int row0 = brow + wr * 64 + m * 16 + fq * 4;
        if (row0 < ROWS) {
#pragma unroll
          for (int n = 0; n < 4; ++n) {
            const int col = bcol + wc * 64 + n * 16 + fr;
            const bfr* gp = gmb + (long)row0 * 3072 + br * 1024 + col;
            const float g0 = bf2f(gp[0]), g1 = bf2f(gp[3072]), g2 = bf2f(gp[2 * 3072]), g3 = bf2f(gp[3 * 3072]);
            const unsigned t0 = tot[m][n][0], t1 = tot[m][n][1];
            tot[m][n][0] = pack2(__uint_as_float(t0 << 16) + g0 * acc[m][n][0], __uint_as_float(t0 & 0xFFFF0000u) + g1 * acc[m][n][1]);
            tot[m][n][1] = pack2(__uint_as_float(t1 << 16) + g2 * acc[m][n][2], __uint_as_float(t1 & 0xFFFF0000u) + g3 * acc[m][n][3]);
          }
        }
      }
    }
#pragma unroll
    for (int m = 0; m < 4; ++m) {
      const int row0 = brow + wr * 64 + m * 16 + fq * 4;
      if (row0 < ROWS) {
#pragma unroll
        for (int n = 0; n < 4; ++n) {
          bfr* mp = merged + (long)row0 * 1024 + bcol + wc * 64 + n * 16 + fr;
          mp[0] = (bfr)(tot[m][n][0] & 0xFFFFu); mp[1024] = (bfr)(tot[m][n][0] >> 16);
          mp[2048] = (bfr)(tot[m][n][1] & 0xFFFFu); mp[3072] = (bfr)(tot[m][n][1] >> 16);
        }
      }
    }
  }
}

DI void phase_out(const Params& p, int layer, char*) {
  const int tid = get_tid(), wid = __builtin_amdgcn_readfirstlane(tid >> 6), lane = tid & 63, wr = wid >> 1, wc = wid & 1, fr = lane & 15, fq = lane >> 4;
  const bfr* A = (const bfr*)(p.ws + W_HN);
  const bfr* Bt = (const bfr*)(p.ws + W_WOT) + (long)layer * 1024 * 1024;
  float* xres = (float*)(p.ws + W_XRES);
  constexpr int NTM = MPAD / 128, NTN = 8;
  for (int tile = blockIdx.x; tile < NTM * NTN; tile += gridDim.x) {
    int tn = tile / NTM, tm = tile % NTM;
    const int brow = tm * 128, bcol = tn * 128;
    f32x4 acc[4][4];
#pragma unroll
    for (int m = 0; m < 4; ++m)
#pragma unroll
      for (int n = 0; n < 4; ++n) acc[m][n] = f32x4{0.f, 0.f, 0.f, 0.f};
    gemm128<4>(A, 1024, Bt, 1024, 1024, brow, bcol, smem, acc);
#pragma unroll
    for (int m = 0; m < 4; ++m)
#pragma unroll
      for (int j = 0; j < 4; ++j) {
        int row = brow + wr * 64 + m * 16 + fq * 4 + j;
        if (row < ROWS) {
#pragma unroll
          for (int n = 0; n < 4; ++n) xres[(long)row * 1024 + bcol + wc * 64 + n * 16 + fr] += acc[m][n][j];
        }
      }
  }
}

constexpr int SEL_QS = 2120;
DI void select_item(const Params& p, int isP, int sq, int c, int sub, char*) {
  const int tid = get_tid(), wid = __builtin_amdgcn_readfirstlane(tid >> 6), lane = tid & 63, fr = lane & 15, fq = lane >> 4;
  int T0, nadm, rowbase;
  const bfr* kib;
  if (isP) {
    if (c == 0) { T0 = 0; nadm = 16; } else { T0 = 16 + 64 * (c - 1) + 16 * sub; nadm = 16 + 64 * c; }
    rowbase = sq * T_P;
    kib = (const bfr*)(p.ws + W_KIBP) + (long)sq * KP_PAD * 64;
  } else {
    T0 = 16 * sub; nadm = S_S; rowbase = ROWS_P + sq * 64;
    kib = (const bfr*)(p.ws + W_KIBS) + (long)sq * S_S * 64;
  }
  unsigned* maskg = (unsigned*)(p.ws + W_MASK);
  const int nsteps = (nadm + 31) >> 5;
  if (nadm <= 256) {
    for (int e = tid; e < 16 * nsteps; e += 256) {
      int q = e / nsteps, s = e - q * nsteps;
      unsigned w = (s * 32 + 32 <= nadm) ? 0xFFFFFFFFu : 0xFFFFu;
      maskg[(long)(rowbase + T0 + q) * MW + s] = w;
    }
    return;
  }
  const int nkt = nadm >> 4;
  const int nmine = (nkt - wid + 3) >> 2;
  const int nregs = (nadm + 63) >> 6;
  const bfr* qib = (const bfr*)(p.ws + W_QIB);
  const float* wib = (const float*)(p.ws + W_WIB);
  unsigned* S = (unsigned*)smem;
#pragma unroll 1
  for (int g = 0; g < 4; ++g) {
    const int qrow = rowbase + T0 + g * 4;
    int koff = (wid * 16 + fr) * 64 + fq * 8;
    asm volatile("" : "+v"(koff));
    const bfr* kbase = kib + koff;
    int nm = nmine;
    asm volatile("" : "+v"(nm));
    nm = __builtin_amdgcn_readfirstlane(nm);
    const bfr* qp = qib + (long)(qrow + (fr >> 2)) * 256 + (fr & 3) * 64 + fq * 8;
    const bf16x8 a0 = *(const bf16x8*)qp;
    const bf16x8 a1 = *(const bf16x8*)(qp + 32);
    const float4 w = *(const float4*)(wib + (long)(qrow + fq) * 4);
    unsigned sc[65];
#pragma unroll
    for (int ch = 0; ch < 5; ++ch) {
      if (ch * 13 < nm) {
        bf16x8 b0[13], b1[13];
#pragma unroll
        for (int u = 0; u < 13; ++u) {
          const int ic = min(ch * 13 + u, nm - 1);
          const bfr* kp = kbase + (long)ic * 4096;
          b0[u] = *(const bf16x8*)kp;
          b1[u] = *(const bf16x8*)(kp + 32);
        }
#pragma unroll
        for (int u = 0; u < 13; ++u) {
          const int i = ch * 13 + u;
          f32x4 a = {0.f, 0.f, 0.f, 0.f};
          a = MFMA16(a0, b0[u], a);
          a = MFMA16(a1, b1[u], a);
          float s = w.x * fmaxf(a[0], 0.f) + w.y * fmaxf(a[1], 0.f) + w.z * fmaxf(a[2], 0.f) + w.w * fmaxf(a[3], 0.f);
          sc[i] = (i < nm) ? sortable(s) : 0u;
        }
      } else {
#pragma unroll
        for (int u = 0; u < 13; ++u) sc[ch * 13 + u] = 0u;
      }
      __builtin_amdgcn_sched_barrier(0);
    }
    unsigned v[65];
    __syncthreads();
#pragma unroll
    for (int i = 0; i < 33; ++i) S[fq * SEL_QS + (i * 4 + wid) * 16 + fr] = sc[i];
    __syncthreads();
#pragma unroll
    for (int j = 0; j < 33; ++j) v[j] = S[wid * SEL_QS + j * 64 + lane];
    if (nregs > 33) {
      __syncthreads();
#pragma unroll
      for (int i = 33; i < 65; ++i) S[fq * SEL_QS + (i * 4 + wid - 132) * 16 + fr] = sc[i];
      __syncthreads();
#pragma unroll
      for (int j = 0; j < 32; ++j) v[33 + j] = S[wid * SEL_QS + j * 64 + lane];
    } else {
#pragma unroll
      for (int j = 0; j < 32; ++j) v[33 + j] = 0u;
    }
    int nr = nregs;
    asm volatile("" : "+v"(nr));
    nr = __builtin_amdgcn_readfirstlane(nr);
    unsigned vmax = 0u;
#pragma unroll
    for (int r = 0; r < 65; ++r) vmax = max(vmax, v[r]);
#pragma unroll
    for (int o = 32; o >= 1; o >>= 1) vmax = max(vmax, (unsigned)__shfl_xor((int)vmax, o));
    vmax = __builtin_amdgcn_readfirstlane(vmax);
    unsigned thr = 0u;
    int exact = 0;
#pragma unroll 1
    for (int bit = 31; bit >= 0; --bit) {
      const unsigned cand = thr | (1u << bit);
      if (cand > vmax) continue;
      int cnt = 0;
#pragma unroll
      for (int ch = 0; ch < 5; ++ch) {
        if (ch * 13 < nr) {
#pragma unroll
          for (int u = 0; u < 13; ++u) cnt += __popcll(__ballot(v[ch * 13 + u] >= cand));
        }
      }
      if (cnt >= 256) {
        thr = cand;
        if (cnt == 256) { exact = 1; break; }
      }
    }
    if (exact) {
      unsigned mn = 0xFFFFFFFFu;
#pragma unroll
      for (int r = 0; r < 65; ++r) mn = min(mn, v[r] >= thr ? v[r] : 0xFFFFFFFFu);
#pragma unroll
      for (int o = 32; o >= 1; o >>= 1) mn = min(mn, (unsigned)__shfl_xor((int)mn, o));
      thr = __builtin_amdgcn_readfirstlane(mn);
    }
    int gt = 0, eq = 0;
#pragma unroll
    for (int r = 0; r < 65; ++r) {
      gt += __popcll(__ballot(v[r] > thr));
      eq += __popcll(__ballot(v[r] == thr));
    }
    const int need = 256 - gt;
    int idxcut = 0x7fffffff;
    if (eq != need) {
      int run = 0;
      bool done = false;
#pragma unroll
      for (int r = 0; r < 65; ++r) {
        if (!done) {
          unsigned long long m = __ballot(v[r] == thr);
          int pc = __popcll(m);
          if (run + pc >= need) {
            const int k = need - run;
            for (int t = 1; t < k; ++t) m &= m - 1ull;
            idxcut = r * 64 + (__ffsll((long long)m) - 1);
            done = true;
          } else run += pc;
        }
      }
    }
    unsigned* mrowp = maskg + (long)(qrow + wid) * MW;
#pragma unroll
    for (int r = 0; r < 65; ++r) {
      if (r < nr) {
        const bool sel = (v[r] > thr) || (v[r] == thr && (r * 64 + lane) <= idxcut);
        const unsigned long long bal = __ballot(sel);
        if (lane == 0) *(uint2*)(mrowp + r * 2) = make_uint2((unsigned)bal, (unsigned)(bal >> 32));
      }
    }
  }
}

DI void lru_tile(const Params& p, int layer, int isP, int sq, int tile, int nb, int pass, char*) {
  const int tid = get_tid(), wid = __builtin_amdgcn_readfirstlane(tid >> 6), lane = tid & 63, fr = lane & 15, fq = lane >> 4;
  float* xbs = (float*)smem;
  float* as_ = xbs;
  float* xcs = xbs + 67 * 64;
  float* bs_ = xcs + 64 * 64;
  float* ab = bs_ + 64 * 64;
  bfr* xca = (bfr*)(ab + 512);
  const int T = isP ? T_P : T_S;
  const int rowbase = isP ? sq * T_P : ROWS_P + sq * 64;
  const int t0 = tile * 64, ch0 = nb * 64;
  const bfr* xbb = (const bfr*)(p.ws + W_XBB);
  bfr* gby = (bfr*)(p.ws + W_GB);
  float* agg = (float*)(p.ws + W_AGG);
  {
    const int c = tid & 63;
    float vv[17];
#pragma unroll
    for (int i = 0; i < 17; ++i) {
      const int rr = i * 4 + (tid >> 6);
      const int tt = t0 - 3 + rr;
      float v = 0.f;
      if (rr < 67) {
        if (tt < 0) { if (!isP) v = p.state_conv[((long)(layer * NB_S + sq) * 3 + (3 + tt)) * 512 + ch0 + c]; }
        else if (tt < T) v = bf2f(xbb[(long)(rowbase + tt) * 512 + ch0 + c]);
      }
      vv[i] = v;
    }
#pragma unroll
    for (int i = 0; i < 17; ++i) { const int rr = i * 4 + (tid >> 6); if (rr < 67) xbs[rr * 64 + c] = vv[i]; }
  }
  __syncthreads();
  {
    const int c = tid & 63;
    const float cb = p.conv_b[layer * 512 + ch0 + c];
    const float w0 = p.conv_w[(layer * 4 + 0) * 512 + ch0 + c], w1 = p.conv_w[(layer * 4 + 1) * 512 + ch0 + c],
                w2 = p.conv_w[(layer * 4 + 2) * 512 + ch0 + c], w3 = p.conv_w[(layer * 4 + 3) * 512 + ch0 + c];
    for (int t = tid >> 6; t < 64; t += 4) {
      float xc = cb + w0 * xbs[t * 64 + c] + w1 * xbs[(t + 1) * 64 + c] + w2 * xbs[(t + 2) * 64 + c] + w3 * xbs[(t + 3) * 64 + c];
      xcs[t * 64 + c] = xc;
      xca[t * 72 + c] = f2bf(xc);
    }
  }
  __syncthreads();
  {
    const bfr* WaT = (const bfr*)(p.ws + W_WAT) + (long)(layer * 8 + nb) * 4096;
    const bfr* WxT = (const bfr*)(p.ws + W_WXT) + (long)(layer * 8 + nb) * 4096;
    bf16x8 af0 = *(const bf16x8*)(xca + (wid * 16 + fr) * 72 + fq * 8);
    bf16x8 af1 = *(const bf16x8*)(xca + (wid * 16 + fr) * 72 + 32 + fq * 8);
#pragma unroll
    for (int nt = 0; nt < 4; ++nt) {
      const int d = nt * 16 + fr;
      bf16x8 ba0 = *(const bf16x8*)(WaT + d * 64 + fq * 8), ba1 = *(const bf16x8*)(WaT + d * 64 + 32 + fq * 8);
      bf16x8 bx0 = *(const bf16x8*)(WxT + d * 64 + fq * 8), bx1 = *(const bf16x8*)(WxT + d * 64 + 32 + fq * 8);
      f32x4 ar = {0.f, 0.f, 0.f, 0.f}, ai = {0.f, 0.f, 0.f, 0.f};
      ar = MFMA16(af0, ba0, ar); ar = MFMA16(af1, ba1, ar);
      ai = MFMA16(af0, bx0, ai); ai = MFMA16(af1, bx1, ai);
      const float bav = p.lru_ba[layer * 512 + ch0 + d], bxv = p.lru_bx[layer * 512 + ch0 + d];
      const float sp = log1pf(__expf(-p.lru_lambda[layer * 512 + ch0 + d]));
#pragma unroll
      for (int j = 0; j < 4; ++j) {
        const int t = wid * 16 + fq * 4 + j;
        float r = sigm(ar[j] + bav), ig = sigm(ai[j] + bxv);
        float la = -8.f * r * sp;
        float a = __expf(la);
        float b = sqrtf(1.f - __expf(2.f * la)) * (ig * xcs[t * 64 + d]);
        if (t0 + t >= T) { a = 1.f; b = 0.f; }
        as_[t * 64 + d] = a;
        bs_[t * 64 + d] = b;
      }
    }
  }
  __syncthreads();
  const int c = tid & 63;
  {
    float A = 1.f, B = 0.f;
#pragma unroll
    for (int tt = 0; tt < 16; ++tt) {
      float a = as_[(wid * 16 + tt) * 64 + c], b = bs_[(wid * 16 + tt) * 64 + c];
      A *= a; B = a * B + b;
    }
    ab[(wid * 64 + c) * 2] = A;
    ab[(wid * 64 + c) * 2 + 1] = B;
  }
  __syncthreads();
  if (pass == 0) {
    if (wid == 0) {
      float A = 1.f, B = 0.f;
#pragma unroll
      for (int w = 0; w < 4; ++w) { float a = ab[(w * 64 + c) * 2], b = ab[(w * 64 + c) * 2 + 1]; A *= a; B = a * B + b; }
      *(float2*)(agg + ((long)(sq * NTILE_P + tile) * 512 + ch0 + c) * 2) = make_float2(A, B);
    }
  } else {
    float h = isP ? 0.f : p.state_lru[(long)(layer * NB_S + sq) * 512 + ch0 + c];
    for (int i0 = 0; i0 < tile; i0 += 16) {
      float2 e[16];
#pragma unroll
      for (int u = 0; u < 16; ++u)
        e[u] = (i0 + u < tile) ? *(const float2*)(agg + ((long)(sq * NTILE_P + i0 + u) * 512 + ch0 + c) * 2) : make_float2(1.f, 0.f);
#pragma unroll
      for (int u = 0; u < 16; ++u) h = e[u].x * h + e[u].y;
    }
    for (int w = 0; w < wid; ++w) h = ab[(w * 64 + c) * 2] * h + ab[(w * 64 + c) * 2 + 1];
#pragma unroll
    for (int tt = 0; tt < 16; ++tt) {
      const int t = wid * 16 + tt;
      h = as_[t * 64 + c] * h + bs_[t * 64 + c];
      if (t0 + t < T) {
        const long idx = (long)(rowbase + t0 + t) * 512 + ch0 + c;
        gby[idx] = f2bf(h * bf2f(gby[idx]));
        if (t0 + t == T - 1) {
          if (isP) p.out[O_LRUP + (long)(layer * NB_P + sq) * 512 + ch0 + c] = h;
          else p.out[O_LRUS + (long)(layer * NB_S + sq) * 512 + ch0 + c] = h;
        }
      }
    }
  }
}

DI void pool_item(const Params& p, int layer, int isP, int sq, int tile, int g, char*) {
  const int tid = get_tid(), wid = __builtin_amdgcn_readfirstlane(tid >> 6), lane = tid & 63, fr = lane & 15, fq = lane >> 4;
  float* xps = (float*)smem;
  bfr* pa = (bfr*)(xps + 79 * 128);
  const int T = isP ? T_P : T_S;
  const int rowbase = isP ? sq * T_P : ROWS_P + sq * 64;
  const int t0 = tile * 64, ch0 = g * 128;
  const bfr* xcb = (const bfr*)(p.ws + W_XCB);
  bfr* gcy = (bfr*)(p.ws + W_GC);
  {
    const int c = tid & 127;
#pragma unroll
    for (int b8 = 0; b8 < 5; ++b8) {
      float vv[8];
#pragma unroll
      for (int u = 0; u < 8; ++u) {
        const int rr = (b8 * 8 + u) * 2 + (tid >> 7);
        const int tt = t0 - 15 + rr;
        float v = 0.f;
        if (rr < 79) {
          if (tt < 0) { if (!isP) v = p.state_pool[((long)(layer * NB_S + sq) * 15 + (15 + tt)) * 512 + ch0 + c]; }
          else if (tt < T) v = bf2f(xcb[(long)(rowbase + tt) * 512 + ch0 + c]);
        }
        vv[u] = v;
      }
#pragma unroll
      for (int u = 0; u < 8; ++u) { const int rr = (b8 * 8 + u) * 2 + (tid >> 7); if (rr < 79) xps[rr * 128 + c] = vv[u]; }
    }
  }
  __syncthreads();
  {
    const int c = tid & 127;
    const int w = 2 << g;
    const int nh = isP ? 0 : PAST;
    for (int t = tid >> 7; t < 64; t += 2) {
      float s = 0.f;
      for (int i = 0; i < w; ++i) s += xps[(15 + t - i) * 128 + c];
      int cnt = min(w, t0 + t + 1 + nh);
      float v = s / (float)cnt - xps[(15 + t) * 128 + c];
      pa[t * 136 + c] = f2bf(v);
    }
  }
  __syncthreads();
  {
    const bfr* PwT = (const bfr*)(p.ws + W_PWT) + (long)(layer * 4 + g) * 16384;
    bf16x8 af[4];
#pragma unroll
    for (int ks = 0; ks < 4; ++ks) af[ks] = *(const bf16x8*)(pa + (wid * 16 + fr) * 136 + ks * 32 + fq * 8);
#pragma unroll
    for (int nt = 0; nt < 8; ++nt) {
      const int d = nt * 16 + fr;
      f32x4 acc = {0.f, 0.f, 0.f, 0.f};
#pragma unroll
      for (int ks = 0; ks < 4; ++ks) {
        bf16x8 bq = *(const bf16x8*)(PwT + d * 128 + ks * 32 + fq * 8);
        acc = MFMA16(af[ks], bq, acc);
      }
      const float scl = p.pool_scale[layer * 512 + ch0 + d];
#pragma unroll
      for (int j = 0; j < 4; ++j) {
        const int t = wid * 16 + fq * 4 + j;
        if (t0 + t < T) {
          const long idx = (long)(rowbase + t0 + t) * 512 + ch0 + d;
          gcy[idx] = f2bf(acc[j] * scl * bf2f(gcy[idx]));
        }
      }
    }
  }
}

DI void kmax_item(const Params& p, int seq, int h, char*) {
  const int tid = get_tid(), wid = __builtin_amdgcn_readfirstlane(tid >> 6), lane = tid & 63;
  const bfr* kb; int S;
  if (seq < NB_P) { kb = (const bfr*)(p.ws + W_KBP) + (long)seq * KP_PAD * 512; S = T_P; }
  else { kb = (const bfr*)(p.ws + W_KBS) + (long)(seq - NB_P) * S_S * 512; S = S_S; }
  float mx = 0.f;
  for (int key = tid; key < S; key += 256) {
    const uint4* r = (const uint4*)(kb + (long)key * 512 + h * 64);
    float ss = 0.f;
#pragma unroll
    for (int i = 0; i < 8; ++i) {
      uint4 v = r[i];
      unsigned u[4] = {v.x, v.y, v.z, v.w};
#pragma unroll
      for (int j = 0; j < 4; ++j) {
        float a = __uint_as_float(u[j] << 16), b = __uint_as_float(u[j] & 0xFFFF0000u);
        ss += a * a + b * b;
      }
    }
    mx = fmaxf(mx, ss);
  }
#pragma unroll
  for (int o = 32; o >= 1; o >>= 1) mx = fmaxf(mx, __shfl_xor(mx, o));
  float* red = (float*)smem;
  if (lane == 0) red[wid] = mx;
  __syncthreads();
  if (tid == 0) ((float*)(p.ws + W_KMAX))[seq * 8 + h] = fmaxf(fmaxf(red[0], red[1]), fmaxf(red[2], red[3]));
}

DI void attn_unit(const Params& p, int isP, int sq, int c, int h, int half, size_t dstoff = W_GA) {
  const int lane = get_tid() & 63, fr = lane & 15, fq = lane >> 4;
  int T0, nqt, nadm, rowbase, vld;
  const bfr *kb, *vt;
  if (isP) {
    if (c == 0) { T0 = 0; nqt = 1; nadm = 16; } else { T0 = 16 + 64 * (c - 1) + 32 * half; nqt = 2; nadm = 16 + 64 * c; }
    rowbase = sq * T_P;
    kb = (const bfr*)(p.ws + W_KBP) + (long)sq * KP_PAD * 512;
    vt = (const bfr*)(p.ws + W_VTP) + (long)sq * 512 * KP_PAD;
    vld = KP_PAD;
  } else {
    T0 = 32 * half; nqt = 2; nadm = S_S; rowbase = ROWS_P + sq * 64;
    kb = (const bfr*)(p.ws + W_KBS) + (long)sq * S_S * 512;
    vt = (const bfr*)(p.ws + W_VTS) + (long)sq * 512 * S_S;
    vld = S_S;
  }
  const int nsteps = (nadm + 31) >> 5;
  const int qrow0 = rowbase + T0;
  const bfr* qb = (const bfr*)(p.ws + W_QB);
  const unsigned* maskg = (const unsigned*)(p.ws + W_MASK);
  bf16x8 qf[2][2];
#pragma unroll
  for (int qt = 0; qt < 2; ++qt)
#pragma unroll
    for (int ks = 0; ks < 2; ++ks) {
      int r = qrow0 + (qt < nqt ? qt * 16 : 0) + fr;
      qf[qt][ks] = *(const bf16x8*)(qb + (long)r * 512 + h * 64 + ks * 32 + fq * 8);
    }
  f32x4 o[2][4];
#pragma unroll
  for (int qt = 0; qt < 2; ++qt)
#pragma unroll
    for (int dt = 0; dt < 4; ++dt) o[qt][dt] = f32x4{0.f, 0.f, 0.f, 0.f};
  const float sc2 = 0.125f * 1.4426950408889634f;
  const float kmax2 = ((const float*)(p.ws + W_KMAX))[(isP ? sq : NB_P + sq) * 8 + h];
  float mref[2], lsum[2] = {0.f, 0.f};
#pragma unroll
  for (int qt = 0; qt < 2; ++qt) {
    float ss = 0.f;
#pragma unroll
    for (int ks = 0; ks < 2; ++ks)
#pragma unroll
      for (int i = 0; i < 8; ++i) { float a = bf2f((bfr)qf[qt][ks][i]); ss += a * a; }
    ss += __shfl_xor(ss, 16);
    ss += __shfl_xor(ss, 32);
    mref[qt] = sqrtf(ss * kmax2) * sc2;
  }
  const unsigned* mrow0 = maskg + (long)(qrow0 + fr) * MW;
  const unsigned* mrow1 = maskg + (long)(qrow0 + (nqt > 1 ? 16 : 0) + fr) * MW;
  const int kofs = (fr >> 2) * 8 + (fr & 3);
  const bfr* kptr = kb + (long)kofs * 512 + h * 64 + fq * 8;
  const bfr* vptr = vt + (long)(h * 64 + fr) * vld + fq * 8;
  bf16x8 ka0 = *(const bf16x8*)kptr, ka1 = *(const bf16x8*)(kptr + 32);
  bf16x8 kb0 = *(const bf16x8*)(kptr + 4 * 512), kb1 = *(const bf16x8*)(kptr + 4 * 512 + 32);
  bf16x8 vf[4];
#pragma unroll
  for (int dt = 0; dt < 4; ++dt) vf[dt] = *(const bf16x8*)(vptr + (long)dt * 16 * vld);
  unsigned mw0 = mrow0[0], mw1 = mrow1[0];
  for (int s = 0; s < nsteps; ++s) {
    const int sn = min(s + 1, nsteps - 1);
    const bfr* pa = kptr + (long)sn * 32 * 512;
    const bf16x8 nka0 = *(const bf16x8*)pa, nka1 = *(const bf16x8*)(pa + 32);
    const bf16x8 nkb0 = *(const bf16x8*)(pa + 4 * 512), nkb1 = *(const bf16x8*)(pa + 4 * 512 + 32);
    bf16x8 nvf[4];
#pragma unroll
    for (int dt = 0; dt < 4; ++dt) nvf[dt] = *(const bf16x8*)(vptr + (long)dt * 16 * vld + sn * 32);
    const unsigned nmw0 = mrow0[sn], nmw1 = mrow1[sn];
#pragma unroll
    for (int qt = 0; qt < 2; ++qt) {
      if (qt < nqt) {
        f32x4 sa = {0.f, 0.f, 0.f, 0.f}, sb = {0.f, 0.f, 0.f, 0.f};
        sa = MFMA16(ka0, qf[qt][0], sa); sa = MFMA16(ka1, qf[qt][1], sa);
        sb = MFMA16(kb0, qf[qt][0], sb); sb = MFMA16(kb1, qf[qt][1], sb);
        const unsigned mb = ((qt == 0 ? mw0 : mw1) >> (fq * 8)) & 0xFFu;
        float pr[8];
#pragma unroll
        for (int i = 0; i < 4; ++i) {
          float pa_ = __builtin_amdgcn_exp2f(sa[i] * sc2 - mref[qt]);
          float pb_ = __builtin_amdgcn_exp2f(sb[i] * sc2 - mref[qt]);
          pr[i] = ((mb >> i) & 1u) ? pa_ : 0.f;
          pr[4 + i] = ((mb >> (4 + i)) & 1u) ? pb_ : 0.f;
        }
        lsum[qt] += ((pr[0] + pr[1]) + (pr[2] + pr[3])) + ((pr[4] + pr[5]) + (pr[6] + pr[7]));
        union { unsigned u[4]; bf16x8 v; } pk;
        pk.u[0] = pack2(pr[0], pr[1]); pk.u[1] = pack2(pr[2], pr[3]); pk.u[2] = pack2(pr[4], pr[5]); pk.u[3] = pack2(pr[6], pr[7]);
#pragma unroll
        for (int dt = 0; dt < 4; ++dt) o[qt][dt] = MFMA16(vf[dt], pk.v, o[qt][dt]);
      }
    }
    ka0 = nka0; ka1 = nka1; kb0 = nkb0; kb1 = nkb1;
#pragma unroll
    for (int dt = 0; dt < 4; ++dt) vf[dt] = nvf[dt];
    mw0 = nmw0; mw1 = nmw1;
  }
  bfr* gay = (bfr*)(p.ws + W_GA);
  bfr* dsty = (bfr*)(p.ws + dstoff);
#pragma unroll
  for (int qt = 0; qt < 2; ++qt) {
    if (qt < nqt) {
      float l = lsum[qt];
      l += __shfl_xor(l, 16);
      l += __shfl_xor(l, 32);
      const float inv = l > 0.f ? 1.f / l : 0.f;
      const long rowoff = (long)(qrow0 + qt * 16 + fr) * 512 + h * 64;
#pragma unroll
      for (int dt = 0; dt < 4; ++dt) {
        uint2* ptr = (uint2*)(gay + rowoff + dt * 16 + fq * 4);
        uint2 gv = *ptr;
        float g0 = __uint_as_float(gv.x << 16), g1 = __uint_as_float(gv.x & 0xFFFF0000u);
        float g2 = __uint_as_float(gv.y << 16), g3 = __uint_as_float(gv.y & 0xFFFF0000u);
        uint2 ov;
        ov.x = pack2(o[qt][dt][0] * inv * g0, o[qt][dt][1] * inv * g1);
        ov.y = pack2(o[qt][dt][2] * inv * g2, o[qt][dt][3] * inv * g3);
        *(uint2*)(dsty + rowoff + dt * 16 + fq * 4) = ov;
      }
    }
  }
}

#define XB_TMO      128
#define XB_XCNT(j)  (256  + 64 * (j))
#define XB_XSUB(j)  (1280 + 64 * (j))
#define XB_XGEN(j)  (2304 + 64 * (j))
#define XB_TOP      3328
#define XB_TOPGEN   3392
#define XCD_BAR_WORDS 3456
#define XB_SPIN_CAP (1u << 18)
#define LAS __attribute__((address_space(3)))

__device__ __forceinline__ unsigned xb_ld(unsigned* p)              { return __hip_atomic_load(p, __ATOMIC_RELAXED, __HIP_MEMORY_SCOPE_AGENT); }
__device__ __forceinline__ unsigned xb_add(unsigned* p, unsigned v) { return __hip_atomic_fetch_add(p, v, __ATOMIC_RELAXED, __HIP_MEMORY_SCOPE_AGENT); }
__device__ __forceinline__ unsigned xb_xcc_id() { return (unsigned)__builtin_amdgcn_s_getreg((3 << 11) | 20) & 0xFu; }
#define XB_SPIN(cond, bar) do { unsigned _sp = 0; while (cond) { __builtin_amdgcn_s_sleep(1); \
    if ((++_sp & 255u) == 0u) { if (xb_ld(&(bar)[XB_TMO])) break; if (_sp > XB_SPIN_CAP) { atomicAdd(&(bar)[XB_TMO], 1u); break; } } } } while (0)

struct XcdBarrier {
    unsigned* bar; unsigned x;
    volatile LAS unsigned* st;
};

__device__ __forceinline__ XcdBarrier xcd_barrier_post(unsigned* bar, volatile LAS unsigned* st) {
    XcdBarrier b; b.bar = bar; b.x = xb_xcc_id(); b.st = st;
    if (threadIdx.x == 0) (void)xb_add(&bar[XB_XCNT(b.x)], 1u);
    return b;
}
__device__ __forceinline__ void xcd_barrier_complete(unsigned* bar, unsigned x, unsigned& nloc, unsigned& nx) {
    const unsigned G = gridDim.x * gridDim.y * gridDim.z;
    unsigned sum, cnt, mine, sp = 0u;
    for (;;) {
        sum = 0u; cnt = 0u; mine = 0u;
#pragma unroll
        for (unsigned j = 0; j < 16; ++j) { const unsigned c = xb_ld(&bar[XB_XCNT(j)]); sum += c; cnt += (c > 0u) ? 1u : 0u; mine = (j == x) ? c : mine; }
        if (sum == G) break;
        __builtin_amdgcn_s_sleep(1);
        if ((++sp & 255u) == 0u) { if (xb_ld(&bar[XB_TMO])) break; if (sp > XB_SPIN_CAP) { atomicAdd(&bar[XB_TMO], 1u); break; } }
    }
    nloc = mine > 0u ? mine : 1u; nx = cnt > 0u ? cnt : 1u;
}

__device__ __forceinline__ void xcd_barrier(const XcdBarrier& b) {
    asm volatile("s_waitcnt vmcnt(0)" ::: "memory");
    __syncthreads();
    if (threadIdx.x == 0) {
        unsigned* bar = b.bar;
        __builtin_amdgcn_s_waitcnt(0);
        unsigned nloc = b.st[0], nx = b.st[1];
        if (nloc == 0u) { xcd_barrier_complete(bar, b.x, nloc, nx); b.st[0] = nloc; b.st[1] = nx; }
        const unsigned old = xb_add(&bar[XB_XSUB(b.x)], 1u);
        const unsigned gen = old / nloc;
        if (old + 1u == (gen + 1u) * nloc) {
            __builtin_amdgcn_fence(__ATOMIC_RELEASE, "agent");
            asm volatile("s_waitcnt vmcnt(0)" ::: "memory");
            const unsigned og = xb_add(&bar[XB_TOP], 1u);
            const unsigned tg = og / nx;
            if (og + 1u == (tg + 1u) * nx) xb_add(&bar[XB_TOPGEN], 1u);
            else XB_SPIN(xb_ld(&bar[XB_TOPGEN]) == tg, bar);
            __builtin_amdgcn_fence(__ATOMIC_ACQUIRE, "agent");
            xb_add(&bar[XB_XGEN(b.x)], 1u);
            asm volatile("s_waitcnt vmcnt(0)" ::: "memory");
        } else {
            XB_SPIN(xb_ld(&bar[XB_XGEN(b.x)]) == gen, bar);
            __builtin_amdgcn_fence(__ATOMIC_ACQUIRE, "agent");
            asm volatile("s_waitcnt vmcnt(0)" ::: "memory");
        }
    }
    __syncthreads();
}


DI void attn_block(const Params& p, int isP, int sq, int c, int h) {
  const int tid = get_tid(), wid = __builtin_amdgcn_readfirstlane(tid >> 6), lane = tid & 63, fr = lane & 15, fq = lane >> 4;
  int T0, nqt, nadm, rowbase, vld;
  const bfr *kb, *vt;
  if (isP) {
    if (c == 0) { T0 = 0; nqt = 1; nadm = 16; } else { T0 = 16 + 64 * (c - 1); nqt = 4; nadm = 16 + 64 * c; }
    rowbase = sq * T_P;
    kb = (const bfr*)(p.ws + W_KBP) + (long)sq * KP_PAD * 512;
    vt = (const bfr*)(p.ws + W_VTP) + (long)sq * 512 * KP_PAD;
    vld = KP_PAD;
  } else {
    T0 = 0; nqt = 4; nadm = S_S; rowbase = ROWS_P + sq * 64;
    kb = (const bfr*)(p.ws + W_KBS) + (long)sq * S_S * 512;
    vt = (const bfr*)(p.ws + W_VTS) + (long)sq * 512 * S_S;
    vld = S_S;
  }
  const int nsteps = (nadm + 31) >> 5;
  const int qrow0 = rowbase + T0;
  const bfr* qb = (const bfr*)(p.ws + W_QB);
  const unsigned* maskg = (const unsigned*)(p.ws + W_MASK);
  bf16x8 qf[4][2];
#pragma unroll
  for (int qt = 0; qt < 4; ++qt)
#pragma unroll
    for (int ks = 0; ks < 2; ++ks) {
      int r = qrow0 + (qt < nqt ? qt * 16 : 0) + fr;
      qf[qt][ks] = *(const bf16x8*)(qb + (long)r * 512 + h * 64 + ks * 32 + fq * 8);
    }
  f32x4 o[4][4];
#pragma unroll
  for (int qt = 0; qt < 4; ++qt)
#pragma unroll
    for (int dt = 0; dt < 4; ++dt) o[qt][dt] = f32x4{0.f, 0.f, 0.f, 0.f};
  const float sc2 = 0.125f * 1.4426950408889634f;
  const float kmax2 = ((const float*)(p.ws + W_KMAX))[(isP ? sq : NB_P + sq) * 8 + h];
  float mref[4], lsum[4] = {0.f, 0.f, 0.f, 0.f};
  const unsigned* mrow[4];
#pragma unroll
  for (int qt = 0; qt < 4; ++qt) {
    float ss = 0.f;
#pragma unroll
    for (int ks = 0; ks < 2; ++ks)
#pragma unroll
      for (int i = 0; i < 8; ++i) { float a = bf2f((bfr)qf[qt][ks][i]); ss += a * a; }
    ss += __shfl_xor(ss, 16);
    ss += __shfl_xor(ss, 32);
    mref[qt] = sqrtf(ss * kmax2) * sc2;
    mrow[qt] = maskg + (long)(qrow0 + (qt < nqt ? qt * 16 : 0) + fr) * MW;
  }
  const int kofs = (fr >> 2) * 8 + (fr & 3);
  const bfr* kptr = kb + (long)kofs * 512 + h * 64 + fq * 8;
  const bfr* vptr = vt + (long)(h * 64 + fr) * vld + fq * 8;
  if (wid < nsteps) {
    int s = wid;
    const bfr* pa0 = kptr + (long)s * 32 * 512;
    bf16x8 ka0 = *(const bf16x8*)pa0, ka1 = *(const bf16x8*)(pa0 + 32);
    bf16x8 kb0 = *(const bf16x8*)(pa0 + 4 * 512), kb1 = *(const bf16x8*)(pa0 + 4 * 512 + 32);
    bf16x8 vf[4];
#pragma unroll
    for (int dt = 0; dt < 4; ++dt) vf[dt] = *(const bf16x8*)(vptr + (long)dt * 16 * vld + s * 32);
    unsigned mw[4];
#pragma unroll
    for (int qt = 0; qt < 4; ++qt) mw[qt] = mrow[qt][s];
    for (; s < nsteps; s += 4) {
      const int sn = (s + 4 < nsteps) ? s + 4 : s;
      const bfr* pa = kptr + (long)sn * 32 * 512;
      const bf16x8 nka0 = *(const bf16x8*)pa, nka1 = *(const bf16x8*)(pa + 32);
      const bf16x8 nkb0 = *(const bf16x8*)(pa + 4 * 512), nkb1 = *(const bf16x8*)(pa + 4 * 512 + 32);
      bf16x8 nvf[4];
#pragma unroll
      for (int dt = 0; dt < 4; ++dt) nvf[dt] = *(const bf16x8*)(vptr + (long)dt * 16 * vld + sn * 32);
      unsigned nmw[4];
#pragma unroll
      for (int qt = 0; qt < 4; ++qt) nmw[qt] = mrow[qt][sn];
#pragma unroll
      for (int qt = 0; qt < 4; ++qt) {
        if (qt < nqt) {
          f32x4 sa = {0.f, 0.f, 0.f, 0.f}, sb = {0.f, 0.f, 0.f, 0.f};
          sa = MFMA16(ka0, qf[qt][0], sa); sa = MFMA16(ka1, qf[qt][1], sa);
          sb = MFMA16(kb0, qf[qt][0], sb); sb = MFMA16(kb1, qf[qt][1], sb);
          const unsigned mb = (mw[qt] >> (fq * 8)) & 0xFFu;
          float pr[8];
#pragma unroll
          for (int i = 0; i < 4; ++i) {
            float pa_ = __builtin_amdgcn_exp2f(sa[i] * sc2 - mref[qt]);
            float pb_ = __builtin_amdgcn_exp2f(sb[i] * sc2 - mref[qt]);
            pr[i] = ((mb >> i) & 1u) ? pa_ : 0.f;
            pr[4 + i] = ((mb >> (4 + i)) & 1u) ? pb_ : 0.f;
          }
          lsum[qt] += ((pr[0] + pr[1]) + (pr[2] + pr[3])) + ((pr[4] + pr[5]) + (pr[6] + pr[7]));
          union { unsigned u[4]; bf16x8 v; } pk;
          pk.u[0] = pack2(pr[0], pr[1]); pk.u[1] = pack2(pr[2], pr[3]); pk.u[2] = pack2(pr[4], pr[5]); pk.u[3] = pack2(pr[6], pr[7]);
#pragma unroll
          for (int dt = 0; dt < 4; ++dt) o[qt][dt] = MFMA16(vf[dt], pk.v, o[qt][dt]);
        }
      }
      ka0 = nka0; ka1 = nka1; kb0 = nkb0; kb1 = nkb1;
#pragma unroll
      for (int dt = 0; dt < 4; ++dt) vf[dt] = nvf[dt];
#pragma unroll
      for (int qt = 0; qt < 4; ++qt) mw[qt] = nmw[qt];
    }
  }
  float* OS = (float*)smem;
  float* LS = OS + 4 * 2048;
  bfr* gay = (bfr*)(p.ws + W_GA);
#pragma unroll
  for (int rd = 0; rd < 2; ++rd) {
    __syncthreads();
#pragma unroll
    for (int q2 = 0; q2 < 2; ++q2) {
      const int qt = rd * 2 + q2;
      float l = lsum[qt];
      l += __shfl_xor(l, 16);
      l += __shfl_xor(l, 32);
      LS[(wid * 2 + q2) * 64 + lane] = l;
#pragma unroll
      for (int dt = 0; dt < 4; ++dt)
#pragma unroll
        for (int j = 0; j < 4; ++j) OS[((wid * 2 + q2) * 16 + dt * 4 + j) * 64 + lane] = o[qt][dt][j];
    }
    __syncthreads();
    const int q2 = wid >> 1, qt = rd * 2 + q2;
    if (qt < nqt) {
      float l = 0.f;
#pragma unroll
      for (int w = 0; w < 4; ++w) l += LS[(w * 2 + q2) * 64 + lane];
      const float inv = l > 0.f ? 1.f / l : 0.f;
      const long rowoff = (long)(qrow0 + qt * 16 + fr) * 512 + h * 64;
#pragma unroll
      for (int d2 = 0; d2 < 2; ++d2) {
        const int dt = (wid & 1) * 2 + d2;
        float acc4[4];
#pragma unroll
        for (int j = 0; j < 4; ++j) {
          float a = 0.f;
#pragma unroll
          for (int w = 0; w < 4; ++w) a += OS[((w * 2 + q2) * 16 + dt * 4 + j) * 64 + lane];
          acc4[j] = a * inv;
        }
        uint2* ptr = (uint2*)(gay + rowoff + dt * 16 + fq * 4);
        uint2 gv = *ptr;
        float g0 = __uint_as_float(gv.x << 16), g1 = __uint_as_float(gv.x & 0xFFFF0000u);
        float g2 = __uint_as_float(gv.y << 16), g3 = __uint_as_float(gv.y & 0xFFFF0000u);
        uint2 ov;
        ov.x = pack2(acc4[0] * g0, acc4[1] * g1);
        ov.y = pack2(acc4[2] * g2, acc4[3] * g3);
        *ptr = ov;
      }
    }
  }
}

DI int pop_block(int* ctr, int*) {
  __syncthreads();
  if (threadIdx.x == 0) sh_item = atomicAdd(ctr, 1);
  __syncthreads();
  return __builtin_amdgcn_readfirstlane(sh_item);
}

constexpr int N_KMAX = 20 * 8;
constexpr int N_SEL = 64 * 16 + 64 + 4;
constexpr int N_LRU1 = NB_P * NTILE_P * 8;
constexpr int N_POOL = NB_P * NTILE_P * 4 + NB_S * 4;
constexpr int N_LRU2 = NB_P * NTILE_P * 8 + NB_S * 8;
constexpr int N_ATT = 64 * 64 + 256 + 32;

DI void phase_b1(const Params& p, int layer, char*, int*) {
  int* ctr = (int*)(p.ws + W_CTR) + layer * 4 + 0;
  for (;;) {
    int it = pop_block(ctr, nullptr);
    if (it >= N_SEL + N_LRU1 + N_POOL + N_KMAX) break;
    if (it >= N_SEL + N_LRU1 + N_POOL) { int j = it - (N_SEL + N_LRU1 + N_POOL); kmax_item(p, j >> 3, j & 7, smem); }
    else if (it < N_SEL) {
      if (it < 1024) { int c = 64 - (it >> 4), b = (it & 15) >> 2, sub = it & 3; select_item(p, 1, b, c, sub, smem); }
      else if (it < 1088) { int j = it - 1024; select_item(p, 0, j >> 2, 0, j & 3, smem); }
      else select_item(p, 1, it - 1088, 0, 0, smem);
    } else if (it < N_SEL + N_LRU1) {
      int j = it - N_SEL;
      int sq = j / (NTILE_P * 8), rem = j % (NTILE_P * 8);
      lru_tile(p, layer, 1, sq, rem >> 3, rem & 7, 0, smem);
    } else {
      int j = it - N_SEL - N_LRU1;
      if (j < NB_P * NTILE_P * 4) { int sq = j / (NTILE_P * 4), rem = j % (NTILE_P * 4); pool_item(p, layer, 1, sq, rem >> 2, rem & 3, smem); }
      else { j -= NB_P * NTILE_P * 4; pool_item(p, layer, 0, j >> 2, 0, j & 3, smem); }
    }
  }
}

constexpr size_t W_DUMMY = W_END;
DI void probe_select(const Params& p, int layer) {
  int* ctr = (int*)(p.ws + W_CTR) + layer * 4 + 3;
  for (;;) {
    int it = pop_block(ctr, nullptr);
    if (it >= N_SEL) break;
    if (it < 1024) { int c = 64 - (it >> 4), b = (it & 15) >> 2, sub = it & 3; select_item(p, 1, b, c, sub, smem); }
    else if (it < 1088) { int j = it - 1024; select_item(p, 0, j >> 2, 0, j & 3, smem); }
    else select_item(p, 1, it - 1088, 0, 0, smem);
  }
}
DI void probe_attn(const Params& p, int layer) {
  int* ctr2 = (int*)(p.ws + W_CTR) + layer * 4 + 3;
  const int lane = get_tid() & 63;
  for (;;) {
    int u = 0;
    if (lane == 0) u = atomicAdd(ctr2, 1);
    u = __builtin_amdgcn_readfirstlane(u);
    if (u >= N_ATT) break;
    if (u < 4096) { int c = 64 - (u >> 6), r = u & 63; attn_unit(p, 1, r >> 4, c, (r >> 1) & 7, r & 1, W_DUMMY); }
    else if (u < 4096 + 256) { int r = u - 4096; attn_unit(p, 0, r >> 4, 0, (r >> 1) & 7, r & 1, W_DUMMY); }
    else { int r = u - 4352; attn_unit(p, 1, r >> 3, 0, r & 7, 0, W_DUMMY); }
  }
}

DI void phase_b2(const Params& p, int layer, char*, int*) {
  int* ctr = (int*)(p.ws + W_CTR) + layer * 4 + 1;
  for (;;) {
    int it = pop_block(ctr, nullptr);
    if (it >= N_LRU2) break;
    if (it < NB_P * NTILE_P * 8) { int sq = it / (NTILE_P * 8), rem = it % (NTILE_P * 8); lru_tile(p, layer, 1, sq, rem >> 3, rem & 7, 1, smem); }
    else { int j = it - NB_P * NTILE_P * 8; lru_tile(p, layer, 0, j >> 3, 0, j & 7, 1, smem); }
  }
  int* ctr2 = (int*)(p.ws + W_CTR) + layer * 4 + 2;
  for (;;) {
    int it = pop_block(ctr2, nullptr);
    if (it >= 2208) break;
    if (it < 2048) { const int c = 64 - (it >> 5), pair = it & 31; attn_block(p, 1, pair >> 3, c, pair & 7); }
    else if (it < 2176) { const int r = it - 2048; attn_block(p, 0, r >> 3, 0, r & 7); }
    else { const int pair = it - 2176; attn_block(p, 1, pair >> 3, 0, pair & 7); }
  }
}

DI Params fresh(const Params& p) {
  Params q = p;
  int z = 0;
  asm volatile("s_mov_b32 %0, 0" : "=s"(z));
  q.ws = p.ws + z;
  q.out = p.out + z;
  return q;
}
DI int fresh_i(int v) {
  asm volatile("" : "+s"(v));
  return v;
}

__shared__ uint4 xb_words;

__global__ void __launch_bounds__(256, 2) fwd_megakernel(Params p) {
  cg::grid_group grid = cg::this_grid();
  if (threadIdx.x == 0) xb_words = make_uint4(0u, 0u, 0u, 0u);
  __syncthreads();
  XcdBarrier xb = xcd_barrier_post((unsigned*)(p.ws + W_BAR), (volatile LAS unsigned*)&xb_words);
  if (threadIdx.x == 0) sh_xinfo[0] = (int)atomicAdd((unsigned*)(p.ws + W_CTR) + 128 + xb.x, 1u);
  prep_phase(fresh(p), smem);
  grid.sync();
  if (threadIdx.x == 0) {
    unsigned* bar = (unsigned*)(p.ws + W_BAR);
    int na = 0, ia = 0, nloc = 1;
    for (unsigned j = 0; j < 16; ++j) {
      const unsigned cj = xb_ld(&bar[XB_XCNT(j)]);
      if (cj > 0u) { if (j < xb.x) ++ia; ++na; }
      if (j == xb.x) nloc = (int)cj;
    }
    sh_xinfo[1] = nloc > 0 ? nloc : 1; sh_xinfo[2] = ia; sh_xinfo[3] = na > 0 ? na : 1;
  }
  __syncthreads();
#if PROBE == 6
#pragma unroll 1
  for (int i = 0; i < 10; ++i) xcd_barrier(xb);
#endif
#pragma unroll 1
  for (int layer = 0; layer < 2; ++layer) {
    phase_inproj(fresh(p), fresh_i(layer), smem);
    xcd_barrier(xb);
#if PROBE == 2
    probe_select(fresh(p), fresh_i(layer));
    xcd_barrier(xb);
#endif
    phase_b1(fresh(p), fresh_i(layer), smem, &sh_item);
    xcd_barrier(xb);
#if PROBE == 3
    probe_attn(fresh(p), fresh_i(layer));
    xcd_barrier(xb);
#endif
    phase_b2(fresh(p), fresh_i(layer), smem, &sh_item);
    xcd_barrier(xb);
    phase_merge(fresh(p), fresh_i(layer), smem);
    xcd_barrier(xb);
#if PROBE == 4
    phase_merge(fresh(p), fresh_i(layer), smem);
    xcd_barrier(xb);
#endif
    phase_out(fresh(p), fresh_i(layer), smem);
    xcd_barrier(xb);
    if (layer == 0) { convert_cache(fresh(p), 1, smem); norm_phase(fresh(p), 1); xcd_barrier(xb); }
    else norm_phase(fresh(p), 2);
  }
}

extern "C" void kernel_launch(void* const* d_in, const int* in_sizes, int n_in, void* d_out, int out_size, void* d_ws,
                              size_t ws_size, hipStream_t stream) {
  constexpr int kDynLds = 65536;
  static int grid_blocks = 0;
  if (!grid_blocks) {
    int dev = 0, cus = 0, per_cu = 0;
    hipGetDevice(&dev);
    hipDeviceGetAttribute(&cus, hipDeviceAttributeMultiprocessorCount, dev);
    hipFuncSetAttribute((const void*)fwd_megakernel, hipFuncAttributeMaxDynamicSharedMemorySize, kDynLds);
    hipOccupancyMaxActiveBlocksPerMultiprocessor(&per_cu, fwd_megakernel, 256, kDynLds);
    if (per_cu > 2) per_cu = 2;
    if (per_cu < 1) per_cu = 1;
    grid_blocks = cus * per_cu;
  }
  if (ws_size < W_END) { fprintf(stderr, "workspace too small: %zu < %zu\n", ws_size, (size_t)W_END); return; }
  Params p{};
  const float** f = (const float**)&p;
  for (int i = 0; i < 23; ++i) f[i] = (const float*)d_in[i];
  p.out = (float*)d_out;
  p.ws = (char*)d_ws;
  hipMemsetAsync(d_ws, 0, 32768, stream);
  void* args[] = {&p};
  hipError_t e = hipLaunchCooperativeKernel((void*)fwd_megakernel, dim3(grid_blocks), dim3(256), args, kDynLds, stream);
  if (e != hipSuccess) fprintf(stderr, "cooperative launch failed: %s (grid %d)\n", hipGetErrorString(e), grid_blocks);
}
```

```cpp
#include <hip/hip_runtime.h>
#include <hip/hip_cooperative_groups.h>
#include <stdint.h>
#include <cstdio>
namespace cg = cooperative_groups;
#ifndef PROBE
#define PROBE 0
#endif

typedef unsigned short bfr;
typedef __attribute__((ext_vector_type(8))) short bf16x8;
typedef __attribute__((ext_vector_type(4))) float f32x4;
typedef __attribute__((ext_vector_type(2))) float f32x2;
typedef __attribute__((ext_vector_type(2))) __bf16 bf2_t;
#define DI __device__ __forceinline__
#define MFMA16(a, b, c) __builtin_amdgcn_mfma_f32_16x16x32_bf16((a), (b), (c), 0, 0, 0)

constexpr int DM = 1024;
constexpr int NB_P = 4, T_P = 4112, SEQ_P = 4096, NMETA = 16;
constexpr int NB_S = 16, T_S = 64, PAST = 2048, S_S = 2112;
constexpr int ROWS_P = NB_P * T_P;
constexpr int ROWS = ROWS_P + NB_S * T_S;
constexpr int MPAD = 17536;
constexpr int NIN = 7492, NPAD = 7552;
constexpr int KP_PAD = 4128;
constexpr int MW = 132;
constexpr int NTILE_P = 65;

constexpr int C_Q = 0, C_K = 512, C_V = 1024, C_GA = 1536, C_QI = 2048, C_KI = 2304, C_XB = 2368, C_GB = 2880,
              C_XC = 3392, C_GC = 3904, C_GM = 4416, C_WI = 7488;

constexpr long O_YP = 0;
constexpr long O_YS = O_YP + (long)NB_P * SEQ_P * DM;
constexpr long O_KP = O_YS + (long)NB_S * T_S * DM;
constexpr long O_VP = O_KP + 2L * NB_P * T_P * 512;
constexpr long O_KIP = O_VP + 2L * NB_P * T_P * 512;
constexpr long O_CONVP = O_KIP + 2L * NB_P * T_P * 64;
constexpr long O_LRUP = O_CONVP + 2L * NB_P * 3 * 512;
constexpr long O_POOLP = O_LRUP + 2L * NB_P * 512;
constexpr long O_KS = O_POOLP + 2L * NB_P * 15 * 512;
constexpr long O_VS = O_KS + 2L * NB_S * T_S * 512;
constexpr long O_KIS = O_VS + 2L * NB_S * T_S * 512;
constexpr long O_CONVS = O_KIS + 2L * NB_S * T_S * 64;
constexpr long O_LRUS = O_CONVS + 2L * NB_S * 3 * 512;
constexpr long O_POOLS = O_LRUS + 2L * NB_S * 512;

constexpr size_t al256(size_t x) { return (x + 255) & ~(size_t)255; }
constexpr size_t W_CTR = 0;
constexpr size_t W_BAR = 4096;
constexpr size_t W_ROPE = 32768;
constexpr size_t W_WINT = al256(W_ROPE + (size_t)T_P * 8 * 8);
constexpr size_t W_WBT = al256(W_WINT + 2ull * NPAD * 1024 * 2);
constexpr size_t W_WOT = al256(W_WBT + 2ull * 3 * 1024 * 512 * 2);
constexpr size_t W_WAT = al256(W_WOT + 2ull * 1024 * 1024 * 2);
constexpr size_t W_WXT = al256(W_WAT + 2ull * 8 * 64 * 64 * 2);
constexpr size_t W_PWT = al256(W_WXT + 2ull * 8 * 64 * 64 * 2);
constexpr size_t W_XRES = al256(W_PWT + 2ull * 4 * 128 * 128 * 2);
constexpr size_t W_HN = al256(W_XRES + (size_t)MPAD * 1024 * 4);
constexpr size_t W_QB = al256(W_HN + (size_t)MPAD * 1024 * 2);
constexpr size_t W_GA = al256(W_QB + (size_t)MPAD * 512 * 2);
constexpr size_t W_QIB = al256(W_GA + (size_t)MPAD * 512 * 2);
constexpr size_t W_WIB = al256(W_QIB + (size_t)MPAD * 256 * 2);
constexpr size_t W_XBB = al256(W_WIB + (size_t)MPAD * 4 * 4);
constexpr size_t W_GB = al256(W_XBB + (size_t)MPAD * 512 * 2);
constexpr size_t W_XCB = al256(W_GB + (size_t)MPAD * 512 * 2);
constexpr size_t W_GC = al256(W_XCB + (size_t)MPAD * 512 * 2);
constexpr size_t W_GM = al256(W_GC + (size_t)MPAD * 512 * 2);
constexpr size_t W_KBP = al256(W_GM + (size_t)MPAD * 3072 * 2);
constexpr size_t W_VTP = al256(W_KBP + (size_t)NB_P * KP_PAD * 512 * 2);
constexpr size_t W_KIBP = al256(W_VTP + (size_t)NB_P * 512 * KP_PAD * 2);
constexpr size_t W_KBS = al256(W_KIBP + (size_t)NB_P * KP_PAD * 64 * 2);
constexpr size_t W_VTS = al256(W_KBS + (size_t)NB_S * S_S * 512 * 2);
constexpr size_t W_KIBS = al256(W_VTS + (size_t)NB_S * 512 * S_S * 2);
constexpr size_t W_MASK = al256(W_KIBS + (size_t)NB_S * S_S * 64 * 2);
constexpr size_t W_AGG = al256(W_MASK + (size_t)ROWS * MW * 4);
constexpr size_t W_KMAX = al256(W_AGG + (size_t)NB_P * NTILE_P * 512 * 2 * 4);
constexpr size_t W_END = al256(W_KMAX + 1024);

struct Params {
  const float *x_prompt, *x_sample, *cache_k, *cache_v, *cache_kidx, *state_conv, *state_lru, *state_pool, *meta,
      *norm_g, *w_in, *conv_w, *conv_b, *lru_wa, *lru_ba, *lru_wx, *lru_bx, *lru_lambda, *pool_w, *pool_scale,
      *w_branch_out, *w_out, *final_g;
  float* out;
  char* ws;
};

extern __shared__ __attribute__((aligned(128))) char smem[];
__shared__ int sh_item;
__shared__ int sh_xinfo[4];

DI float bf2f(bfr b) { return __uint_as_float(((unsigned)b) << 16); }
DI unsigned pack2(float a, float b) {
  f32x2 v = {a, b};
  bf2_t r = __builtin_convertvector(v, bf2_t);
  return __builtin_bit_cast(unsigned, r);
}
DI bfr f2bf(float x) { return (bfr)(pack2(x, 0.f) & 0xFFFFu); }
DI float sigm(float x) { return __builtin_amdgcn_rcpf(1.f + __expf(-x)); }
DI float silu(float x) { return x * __builtin_amdgcn_rcpf(1.f + __expf(-x)); }
DI int get_tid() {
  int t = threadIdx.x;
  asm volatile("" : "+v"(t));
  return t;
}
DI unsigned sortable(float f) {
  unsigned u = __float_as_uint(f);
  return (u & 0x80000000u) ? ~u : (u | 0x80000000u);
}
DI void decode_row(int row, int& isP, int& sq, int& t) {
  if (row < ROWS_P) { isP = 1; sq = row / T_P; t = row - sq * T_P; }
  else { isP = 0; int r = row - ROWS_P; sq = r >> 6; t = r & 63; }
}

DI void tc_tile(const float* src, long sld, bfr* dst, long dld, int k0, int n0, float* tile, int mapmode) {
  const int tid = get_tid();
  const int nn = tid & 63, kk0 = tid >> 6;
  int n = n0 + nn, sn = n;
  if (mapmode) sn = n < 2368 ? n : (n < 7488 ? n + 4 : (n < 7492 ? 2368 + (n - 7488) : -1));
  float v[16];
#pragma unroll
  for (int i = 0; i < 16; ++i) v[i] = sn >= 0 ? src[(long)(k0 + i * 4 + kk0) * sld + sn] : 0.f;
#pragma unroll
  for (int i = 0; i < 16; ++i) tile[(i * 4 + kk0) * 65 + nn] = v[i];
  __syncthreads();
#pragma unroll
  for (int i = 0; i < 16; ++i) {
    int nn2 = i * 4 + (tid >> 6), kk = tid & 63;
    dst[(long)(n0 + nn2) * dld + k0 + kk] = f2bf(tile[kk * 65 + nn2]);
  }
  __syncthreads();
}

DI void convert_cache(const Params& p, int layer, char*) {
  const int tid = get_tid();
  bfr* kbs = (bfr*)(p.ws + W_KBS);
  bfr* vts = (bfr*)(p.ws + W_VTS);
  bfr* kibs = (bfr*)(p.ws + W_KIBS);
  for (int it = blockIdx.x; it < NB_S * 32 * 8; it += gridDim.x) {
    int sb = it >> 8, r = it & 255, kt = r >> 3, nt = r & 7;
    tc_tile(p.cache_v + ((long)(layer * NB_S + sb) * PAST) * 512, 512, vts + (long)sb * 512 * S_S, S_S, kt * 64, nt * 64,
            (float*)smem, 0);
  }
  {
    const float4* src = (const float4*)(p.cache_k + (long)layer * NB_S * PAST * 512);
    const long n4 = (long)NB_S * PAST * 512 / 4;
    const long stride = (long)gridDim.x * 256;
    for (long i = (long)blockIdx.x * 256 + tid; i < n4; i += 4 * stride) {
      float4 v[4];
#pragma unroll
      for (int u = 0; u < 4; ++u) { const long ii = i + u * stride; v[u] = ii < n4 ? src[ii] : make_float4(0.f, 0.f, 0.f, 0.f); }
#pragma unroll
      for (int u = 0; u < 4; ++u) {
        const long ii = i + u * stride;
        if (ii < n4) {
          const long e = ii * 4;
          const int sb = (int)(e / ((long)PAST * 512));
          const long rem = e - (long)sb * PAST * 512;
          uint2 o; o.x = pack2(v[u].x, v[u].y); o.y = pack2(v[u].z, v[u].w);
          *(uint2*)(kbs + (long)sb * S_S * 512 + rem) = o;
        }
      }
    }
  }
  {
    const float4* src = (const float4*)(p.cache_kidx + (long)layer * NB_S * PAST * 64);
    const long n4 = (long)NB_S * PAST * 64 / 4;
    const long stride = (long)gridDim.x * 256;
    for (long i = (long)blockIdx.x * 256 + tid; i < n4; i += 4 * stride) {
      float4 v[4];
#pragma unroll
      for (int u = 0; u < 4; ++u) { const long ii = i + u * stride; v[u] = ii < n4 ? src[ii] : make_float4(0.f, 0.f, 0.f, 0.f); }
#pragma unroll
      for (int u = 0; u < 4; ++u) {
        const long ii = i + u * stride;
        if (ii < n4) {
          const long e = ii * 4;
          const int sb = (int)(e / ((long)PAST * 64));
          const long rem = e - (long)sb * PAST * 64;
          uint2 o; o.x = pack2(v[u].x, v[u].y); o.y = pack2(v[u].z, v[u].w);
          *(uint2*)(kibs + (long)sb * S_S * 64 + rem) = o;
        }
      }
    }
  }
}

DI void norm_phase(const Params& p, int mode) {
  const int tid = get_tid(), wid = __builtin_amdgcn_readfirstlane(tid >> 6), lane = tid & 63;
  float* xres = (float*)(p.ws + W_XRES);
  bfr* hn = (bfr*)(p.ws + W_HN);
  const float* g = mode == 0 ? p.norm_g : (mode == 1 ? p.norm_g + 1024 : p.final_g);
  for (int row = blockIdx.x * 4 + wid; row < ROWS; row += gridDim.x * 4) {
    int isP, sq, t;
    decode_row(row, isP, sq, t);
    const float* src;
    if (mode == 0) {
      if (isP) src = t < NMETA ? p.meta + (long)t * 1024 : p.x_prompt + ((long)sq * SEQ_P + t - NMETA) * 1024;
      else src = p.x_sample + (long)(row - ROWS_P) * 1024;
    } else src = xres + (long)row * 1024;
    float4 v[4];
    float ss = 0.f;
#pragma unroll
    for (int i = 0; i < 4; ++i) {
      v[i] = ((const float4*)src)[lane + i * 64];
      ss += v[i].x * v[i].x + v[i].y * v[i].y + v[i].z * v[i].z + v[i].w * v[i].w;
    }
#pragma unroll
    for (int o = 32; o >= 1; o >>= 1) ss += __shfl_xor(ss, o);
    const float inv = rsqrtf(ss * (1.f / 1024.f) + 1e-6f);
    float* dsty = nullptr;
    if (mode == 2) {
      if (isP) { if (t >= NMETA) dsty = p.out + O_YP + ((long)sq * SEQ_P + t - NMETA) * 1024; }
      else dsty = p.out + O_YS + (long)(row - ROWS_P) * 1024;
    }
#pragma unroll
    for (int i = 0; i < 4; ++i) {
      float4 gg = ((const float4*)g)[lane + i * 64];
      float4 y;
      y.x = v[i].x * inv * gg.x; y.y = v[i].y * inv * gg.y; y.z = v[i].z * inv * gg.z; y.w = v[i].w * inv * gg.w;
      if (mode == 0) ((float4*)(xres + (long)row * 1024))[lane + i * 64] = v[i];
      if (mode < 2) {
        uint2 o; o.x = pack2(y.x, y.y); o.y = pack2(y.z, y.w);
        *(uint2*)(hn + (long)row * 1024 + (lane + i * 64) * 4) = o;
      } else if (dsty) ((float4*)dsty)[lane + i * 64] = y;
    }
  }
}

DI void prep_phase(const Params& p, char*) {
  const int tid = get_tid();
  for (int it = blockIdx.x; it < 2 * 118 * 16; it += gridDim.x) {
    int l = it / (118 * 16), r = it % (118 * 16), nt = r / 16, kt = r % 16;
    tc_tile(p.w_in + (long)l * 1024 * NIN, NIN, (bfr*)(p.ws + W_WINT) + (long)l * NPAD * 1024, 1024, kt * 64, nt * 64,
            (float*)smem, 1);
  }
  for (int it = blockIdx.x; it < 6 * 16 * 8; it += gridDim.x) {
    int mtx = it / 128, r = it % 128, nt = r / 8, kt = r % 8;
    tc_tile(p.w_branch_out + (long)mtx * 512 * 1024, 1024, (bfr*)(p.ws + W_WBT) + (long)mtx * 1024 * 512, 512, kt * 64,
            nt * 64, (float*)smem, 0);
  }
  for (int it = blockIdx.x; it < 2 * 16 * 16; it += gridDim.x) {
    int l = it / 256, r = it % 256, nt = r / 16, kt = r % 16;
    tc_tile(p.w_out + (long)l * 1024 * 1024, 1024, (bfr*)(p.ws + W_WOT) + (long)l * 1024 * 1024, 1024, kt * 64, nt * 64,
            (float*)smem, 0);
  }
  for (int it = blockIdx.x; it < 32; it += gridDim.x) {
    int which = it >> 4, mtx = it & 15;
    tc_tile((which ? p.lru_wx : p.lru_wa) + (long)mtx * 4096, 64, (bfr*)(p.ws + (which ? W_WXT : W_WAT)) + (long)mtx * 4096,
            64, 0, 0, (float*)smem, 0);
  }
  for (int it = blockIdx.x; it < 32; it += gridDim.x) {
    int mtx = it >> 2, r = it & 3, nt = r >> 1, kt = r & 1;
    tc_tile(p.pool_w + (long)mtx * 16384, 128, (bfr*)(p.ws + W_PWT) + (long)mtx * 16384, 128, kt * 64, nt * 64,
            (float*)smem, 0);
  }
  {
    float2* rt = (float2*)(p.ws + W_ROPE);
    for (int e = blockIdx.x * 256 + tid; e < T_P * 8; e += gridDim.x * 256) {
      int pos = e >> 3, d = e & 7;
      float inv = powf(500000.f, -(float)d * 0.125f);
      float ang = (float)pos * inv;
      rt[e] = make_float2(cosf(ang), sinf(ang));
    }
  }
  convert_cache(p, 0, smem);
  norm_phase(p, 0);
}

template <int NF>
DI void gemm128(const bfr* A, int lda, const bfr* Bt, int ldb, int K, int brow, int bcol, char*, f32x4 (&acc)[4][NF],
             bool chained = false, bool first = true, int nbrow = -1, int nbcol = 0, const bfr* nA = nullptr, const bfr* nBt = nullptr) {
  const int tid = get_tid(), wid = __builtin_amdgcn_readfirstlane(tid >> 6), lane = tid & 63, wr = wid >> 1, wc = wid & 1, fr = lane & 15, fq = lane >> 4;
  const int r0 = tid >> 3;
  const int cg = ((tid & 7) ^ (r0 & 7)) * 8;
  const bfr* ga = A + (long)(brow + r0) * lda + cg;
  const bfr* gb = Bt + (long)(bcol + r0) * ldb + cg;
  const long a32 = (long)32 * lda, b32 = (long)32 * ldb;
  const int nk = K / 64;
  auto stage = [&](int kt, int buf) {
    char* SA = smem + buf * 32768;
    char* SB = SA + 16384;
#pragma unroll
    for (int i = 0; i < 4; ++i)
      __builtin_amdgcn_global_load_lds((const unsigned*)(ga + i * a32 + kt * 64), (unsigned*)(SA + tid * 16 + i * 4096), 16, 0, 0);
#pragma unroll
    for (int i = 0; i < NF; ++i)
      __builtin_amdgcn_global_load_lds((const unsigned*)(gb + i * b32 + kt * 64), (unsigned*)(SB + tid * 16 + i * 4096), 16, 0, 0);
  };
  if (!chained || first) {
    asm volatile("s_waitcnt vmcnt(0)" ::: "memory");
    __syncthreads();
    stage(0, 0);
  }
  const unsigned lds0 = (unsigned)(size_t)smem;
  const unsigned sw0 = (unsigned)((fq ^ (fr & 7)) * 16), sw1 = (unsigned)(((4 + fq) ^ (fr & 7)) * 16);
  const unsigned arow = lds0 + (wr * 64 + fr) * 128, brw = lds0 + 16384 + (wc * NF * 16 + fr) * 128;
  for (int kt = 0; kt < nk; ++kt) {
    asm volatile("s_waitcnt vmcnt(0)" ::: "memory");
    __builtin_amdgcn_s_barrier();
    if (kt + 1 < nk) stage(kt + 1, (kt + 1) & 1);
    else if (chained && nbrow >= 0) {
      const bfr* na = (nA ? nA : A) + (long)(nbrow + r0) * lda + cg;
      const bfr* nb = (nBt ? nBt : Bt) + (long)(nbcol + r0) * ldb + cg;
#pragma unroll
      for (int i = 0; i < 4; ++i)
        __builtin_amdgcn_global_load_lds((const unsigned*)(na + i * a32), (unsigned*)(smem + tid * 16 + i * 4096), 16, 0, 0);
#pragma unroll
      for (int i = 0; i < NF; ++i)
        __builtin_amdgcn_global_load_lds((const unsigned*)(nb + i * b32), (unsigned*)(smem + 16384 + tid * 16 + i * 4096), 16, 0, 0);
    }
    const unsigned bo = (kt & 1) * 32768;
    bf16x8 af[2][4], bfg[2][4];
    if (NF == 4) {
      asm volatile(
          "ds_read_b128 %0, %16\n\tds_read_b128 %1, %16 offset:2048\n\tds_read_b128 %2, %16 offset:4096\n\tds_read_b128 %3, %16 offset:6144\n\t"
          "ds_read_b128 %4, %17\n\tds_read_b128 %5, %17 offset:2048\n\tds_read_b128 %6, %17 offset:4096\n\tds_read_b128 %7, %17 offset:6144\n\t"
          "ds_read_b128 %8, %18\n\tds_read_b128 %9, %18 offset:2048\n\tds_read_b128 %10, %18 offset:4096\n\tds_read_b128 %11, %18 offset:6144\n\t"
          "ds_read_b128 %12, %19\n\tds_read_b128 %13, %19 offset:2048\n\tds_read_b128 %14, %19 offset:4096\n\tds_read_b128 %15, %19 offset:6144\n\t"
          "s_waitcnt lgkmcnt(0)"
          : "=&v"(af[0][0]), "=&v"(af[0][1]), "=&v"(af[0][2]), "=&v"(af[0][3]), "=&v"(bfg[0][0]), "=&v"(bfg[0][1]), "=&v"(bfg[0][2]), "=&v"(bfg[0][3]),
            "=&v"(af[1][0]), "=&v"(af[1][1]), "=&v"(af[1][2]), "=&v"(af[1][3]), "=&v"(bfg[1][0]), "=&v"(bfg[1][1]), "=&v"(bfg[1][2]), "=&v"(bfg[1][3])
          : "v"(arow + sw0 + bo), "v"(brw + sw0 + bo), "v"(arow + sw1 + bo), "v"(brw + sw1 + bo)
          : "memory");
    } else {
      asm volatile(
          "ds_read_b128 %0, %12\n\tds_read_b128 %1, %12 offset:2048\n\tds_read_b128 %2, %12 offset:4096\n\tds_read_b128 %3, %12 offset:6144\n\t"
          "ds_read_b128 %4, %13\n\tds_read_b128 %5, %13 offset:2048\n\t"
          "ds_read_b128 %6, %14\n\tds_read_b128 %7, %14 offset:2048\n\tds_read_b128 %8, %14 offset:4096\n\tds_read_b128 %9, %14 offset:6144\n\t"
          "ds_read_b128 %10, %15\n\tds_read_b128 %11, %15 offset:2048\n\t"
          "s_waitcnt lgkmcnt(0)"
          : "=&v"(af[0][0]), "=&v"(af[0][1]), "=&v"(af[0][2]), "=&v"(af[0][3]), "=&v"(bfg[0][0]), "=&v"(bfg[0][1]),
            "=&v"(af[1][0]), "=&v"(af[1][1]), "=&v"(af[1][2]), "=&v"(af[1][3]), "=&v"(bfg[1][0]), "=&v"(bfg[1][1])
          : "v"(arow + sw0 + bo), "v"(brw + sw0 + bo), "v"(arow + sw1 + bo), "v"(brw + sw1 + bo)
          : "memory");
    }
#pragma unroll
    for (int ks = 0; ks < 2; ++ks)
#pragma unroll
      for (int m = 0; m < 4; ++m)
#pragma unroll
        for (int n = 0; n < NF; ++n) acc[m][n] = MFMA16(af[ks][m], bfg[ks][n], acc[m][n]);
  }
}

constexpr int EPI_PITCH = 64;
template <int REG>
DI void epi_region(const Params& p, int layer, f32x4 (&acc)[4][4], int rbase0, int rel, int lane, int wid) {
  const int fr = lane & 15, fq = lane >> 4;
  const float2* rt = (const float2*)(p.ws + W_ROPE);
  constexpr bool doRope = (REG == 0 || REG == 1 || REG == 4 || REG == 5);
  constexpr bool staged = (REG != 2 && REG != 11);
  bfr* img = (bfr*)(smem + 32768 + wid * (64 * EPI_PITCH * 2));
#pragma unroll
  for (int m = 0; m < 4; ++m) {
    const int rbase = rbase0 + m * 16 + fq * 4;
    const bool rowsValid = rbase < ROWS;
    int isP, sq, t0;
    decode_row(rowsValid ? rbase : 0, isP, sq, t0);
    if (doRope) {
      const int pos0 = isP ? t0 : PAST + t0;
#pragma unroll
      for (int j = 0; j < 4; ++j) {
        float v = acc[m][0][j];
        float pv = __shfl_xor(v, 8);
        float2 cs = rt[(pos0 + j) * 8 + (fr & 7)];
        acc[m][0][j] = (fr < 8) ? (v * cs.x - pv * cs.y) : (v * cs.x + pv * cs.y);
      }
    }
#pragma unroll
    for (int n = 0; n < 4; ++n) {
      const int col = rel + n * 16 + fr;
      if (REG == 2 && rowsValid) {
        uint2 pk; pk.x = pack2(acc[m][n][0], acc[m][n][1]); pk.y = pack2(acc[m][n][2], acc[m][n][3]);
        if (isP) *(uint2*)((bfr*)(p.ws + W_VTP) + ((long)sq * 512 + col) * KP_PAD + t0) = pk;
        else *(uint2*)((bfr*)(p.ws + W_VTS) + ((long)sq * 512 + col) * S_S + PAST + t0) = pk;
      }
#pragma unroll
      for (int j = 0; j < 4; ++j) {
        const float v = acc[m][n][j];
        const int row = rbase + j, t = t0 + j;
        if (rowsValid) {
          if (REG == 1) { if (isP) p.out[O_KP + ((long)(layer * NB_P + sq) * T_P + t) * 512 + col] = v; else p.out[O_KS + ((long)(layer * NB_S + sq) * T_S + t) * 512 + col] = v; }
          if (REG == 2) { if (isP) p.out[O_VP + ((long)(layer * NB_P + sq) * T_P + t) * 512 + col] = v; else p.out[O_VS + ((long)(layer * NB_S + sq) * T_S + t) * 512 + col] = v; }
          if (REG == 5) { if (isP) p.out[O_KIP + ((long)(layer * NB_P + sq) * T_P + t) * 64 + col] = v; else p.out[O_KIS + ((long)(layer * NB_S + sq) * T_S + t) * 64 + col] = v; }
          if (REG == 6) {
            if (isP) { if (t >= T_P - 3) p.out[O_CONVP + ((long)(layer * NB_P + sq) * 3 + (t - (T_P - 3))) * 512 + col] = v; }
            else { if (t >= T_S - 3) p.out[O_CONVS + ((long)(layer * NB_S + sq) * 3 + (t - (T_S - 3))) * 512 + col] = v; }
          }
          if (REG == 8) {
            if (isP) { if (t >= T_P - 15) p.out[O_POOLP + ((long)(layer * NB_P + sq) * 15 + (t - (T_P - 15))) * 512 + col] = v; }
            else { if (t >= T_S - 15) p.out[O_POOLS + ((long)(layer * NB_S + sq) * 15 + (t - (T_S - 15))) * 512 + col] = v; }
          }
          if (REG == 11) { if (col < 4) ((float*)(p.ws + W_WIB))[(long)row * 4 + col] = v; }
        }
        if (staged) {
          float y = v;
          if (REG == 3 || REG == 7 || REG == 9) y = silu(v);
          if (REG == 10) y = sigm(v);
          img[(m * 16 + fq * 4 + j) * EPI_PITCH + n * 16 + fr] = f2bf(y);
        }
      }
    }
  }
  if (staged) {
    asm volatile("s_waitcnt lgkmcnt(0)" ::: "memory");
#pragma unroll
    for (int it = 0; it < 8; ++it) {
      const int r = it * 8 + (lane >> 3), ch = lane & 7;
      const int row = rbase0 + r;
      if (row < ROWS) {
        int isP, sq, t;
        decode_row(row, isP, sq, t);
        bfr* dst;
        if (REG == 0) dst = (bfr*)(p.ws + W_QB) + (long)row * 512;
        else if (REG == 1) dst = isP ? (bfr*)(p.ws + W_KBP) + ((long)sq * KP_PAD + t) * 512 : (bfr*)(p.ws + W_KBS) + ((long)sq * S_S + PAST + t) * 512;
        else if (REG == 3) dst = (bfr*)(p.ws + W_GA) + (long)row * 512;
        else if (REG == 4) dst = (bfr*)(p.ws + W_QIB) + (long)row * 256;
        else if (REG == 5) dst = isP ? (bfr*)(p.ws + W_KIBP) + ((long)sq * KP_PAD + t) * 64 : (bfr*)(p.ws + W_KIBS) + ((long)sq * S_S + PAST + t) * 64;
        else if (REG == 6) dst = (bfr*)(p.ws + W_XBB) + (long)row * 512;
        else if (REG == 7) dst = (bfr*)(p.ws + W_GB) + (long)row * 512;
        else if (REG == 8) dst = (bfr*)(p.ws + W_XCB) + (long)row * 512;
        else if (REG == 9) dst = (bfr*)(p.ws + W_GC) + (long)row * 512;
        else dst = (bfr*)(p.ws + W_GM) + (long)row * 3072;
        const uint4 val = *(const uint4*)(img + r * EPI_PITCH + ch * 8);
        *(uint4*)(dst + rel + ch * 8) = val;
      }
    }
  }
}

DI void epi_inproj(const Params& p, int layer, f32x4 (&acc)[4][4], int brow, int bcol) {
  const int tid = get_tid(), wid = __builtin_amdgcn_readfirstlane(tid >> 6), lane = tid & 63, wr = wid >> 1, wc = wid & 1;
  const int c0 = bcol + wc * 64;
  const int rb = brow + wr * 64;
  asm volatile("s_waitcnt lgkmcnt(0)" ::: "memory");
  __builtin_amdgcn_s_barrier();
  if (c0 < C_K) epi_region<0>(p, layer, acc, rb, c0 - C_Q, lane, wid);
  else if (c0 < C_V) epi_region<1>(p, layer, acc, rb, c0 - C_K, lane, wid);
  else if (c0 < C_GA) epi_region<2>(p, layer, acc, rb, c0 - C_V, lane, wid);
  else if (c0 < C_QI) epi_region<3>(p, layer, acc, rb, c0 - C_GA, lane, wid);
  else if (c0 < C_KI) epi_region<4>(p, layer, acc, rb, c0 - C_QI, lane, wid);
  else if (c0 < C_XB) epi_region<5>(p, layer, acc, rb, c0 - C_KI, lane, wid);
  else if (c0 < C_GB) epi_region<6>(p, layer, acc, rb, c0 - C_XB, lane, wid);
  else if (c0 < C_XC) epi_region<7>(p, layer, acc, rb, c0 - C_GB, lane, wid);
  else if (c0 < C_GC) epi_region<8>(p, layer, acc, rb, c0 - C_XC, lane, wid);
  else if (c0 < C_GM) epi_region<9>(p, layer, acc, rb, c0 - C_GC, lane, wid);
  else if (c0 < C_WI) epi_region<10>(p, layer, acc, rb, c0 - C_GM, lane, wid);
  else epi_region<11>(p, layer, acc, rb, c0 - C_WI, lane, wid);
}

DI void phase_inproj(const Params& p, int layer, char*) {
  const bfr* A = (const bfr*)(p.ws + W_HN);
  const bfr* Bt = (const bfr*)(p.ws + W_WINT) + (long)layer * NPAD * 1024;
  constexpr int NTM = MPAD / 128, NTN = NPAD / 128;
  const int rank = sh_xinfo[0], nloc = sh_xinfo[1], ia = sh_xinfo[2], na = sh_xinfo[3];
  const int nbase = NTN / na, nrem = NTN % na;
  const int nn = nbase + (ia < nrem ? 1 : 0), n0 = ia * nbase + min(ia, nrem);
  const int target = (NTM * NTN + na - 1) / na;
  const int keep = min(NTM * nn, target);
  int poff = 0, stot = 0;
  for (int a = 0; a < na; ++a) {
    const int o = NTM * (nbase + (a < nrem ? 1 : 0)), kp = min(o, target);
    if (a < ia) poff += target - kp;
    stot += o - kp;
  }
  const int dend = min(poff + (target - keep), stot);
  const int kown = rank < keep ? (keep - rank + nloc - 1) / nloc : 0;
  auto get_tile = [&](int k, int& tm_, int& tn_) -> bool {
    if (k < kown) { const int i = rank + k * nloc; tm_ = i / nn; tn_ = n0 + (i - tm_ * nn); return true; }
    const int e = poff + rank + (k - kown) * nloc;
    if (e >= dend) return false;
    int accs = 0;
    for (int a = 0; a < na; ++a) {
      const int nna = nbase + (a < nrem ? 1 : 0), o = NTM * nna, kp = min(o, target), sp = o - kp;
      if (e < accs + sp) {
        const int i = kp + (e - accs);
        tm_ = i / nna;
        tn_ = a * nbase + min(a, nrem) + (i - tm_ * nna);
        return true;
      }
      accs += sp;
    }
    return false;
  };
  bool first = true;
  int tm = 0, tn = 0;
  bool have = get_tile(0, tm, tn);
#pragma unroll 1
  for (int k = 0; have; ++k) {
    int tm2 = 0, tn2 = 0;
    const bool nxt = get_tile(k + 1, tm2, tn2);
    const int nbr = nxt ? tm2 * 128 : -1, nbc = tn2 * 128;
    f32x4 acc[4][4];
#pragma unroll
    for (int m = 0; m < 4; ++m)
#pragma unroll
      for (int n = 0; n < 4; ++n) acc[m][n] = f32x4{0.f, 0.f, 0.f, 0.f};
    gemm128<4>(A, 1024, Bt, 1024, 1024, tm * 128, tn * 128, smem, acc, true, first, nbr, nbc);
    first = false;
    epi_inproj(p, layer, acc, tm * 128, tn * 128);
    tm = tm2; tn = tn2; have = nxt;
  }
}

template <int NF>
DI void merge_tile(const Params& p, int layer, int brow, int bcol, bool& first, bool hasNext, int nbrow, int nbcol) {
  const int tid = get_tid(), wid = __builtin_amdgcn_readfirstlane(tid >> 6), lane = tid & 63, wr = wid >> 1, wc = wid & 1, fr = lane & 15, fq = lane >> 4;
  const bfr* gmb = (const bfr*)(p.ws + W_GM);
  bfr* merged = (bfr*)(p.ws + W_HN);
  unsigned tot[4][NF][2];
#pragma unroll
  for (int m = 0; m < 4; ++m)
#pragma unroll
    for (int n = 0; n < NF; ++n) { tot[m][n][0] = 0u; tot[m][n][1] = 0u; }
#pragma unroll 1
  for (int br = 0; br < 3; ++br) {
    const bfr* A = (const bfr*)(p.ws + (br == 0 ? W_GA : (br == 1 ? W_GB : W_GC)));
    const bfr* Bt = (const bfr*)(p.ws + W_WBT) + (long)(layer * 3 + br) * 1024 * 512;
    const bfr* nA = (const bfr*)(p.ws + (br == 0 ? W_GB : (br == 1 ? W_GC : W_GA)));
    const bfr* nBt = (const bfr*)(p.ws + W_WBT) + (long)(layer * 3 + (br == 2 ? 0 : br + 1)) * 1024 * 512;
    const bool nx = br < 2 || hasNext;
    f32x4 acc[4][NF];
#pragma unroll
    for (int m = 0; m < 4; ++m)
#pragma unroll
      for (int n = 0; n < NF; ++n) acc[m][n] = f32x4{0.f, 0.f, 0.f, 0.f};
    gemm128<NF>(A, 512, Bt, 512, 512, brow, bcol, smem, acc, true, first, nx ? (br < 2 ? brow : nbrow) : -1, br < 2 ? bcol : nbcol, nA, nBt);
    first = false;
#pragma unroll
    for (int m = 0; m < 4; ++m) {
      const int row0 = brow + wr * 64 + m * 16 + fq * 4;
      if (row0 < ROWS) {
#pragma unroll
        for (int n = 0; n < NF; ++n) {
          const int col = bcol + wc * (NF * 16) + n * 16 + fr;
          const bfr* gp = gmb + (long)row0 * 3072 + br * 1024 + col;
          const float g0 = bf2f(gp[0]), g1 = bf2f(gp[3072]), g2 = bf2f(gp[2 * 3072]), g3 = bf2f(gp[3 * 3072]);
          const unsigned t0 = tot[m][n][0], t1 = tot[m][n][1];
          tot[m][n][0] = pack2(__uint_as_float(t0 << 16) + g0 * acc[m][n][0], __uint_as_float(t0 & 0xFFFF0000u) + g1 * acc[m][n][1]);
          tot[m][n][1] = pack2(__uint_as_float(t1 << 16) + g2 * acc[m][n][2], __uint_as_float(t1 & 0xFFFF0000u) + g3 * acc[m][n][3]);
        }
      }
    }
  }
#pragma unroll
  for (int m = 0; m < 4; ++m) {
    const int row0 = brow + wr * 64 + m * 16 + fq * 4;
    if (row0 < ROWS) {
#pragma unroll
      for (int n = 0; n < NF; ++n) {
        bfr* mp = merged + (long)row0 * 1024 + bcol + wc * (NF * 16) + n * 16 + fr;
        mp[0] = (bfr)(tot[m][n][0] & 0xFFFFu); mp[1024] = (bfr)(tot[m][n][0] >> 16);
        mp[2048] = (bfr)(tot[m][n][1] & 0xFFFFu); mp[3072] = (bfr)(tot[m][n][1] >> 16);
      }
    }
  }
}

DI void phase_merge(const Params& p, int layer, char*) {
  constexpr int NTM = MPAD / 128, NTN = 8, NT = NTM * NTN;
  const int G = gridDim.x;
  const int nfull = (NT / G) * G, rem = NT - nfull;
  const bool split = rem > 0 && 2 * rem <= G;
  const int lim = split ? nfull : NT;
  bool first = true;
  for (int tile = blockIdx.x; tile < lim; tile += G) {
    const int tn = tile / NTM, tm = tile % NTM;
    const int t2 = tile + G;
    const bool hasNext = t2 < lim;
    merge_tile<4>(p, layer, tm * 128, tn * 128, first, hasNext, (t2 % NTM) * 128, (t2 / NTM) * 128);
  }
  if (split && (int)blockIdx.x < 2 * rem) {
    const int tile = nfull + ((int)blockIdx.x >> 1), half = blockIdx.x & 1;
    const int tn = tile / NTM, tm = tile % NTM;
    bool f2 = true;
    merge_tile<2>(p, layer, tm * 128, tn * 128 + half * 64, f2, false, 0, 0);
  }
}

template <int NF>
DI void out_tile(const Params& p, int layer, int brow, int bcol, bool& first, bool hasNext, int nbrow, int nbcol) {
  const int tid = get_tid(), wid = __builtin_amdgcn_readfirstlane(tid >> 6), lane = tid & 63, wr = wid >> 1, wc = wid & 1, fr = lane & 15, fq = lane >> 4;
  const bfr* A = (const bfr*)(p.ws + W_HN);
  const bfr* Bt = (const bfr*)(p.ws + W_WOT) + (long)layer * 1024 * 1024;
  float* xres = (float*)(p.ws + W_XRES);
  f32x4 acc[4][NF];
#pragma unroll
  for (int m = 0; m < 4; ++m)
#pragma unroll
    for (int n = 0; n < NF; ++n) acc[m][n] = f32x4{0.f, 0.f, 0.f, 0.f};
  gemm128<NF>(A, 1024, Bt, 1024, 1024, brow, bcol, smem, acc, true, first, hasNext ? nbrow : -1, nbcol);
  first = false;
#pragma unroll
  for (int m = 0; m < 4; ++m)
#pragma unroll
    for (int j = 0; j < 4; ++j) {
      int row = brow + wr * 64 + m * 16 + fq * 4 + j;
      if (row < ROWS) {
#pragma unroll
        for (int n = 0; n < NF; ++n) xres[(long)row * 1024 + bcol + wc * (NF * 16) + n * 16 + fr] += acc[m][n][j];
      }
    }
}

DI void phase_out(const Params& p, int layer, char*) {
  constexpr int NTM = MPAD / 128, NTN = 8, NT = NTM * NTN;
  const int G = gridDim.x;
  const int nfull = (NT / G) * G, rem = NT - nfull;
  const bool split = rem > 0 && 2 * rem <= G;
  const int lim = split ? nfull : NT;
  bool first = true;
  for (int tile = blockIdx.x; tile < lim; tile += G) {
    const int tn = tile / NTM, tm = tile % NTM;
    const int t2 = tile + G;
    out_tile<4>(p, layer, tm * 128, tn * 128, first, t2 < lim, (t2 % NTM) * 128, (t2 / NTM) * 128);
  }
  if (split && (int)blockIdx.x < 2 * rem) {
    const int tile = nfull + ((int)blockIdx.x >> 1), half = blockIdx.x & 1;
    const int tn = tile / NTM, tm = tile % NTM;
    bool f2 = true;
    out_tile<2>(p, layer, tm * 128, tn * 128 + half * 64, f2, false, 0, 0);
  }
}

constexpr int SEL_QS = 2120;
DI void select_item(const Params& p, int isP, int sq, int c, int sub, char*) {
  const int tid = get_tid(), wid = __builtin_amdgcn_readfirstlane(tid >> 6), lane = tid & 63, fr = lane & 15, fq = lane >> 4;
  int T0, nadm, rowbase;
  const bfr* kib;
  if (isP) {
    if (c == 0) { T0 = 0; nadm = 16; } else { T0 = 16 + 64 * (c - 1) + 16 * sub; nadm = 16 + 64 * c; }
    rowbase = sq * T_P;
    kib = (const bfr*)(p.ws + W_KIBP) + (long)sq * KP_PAD * 64;
  } else {
    T0 = 16 * sub; nadm = S_S; rowbase = ROWS_P + sq * 64;
    kib = (const bfr*)(p.ws + W_KIBS) + (long)sq * S_S * 64;
  }
  unsigned* maskg = (unsigned*)(p.ws + W_MASK);
  const int nsteps = (nadm + 31) >> 5;
  if (nadm <= 256) {
    for (int e = tid; e < 16 * nsteps; e += 256) {
      int q = e / nsteps, s = e - q * nsteps;
      unsigned w = (s * 32 + 32 <= nadm) ? 0xFFFFFFFFu : 0xFFFFu;
      maskg[(long)(rowbase + T0 + q) * MW + s] = w;
    }
    return;
  }
  const int nkt = nadm >> 4;
  const int nmine = (nkt - wid + 3) >> 2;
  const int nregs = (nadm + 63) >> 6;
  const bfr* qib = (const bfr*)(p.ws + W_QIB);
  const float* wib = (const float*)(p.ws + W_WIB);
  unsigned* S = (unsigned*)smem;
#pragma unroll 1
  for (int g = 0; g < 4; ++g) {
    const int qrow = rowbase + T0 + g * 4;
    int koff = (wid * 16 + fr) * 64 + fq * 8;
    asm volatile("" : "+v"(koff));
    const bfr* kbase = kib + koff;
    int nm = nmine;
    asm volatile("" : "+v"(nm));
    nm = __builtin_amdgcn_readfirstlane(nm);
    const bfr* qp = qib + (long)(qrow + (fr >> 2)) * 256 + (fr & 3) * 64 + fq * 8;
    const bf16x8 a0 = *(const bf16x8*)qp;
    const bf16x8 a1 = *(const bf16x8*)(qp + 32);
    const float4 w = *(const float4*)(wib + (long)(qrow + fq) * 4);
    unsigned sc[65];
#pragma unroll
    for (int ch = 0; ch < 5; ++ch) {
      if (ch * 13 < nm) {
        bf16x8 b0[13], b1[13];
#pragma unroll
        for (int u = 0; u < 13; ++u) {
          const int ic = min(ch * 13 + u, nm - 1);
          const bfr* kp = kbase + (long)ic * 4096;
          b0[u] = *(const bf16x8*)kp;
          b1[u] = *(const bf16x8*)(kp + 32);
        }
#pragma unroll
        for (int u = 0; u < 13; ++u) {
          const int i = ch * 13 + u;
          f32x4 a = {0.f, 0.f, 0.f, 0.f};
          a = MFMA16(a0, b0[u], a);
          a = MFMA16(a1, b1[u], a);
          float s = w.x * fmaxf(a[0], 0.f) + w.y * fmaxf(a[1], 0.f) + w.z * fmaxf(a[2], 0.f) + w.w * fmaxf(a[3], 0.f);
          sc[i] = (i < nm) ? sortable(s) : 0u;
        }
      } else {
#pragma unroll
        for (int u = 0; u < 13; ++u) sc[ch * 13 + u] = 0u;
      }
      __builtin_amdgcn_sched_barrier(0);
    }
    unsigned v[65];
    __syncthreads();
#pragma unroll
    for (int i = 0; i < 33; ++i) S[fq * SEL_QS + (i * 4 + wid) * 16 + fr] = sc[i];
    __syncthreads();
#pragma unroll
    for (int j = 0; j < 33; ++j) v[j] = S[wid * SEL_QS + j * 64 + lane];
    if (nregs > 33) {
      __syncthreads();
#pragma unroll
      for (int i = 33; i < 65; ++i) S[fq * SEL_QS + (i * 4 + wid - 132) * 16 + fr] = sc[i];
      __syncthreads();
#pragma unroll
      for (int j = 0; j < 32; ++j) v[33 + j] = S[wid * SEL_QS + j * 64 + lane];
    } else {
#pragma unroll
      for (int j = 0; j < 32; ++j) v[33 + j] = 0u;
    }
    int nr = nregs;
    asm volatile("" : "+v"(nr));
    nr = __builtin_amdgcn_readfirstlane(nr);
    unsigned vmax = 0u;
#pragma unroll
    for (int r = 0; r < 65; ++r) vmax = max(vmax, v[r]);
#pragma unroll
    for (int o = 32; o >= 1; o >>= 1) vmax = max(vmax, (unsigned)__shfl_xor((int)vmax, o));
    vmax = __builtin_amdgcn_readfirstlane(vmax);
    unsigned thr = 0u;
    int exact = 0;
#pragma unroll 1
    for (int bit = 31; bit >= 0; --bit) {
      const unsigned cand = thr | (1u << bit);
      if (cand > vmax) continue;
      int cnt = 0;
#pragma unroll
      for (int ch = 0; ch < 5; ++ch) {
        if (ch * 13 < nr) {
#pragma unroll
          for (int u = 0; u < 13; ++u) cnt += __popcll(__ballot(v[ch * 13 + u] >= cand));
        }
      }
      if (cnt >= 256) {
        thr = cand;
        if (cnt == 256) { exact = 1; break; }
      }
    }
    if (exact) {
      unsigned mn = 0xFFFFFFFFu;
#pragma unroll
      for (int r = 0; r < 65; ++r) mn = min(mn, v[r] >= thr ? v[r] : 0xFFFFFFFFu);
#pragma unroll
      for (int o = 32; o >= 1; o >>= 1) mn = min(mn, (unsigned)__shfl_xor((int)mn, o));
      thr = __builtin_amdgcn_readfirstlane(mn);
    }
    int gt = 0, eq = 0;
#pragma unroll
    for (int r = 0; r < 65; ++r) {
      gt += __popcll(__ballot(v[r] > thr));
      eq += __popcll(__ballot(v[r] == thr));
    }
    const int need = 256 - gt;
    int idxcut = 0x7fffffff;
    if (eq != need) {
      int run = 0;
      bool done = false;
#pragma unroll
      for (int r = 0; r < 65; ++r) {
        if (!done) {
          unsigned long long m = __ballot(v[r] == thr);
          int pc = __popcll(m);
          if (run + pc >= need) {
            const int k = need - run;
            for (int t = 1; t < k; ++t) m &= m - 1ull;
            idxcut = r * 64 + (__ffsll((long long)m) - 1);
            done = true;
          } else run += pc;
        }
      }
    }
    unsigned* mrowp = maskg + (long)(qrow + wid) * MW;
#pragma unroll
    for (int r = 0; r < 65; ++r) {
      if (r < nr) {
        const bool sel = (v[r] > thr) || (v[r] == thr && (r * 64 + lane) <= idxcut);
        const unsigned long long bal = __ballot(sel);
        if (lane == 0) *(uint2*)(mrowp + r * 2) = make_uint2((unsigned)bal, (unsigned)(bal >> 32));
      }
    }
  }
}

DI void lru_tile(const Params& p, int layer, int isP, int sq, int tile, int nb, int pass, char*) {
  const int tid = get_tid(), wid = __builtin_amdgcn_readfirstlane(tid >> 6), lane = tid & 63, fr = lane & 15, fq = lane >> 4;
  float* xbs = (float*)smem;
  float* as_ = xbs;
  float* xcs = xbs + 67 * 64;
  float* bs_ = xcs + 64 * 64;
  float* ab = bs_ + 64 * 64;
  bfr* xca = (bfr*)(ab + 512);
  const int T = isP ? T_P : T_S;
  const int rowbase = isP ? sq * T_P : ROWS_P + sq * 64;
  const int t0 = tile * 64, ch0 = nb * 64;
  const bfr* xbb = (const bfr*)(p.ws + W_XBB);
  bfr* gby = (bfr*)(p.ws + W_GB);
  float* agg = (float*)(p.ws + W_AGG);
  {
    const int c = tid & 63;
    float vv[17];
#pragma unroll
    for (int i = 0; i < 17; ++i) {
      const int rr = i * 4 + (tid >> 6);
      const int tt = t0 - 3 + rr;
      float v = 0.f;
      if (rr < 67) {
        if (tt < 0) { if (!isP) v = p.state_conv[((long)(layer * NB_S + sq) * 3 + (3 + tt)) * 512 + ch0 + c]; }
        else if (tt < T) v = bf2f(xbb[(long)(rowbase + tt) * 512 + ch0 + c]);
      }
      vv[i] = v;
    }
#pragma unroll
    for (int i = 0; i < 17; ++i) { const int rr = i * 4 + (tid >> 6); if (rr < 67) xbs[rr * 64 + c] = vv[i]; }
  }
  __syncthreads();
  {
    const int c = tid & 63;
    const float cb = p.conv_b[layer * 512 + ch0 + c];
    const float w0 = p.conv_w[(layer * 4 + 0) * 512 + ch0 + c], w1 = p.conv_w[(layer * 4 + 1) * 512 + ch0 + c],
                w2 = p.conv_w[(layer * 4 + 2) * 512 + ch0 + c], w3 = p.conv_w[(layer * 4 + 3) * 512 + ch0 + c];
    for (int t = tid >> 6; t < 64; t += 4) {
      float xc = cb + w0 * xbs[t * 64 + c] + w1 * xbs[(t + 1) * 64 + c] + w2 * xbs[(t + 2) * 64 + c] + w3 * xbs[(t + 3) * 64 + c];
      xcs[t * 64 + c] = xc;
      xca[t * 72 + c] = f2bf(xc);
    }
  }
  __syncthreads();
  {
    const bfr* WaT = (const bfr*)(p.ws + W_WAT) + (long)(layer * 8 + nb) * 4096;
    const bfr* WxT = (const bfr*)(p.ws + W_WXT) + (long)(layer * 8 + nb) * 4096;
    bf16x8 af0 = *(const bf16x8*)(xca + (wid * 16 + fr) * 72 + fq * 8);
    bf16x8 af1 = *(const bf16x8*)(xca + (wid * 16 + fr) * 72 + 32 + fq * 8);
#pragma unroll
    for (int nt = 0; nt < 4; ++nt) {
      const int d = nt * 16 + fr;
      bf16x8 ba0 = *(const bf16x8*)(WaT + d * 64 + fq * 8), ba1 = *(const bf16x8*)(WaT + d * 64 + 32 + fq * 8);
      bf16x8 bx0 = *(const bf16x8*)(WxT + d * 64 + fq * 8), bx1 = *(const bf16x8*)(WxT + d * 64 + 32 + fq * 8);
      f32x4 ar = {0.f, 0.f, 0.f, 0.f}, ai = {0.f, 0.f, 0.f, 0.f};
      ar = MFMA16(af0, ba0, ar); ar = MFMA16(af1, ba1, ar);
      ai = MFMA16(af0, bx0, ai); ai = MFMA16(af1, bx1, ai);
      const float bav = p.lru_ba[layer * 512 + ch0 + d], bxv = p.lru_bx[layer * 512 + ch0 + d];
      const float sp = log1pf(__expf(-p.lru_lambda[layer * 512 + ch0 + d]));
#pragma unroll
      for (int j = 0; j < 4; ++j) {
        const int t = wid * 16 + fq * 4 + j;
        float r = sigm(ar[j] + bav), ig = sigm(ai[j] + bxv);
        float la = -8.f * r * sp;
        float a = __expf(la);
        float b = sqrtf(1.f - __expf(2.f * la)) * (ig * xcs[t * 64 + d]);
        if (t0 + t >= T) { a = 1.f; b = 0.f; }
        as_[t * 64 + d] = a;
        bs_[t * 64 + d] = b;
      }
    }
  }
  __syncthreads();
  const int c = tid & 63;
  {
    float A = 1.f, B = 0.f;
#pragma unroll
    for (int tt = 0; tt < 16; ++tt) {
      float a = as_[(wid * 16 + tt) * 64 + c], b = bs_[(wid * 16 + tt) * 64 + c];
      A *= a; B = a * B + b;
    }
    ab[(wid * 64 + c) * 2] = A;
    ab[(wid * 64 + c) * 2 + 1] = B;
  }
  __syncthreads();
  if (pass == 0) {
    if (wid == 0) {
      float A = 1.f, B = 0.f;
#pragma unroll
      for (int w = 0; w < 4; ++w) { float a = ab[(w * 64 + c) * 2], b = ab[(w * 64 + c) * 2 + 1]; A *= a; B = a * B + b; }
      *(float2*)(agg + ((long)(sq * NTILE_P + tile) * 512 + ch0 + c) * 2) = make_float2(A, B);
    }
  } else {
    float h = isP ? 0.f : p.state_lru[(long)(layer * NB_S + sq) * 512 + ch0 + c];
    for (int i0 = 0; i0 < tile; i0 += 16) {
      float2 e[16];
#pragma unroll
      for (int u = 0; u < 16; ++u)
        e[u] = (i0 + u < tile) ? *(const float2*)(agg + ((long)(sq * NTILE_P + i0 + u) * 512 + ch0 + c) * 2) : make_float2(1.f, 0.f);
#pragma unroll
      for (int u = 0; u < 16; ++u) h = e[u].x * h + e[u].y;
    }
    for (int w = 0; w < wid; ++w) h = ab[(w * 64 + c) * 2] * h + ab[(w * 64 + c) * 2 + 1];
#pragma unroll
    for (int tt = 0; tt < 16; ++tt) {
      const int t = wid * 16 + tt;
      h = as_[t * 64 + c] * h + bs_[t * 64 + c];
      if (t0 + t < T) {
        const long idx = (long)(rowbase + t0 + t) * 512 + ch0 + c;
        gby[idx] = f2bf(h * bf2f(gby[idx]));
        if (t0 + t == T - 1) {
          if (isP) p.out[O_LRUP + (long)(layer * NB_P + sq) * 512 + ch0 + c] = h;
          else p.out[O_LRUS + (long)(layer * NB_S + sq) * 512 + ch0 + c] = h;
        }
      }
    }
  }
}

DI void pool_item(const Params& p, int layer, int isP, int sq, int tile, int g, char*) {
  const int tid = get_tid(), wid = __builtin_amdgcn_readfirstlane(tid >> 6), lane = tid & 63, fr = lane & 15, fq = lane >> 4;
  float* xps = (float*)smem;
  bfr* pa = (bfr*)(xps + 79 * 128);
  const int T = isP ? T_P : T_S;
  const int rowbase = isP ? sq * T_P : ROWS_P + sq * 64;
  const int t0 = tile * 64, ch0 = g * 128;
  const bfr* xcb = (const bfr*)(p.ws + W_XCB);
  bfr* gcy = (bfr*)(p.ws + W_GC);
  {
    const int c = tid & 127;
#pragma unroll
    for (int b8 = 0; b8 < 5; ++b8) {
      float vv[8];
#pragma unroll
      for (int u = 0; u < 8; ++u) {
        const int rr = (b8 * 8 + u) * 2 + (tid >> 7);
        const int tt = t0 - 15 + rr;
        float v = 0.f;
        if (rr < 79) {
          if (tt < 0) { if (!isP) v = p.state_pool[((long)(layer * NB_S + sq) * 15 + (15 + tt)) * 512 + ch0 + c]; }
          else if (tt < T) v = bf2f(xcb[(long)(rowbase + tt) * 512 + ch0 + c]);
        }
        vv[u] = v;
      }
#pragma unroll
      for (int u = 0; u < 8; ++u) { const int rr = (b8 * 8 + u) * 2 + (tid >> 7); if (rr < 79) xps[rr * 128 + c] = vv[u]; }
    }
  }
  __syncthreads();
  {
    const int c = tid & 127;
    const int w = 2 << g;
    const int nh = isP ? 0 : PAST;
    for (int t = tid >> 7; t < 64; t += 2) {
      float s = 0.f;
      for (int i = 0; i < w; ++i) s += xps[(15 + t - i) * 128 + c];
      int cnt = min(w, t0 + t + 1 + nh);
      float v = s / (float)cnt - xps[(15 + t) * 128 + c];
      pa[t * 136 + c] = f2bf(v);
    }
  }
  __syncthreads();
  {
    const bfr* PwT = (const bfr*)(p.ws + W_PWT) + (long)(layer * 4 + g) * 16384;
    bf16x8 af[4];
#pragma unroll
    for (int ks = 0; ks < 4; ++ks) af[ks] = *(const bf16x8*)(pa + (wid * 16 + fr) * 136 + ks * 32 + fq * 8);
#pragma unroll
    for (int nt = 0; nt < 8; ++nt) {
      const int d = nt * 16 + fr;
      f32x4 acc = {0.f, 0.f, 0.f, 0.f};
#pragma unroll
      for (int ks = 0; ks < 4; ++ks) {
        bf16x8 bq = *(const bf16x8*)(PwT + d * 128 + ks * 32 + fq * 8);
        acc = MFMA16(af[ks], bq, acc);
      }
      const float scl = p.pool_scale[layer * 512 + ch0 + d];
#pragma unroll
      for (int j = 0; j < 4; ++j) {
        const int t = wid * 16 + fq * 4 + j;
        if (t0 + t < T) {
          const long idx = (long)(rowbase + t0 + t) * 512 + ch0 + d;
          gcy[idx] = f2bf(acc[j] * scl * bf2f(gcy[idx]));
        }
      }
    }
  }
}

DI void kmax_item(const Params& p, int seq, int h, char*) {
  const int tid = get_tid(), wid = __builtin_amdgcn_readfirstlane(tid >> 6), lane = tid & 63;
  const bfr* kb; int S;
  if (seq < NB_P) { kb = (const bfr*)(p.ws + W_KBP) + (long)seq * KP_PAD * 512; S = T_P; }
  else { kb = (const bfr*)(p.ws + W_KBS) + (long)(seq - NB_P) * S_S * 512; S = S_S; }
  float mx = 0.f;
  for (int key = tid; key < S; key += 256) {
    const uint4* r = (const uint4*)(kb + (long)key * 512 + h * 64);
    float ss = 0.f;
#pragma unroll
    for (int i = 0; i < 8; ++i) {
      uint4 v = r[i];
      unsigned u[4] = {v.x, v.y, v.z, v.w};
#pragma unroll
      for (int j = 0; j < 4; ++j) {
        float a = __uint_as_float(u[j] << 16), b = __uint_as_float(u[j] & 0xFFFF0000u);
        ss += a * a + b * b;
      }
    }
    mx = fmaxf(mx, ss);
  }
#pragma unroll
  for (int o = 32; o >= 1; o >>= 1) mx = fmaxf(mx, __shfl_xor(mx, o));
  float* red = (float*)smem;
  if (lane == 0) red[wid] = mx;
  __syncthreads();
  if (tid == 0) ((float*)(p.ws + W_KMAX))[seq * 8 + h] = fmaxf(fmaxf(red[0], red[1]), fmaxf(red[2], red[3]));
}

DI void attn_unit(const Params& p, int isP, int sq, int c, int h, int half, size_t dstoff = W_GA) {
  const int lane = get_tid() & 63, fr = lane & 15, fq = lane >> 4;
  int T0, nqt, nadm, rowbase, vld;
  const bfr *kb, *vt;
  if (isP) {
    if (c == 0) { T0 = 0; nqt = 1; nadm = 16; } else { T0 = 16 + 64 * (c - 1) + 32 * half; nqt = 2; nadm = 16 + 64 * c; }
    rowbase = sq * T_P;
    kb = (const bfr*)(p.ws + W_KBP) + (long)sq * KP_PAD * 512;
    vt = (const bfr*)(p.ws + W_VTP) + (long)sq * 512 * KP_PAD;
    vld = KP_PAD;
  } else {
    T0 = 32 * half; nqt = 2; nadm = S_S; rowbase = ROWS_P + sq * 64;
    kb = (const bfr*)(p.ws + W_KBS) + (long)sq * S_S * 512;
    vt = (const bfr*)(p.ws + W_VTS) + (long)sq * 512 * S_S;
    vld = S_S;
  }
  const int nsteps = (nadm + 31) >> 5;
  const int qrow0 = rowbase + T0;
  const bfr* qb = (const bfr*)(p.ws + W_QB);
  const unsigned* maskg = (const unsigned*)(p.ws + W_MASK);
  bf16x8 qf[2][2];
#pragma unroll
  for (int qt = 0; qt < 2; ++qt)
#pragma unroll
    for (int ks = 0; ks < 2; ++ks) {
      int r = qrow0 + (qt < nqt ? qt * 16 : 0) + fr;
      qf[qt][ks] = *(const bf16x8*)(qb + (long)r * 512 + h * 64 + ks * 32 + fq * 8);
    }
  f32x4 o[2][4];
#pragma unroll
  for (int qt = 0; qt < 2; ++qt)
#pragma unroll
    for (int dt = 0; dt < 4; ++dt) o[qt][dt] = f32x4{0.f, 0.f, 0.f, 0.f};
  const float sc2 = 0.125f * 1.4426950408889634f;
  const float kmax2 = ((const float*)(p.ws + W_KMAX))[(isP ? sq : NB_P + sq) * 8 + h];
  float mref[2], lsum[2] = {0.f, 0.f};
#pragma unroll
  for (int qt = 0; qt < 2; ++qt) {
    float ss = 0.f;
#pragma unroll
    for (int ks = 0; ks < 2; ++ks)
#pragma unroll
      for (int i = 0; i < 8; ++i) { float a = bf2f((bfr)qf[qt][ks][i]); ss += a * a; }
    ss += __shfl_xor(ss, 16);
    ss += __shfl_xor(ss, 32);
    mref[qt] = sqrtf(ss * kmax2) * sc2;
  }
  const unsigned* mrow0 = maskg + (long)(qrow0 + fr) * MW;
  const unsigned* mrow1 = maskg + (long)(qrow0 + (nqt > 1 ? 16 : 0) + fr) * MW;
  const int kofs = (fr >> 2) * 8 + (fr & 3);
  const bfr* kptr = kb + (long)kofs * 512 + h * 64 + fq * 8;
  const bfr* vptr = vt + (long)(h * 64 + fr) * vld + fq * 8;
  bf16x8 ka0 = *(const bf16x8*)kptr, ka1 = *(const bf16x8*)(kptr + 32);
  bf16x8 kb0 = *(const bf16x8*)(kptr + 4 * 512), kb1 = *(const bf16x8*)(kptr + 4 * 512 + 32);
  bf16x8 vf[4];
#pragma unroll
  for (int dt = 0; dt < 4; ++dt) vf[dt] = *(const bf16x8*)(vptr + (long)dt * 16 * vld);
  unsigned mw0 = mrow0[0], mw1 = mrow1[0];
  for (int s = 0; s < nsteps; ++s) {
    const int sn = min(s + 1, nsteps - 1);
    const bfr* pa = kptr + (long)sn * 32 * 512;
    const bf16x8 nka0 = *(const bf16x8*)pa, nka1 = *(const bf16x8*)(pa + 32);
    const bf16x8 nkb0 = *(const bf16x8*)(pa + 4 * 512), nkb1 = *(const bf16x8*)(pa + 4 * 512 + 32);
    bf16x8 nvf[4];
#pragma unroll
    for (int dt = 0; dt < 4; ++dt) nvf[dt] = *(const bf16x8*)(vptr + (long)dt * 16 * vld + sn * 32);
    const unsigned nmw0 = mrow0[sn], nmw1 = mrow1[sn];
#pragma unroll
    for (int qt = 0; qt < 2; ++qt) {
      if (qt < nqt) {
        f32x4 sa = {0.f, 0.f, 0.f, 0.f}, sb = {0.f, 0.f, 0.f, 0.f};
        sa = MFMA16(ka0, qf[qt][0], sa); sa = MFMA16(ka1, qf[qt][1], sa);
        sb = MFMA16(kb0, qf[qt][0], sb); sb = MFMA16(kb1, qf[qt][1], sb);
        const unsigned mb = ((qt == 0 ? mw0 : mw1) >> (fq * 8)) & 0xFFu;
        float pr[8];
#pragma unroll
        for (int i = 0; i < 4; ++i) {
          float pa_ = __builtin_amdgcn_exp2f(sa[i] * sc2 - mref[qt]);
          float pb_ = __builtin_amdgcn_exp2f(sb[i] * sc2 - mref[qt]);
          pr[i] = ((mb >> i) & 1u) ? pa_ : 0.f;
          pr[4 + i] = ((mb >> (4 + i)) & 1u) ? pb_ : 0.f;
        }
        lsum[qt] += ((pr[0] + pr[1]) + (pr[2] + pr[3])) + ((pr[4] + pr[5]) + (pr[6] + pr[7]));
        union { unsigned u[4]; bf16x8 v; } pk;
        pk.u[0] = pack2(pr[0], pr[1]); pk.u[1] = pack2(pr[2], pr[3]); pk.u[2] = pack2(pr[4], pr[5]); pk.u[3] = pack2(pr[6], pr[7]);
#pragma unroll
        for (int dt = 0; dt < 4; ++dt) o[qt][dt] = MFMA16(vf[dt], pk.v, o[qt][dt]);
      }
    }
    ka0 = nka0; ka1 = nka1; kb0 = nkb0; kb1 = nkb1;
#pragma unroll
    for (int dt = 0; dt < 4; ++dt) vf[dt] = nvf[dt];
    mw0 = nmw0; mw1 = nmw1;
  }
  bfr* gay = (bfr*)(p.ws + W_GA);
  bfr* dsty = (bfr*)(p.ws + dstoff);
#pragma unroll
  for (int qt = 0; qt < 2; ++qt) {
    if (qt < nqt) {
      float l = lsum[qt];
      l += __shfl_xor(l, 16);
      l += __shfl_xor(l, 32);
      const float inv = l > 0.f ? 1.f / l : 0.f;
      const long rowoff = (long)(qrow0 + qt * 16 + fr) * 512 + h * 64;
#pragma unroll
      for (int dt = 0; dt < 4; ++dt) {
        uint2* ptr = (uint2*)(gay + rowoff + dt * 16 + fq * 4);
        uint2 gv = *ptr;
        float g0 = __uint_as_float(gv.x << 16), g1 = __uint_as_float(gv.x & 0xFFFF0000u);
        float g2 = __uint_as_float(gv.y << 16), g3 = __uint_as_float(gv.y & 0xFFFF0000u);
        uint2 ov;
        ov.x = pack2(o[qt][dt][0] * inv * g0, o[qt][dt][1] * inv * g1);
        ov.y = pack2(o[qt][dt][2] * inv * g2, o[qt][dt][3] * inv * g3);
        *(uint2*)(dsty + rowoff + dt * 16 + fq * 4) = ov;
      }
    }
  }
}

#define XB_TMO      128
#define XB_XCNT(j)  (256  + 64 * (j))
#define XB_XSUB(j)  (1280 + 64 * (j))
#define XB_XGEN(j)  (2304 + 64 * (j))
#define XB_TOP      3328
#define XB_TOPGEN   3392
#define XCD_BAR_WORDS 3456
#define XB_SPIN_CAP (1u << 18)
#define LAS __attribute__((address_space(3)))

__device__ __forceinline__ unsigned xb_ld(unsigned* p)              { return __hip_atomic_load(p, __ATOMIC_RELAXED, __HIP_MEMORY_SCOPE_AGENT); }
__device__ __forceinline__ unsigned xb_add(unsigned* p, unsigned v) { return __hip_atomic_fetch_add(p, v, __ATOMIC_RELAXED, __HIP_MEMORY_SCOPE_AGENT); }
__device__ __forceinline__ unsigned xb_xcc_id() { return (unsigned)__builtin_amdgcn_s_getreg((3 << 11) | 20) & 0xFu; }
#define XB_SPIN(cond, bar) do { unsigned _sp = 0; while (cond) { __builtin_amdgcn_s_sleep(1); \
    if ((++_sp & 255u) == 0u) { if (xb_ld(&(bar)[XB_TMO])) break; if (_sp > XB_SPIN_CAP) { atomicAdd(&(bar)[XB_TMO], 1u); break; } } } } while (0)

struct XcdBarrier {
    unsigned* bar; unsigned x;
    volatile LAS unsigned* st;
};

__device__ __forceinline__ XcdBarrier xcd_barrier_post(unsigned* bar, volatile LAS unsigned* st) {
    XcdBarrier b; b.bar = bar; b.x = xb_xcc_id(); b.st = st;
    if (threadIdx.x == 0) (void)xb_add(&bar[XB_XCNT(b.x)], 1u);
    return b;
}
__device__ __forceinline__ void xcd_barrier_complete(unsigned* bar, unsigned x, unsigned& nloc, unsigned& nx) {
    const unsigned G = gridDim.x * gridDim.y * gridDim.z;
    unsigned sum, cnt, mine, sp = 0u;
    for (;;) {
        sum = 0u; cnt = 0u; mine = 0u;
#pragma unroll
        for (unsigned j = 0; j < 16; ++j) { const unsigned c = xb_ld(&bar[XB_XCNT(j)]); sum += c; cnt += (c > 0u) ? 1u : 0u; mine = (j == x) ? c : mine; }
        if (sum == G) break;
        __builtin_amdgcn_s_sleep(1);
        if ((++sp & 255u) == 0u) { if (xb_ld(&bar[XB_TMO])) break; if (sp > XB_SPIN_CAP) { atomicAdd(&bar[XB_TMO], 1u); break; } }
    }
    nloc = mine > 0u ? mine : 1u; nx = cnt > 0u ? cnt : 1u;
}

__device__ __forceinline__ void xcd_barrier(const XcdBarrier& b) {
    asm volatile("s_waitcnt vmcnt(0)" ::: "memory");
    __syncthreads();
    if (threadIdx.x == 0) {
        unsigned* bar = b.bar;
        __builtin_amdgcn_s_waitcnt(0);
        unsigned nloc = b.st[0], nx = b.st[1];
        if (nloc == 0u) { xcd_barrier_complete(bar, b.x, nloc, nx); b.st[0] = nloc; b.st[1] = nx; }
        const unsigned old = xb_add(&bar[XB_XSUB(b.x)], 1u);
        const unsigned gen = old / nloc;
        if (old + 1u == (gen + 1u) * nloc) {
            __builtin_amdgcn_fence(__ATOMIC_RELEASE, "agent");
            asm volatile("s_waitcnt vmcnt(0)" ::: "memory");
            const unsigned og = xb_add(&bar[XB_TOP], 1u);
            const unsigned tg = og / nx;
            if (og + 1u == (tg + 1u) * nx) xb_add(&bar[XB_TOPGEN], 1u);
            else XB_SPIN(xb_ld(&bar[XB_TOPGEN]) == tg, bar);
            __builtin_amdgcn_fence(__ATOMIC_ACQUIRE, "agent");
            xb_add(&bar[XB_XGEN(b.x)], 1u);
            asm volatile("s_waitcnt vmcnt(0)" ::: "memory");
        } else {
            XB_SPIN(xb_ld(&bar[XB_XGEN(b.x)]) == gen, bar);
            __builtin_amdgcn_fence(__ATOMIC_ACQUIRE, "agent");
            asm volatile("s_waitcnt vmcnt(0)" ::: "memory");
        }
    }
    __syncthreads();
}


DI void attn_block(const Params& p, int isP, int sq, int c, int h) {
  const int tid = get_tid(), wid = __builtin_amdgcn_readfirstlane(tid >> 6), lane = tid & 63, fr = lane & 15, fq = lane >> 4;
  int T0, nqt, nadm, rowbase, vld;
  const bfr *kb, *vt;
  if (isP) {
    if (c == 0) { T0 = 0; nqt = 1; nadm = 16; } else { T0 = 16 + 64 * (c - 1); nqt = 4; nadm = 16 + 64 * c; }
    rowbase = sq * T_P;
    kb = (const bfr*)(p.ws + W_KBP) + (long)sq * KP_PAD * 512;
    vt = (const bfr*)(p.ws + W_VTP) + (long)sq * 512 * KP_PAD;
    vld = KP_PAD;
  } else {
    T0 = 0; nqt = 4; nadm = S_S; rowbase = ROWS_P + sq * 64;
    kb = (const bfr*)(p.ws + W_KBS) + (long)sq * S_S * 512;
    vt = (const bfr*)(p.ws + W_VTS) + (long)sq * 512 * S_S;
    vld = S_S;
  }
  const int nsteps = (nadm + 31) >> 5;
  const int qrow0 = rowbase + T0;
  const bfr* qb = (const bfr*)(p.ws + W_QB);
  const unsigned* maskg = (const unsigned*)(p.ws + W_MASK);
  bf16x8 qf[4][2];
#pragma unroll
  for (int qt = 0; qt < 4; ++qt)
#pragma unroll
    for (int ks = 0; ks < 2; ++ks) {
      int r = qrow0 + (qt < nqt ? qt * 16 : 0) + fr;
      qf[qt][ks] = *(const bf16x8*)(qb + (long)r * 512 + h * 64 + ks * 32 + fq * 8);
    }
  f32x4 o[4][4];
#pragma unroll
  for (int qt = 0; qt < 4; ++qt)
#pragma unroll
    for (int dt = 0; dt < 4; ++dt) o[qt][dt] = f32x4{0.f, 0.f, 0.f, 0.f};
  const float sc2 = 0.125f * 1.4426950408889634f;
  const float kmax2 = ((const float*)(p.ws + W_KMAX))[(isP ? sq : NB_P + sq) * 8 + h];
  float mref[4], lsum[4] = {0.f, 0.f, 0.f, 0.f};
  const unsigned* mrow[4];
#pragma unroll
  for (int qt = 0; qt < 4; ++qt) {
    float ss = 0.f;
#pragma unroll
    for (int ks = 0; ks < 2; ++ks)
#pragma unroll
      for (int i = 0; i < 8; ++i) { float a = bf2f((bfr)qf[qt][ks][i]); ss += a * a; }
    ss += __shfl_xor(ss, 16);
    ss += __shfl_xor(ss, 32);
    mref[qt] = sqrtf(ss * kmax2) * sc2;
    mrow[qt] = maskg + (long)(qrow0 + (qt < nqt ? qt * 16 : 0) + fr) * MW;
  }
  const int kofs = (fr >> 2) * 8 + (fr & 3);
  const bfr* kptr = kb + (long)kofs * 512 + h * 64 + fq * 8;
  const bfr* vptr = vt + (long)(h * 64 + fr) * vld + fq * 8;
  if (wid < nsteps) {
    int s = wid;
    const bfr* pa0 = kptr + (long)s * 32 * 512;
    bf16x8 ka0 = *(const bf16x8*)pa0, ka1 = *(const bf16x8*)(pa0 + 32);
    bf16x8 kb0 = *(const bf16x8*)(pa0 + 4 * 512), kb1 = *(const bf16x8*)(pa0 + 4 * 512 + 32);
    bf16x8 vf[4];
#pragma unroll
    for (int dt = 0; dt < 4; ++dt) vf[dt] = *(const bf16x8*)(vptr + (long)dt * 16 * vld + s * 32);
    unsigned mw[4];
#pragma unroll
    for (int qt = 0; qt < 4; ++qt) mw[qt] = mrow[qt][s];
    for (; s < nsteps; s += 4) {
      const int sn = (s + 4 < nsteps) ? s + 4 : s;
      const bfr* pa = kptr + (long)sn * 32 * 512;
      const bf16x8 nka0 = *(const bf16x8*)pa, nka1 = *(const bf16x8*)(pa + 32);
      const bf16x8 nkb0 = *(const bf16x8*)(pa + 4 * 512), nkb1 = *(const bf16x8*)(pa + 4 * 512 + 32);
      bf16x8 nvf[4];
#pragma unroll
      for (int dt = 0; dt < 4; ++dt) nvf[dt] = *(const bf16x8*)(vptr + (long)dt * 16 * vld + sn * 32);
      unsigned nmw[4];
#pragma unroll
      for (int qt = 0; qt < 4; ++qt) nmw[qt] = mrow[qt][sn];
#pragma unroll
      for (int qt = 0; qt < 4; ++qt) {
        if (qt < nqt) {
          f32x4 sa = {0.f, 0.f, 0.f, 0.f}, sb = {0.f, 0.f, 0.f, 0.f};
          sa = MFMA16(ka0, qf[qt][0], sa); sa = MFMA16(ka1, qf[qt][1], sa);
          sb = MFMA16(kb0, qf[qt][0], sb); sb = MFMA16(kb1, qf[qt][1], sb);
          const unsigned mb = (mw[qt] >> (fq * 8)) & 0xFFu;
          float pr[8];
#pragma unroll
          for (int i = 0; i < 4; ++i) {
            float pa_ = __builtin_amdgcn_exp2f(sa[i] * sc2 - mref[qt]);
            float pb_ = __builtin_amdgcn_exp2f(sb[i] * sc2 - mref[qt]);
            pr[i] = ((mb >> i) & 1u) ? pa_ : 0.f;
            pr[4 + i] = ((mb >> (4 + i)) & 1u) ? pb_ : 0.f;
          }
          lsum[qt] += ((pr[0] + pr[1]) + (pr[2] + pr[3])) + ((pr[4] + pr[5]) + (pr[6] + pr[7]));
          union { unsigned u[4]; bf16x8 v; } pk;
          pk.u[0] = pack2(pr[0], pr[1]); pk.u[1] = pack2(pr[2], pr[3]); pk.u[2] = pack2(pr[4], pr[5]); pk.u[3] = pack2(pr[6], pr[7]);
#pragma unroll
          for (int dt = 0; dt < 4; ++dt) o[qt][dt] = MFMA16(vf[dt], pk.v, o[qt][dt]);
        }
      }
      ka0 = nka0; ka1 = nka1; kb0 = nkb0; kb1 = nkb1;
#pragma unroll
      for (int dt = 0; dt < 4; ++dt) vf[dt] = nvf[dt];
#pragma unroll
      for (int qt = 0; qt < 4; ++qt) mw[qt] = nmw[qt];
    }
  }
  float* OS = (float*)smem;
  float* LS = OS + 4 * 2048;
  bfr* gay = (bfr*)(p.ws + W_GA);
#pragma unroll
  for (int rd = 0; rd < 2; ++rd) {
    __syncthreads();
#pragma unroll
    for (int q2 = 0; q2 < 2; ++q2) {
      const int qt = rd * 2 + q2;
      float l = lsum[qt];
      l += __shfl_xor(l, 16);
      l += __shfl_xor(l, 32);
      LS[(wid * 2 + q2) * 64 + lane] = l;
#pragma unroll
      for (int dt = 0; dt < 4; ++dt)
#pragma unroll
        for (int j = 0; j < 4; ++j) OS[((wid * 2 + q2) * 16 + dt * 4 + j) * 64 + lane] = o[qt][dt][j];
    }
    __syncthreads();
    const int q2 = wid >> 1, qt = rd * 2 + q2;
    if (qt < nqt) {
      float l = 0.f;
#pragma unroll
      for (int w = 0; w < 4; ++w) l += LS[(w * 2 + q2) * 64 + lane];
      const float inv = l > 0.f ? 1.f / l : 0.f;
      const long rowoff = (long)(qrow0 + qt * 16 + fr) * 512 + h * 64;
#pragma unroll
      for (int d2 = 0; d2 < 2; ++d2) {
        const int dt = (wid & 1) * 2 + d2;
        float acc4[4];
#pragma unroll
        for (int j = 0; j < 4; ++j) {
          float a = 0.f;
#pragma unroll
          for (int w = 0; w < 4; ++w) a += OS[((w * 2 + q2) * 16 + dt * 4 + j) * 64 + lane];
          acc4[j] = a * inv;
        }
        uint2* ptr = (uint2*)(gay + rowoff + dt * 16 + fq * 4);
        uint2 gv = *ptr;
        float g0 = __uint_as_float(gv.x << 16), g1 = __uint_as_float(gv.x & 0xFFFF0000u);
        float g2 = __uint_as_float(gv.y << 16), g3 = __uint_as_float(gv.y & 0xFFFF0000u);
        uint2 ov;
        ov.x = pack2(acc4[0] * g0, acc4[1] * g1);
        ov.y = pack2(acc4[2] * g2, acc4[3] * g3);
        *ptr = ov;
      }
    }
  }
}

DI int pop_block(int* ctr, int*) {
  __syncthreads();
  if (threadIdx.x == 0) sh_item = atomicAdd(ctr, 1);
  __syncthreads();
  return __builtin_amdgcn_readfirstlane(sh_item);
}

constexpr int N_KMAX = 20 * 8;
constexpr int N_SEL = 64 * 16 + 64 + 4;
constexpr int N_LRU1 = NB_P * NTILE_P * 8;
constexpr int N_POOL = NB_P * NTILE_P * 4 + NB_S * 4;
constexpr int N_LRU2 = NB_P * NTILE_P * 8 + NB_S * 8;
constexpr int N_ATT = 64 * 64 + 256 + 32;

DI void phase_b1(const Params& p, int layer, char*, int*) {
  int* ctr = (int*)(p.ws + W_CTR) + layer * 4 + 0;
  for (;;) {
    int it = pop_block(ctr, nullptr);
    if (it >= N_SEL + N_LRU1 + N_POOL + N_KMAX) break;
    if (it >= N_SEL + N_LRU1 + N_POOL) { int j = it - (N_SEL + N_LRU1 + N_POOL); kmax_item(p, j >> 3, j & 7, smem); }
    else if (it < N_SEL) {
      if (it < 1024) { int c = 64 - (it >> 4), b = (it & 15) >> 2, sub = it & 3; select_item(p, 1, b, c, sub, smem); }
      else if (it < 1088) { int j = it - 1024; select_item(p, 0, j >> 2, 0, j & 3, smem); }
      else select_item(p, 1, it - 1088, 0, 0, smem);
    } else if (it < N_SEL + N_LRU1) {
      int j = it - N_SEL;
      int sq = j / (NTILE_P * 8), rem = j % (NTILE_P * 8);
      lru_tile(p, layer, 1, sq, rem >> 3, rem & 7, 0, smem);
    } else {
      int j = it - N_SEL - N_LRU1;
      if (j < NB_P * NTILE_P * 4) { int sq = j / (NTILE_P * 4), rem = j % (NTILE_P * 4); pool_item(p, layer, 1, sq, rem >> 2, rem & 3, smem); }
      else { j -= NB_P * NTILE_P * 4; pool_item(p, layer, 0, j >> 2, 0, j & 3, smem); }
    }
  }
}

constexpr size_t W_DUMMY = W_END;
DI void probe_select(const Params& p, int layer) {
  int* ctr = (int*)(p.ws + W_CTR) + layer * 4 + 3;
  for (;;) {
    int it = pop_block(ctr, nullptr);
    if (it >= N_SEL) break;
    if (it < 1024) { int c = 64 - (it >> 4), b = (it & 15) >> 2, sub = it & 3; select_item(p, 1, b, c, sub, smem); }
    else if (it < 1088) { int j = it - 1024; select_item(p, 0, j >> 2, 0, j & 3, smem); }
    else select_item(p, 1, it - 1088, 0, 0, smem);
  }
}
DI void probe_attn(const Params& p, int layer) {
  int* ctr2 = (int*)(p.ws + W_CTR) + layer * 4 + 3;
  const int lane = get_tid() & 63;
  for (;;) {
    int u = 0;
    if (lane == 0) u = atomicAdd(ctr2, 1);
    u = __builtin_amdgcn_readfirstlane(u);
    if (u >= N_ATT) break;
    if (u < 4096) { int c = 64 - (u >> 6), r = u & 63; attn_unit(p, 1, r >> 4, c, (r >> 1) & 7, r & 1, W_DUMMY); }
    else if (u < 4096 + 256) { int r = u - 4096; attn_unit(p, 0, r >> 4, 0, (r >> 1) & 7, r & 1, W_DUMMY); }
    else { int r = u - 4352; attn_unit(p, 1, r >> 3, 0, r & 7, 0, W_DUMMY); }
  }
}

DI void phase_b2(const Params& p, int layer, char*, int*) {
  int* ctr = (int*)(p.ws + W_CTR) + layer * 4 + 1;
  for (;;) {
    int it = pop_block(ctr, nullptr);
    if (it >= N_LRU2) break;
    if (it < NB_P * NTILE_P * 8) { int sq = it / (NTILE_P * 8), rem = it % (NTILE_P * 8); lru_tile(p, layer, 1, sq, rem >> 3, rem & 7, 1, smem); }
    else { int j = it - NB_P * NTILE_P * 8; lru_tile(p, layer, 0, j >> 3, 0, j & 7, 1, smem); }
  }
  int* ctr2 = (int*)(p.ws + W_CTR) + layer * 4 + 2;
  for (;;) {
    int it = pop_block(ctr2, nullptr);
    if (it >= 2208) break;
    if (it < 2048) { const int c = 64 - (it >> 5), pair = it & 31; attn_block(p, 1, pair >> 3, c, pair & 7); }
    else if (it < 2176) { const int r = it - 2048; attn_block(p, 0, r >> 3, 0, r & 7); }
    else { const int pair = it - 2176; attn_block(p, 1, pair >> 3, 0, pair & 7); }
  }
}

DI Params fresh(const Params& p) {
  Params q = p;
  int z = 0;
  asm volatile("s_mov_b32 %0, 0" : "=s"(z));
  q.ws = p.ws + z;
  q.out = p.out + z;
  return q;
}
DI int fresh_i(int v) {
  asm volatile("" : "+s"(v));
  return v;
}

__shared__ uint4 xb_words;

__global__ void __launch_bounds__(256, 2) fwd_megakernel(Params p) {
  cg::grid_group grid = cg::this_grid();
  if (threadIdx.x == 0) xb_words = make_uint4(0u, 0u, 0u, 0u);
  __syncthreads();
  XcdBarrier xb = xcd_barrier_post((unsigned*)(p.ws + W_BAR), (volatile LAS unsigned*)&xb_words);
  if (threadIdx.x == 0) sh_xinfo[0] = (int)atomicAdd((unsigned*)(p.ws + W_CTR) + 128 + xb.x, 1u);
  prep_phase(fresh(p), smem);
  grid.sync();
  if (threadIdx.x == 0) {
    unsigned* bar = (unsigned*)(p.ws + W_BAR);
    int na = 0, ia = 0, nloc = 1;
    for (unsigned j = 0; j < 16; ++j) {
      const unsigned cj = xb_ld(&bar[XB_XCNT(j)]);
      if (cj > 0u) { if (j < xb.x) ++ia; ++na; }
      if (j == xb.x) nloc = (int)cj;
    }
    sh_xinfo[1] = nloc > 0 ? nloc : 1; sh_xinfo[2] = ia; sh_xinfo[3] = na > 0 ? na : 1;
  }
  __syncthreads();
#if PROBE == 6
#pragma unroll 1
  for (int i = 0; i < 10; ++i) xcd_barrier(xb);
#endif
#pragma unroll 1
  for (int layer = 0; layer < 2; ++layer) {
    phase_inproj(fresh(p), fresh_i(layer), smem);
    xcd_barrier(xb);
#if PROBE == 2
    probe_select(fresh(p), fresh_i(layer));
    xcd_barrier(xb);
#endif
    phase_b1(fresh(p), fresh_i(layer), smem, &sh_item);
    xcd_barrier(xb);
#if PROBE == 3
    probe_attn(fresh(p), fresh_i(layer));
    xcd_barrier(xb);
#endif
    phase_b2(fresh(p), fresh_i(layer), smem, &sh_item);
    xcd_barrier(xb);
    phase_merge(fresh(p), fresh_i(layer), smem);
    xcd_barrier(xb);
#if PROBE == 4
    phase_merge(fresh(p), fresh_i(layer), smem);
    xcd_barrier(xb);
#endif
    phase_out(fresh(p), fresh_i(layer), smem);
    xcd_barrier(xb);
    if (layer == 0) { convert_cache(fresh(p), 1, smem); norm_phase(fresh(p), 1); xcd_barrier(xb); }
    else norm_phase(fresh(p), 2);
  }
}

extern "C" void kernel_launch(void* const* d_in, const int* in_sizes, int n_in, void* d_out, int out_size, void* d_ws,
                              size_t ws_size, hipStream_t stream) {
  constexpr int kDynLds = 65536;
  static int grid_blocks = 0;
  if (!grid_blocks) {
    int dev = 0, cus = 0, per_cu = 0;
    hipGetDevice(&dev);
    hipDeviceGetAttribute(&cus, hipDeviceAttributeMultiprocessorCount, dev);
    hipFuncSetAttribute((const void*)fwd_megakernel, hipFuncAttributeMaxDynamicSharedMemorySize, kDynLds);
    hipOccupancyMaxActiveBlocksPerMultiprocessor(&per_cu, fwd_megakernel, 256, kDynLds);
    if (per_cu > 2) per_cu = 2;
    if (per_cu < 1) per_cu = 1;
    grid_blocks = cus * per_cu;
  }
  if (ws_size < W_END) { fprintf(stderr, "workspace too small: %zu < %zu\n", ws_size, (size_t)W_END); return; }
  Params p{};
  const float** f = (const float**)&p;
  for (int i = 0; i < 23; ++i) f[i] = (const float*)d_in[i];
  p.out = (float*)d_out;
  p.ws = (char*)d_ws;
  hipMemsetAsync(d_ws, 0, 32768, stream);
  void* args[] = {&p};
  hipError_t e = hipLaunchCooperativeKernel((void*)fwd_megakernel, dim3(grid_blocks), dim3(256), args, kDynLds, stream);
  if (e != hipSuccess) fprintf(stderr, "cooperative launch failed: %s (grid %d)\n", hipGetErrorString(e), grid_blocks);
}
```

```cpp
#include <hip/hip_runtime.h>
#include <hip/hip_cooperative_groups.h>
#include <stdint.h>
#include <cstdio>
namespace cg = cooperative_groups;
#ifndef PROBE
#define PROBE 0
#endif

typedef unsigned short bfr;
typedef __attribute__((ext_vector_type(8))) short bf16x8;
typedef __attribute__((ext_vector_type(4))) float f32x4;
typedef __attribute__((ext_vector_type(2))) float f32x2;
typedef __attribute__((ext_vector_type(2))) __bf16 bf2_t;
#define DI __device__ __forceinline__
#define MFMA16(a, b, c) __builtin_amdgcn_mfma_f32_16x16x32_bf16((a), (b), (c), 0, 0, 0)

constexpr int DM = 1024;
constexpr int NB_P = 4, T_P = 4112, SEQ_P = 4096, NMETA = 16;
constexpr int NB_S = 16, T_S = 64, PAST = 2048, S_S = 2112;
constexpr int ROWS_P = NB_P * T_P;
constexpr int ROWS = ROWS_P + NB_S * T_S;
constexpr int MPAD = 17536;
constexpr int NIN = 7492, NPAD = 7552;
constexpr int KP_PAD = 4128;
constexpr int MW = 132;
constexpr int NTILE_P = 65;

constexpr int C_Q = 0, C_K = 512, C_V = 1024, C_GA = 1536, C_QI = 2048, C_KI = 2304, C_XB = 2368, C_GB = 2880,
              C_XC = 3392, C_GC = 3904, C_GM = 4416, C_WI = 7488;

constexpr long O_YP = 0;
constexpr long O_YS = O_YP + (long)NB_P * SEQ_P * DM;
constexpr long O_KP = O_YS + (long)NB_S * T_S * DM;
constexpr long O_VP = O_KP + 2L * NB_P * T_P * 512;
constexpr long O_KIP = O_VP + 2L * NB_P * T_P * 512;
constexpr long O_CONVP = O_KIP + 2L * NB_P * T_P * 64;
constexpr long O_LRUP = O_CONVP + 2L * NB_P * 3 * 512;
constexpr long O_POOLP = O_LRUP + 2L * NB_P * 512;
constexpr long O_KS = O_POOLP + 2L * NB_P * 15 * 512;
constexpr long O_VS = O_KS + 2L * NB_S * T_S * 512;
constexpr long O_KIS = O_VS + 2L * NB_S * T_S * 512;
constexpr long O_CONVS = O_KIS + 2L * NB_S * T_S * 64;
constexpr long O_LRUS = O_CONVS + 2L * NB_S * 3 * 512;
constexpr long O_POOLS = O_LRUS + 2L * NB_S * 512;

constexpr size_t al256(size_t x) { return (x + 255) & ~(size_t)255; }
constexpr size_t W_CTR = 0;
constexpr size_t W_BAR = 4096;
constexpr size_t W_ROPE = 32768;
constexpr size_t W_WINT = al256(W_ROPE + (size_t)T_P * 8 * 8);
constexpr size_t W_WBT = al256(W_WINT + 2ull * NPAD * 1024 * 2);
constexpr size_t W_WOT = al256(W_WBT + 2ull * 3 * 1024 * 512 * 2);
constexpr size_t W_WAT = al256(W_WOT + 2ull * 1024 * 1024 * 2);
constexpr size_t W_WXT = al256(W_WAT + 2ull * 8 * 64 * 64 * 2);
constexpr size_t W_PWT = al256(W_WXT + 2ull * 8 * 64 * 64 * 2);
constexpr size_t W_XRES = al256(W_PWT + 2ull * 4 * 128 * 128 * 2);
constexpr size_t W_HN = al256(W_XRES + (size_t)MPAD * 1024 * 4);
constexpr size_t W_QB = al256(W_HN + (size_t)MPAD * 1024 * 2);
constexpr size_t W_GA = al256(W_QB + (size_t)MPAD * 512 * 2);
constexpr size_t W_QIB = al256(W_GA + (size_t)MPAD * 512 * 2);
constexpr size_t W_WIB = al256(W_QIB + (size_t)MPAD * 256 * 2);
constexpr size_t W_XBB = al256(W_WIB + (size_t)MPAD * 4 * 4);
constexpr size_t W_GB = al256(W_XBB + (size_t)MPAD * 512 * 2);
constexpr size_t W_XCB = al256(W_GB + (size_t)MPAD * 512 * 2);
constexpr size_t W_GC = al256(W_XCB + (size_t)MPAD * 512 * 2);
constexpr size_t W_GM = al256(W_GC + (size_t)MPAD * 512 * 2);
constexpr size_t W_KBP = al256(W_GM + (size_t)MPAD * 3072 * 2);
constexpr size_t W_VTP = al256(W_KBP + (size_t)NB_P * KP_PAD * 512 * 2);
constexpr size_t W_KIBP = al256(W_VTP + (size_t)NB_P * 512 * KP_PAD * 2);
constexpr size_t W_KBS = al256(W_KIBP + (size_t)NB_P * KP_PAD * 64 * 2);
constexpr size_t W_VTS = al256(W_KBS + (size_t)NB_S * S_S * 512 * 2);
constexpr size_t W_KIBS = al256(W_VTS + (size_t)NB_S * 512 * S_S * 2);
constexpr size_t W_MASK = al256(W_KIBS + (size_t)NB_S * S_S * 64 * 2);
constexpr size_t W_AGG = al256(W_MASK + (size_t)ROWS * MW * 4);
constexpr size_t W_KMAX = al256(W_AGG + (size_t)NB_P * NTILE_P * 512 * 2 * 4);
constexpr size_t W_END = al256(W_KMAX + 1024);

struct Params {
  const float *x_prompt, *x_sample, *cache_k, *cache_v, *cache_kidx, *state_conv, *state_lru, *state_pool, *meta,
      *norm_g, *w_in, *conv_w, *conv_b, *lru_wa, *lru_ba, *lru_wx, *lru_bx, *lru_lambda, *pool_w, *pool_scale,
      *w_branch_out, *w_out, *final_g;
  float* out;
  char* ws;
};

extern __shared__ __attribute__((aligned(128))) char smem[];
__shared__ int sh_item;
__shared__ int sh_xinfo[4];

DI float bf2f(bfr b) { return __uint_as_float(((unsigned)b) << 16); }
DI unsigned pack2(float a, float b) {
  f32x2 v = {a, b};
  bf2_t r = __builtin_convertvector(v, bf2_t);
  return __builtin_bit_cast(unsigned, r);
}
DI bfr f2bf(float x) { return (bfr)(pack2(x, 0.f) & 0xFFFFu); }
DI float sigm(float x) { return __builtin_amdgcn_rcpf(1.f + __expf(-x)); }
DI float silu(float x) { return x * __builtin_amdgcn_rcpf(1.f + __expf(-x)); }
DI int get_tid() {
  int t = threadIdx.x;
  asm volatile("" : "+v"(t));
  return t;
}
DI unsigned sortable(float f) {
  unsigned u = __float_as_uint(f);
  return (u & 0x80000000u) ? ~u : (u | 0x80000000u);
}
DI void decode_row(int row, int& isP, int& sq, int& t) {
  if (row < ROWS_P) { isP = 1; sq = row / T_P; t = row - sq * T_P; }
  else { isP = 0; int r = row - ROWS_P; sq = r >> 6; t = r & 63; }
}

DI void tc_tile(const float* src, long sld, bfr* dst, long dld, int k0, int n0, float* tile, int mapmode) {
  const int tid = get_tid();
  const int nn = tid & 63, kk0 = tid >> 6;
  int n = n0 + nn, sn = n;
  if (mapmode) sn = n < 2368 ? n : (n < 7488 ? n + 4 : (n < 7492 ? 2368 + (n - 7488) : -1));
  float v[16];
#pragma unroll
  for (int i = 0; i < 16; ++i) v[i] = sn >= 0 ? __builtin_nontemporal_load(src + (long)(k0 + i * 4 + kk0) * sld + sn) : 0.f;
#pragma unroll
  for (int i = 0; i < 16; ++i) tile[(i * 4 + kk0) * 65 + nn] = v[i];
  __syncthreads();
#pragma unroll
  for (int i = 0; i < 16; ++i) {
    int nn2 = i * 4 + (tid >> 6), kk = tid & 63;
    dst[(long)(n0 + nn2) * dld + k0 + kk] = f2bf(tile[kk * 65 + nn2]);
  }
  __syncthreads();
}

DI void convert_cache(const Params& p, int layer, char*, bool doV = true) {
  const int tid = get_tid();
  bfr* kbs = (bfr*)(p.ws + W_KBS);
  bfr* vts = (bfr*)(p.ws + W_VTS);
  bfr* kibs = (bfr*)(p.ws + W_KIBS);
  for (int it = blockIdx.x; doV && it < NB_S * 32 * 8; it += gridDim.x) {
    int sb = it >> 8, r = it & 255, kt = r >> 3, nt = r & 7;
    tc_tile(p.cache_v + ((long)(layer * NB_S + sb) * PAST) * 512, 512, vts + (long)sb * 512 * S_S, S_S, kt * 64, nt * 64,
            (float*)smem, 0);
  }
  {
    const float4* src = (const float4*)(p.cache_k + (long)layer * NB_S * PAST * 512);
    const long n4 = (long)NB_S * PAST * 512 / 4;
    const long stride = (long)gridDim.x * 256;
    for (long i = (long)blockIdx.x * 256 + tid; i < n4; i += 4 * stride) {
      float4 v[4];
#pragma unroll
      for (int u = 0; u < 4; ++u) { const long ii = i + u * stride; if (ii < n4) { f32x4 t = __builtin_nontemporal_load((const f32x4*)src + ii); v[u] = make_float4(t[0], t[1], t[2], t[3]); } else v[u] = make_float4(0.f, 0.f, 0.f, 0.f); }
#pragma unroll
      for (int u = 0; u < 4; ++u) {
        const long ii = i + u * stride;
        if (ii < n4) {
          const long e = ii * 4;
          const int sb = (int)(e / ((long)PAST * 512));
          const long rem = e - (long)sb * PAST * 512;
          uint2 o; o.x = pack2(v[u].x, v[u].y); o.y = pack2(v[u].z, v[u].w);
          *(uint2*)(kbs + (long)sb * S_S * 512 + rem) = o;
        }
      }
    }
  }
  {
    const float4* src = (const float4*)(p.cache_kidx + (long)layer * NB_S * PAST * 64);
    const long n4 = (long)NB_S * PAST * 64 / 4;
    const long stride = (long)gridDim.x * 256;
    for (long i = (long)blockIdx.x * 256 + tid; i < n4; i += 4 * stride) {
      float4 v[4];
#pragma unroll
      for (int u = 0; u < 4; ++u) { const long ii = i + u * stride; if (ii < n4) { f32x4 t = __builtin_nontemporal_load((const f32x4*)src + ii); v[u] = make_float4(t[0], t[1], t[2], t[3]); } else v[u] = make_float4(0.f, 0.f, 0.f, 0.f); }
#pragma unroll
      for (int u = 0; u < 4; ++u) {
        const long ii = i + u * stride;
        if (ii < n4) {
          const long e = ii * 4;
          const int sb = (int)(e / ((long)PAST * 64));
          const long rem = e - (long)sb * PAST * 64;
          uint2 o; o.x = pack2(v[u].x, v[u].y); o.y = pack2(v[u].z, v[u].w);
          *(uint2*)(kibs + (long)sb * S_S * 64 + rem) = o;
        }
      }
    }
  }
}

DI void norm_phase(const Params& p, int mode) {
  const int tid = get_tid(), wid = __builtin_amdgcn_readfirstlane(tid >> 6), lane = tid & 63;
  float* xres = (float*)(p.ws + W_XRES);
  bfr* hn = (bfr*)(p.ws + W_HN);
  const float* g = mode == 0 ? p.norm_g : (mode == 1 ? p.norm_g + 1024 : p.final_g);
  for (int row = blockIdx.x * 4 + wid; row < ROWS; row += gridDim.x * 4) {
    int isP, sq, t;
    decode_row(row, isP, sq, t);
    const float* src;
    if (mode == 0) {
      if (isP) src = t < NMETA ? p.meta + (long)t * 1024 : p.x_prompt + ((long)sq * SEQ_P + t - NMETA) * 1024;
      else src = p.x_sample + (long)(row - ROWS_P) * 1024;
    } else src = xres + (long)row * 1024;
    float4 v[4];
    float ss = 0.f;
#pragma unroll
    for (int i = 0; i < 4; ++i) {
      { f32x4 t = (mode == 0) ? __builtin_nontemporal_load((const f32x4*)src + lane + i * 64) : *((const f32x4*)src + lane + i * 64); v[i] = make_float4(t[0], t[1], t[2], t[3]); }
      ss += v[i].x * v[i].x + v[i].y * v[i].y + v[i].z * v[i].z + v[i].w * v[i].w;
    }
#pragma unroll
    for (int o = 32; o >= 1; o >>= 1) ss += __shfl_xor(ss, o);
    const float inv = rsqrtf(ss * (1.f / 1024.f) + 1e-6f);
    float* dsty = nullptr;
    if (mode == 2) {
      if (isP) { if (t >= NMETA) dsty = p.out + O_YP + ((long)sq * SEQ_P + t - NMETA) * 1024; }
      else dsty = p.out + O_YS + (long)(row - ROWS_P) * 1024;
    }
#pragma unroll
    for (int i = 0; i < 4; ++i) {
      float4 gg = ((const float4*)g)[lane + i * 64];
      float4 y;
      y.x = v[i].x * inv * gg.x; y.y = v[i].y * inv * gg.y; y.z = v[i].z * inv * gg.z; y.w = v[i].w * inv * gg.w;
      if (mode == 0) ((float4*)(xres + (long)row * 1024))[lane + i * 64] = v[i];
      if (mode < 2) {
        uint2 o; o.x = pack2(y.x, y.y); o.y = pack2(y.z, y.w);
        *(uint2*)(hn + (long)row * 1024 + (lane + i * 64) * 4) = o;
      } else if (dsty) { f32x4 t = {y.x, y.y, y.z, y.w}; __builtin_nontemporal_store(t, (f32x4*)dsty + lane + i * 64); }
    }
  }
}

DI void prep_phase(const Params& p, char*) {
  const int tid = get_tid();
  for (int it0 = blockIdx.x; it0 < 9216; it0 += gridDim.x) {
    int it = it0;
    if (it < 3776) {
      int l = it / (118 * 16), r = it % (118 * 16), nt = r / 16, kt = r % 16;
      tc_tile(p.w_in + (long)l * 1024 * NIN, NIN, (bfr*)(p.ws + W_WINT) + (long)l * NPAD * 1024, 1024, kt * 64, nt * 64, (float*)smem, 1);
      continue;
    }
    it -= 3776;
    if (it < 768) {
      int mtx = it / 128, r = it % 128, nt = r / 8, kt = r % 8;
      tc_tile(p.w_branch_out + (long)mtx * 512 * 1024, 1024, (bfr*)(p.ws + W_WBT) + (long)mtx * 1024 * 512, 512, kt * 64, nt * 64, (float*)smem, 0);
      continue;
    }
    it -= 768;
    if (it < 512) {
      int l = it / 256, r = it % 256, nt = r / 16, kt = r % 16;
      tc_tile(p.w_out + (long)l * 1024 * 1024, 1024, (bfr*)(p.ws + W_WOT) + (long)l * 1024 * 1024, 1024, kt * 64, nt * 64, (float*)smem, 0);
      continue;
    }
    it -= 512;
    if (it < 32) {
      int which = it >> 4, mtx = it & 15;
      tc_tile((which ? p.lru_wx : p.lru_wa) + (long)mtx * 4096, 64, (bfr*)(p.ws + (which ? W_WXT : W_WAT)) + (long)mtx * 4096, 64, 0, 0, (float*)smem, 0);
      continue;
    }
    it -= 32;
    if (it < 32) {
      int mtx = it >> 2, r = it & 3, nt = r >> 1, kt = r & 1;
      tc_tile(p.pool_w + (long)mtx * 16384, 128, (bfr*)(p.ws + W_PWT) + (long)mtx * 16384, 128, kt * 64, nt * 64, (float*)smem, 0);
      continue;
    }
    it -= 32;
    {
      int sb = it >> 8, r = it & 255, kt = r >> 3, nt = r & 7;
      tc_tile(p.cache_v + ((long)sb * PAST) * 512, 512, (bfr*)(p.ws + W_VTS) + (long)sb * 512 * S_S, S_S, kt * 64, nt * 64, (float*)smem, 0);
    }
  }
  {
    float2* rt = (float2*)(p.ws + W_ROPE);
    for (int e = blockIdx.x * 256 + tid; e < T_P * 8; e += gridDim.x * 256) {
      int pos = e >> 3, d = e & 7;
      float inv = powf(500000.f, -(float)d * 0.125f);
      float ang = (float)pos * inv;
      rt[e] = make_float2(cosf(ang), sinf(ang));
    }
  }
  convert_cache(p, 0, smem, false);
  norm_phase(p, 0);
}

template <int NF>
DI void gemm128(const bfr* A, int lda, const bfr* Bt, int ldb, int K, int brow, int bcol, char*, f32x4 (&acc)[4][NF],
             bool chained = false, bool first = true, int nbrow = -1, int nbcol = 0, const bfr* nA = nullptr, const bfr* nBt = nullptr) {
  const int tid = get_tid(), wid = __builtin_amdgcn_readfirstlane(tid >> 6), lane = tid & 63, wr = wid >> 1, wc = wid & 1, fr = lane & 15, fq = lane >> 4;
  const int r0 = tid >> 3;
  const int cg = ((tid & 7) ^ (r0 & 7)) * 8;
  const bfr* ga = A + (long)(brow + r0) * lda + cg;
  const bfr* gb = Bt + (long)(bcol + r0) * ldb + cg;
  const long a32 = (long)32 * lda, b32 = (long)32 * ldb;
  const int nk = K / 64;
  auto stage = [&](int kt, int buf) {
    char* SA = smem + buf * 32768;
    char* SB = SA + 16384;
#pragma unroll
    for (int i = 0; i < 4; ++i)
      __builtin_amdgcn_global_load_lds((const unsigned*)(ga + i * a32 + kt * 64), (unsigned*)(SA + tid * 16 + i * 4096), 16, 0, 0);
#pragma unroll
    for (int i = 0; i < NF; ++i)
      __builtin_amdgcn_global_load_lds((const unsigned*)(gb + i * b32 + kt * 64), (unsigned*)(SB + tid * 16 + i * 4096), 16, 0, 0);
  };
  if (!chained || first) {
    asm volatile("s_waitcnt vmcnt(0)" ::: "memory");
    __syncthreads();
    stage(0, 0);
  }
  const unsigned lds0 = (unsigned)(size_t)smem;
  const unsigned sw0 = (unsigned)((fq ^ (fr & 7)) * 16), sw1 = (unsigned)(((4 + fq) ^ (fr & 7)) * 16);
  const unsigned arow = lds0 + (wr * 64 + fr) * 128, brw = lds0 + 16384 + (wc * NF * 16 + fr) * 128;
  for (int kt = 0; kt < nk; ++kt) {
    asm volatile("s_waitcnt vmcnt(0)" ::: "memory");
    __builtin_amdgcn_s_barrier();
    if (kt + 1 < nk) stage(kt + 1, (kt + 1) & 1);
    else if (chained && nbrow >= 0) {
      const bfr* na = (nA ? nA : A) + (long)(nbrow + r0) * lda + cg;
      const bfr* nb = (nBt ? nBt : Bt) + (long)(nbcol + r0) * ldb + cg;
#pragma unroll
      for (int i = 0; i < 4; ++i)
        __builtin_amdgcn_global_load_lds((const unsigned*)(na + i * a32), (unsigned*)(smem + tid * 16 + i * 4096), 16, 0, 0);
#pragma unroll
      for (int i = 0; i < NF; ++i)
        __builtin_amdgcn_global_load_lds((const unsigned*)(nb + i * b32), (unsigned*)(smem + 16384 + tid * 16 + i * 4096), 16, 0, 0);
    }
    const unsigned bo = (kt & 1) * 32768;
    bf16x8 af[2][4], bfg[2][4];
    if (NF == 4) {
      asm volatile(
          "ds_read_b128 %0, %16\n\tds_read_b128 %1, %16 offset:2048\n\tds_read_b128 %2, %16 offset:4096\n\tds_read_b128 %3, %16 offset:6144\n\t"
          "ds_read_b128 %4, %17\n\tds_read_b128 %5, %17 offset:2048\n\tds_read_b128 %6, %17 offset:4096\n\tds_read_b128 %7, %17 offset:6144\n\t"
          "ds_read_b128 %8, %18\n\tds_read_b128 %9, %18 offset:2048\n\tds_read_b128 %10, %18 offset:4096\n\tds_read_b128 %11, %18 offset:6144\n\t"
          "ds_read_b128 %12, %19\n\tds_read_b128 %13, %19 offset:2048\n\tds_read_b128 %14, %19 offset:4096\n\tds_read_b128 %15, %19 offset:6144\n\t"
          "s_waitcnt lgkmcnt(0)"
          : "=&v"(af[0][0]), "=&v"(af[0][1]), "=&v"(af[0][2]), "=&v"(af[0][3]), "=&v"(bfg[0][0]), "=&v"(bfg[0][1]), "=&v"(bfg[0][2]), "=&v"(bfg[0][3]),
            "=&v"(af[1][0]), "=&v"(af[1][1]), "=&v"(af[1][2]), "=&v"(af[1][3]), "=&v"(bfg[1][0]), "=&v"(bfg[1][1]), "=&v"(bfg[1][2]), "=&v"(bfg[1][3])
          : "v"(arow + sw0 + bo), "v"(brw + sw0 + bo), "v"(arow + sw1 + bo), "v"(brw + sw1 + bo)
          : "memory");
    } else {
      asm volatile(
          "ds_read_b128 %0, %12\n\tds_read_b128 %1, %12 offset:2048\n\tds_read_b128 %2, %12 offset:4096\n\tds_read_b128 %3, %12 offset:6144\n\t"
          "ds_read_b128 %4, %13\n\tds_read_b128 %5, %13 offset:2048\n\t"
          "ds_read_b128 %6, %14\n\tds_read_b128 %7, %14 offset:2048\n\tds_read_b128 %8, %14 offset:4096\n\tds_read_b128 %9, %14 offset:6144\n\t"
          "ds_read_b128 %10, %15\n\tds_read_b128 %11, %15 offset:2048\n\t"
          "s_waitcnt lgkmcnt(0)"
          : "=&v"(af[0][0]), "=&v"(af[0][1]), "=&v"(af[0][2]), "=&v"(af[0][3]), "=&v"(bfg[0][0]), "=&v"(bfg[0][1]),
            "=&v"(af[1][0]), "=&v"(af[1][1]), "=&v"(af[1][2]), "=&v"(af[1][3]), "=&v"(bfg[1][0]), "=&v"(bfg[1][1])
          : "v"(arow + sw0 + bo), "v"(brw + sw0 + bo), "v"(arow + sw1 + bo), "v"(brw + sw1 + bo)
          : "memory");
    }
#pragma unroll
    for (int ks = 0; ks < 2; ++ks)
#pragma unroll
      for (int m = 0; m < 4; ++m)
#pragma unroll
        for (int n = 0; n < NF; ++n) acc[m][n] = MFMA16(af[ks][m], bfg[ks][n], acc[m][n]);
  }
}

constexpr int EPI_PITCH = 64;
template <int REG>
DI void epi_region(const Params& p, int layer, f32x4 (&acc)[4][4], int rbase0, int rel, int lane, int wid) {
  const int fr = lane & 15, fq = lane >> 4;
  const float2* rt = (const float2*)(p.ws + W_ROPE);
  constexpr bool doRope = (REG == 0 || REG == 1 || REG == 4 || REG == 5);
  constexpr bool staged = (REG != 2 && REG != 11);
  bfr* img = (bfr*)(smem + 32768 + wid * (64 * EPI_PITCH * 2));
#pragma unroll
  for (int m = 0; m < 4; ++m) {
    const int rbase = rbase0 + m * 16 + fq * 4;
    const bool rowsValid = rbase < ROWS;
    int isP, sq, t0;
    decode_row(rowsValid ? rbase : 0, isP, sq, t0);
    if (doRope) {
      const int pos0 = isP ? t0 : PAST + t0;
#pragma unroll
      for (int j = 0; j < 4; ++j) {
        float v = acc[m][0][j];
        float pv = __shfl_xor(v, 8);
        float2 cs = rt[(pos0 + j) * 8 + (fr & 7)];
        acc[m][0][j] = (fr < 8) ? (v * cs.x - pv * cs.y) : (v * cs.x + pv * cs.y);
      }
    }
#pragma unroll
    for (int n = 0; n < 4; ++n) {
      const int col = rel + n * 16 + fr;
      if (REG == 2 && rowsValid) {
        uint2 pk; pk.x = pack2(acc[m][n][0], acc[m][n][1]); pk.y = pack2(acc[m][n][2], acc[m][n][3]);
        if (isP) *(uint2*)((bfr*)(p.ws + W_VTP) + ((long)sq * 512 + col) * KP_PAD + t0) = pk;
        else *(uint2*)((bfr*)(p.ws + W_VTS) + ((long)sq * 512 + col) * S_S + PAST + t0) = pk;
      }
#pragma unroll
      for (int j = 0; j < 4; ++j) {
        const float v = acc[m][n][j];
        const int row = rbase + j, t = t0 + j;
        if (rowsValid) {
          if (REG == 1) { if (isP) p.out[O_KP + ((long)(layer * NB_P + sq) * T_P + t) * 512 + col] = v; else p.out[O_KS + ((long)(layer * NB_S + sq) * T_S + t) * 512 + col] = v; }
          if (REG == 2) { if (isP) p.out[O_VP + ((long)(layer * NB_P + sq) * T_P + t) * 512 + col] = v; else p.out[O_VS + ((long)(layer * NB_S + sq) * T_S + t) * 512 + col] = v; }
          if (REG == 5) { if (isP) p.out[O_KIP + ((long)(layer * NB_P + sq) * T_P + t) * 64 + col] = v; else p.out[O_KIS + ((long)(layer * NB_S + sq) * T_S + t) * 64 + col] = v; }
          if (REG == 6) {
            if (isP) { if (t >= T_P - 3) p.out[O_CONVP + ((long)(layer * NB_P + sq) * 3 + (t - (T_P - 3))) * 512 + col] = v; }
            else { if (t >= T_S - 3) p.out[O_CONVS + ((long)(layer * NB_S + sq) * 3 + (t - (T_S - 3))) * 512 + col] = v; }
          }
          if (REG == 8) {
            if (isP) { if (t >= T_P - 15) p.out[O_POOLP + ((long)(layer * NB_P + sq) * 15 + (t - (T_P - 15))) * 512 + col] = v; }
            else { if (t >= T_S - 15) p.out[O_POOLS + ((long)(layer * NB_S + sq) * 15 + (t - (T_S - 15))) * 512 + col] = v; }
          }
          if (REG == 11) { if (col < 4) ((float*)(p.ws + W_WIB))[(long)row * 4 + col] = v; }
        }
        if (staged) {
          float y = v;
          if (REG == 3 || REG == 7 || REG == 9) y = silu(v);
          if (REG == 10) y = sigm(v);
          img[(m * 16 + fq * 4 + j) * EPI_PITCH + n * 16 + fr] = f2bf(y);
        }
      }
    }
  }
  if (staged) {
    asm volatile("s_waitcnt lgkmcnt(0)" ::: "memory");
#pragma unroll
    for (int it = 0; it < 8; ++it) {
      const int r = it * 8 + (lane >> 3), ch = lane & 7;
      const int row = rbase0 + r;
      if (row < ROWS) {
        int isP, sq, t;
        decode_row(row, isP, sq, t);
        bfr* dst;
        if (REG == 0) dst = (bfr*)(p.ws + W_QB) + (long)row * 512;
        else if (REG == 1) dst = isP ? (bfr*)(p.ws + W_KBP) + ((long)sq * KP_PAD + t) * 512 : (bfr*)(p.ws + W_KBS) + ((long)sq * S_S + PAST + t) * 512;
        else if (REG == 3) dst = (bfr*)(p.ws + W_GA) + (long)row * 512;
        else if (REG == 4) dst = (bfr*)(p.ws + W_QIB) + (long)row * 256;
        else if (REG == 5) dst = isP ? (bfr*)(p.ws + W_KIBP) + ((long)sq * KP_PAD + t) * 64 : (bfr*)(p.ws + W_KIBS) + ((long)sq * S_S + PAST + t) * 64;
        else if (REG == 6) dst = (bfr*)(p.ws + W_XBB) + (long)row * 512;
        else if (REG == 7) dst = (bfr*)(p.ws + W_GB) + (long)row * 512;
        else if (REG == 8) dst = (bfr*)(p.ws + W_XCB) + (long)row * 512;
        else if (REG == 9) dst = (bfr*)(p.ws + W_GC) + (long)row * 512;
        else dst = (bfr*)(p.ws + W_GM) + (long)row * 3072;
        const uint4 val = *(const uint4*)(img + r * EPI_PITCH + ch * 8);
        *(uint4*)(dst + rel + ch * 8) = val;
      }
    }
  }
}

DI void epi_inproj(const Params& p, int layer, f32x4 (&acc)[4][4], int brow, int bcol) {
  const int tid = get_tid(), wid = __builtin_amdgcn_readfirstlane(tid >> 6), lane = tid & 63, wr = wid >> 1, wc = wid & 1;
  const int c0 = bcol + wc * 64;
  const int rb = brow + wr * 64;
  asm volatile("s_waitcnt lgkmcnt(0)" ::: "memory");
  __builtin_amdgcn_s_barrier();
  if (c0 < C_K) epi_region<0>(p, layer, acc, rb, c0 - C_Q, lane, wid);
  else if (c0 < C_V) epi_region<1>(p, layer, acc, rb, c0 - C_K, lane, wid);
  else if (c0 < C_GA) epi_region<2>(p, layer, acc, rb, c0 - C_V, lane, wid);
  else if (c0 < C_QI) epi_region<3>(p, layer, acc, rb, c0 - C_GA, lane, wid);
  else if (c0 < C_KI) epi_region<4>(p, layer, acc, rb, c0 - C_QI, lane, wid);
  else if (c0 < C_XB) epi_region<5>(p, layer, acc, rb, c0 - C_KI, lane, wid);
  else if (c0 < C_GB) epi_region<6>(p, layer, acc, rb, c0 - C_XB, lane, wid);
  else if (c0 < C_XC) epi_region<7>(p, layer, acc, rb, c0 - C_GB, lane, wid);
  else if (c0 < C_GC) epi_region<8>(p, layer, acc, rb, c0 - C_XC, lane, wid);
  else if (c0 < C_GM) epi_region<9>(p, layer, acc, rb, c0 - C_GC, lane, wid);
  else if (c0 < C_WI) epi_region<10>(p, layer, acc, rb, c0 - C_GM, lane, wid);
  else epi_region<11>(p, layer, acc, rb, c0 - C_WI, lane, wid);
}

DI void phase_inproj(const Params& p, int layer, char*) {
  const bfr* A = (const bfr*)(p.ws + W_HN);
  const bfr* Bt = (const bfr*)(p.ws + W_WINT) + (long)layer * NPAD * 1024;
  constexpr int NTM = MPAD / 128, NTN = NPAD / 128;
  const int rank = sh_xinfo[0], nloc = sh_xinfo[1], ia = sh_xinfo[2], na = sh_xinfo[3];
  const int nbase = NTN / na, nrem = NTN % na;
  const int nn = nbase + (ia < nrem ? 1 : 0), n0 = ia * nbase + min(ia, nrem);
  const int target = (NTM * NTN + na - 1) / na;
  const int keep = min(NTM * nn, target);
  int poff = 0, stot = 0;
  for (int a = 0; a < na; ++a) {
    const int o = NTM * (nbase + (a < nrem ? 1 : 0)), kp = min(o, target);
    if (a < ia) poff += target - kp;
    stot += o - kp;
  }
  const int dend = min(poff + (target - keep), stot);
  const int kown = rank < keep ? (keep - rank + nloc - 1) / nloc : 0;
  auto get_tile = [&](int k, int& tm_, int& tn_) -> bool {
    if (k < kown) { const int i = rank + k * nloc; tm_ = i / nn; tn_ = n0 + (i - tm_ * nn); return true; }
    const int e = poff + rank + (k - kown) * nloc;
    if (e >= dend) return false;
    int accs = 0;
    for (int a = 0; a < na; ++a) {
      const int nna = nbase + (a < nrem ? 1 : 0), o = NTM * nna, kp = min(o, target), sp = o - kp;
      if (e < accs + sp) {
        const int i = kp + (e - accs);
        tm_ = i / nna;
        tn_ = a * nbase + min(a, nrem) + (i - tm_ * nna);
        return true;
      }
      accs += sp;
    }
    return false;
  };
  bool first = true;
  int tm = 0, tn = 0;
  bool have = get_tile(0, tm, tn);
#pragma unroll 1
  for (int k = 0; have; ++k) {
    int tm2 = 0, tn2 = 0;
    const bool nxt = get_tile(k + 1, tm2, tn2);
    const int nbr = nxt ? tm2 * 128 : -1, nbc = tn2 * 128;
    f32x4 acc[4][4];
#pragma unroll
    for (int m = 0; m < 4; ++m)
#pragma unroll
      for (int n = 0; n < 4; ++n) acc[m][n] = f32x4{0.f, 0.f, 0.f, 0.f};
    gemm128<4>(A, 1024, Bt, 1024, 1024, tm * 128, tn * 128, smem, acc, true, first, nbr, nbc);
    first = false;
    epi_inproj(p, layer, acc, tm * 128, tn * 128);
    tm = tm2; tn = tn2; have = nxt;
  }
}

template <int NF>
DI void merge_tile(const Params& p, int layer, int brow, int bcol, bool& first, bool hasNext, int nbrow, int nbcol) {
  const int tid = get_tid(), wid = __builtin_amdgcn_readfirstlane(tid >> 6), lane = tid & 63, wr = wid >> 1, wc = wid & 1, fr = lane & 15, fq = lane >> 4;
  const bfr* gmb = (const bfr*)(p.ws + W_GM);
  bfr* merged = (bfr*)(p.ws + W_HN);
  unsigned tot[4][NF][2];
#pragma unroll
  for (int m = 0; m < 4; ++m)
#pragma unroll
    for (int n = 0; n < NF; ++n) { tot[m][n][0] = 0u; tot[m][n][1] = 0u; }
#pragma unroll 1
  for (int br = 0; br < 3; ++br) {
    const bfr* A = (const bfr*)(p.ws + (br == 0 ? W_GA : (br == 1 ? W_GB : W_GC)));
    const bfr* Bt = (const bfr*)(p.ws + W_WBT) + (long)(layer * 3 + br) * 1024 * 512;
    const bfr* nA = (const bfr*)(p.ws + (br == 0 ? W_GB : (br == 1 ? W_GC : W_GA)));
    const bfr* nBt = (const bfr*)(p.ws + W_WBT) + (long)(layer * 3 + (br == 2 ? 0 : br + 1)) * 1024 * 512;
    const bool nx = br < 2 || hasNext;
    f32x4 acc[4][NF];
#pragma unroll
    for (int m = 0; m < 4; ++m)
#pragma unroll
      for (int n = 0; n < NF; ++n) acc[m][n] = f32x4{0.f, 0.f, 0.f, 0.f};
    gemm128<NF>(A, 512, Bt, 512, 512, brow, bcol, smem, acc, true, first, nx ? (br < 2 ? brow : nbrow) : -1, br < 2 ? bcol : nbcol, nA, nBt);
    first = false;
#pragma unroll
    for (int m = 0; m < 4; ++m) {
      const int row0 = brow + wr * 64 + m * 16 + fq * 4;
      if (row0 < ROWS) {
#pragma unroll
        for (int n = 0; n < NF; ++n) {
          const int col = bcol + wc * (NF * 16) + n * 16 + fr;
          const bfr* gp = gmb + (long)row0 * 3072 + br * 1024 + col;
          const float g0 = bf2f(gp[0]), g1 = bf2f(gp[3072]), g2 = bf2f(gp[2 * 3072]), g3 = bf2f(gp[3 * 3072]);
          const unsigned t0 = tot[m][n][0], t1 = tot[m][n][1];
          tot[m][n][0] = pack2(__uint_as_float(t0 << 16) + g0 * acc[m][n][0], __uint_as_float(t0 & 0xFFFF0000u) + g1 * acc[m][n][1]);
          tot[m][n][1] = pack2(__uint_as_float(t1 << 16) + g2 * acc[m][n][2], __uint_as_float(t1 & 0xFFFF0000u) + g3 * acc[m][n][3]);
        }
      }
    }
  }
#pragma unroll
  for (int m = 0; m < 4; ++m) {
    const int row0 = brow + wr * 64 + m * 16 + fq * 4;
    if (row0 < ROWS) {
#pragma unroll
      for (int n = 0; n < NF; ++n) {
        bfr* mp = merged + (long)row0 * 1024 + bcol + wc * (NF * 16) + n * 16 + fr;
        mp[0] = (bfr)(tot[m][n][0] & 0xFFFFu); mp[1024] = (bfr)(tot[m][n][0] >> 16);
        mp[2048] = (bfr)(tot[m][n][1] & 0xFFFFu); mp[3072] = (bfr)(tot[m][n][1] >> 16);
      }
    }
  }
}

DI void phase_merge(const Params& p, int layer, char*) {
  constexpr int NTM = MPAD / 128, NTN = 8, NT = NTM * NTN;
  const int G = gridDim.x;
  const int nfull = (NT / G) * G, rem = NT - nfull;
  const bool split = rem > 0 && 2 * rem <= G;
  const int lim = split ? nfull : NT;
  bool first = true;
  for (int tile = blockIdx.x; tile < lim; tile += G) {
    const int tn = tile / NTM, tm = tile % NTM;
    const int t2 = tile + G;
    const bool hasNext = t2 < lim;
    merge_tile<4>(p, layer, tm * 128, tn * 128, first, hasNext, (t2 % NTM) * 128, (t2 / NTM) * 128);
  }
  if (split && (int)blockIdx.x < 2 * rem) {
    const int tile = nfull + ((int)blockIdx.x >> 1), half = blockIdx.x & 1;
    const int tn = tile / NTM, tm = tile % NTM;
    bool f2 = true;
    merge_tile<2>(p, layer, tm * 128, tn * 128 + half * 64, f2, false, 0, 0);
  }
}

template <int NF>
DI void out_tile(const Params& p, int layer, int brow, int bcol, bool& first, bool hasNext, int nbrow, int nbcol) {
  const int tid = get_tid(), wid = __builtin_amdgcn_readfirstlane(tid >> 6), lane = tid & 63, wr = wid >> 1, wc = wid & 1, fr = lane & 15, fq = lane >> 4;
  const bfr* A = (const bfr*)(p.ws + W_HN);
  const bfr* Bt = (const bfr*)(p.ws + W_WOT) + (long)layer * 1024 * 1024;
  float* xres = (float*)(p.ws + W_XRES);
  f32x4 acc[4][NF];
#pragma unroll
  for (int m = 0; m < 4; ++m)
#pragma unroll
    for (int n = 0; n < NF; ++n) acc[m][n] = f32x4{0.f, 0.f, 0.f, 0.f};
  gemm128<NF>(A, 1024, Bt, 1024, 1024, brow, bcol, smem, acc, true, first, hasNext ? nbrow : -1, nbcol);
  first = false;
#pragma unroll
  for (int m = 0; m < 4; ++m)
#pragma unroll
    for (int j = 0; j < 4; ++j) {
      int row = brow + wr * 64 + m * 16 + fq * 4 + j;
      if (row < ROWS) {
#pragma unroll
        for (int n = 0; n < NF; ++n) xres[(long)row * 1024 + bcol + wc * (NF * 16) + n * 16 + fr] += acc[m][n][j];
      }
    }
}

DI void phase_out(const Params& p, int layer, char*) {
  constexpr int NTM = MPAD / 128, NTN = 8, NT = NTM * NTN;
  const int G = gridDim.x;
  const int nfull = (NT / G) * G, rem = NT - nfull;
  const bool split = rem > 0 && 2 * rem <= G;
  const int lim = split ? nfull : NT;
  bool first = true;
  for (int tile = blockIdx.x; tile < lim; tile += G) {
    const int tn = tile / NTM, tm = tile % NTM;
    const int t2 = tile + G;
    out_tile<4>(p, layer, tm * 128, tn * 128, first, t2 < lim, (t2 % NTM) * 128, (t2 / NTM) * 128);
  }
  if (split && (int)blockIdx.x < 2 * rem) {
    const int tile = nfull + ((int)blockIdx.x >> 1), half = blockIdx.x & 1;
    const int tn = tile / NTM, tm = tile % NTM;
    bool f2 = true;
    out_tile<2>(p, layer, tm * 128, tn * 128 + half * 64, f2, false, 0, 0);
  }
}

constexpr int SEL_QS = 2120;
DI void select_item(const Params& p, int isP, int sq, int c, int sub, char*) {
  const int tid = get_tid(), wid = __builtin_amdgcn_readfirstlane(tid >> 6), lane = tid & 63, fr = lane & 15, fq = lane >> 4;
  int T0, nadm, rowbase;
  const bfr* kib;
  if (isP) {
    if (c == 0) { T0 = 0; nadm = 16; } else { T0 = 16 + 64 * (c - 1) + 16 * sub; nadm = 16 + 64 * c; }
    rowbase = sq * T_P;
    kib = (const bfr*)(p.ws + W_KIBP) + (long)sq * KP_PAD * 64;
  } else {
    T0 = 16 * sub; nadm = S_S; rowbase = ROWS_P + sq * 64;
    kib = (const bfr*)(p.ws + W_KIBS) + (long)sq * S_S * 64;
  }
  unsigned* maskg = (unsigned*)(p.ws + W_MASK);
  const int nsteps = (nadm + 31) >> 5;
  if (nadm <= 256) {
    for (int e = tid; e < 16 * nsteps; e += 256) {
      int q = e / nsteps, s = e - q * nsteps;
      unsigned w = (s * 32 + 32 <= nadm) ? 0xFFFFFFFFu : 0xFFFFu;
      maskg[(long)(rowbase + T0 + q) * MW + s] = w;
    }
    return;
  }
  const int nkt = nadm >> 4;
  const int nmine = (nkt - wid + 3) >> 2;
  const int nregs = (nadm + 63) >> 6;
  const bfr* qib = (const bfr*)(p.ws + W_QIB);
  const float* wib = (const float*)(p.ws + W_WIB);
  unsigned* S = (unsigned*)smem;
#pragma unroll 1
  for (int g = 0; g < 4; ++g) {
    const int qrow = rowbase + T0 + g * 4;
    int koff = (wid * 16 + fr) * 64 + fq * 8;
    asm volatile("" : "+v"(koff));
    const bfr* kbase = kib + koff;
    int nm = nmine;
    asm volatile("" : "+v"(nm));
    nm = __builtin_amdgcn_readfirstlane(nm);
    const bfr* qp = qib + (long)(qrow + (fr >> 2)) * 256 + (fr & 3) * 64 + fq * 8;
    const bf16x8 a0 = *(const bf16x8*)qp;
    const bf16x8 a1 = *(const bf16x8*)(qp + 32);
    const float4 w = *(const float4*)(wib + (long)(qrow + fq) * 4);
    unsigned sc[65];
#pragma unroll
    for (int ch = 0; ch < 5; ++ch) {
      if (ch * 13 < nm) {
        bf16x8 b0[13], b1[13];
#pragma unroll
        for (int u = 0; u < 13; ++u) {
          const int ic = min(ch * 13 + u, nm - 1);
          const bfr* kp = kbase + (long)ic * 4096;
          b0[u] = *(const bf16x8*)kp;
          b1[u] = *(const bf16x8*)(kp + 32);
        }
#pragma unroll
        for (int u = 0; u < 13; ++u) {
          const int i = ch * 13 + u;
          f32x4 a = {0.f, 0.f, 0.f, 0.f};
          a = MFMA16(a0, b0[u], a);
          a = MFMA16(a1, b1[u], a);
          float s = w.x * fmaxf(a[0], 0.f) + w.y * fmaxf(a[1], 0.f) + w.z * fmaxf(a[2], 0.f) + w.w * fmaxf(a[3], 0.f);
          sc[i] = (i < nm) ? sortable(s) : 0u;
        }
      } else {
#pragma unroll
        for (int u = 0; u < 13; ++u) sc[ch * 13 + u] = 0u;
      }
      __builtin_amdgcn_sched_barrier(0);
    }
    unsigned v[65];
    __syncthreads();
#pragma unroll
    for (int i = 0; i < 33; ++i) S[fq * SEL_QS + (i * 4 + wid) * 16 + fr] = sc[i];
    __syncthreads();
#pragma unroll
    for (int j = 0; j < 33; ++j) v[j] = S[wid * SEL_QS + j * 64 + lane];
    if (nregs > 33) {
      __syncthreads();
#pragma unroll
      for (int i = 33; i < 65; ++i) S[fq * SEL_QS + (i * 4 + wid - 132) * 16 + fr] = sc[i];
      __syncthreads();
#pragma unroll
      for (int j = 0; j < 32; ++j) v[33 + j] = S[wid * SEL_QS + j * 64 + lane];
    } else {
#pragma unroll
      for (int j = 0; j < 32; ++j) v[33 + j] = 0u;
    }
    int nr = nregs;
    asm volatile("" : "+v"(nr));
    nr = __builtin_amdgcn_readfirstlane(nr);
    unsigned vmax = 0u;
#pragma unroll
    for (int r = 0; r < 65; ++r) vmax = max(vmax, v[r]);
#pragma unroll
    for (int o = 32; o >= 1; o >>= 1) vmax = max(vmax, (unsigned)__shfl_xor((int)vmax, o));
    vmax = __builtin_amdgcn_readfirstlane(vmax);
    unsigned thr = 0u;
    int exact = 0;
#pragma unroll 1
    for (int bit = 31; bit >= 0; --bit) {
      const unsigned cand = thr | (1u << bit);
      if (cand > vmax) continue;
      int cnt = 0;
#pragma unroll
      for (int ch = 0; ch < 5; ++ch) {
        if (ch * 13 < nr) {
#pragma unroll
          for (int u = 0; u < 13; ++u) cnt += __popcll(__ballot(v[ch * 13 + u] >= cand));
        }
      }
      if (cnt >= 256) {
        thr = cand;
        if (cnt == 256) { exact = 1; break; }
      }
    }
    if (exact) {
      unsigned mn = 0xFFFFFFFFu;
#pragma unroll
      for (int r = 0; r < 65; ++r) mn = min(mn, v[r] >= thr ? v[r] : 0xFFFFFFFFu);
#pragma unroll
      for (int o = 32; o >= 1; o >>= 1) mn = min(mn, (unsigned)__shfl_xor((int)mn, o));
      thr = __builtin_amdgcn_readfirstlane(mn);
    }
    int gt = 0, eq = 0;
#pragma unroll
    for (int r = 0; r < 65; ++r) {
      gt += __popcll(__ballot(v[r] > thr));
      eq += __popcll(__ballot(v[r] == thr));
    }
    const int need = 256 - gt;
    int idxcut = 0x7fffffff;
    if (eq != need) {
      int run = 0;
      bool done = false;
#pragma unroll
      for (int r = 0; r < 65; ++r) {
        if (!done) {
          unsigned long long m = __ballot(v[r] == thr);
          int pc = __popcll(m);
          if (run + pc >= need) {
            const int k = need - run;
            for (int t = 1; t < k; ++t) m &= m - 1ull;
            idxcut = r * 64 + (__ffsll((long long)m) - 1);
            done = true;
          } else run += pc;
        }
      }
    }
    unsigned* mrowp = maskg + (long)(qrow + wid) * MW;
#pragma unroll
    for (int r = 0; r < 65; ++r) {
      if (r < nr) {
        const bool sel = (v[r] > thr) || (v[r] == thr && (r * 64 + lane) <= idxcut);
        const unsigned long long bal = __ballot(sel);
        if (lane == 0) *(uint2*)(mrowp + r * 2) = make_uint2((unsigned)bal, (unsigned)(bal >> 32));
      }
    }
  }
}

DI void lru_tile(const Params& p, int layer, int isP, int sq, int tile, int nb, int pass, char*) {
  const int tid = get_tid(), wid = __builtin_amdgcn_readfirstlane(tid >> 6), lane = tid & 63, fr = lane & 15, fq = lane >> 4;
  float* xbs = (float*)smem;
  float* as_ = xbs;
  float* xcs = xbs + 67 * 64;
  float* bs_ = xcs + 64 * 64;
  float* ab = bs_ + 64 * 64;
  bfr* xca = (bfr*)(ab + 512);
  const int T = isP ? T_P : T_S;
  const int rowbase = isP ? sq * T_P : ROWS_P + sq * 64;
  const int t0 = tile * 64, ch0 = nb * 64;
  const bfr* xbb = (const bfr*)(p.ws + W_XBB);
  bfr* gby = (bfr*)(p.ws + W_GB);
  float* agg = (float*)(p.ws + W_AGG);
  {
    const int c = tid & 63;
    float vv[17];
#pragma unroll
    for (int i = 0; i < 17; ++i) {
      const int rr = i * 4 + (tid >> 6);
      const int tt = t0 - 3 + rr;
      float v = 0.f;
      if (rr < 67) {
        if (tt < 0) { if (!isP) v = p.state_conv[((long)(layer * NB_S + sq) * 3 + (3 + tt)) * 512 + ch0 + c]; }
        else if (tt < T) v = bf2f(xbb[(long)(rowbase + tt) * 512 + ch0 + c]);
      }
      vv[i] = v;
    }
#pragma unroll
    for (int i = 0; i < 17; ++i) { const int rr = i * 4 + (tid >> 6); if (rr < 67) xbs[rr * 64 + c] = vv[i]; }
  }
  __syncthreads();
  {
    const int c = tid & 63;
    const float cb = p.conv_b[layer * 512 + ch0 + c];
    const float w0 = p.conv_w[(layer * 4 + 0) * 512 + ch0 + c], w1 = p.conv_w[(layer * 4 + 1) * 512 + ch0 + c],
                w2 = p.conv_w[(layer * 4 + 2) * 512 + ch0 + c], w3 = p.conv_w[(layer * 4 + 3) * 512 + ch0 + c];
    for (int t = tid >> 6; t < 64; t += 4) {
      float xc = cb + w0 * xbs[t * 64 + c] + w1 * xbs[(t + 1) * 64 + c] + w2 * xbs[(t + 2) * 64 + c] + w3 * xbs[(t + 3) * 64 + c];
      xcs[t * 64 + c] = xc;
      xca[t * 72 + c] = f2bf(xc);
    }
  }
  __syncthreads();
  {
    const bfr* WaT = (const bfr*)(p.ws + W_WAT) + (long)(layer * 8 + nb) * 4096;
    const bfr* WxT = (const bfr*)(p.ws + W_WXT) + (long)(layer * 8 + nb) * 4096;
    bf16x8 af0 = *(const bf16x8*)(xca + (wid * 16 + fr) * 72 + fq * 8);
    bf16x8 af1 = *(const bf16x8*)(xca + (wid * 16 + fr) * 72 + 32 + fq * 8);
#pragma unroll
    for (int nt = 0; nt < 4; ++nt) {
      const int d = nt * 16 + fr;
      bf16x8 ba0 = *(const bf16x8*)(WaT + d * 64 + fq * 8), ba1 = *(const bf16x8*)(WaT + d * 64 + 32 + fq * 8);
      bf16x8 bx0 = *(const bf16x8*)(WxT + d * 64 + fq * 8), bx1 = *(const bf16x8*)(WxT + d * 64 + 32 + fq * 8);
      f32x4 ar = {0.f, 0.f, 0.f, 0.f}, ai = {0.f, 0.f, 0.f, 0.f};
      ar = MFMA16(af0, ba0, ar); ar = MFMA16(af1, ba1, ar);
      ai = MFMA16(af0, bx0, ai); ai = MFMA16(af1, bx1, ai);
      const float bav = p.lru_ba[layer * 512 + ch0 + d], bxv = p.lru_bx[layer * 512 + ch0 + d];
      const float sp = log1pf(__expf(-p.lru_lambda[layer * 512 + ch0 + d]));
#pragma unroll
      for (int j = 0; j < 4; ++j) {
        const int t = wid * 16 + fq * 4 + j;
        float r = sigm(ar[j] + bav), ig = sigm(ai[j] + bxv);
        float la = -8.f * r * sp;
        float a = __expf(la);
        float b = sqrtf(1.f - __expf(2.f * la)) * (ig * xcs[t * 64 + d]);
        if (t0 + t >= T) { a = 1.f; b = 0.f; }
        as_[t * 64 + d] = a;
        bs_[t * 64 + d] = b;
      }
    }
  }
  __syncthreads();
  const int c = tid & 63;
  {
    float A = 1.f, B = 0.f;
#pragma unroll
    for (int tt = 0; tt < 16; ++tt) {
      float a = as_[(wid * 16 + tt) * 64 + c], b = bs_[(wid * 16 + tt) * 64 + c];
      A *= a; B = a * B + b;
    }
    ab[(wid * 64 + c) * 2] = A;
    ab[(wid * 64 + c) * 2 + 1] = B;
  }
  __syncthreads();
  if (pass == 0) {
    if (wid == 0) {
      float A = 1.f, B = 0.f;
#pragma unroll
      for (int w = 0; w < 4; ++w) { float a = ab[(w * 64 + c) * 2], b = ab[(w * 64 + c) * 2 + 1]; A *= a; B = a * B + b; }
      *(float2*)(agg + ((long)(sq * NTILE_P + tile) * 512 + ch0 + c) * 2) = make_float2(A, B);
    }
  } else {
    float h = isP ? 0.f : p.state_lru[(long)(layer * NB_S + sq) * 512 + ch0 + c];
    for (int i0 = 0; i0 < tile; i0 += 16) {
      float2 e[16];
#pragma unroll
      for (int u = 0; u < 16; ++u)
        e[u] = (i0 + u < tile) ? *(const float2*)(agg + ((long)(sq * NTILE_P + i0 + u) * 512 + ch0 + c) * 2) : make_float2(1.f, 0.f);
#pragma unroll
      for (int u = 0; u < 16; ++u) h = e[u].x * h + e[u].y;
    }
    for (int w = 0; w < wid; ++w) h = ab[(w * 64 + c) * 2] * h + ab[(w * 64 + c) * 2 + 1];
#pragma unroll
    for (int tt = 0; tt < 16; ++tt) {
      const int t = wid * 16 + tt;
      h = as_[t * 64 + c] * h + bs_[t * 64 + c];
      if (t0 + t < T) {
        const long idx = (long)(rowbase + t0 + t) * 512 + ch0 + c;
        gby[idx] = f2bf(h * bf2f(gby[idx]));
        if (t0 + t == T - 1) {
          if (isP) p.out[O_LRUP + (long)(layer * NB_P + sq) * 512 + ch0 + c] = h;
          else p.out[O_LRUS + (long)(layer * NB_S + sq) * 512 + ch0 + c] = h;
        }
      }
    }
  }
}

DI void pool_item(const Params& p, int layer, int isP, int sq, int tile, int g, char*) {
  const int tid = get_tid(), wid = __builtin_amdgcn_readfirstlane(tid >> 6), lane = tid & 63, fr = lane & 15, fq = lane >> 4;
  float* xps = (float*)smem;
  bfr* pa = (bfr*)(xps + 79 * 128);
  const int T = isP ? T_P : T_S;
  const int rowbase = isP ? sq * T_P : ROWS_P + sq * 64;
  const int t0 = tile * 64, ch0 = g * 128;
  const bfr* xcb = (const bfr*)(p.ws + W_XCB);
  bfr* gcy = (bfr*)(p.ws + W_GC);
  {
    const int c = tid & 127;
#pragma unroll
    for (int b8 = 0; b8 < 5; ++b8) {
      float vv[8];
#pragma unroll
      for (int u = 0; u < 8; ++u) {
        const int rr = (b8 * 8 + u) * 2 + (tid >> 7);
        const int tt = t0 - 15 + rr;
        float v = 0.f;
        if (rr < 79) {
          if (tt < 0) { if (!isP) v = p.state_pool[((long)(layer * NB_S + sq) * 15 + (15 + tt)) * 512 + ch0 + c]; }
          else if (tt < T) v = bf2f(xcb[(long)(rowbase + tt) * 512 + ch0 + c]);
        }
        vv[u] = v;
      }
#pragma unroll
      for (int u = 0; u < 8; ++u) { const int rr = (b8 * 8 + u) * 2 + (tid >> 7); if (rr < 79) xps[rr * 128 + c] = vv[u]; }
    }
  }
  __syncthreads();
  {
    const int c = tid & 127;
    const int w = 2 << g;
    const int nh = isP ? 0 : PAST;
    for (int t = tid >> 7; t < 64; t += 2) {
      float s = 0.f;
      for (int i = 0; i < w; ++i) s += xps[(15 + t - i) * 128 + c];
      int cnt = min(w, t0 + t + 1 + nh);
      float v = s / (float)cnt - xps[(15 + t) * 128 + c];
      pa[t * 136 + c] = f2bf(v);
    }
  }
  __syncthreads();
  {
    const bfr* PwT = (const bfr*)(p.ws + W_PWT) + (long)(layer * 4 + g) * 16384;
    bf16x8 af[4];
#pragma unroll
    for (int ks = 0; ks < 4; ++ks) af[ks] = *(const bf16x8*)(pa + (wid * 16 + fr) * 136 + ks * 32 + fq * 8);
#pragma unroll
    for (int nt = 0; nt < 8; ++nt) {
      const int d = nt * 16 + fr;
      f32x4 acc = {0.f, 0.f, 0.f, 0.f};
#pragma unroll
      for (int ks = 0; ks < 4; ++ks) {
        bf16x8 bq = *(const bf16x8*)(PwT + d * 128 + ks * 32 + fq * 8);
        acc = MFMA16(af[ks], bq, acc);
      }
      const float scl = p.pool_scale[layer * 512 + ch0 + d];
#pragma unroll
      for (int j = 0; j < 4; ++j) {
        const int t = wid * 16 + fq * 4 + j;
        if (t0 + t < T) {
          const long idx = (long)(rowbase + t0 + t) * 512 + ch0 + d;
          gcy[idx] = f2bf(acc[j] * scl * bf2f(gcy[idx]));
        }
      }
    }
  }
}

DI void kmax_item(const Params& p, int seq, int h, char*) {
  const int tid = get_tid(), wid = __builtin_amdgcn_readfirstlane(tid >> 6), lane = tid & 63;
  const bfr* kb; int S;
  if (seq < NB_P) { kb = (const bfr*)(p.ws + W_KBP) + (long)seq * KP_PAD * 512; S = T_P; }
  else { kb = (const bfr*)(p.ws + W_KBS) + (long)(seq - NB_P) * S_S * 512; S = S_S; }
  float mx = 0.f;
  for (int key = tid; key < S; key += 256) {
    const uint4* r = (const uint4*)(kb + (long)key * 512 + h * 64);
    float ss = 0.f;
#pragma unroll
    for (int i = 0; i < 8; ++i) {
      uint4 v = r[i];
      unsigned u[4] = {v.x, v.y, v.z, v.w};
#pragma unroll
      for (int j = 0; j < 4; ++j) {
        float a = __uint_as_float(u[j] << 16), b = __uint_as_float(u[j] & 0xFFFF0000u);
        ss += a * a + b * b;
      }
    }
    mx = fmaxf(mx, ss);
  }
#pragma unroll
  for (int o = 32; o >= 1; o >>= 1) mx = fmaxf(mx, __shfl_xor(mx, o));
  float* red = (float*)smem;
  if (lane == 0) red[wid] = mx;
  __syncthreads();
  if (tid == 0) ((float*)(p.ws + W_KMAX))[seq * 8 + h] = fmaxf(fmaxf(red[0], red[1]), fmaxf(red[2], red[3]));
}

DI void attn_unit(const Params& p, int isP, int sq, int c, int h, int half, size_t dstoff = W_GA) {
  const int lane = get_tid() & 63, fr = lane & 15, fq = lane >> 4;
  int T0, nqt, nadm, rowbase, vld;
  const bfr *kb, *vt;
  if (isP) {
    if (c == 0) { T0 = 0; nqt = 1; nadm = 16; } else { T0 = 16 + 64 * (c - 1) + 32 * half; nqt = 2; nadm = 16 + 64 * c; }
    rowbase = sq * T_P;
    kb = (const bfr*)(p.ws + W_KBP) + (long)sq * KP_PAD * 512;
    vt = (const bfr*)(p.ws + W_VTP) + (long)sq * 512 * KP_PAD;
    vld = KP_PAD;
  } else {
    T0 = 32 * half; nqt = 2; nadm = S_S; rowbase = ROWS_P + sq * 64;
    kb = (const bfr*)(p.ws + W_KBS) + (long)sq * S_S * 512;
    vt = (const bfr*)(p.ws + W_VTS) + (long)sq * 512 * S_S;
    vld = S_S;
  }
  const int nsteps = (nadm + 31) >> 5;
  const int qrow0 = rowbase + T0;
  const bfr* qb = (const bfr*)(p.ws + W_QB);
  const unsigned* maskg = (const unsigned*)(p.ws + W_MASK);
  bf16x8 qf[2][2];
#pragma unroll
  for (int qt = 0; qt < 2; ++qt)
#pragma unroll
    for (int ks = 0; ks < 2; ++ks) {
      int r = qrow0 + (qt < nqt ? qt * 16 : 0) + fr;
      qf[qt][ks] = *(const bf16x8*)(qb + (long)r * 512 + h * 64 + ks * 32 + fq * 8);
    }
  f32x4 o[2][4];
#pragma unroll
  for (int qt = 0; qt < 2; ++qt)
#pragma unroll
    for (int dt = 0; dt < 4; ++dt) o[qt][dt] = f32x4{0.f, 0.f, 0.f, 0.f};
  const float sc2 = 0.125f * 1.4426950408889634f;
  const float kmax2 = ((const float*)(p.ws + W_KMAX))[(isP ? sq : NB_P + sq) * 8 + h];
  float mref[2], lsum[2] = {0.f, 0.f};
#pragma unroll
  for (int qt = 0; qt < 2; ++qt) {
    float ss = 0.f;
#pragma unroll
    for (int ks = 0; ks < 2; ++ks)
#pragma unroll
      for (int i = 0; i < 8; ++i) { float a = bf2f((bfr)qf[qt][ks][i]); ss += a * a; }
    ss += __shfl_xor(ss, 16);
    ss += __shfl_xor(ss, 32);
    mref[qt] = sqrtf(ss * kmax2) * sc2;
  }
  const unsigned* mrow0 = maskg + (long)(qrow0 + fr) * MW;
  const unsigned* mrow1 = maskg + (long)(qrow0 + (nqt > 1 ? 16 : 0) + fr) * MW;
  const int kofs = (fr >> 2) * 8 + (fr & 3);
  const bfr* kptr = kb + (long)kofs * 512 + h * 64 + fq * 8;
  const bfr* vptr = vt + (long)(h * 64 + fr) * vld + fq * 8;
  bf16x8 ka0 = *(const bf16x8*)kptr, ka1 = *(const bf16x8*)(kptr + 32);
  bf16x8 kb0 = *(const bf16x8*)(kptr + 4 * 512), kb1 = *(const bf16x8*)(kptr + 4 * 512 + 32);
  bf16x8 vf[4];
#pragma unroll
  for (int dt = 0; dt < 4; ++dt) vf[dt] = *(const bf16x8*)(vptr + (long)dt * 16 * vld);
  unsigned mw0 = mrow0[0], mw1 = mrow1[0];
  for (int s = 0; s < nsteps; ++s) {
    const int sn = min(s + 1, nsteps - 1);
    const bfr* pa = kptr + (long)sn * 32 * 512;
    const bf16x8 nka0 = *(const bf16x8*)pa, nka1 = *(const bf16x8*)(pa + 32);
    const bf16x8 nkb0 = *(const bf16x8*)(pa + 4 * 512), nkb1 = *(const bf16x8*)(pa + 4 * 512 + 32);
    bf16x8 nvf[4];
#pragma unroll
    for (int dt = 0; dt < 4; ++dt) nvf[dt] = *(const bf16x8*)(vptr + (long)dt * 16 * vld + sn * 32);
    const unsigned nmw0 = mrow0[sn], nmw1 = mrow1[sn];
#pragma unroll
    for (int qt = 0; qt < 2; ++qt) {
      if (qt < nqt) {
        f32x4 sa = {0.f, 0.f, 0.f, 0.f}, sb = {0.f, 0.f, 0.f, 0.f};
        sa = MFMA16(ka0, qf[qt][0], sa); sa = MFMA16(ka1, qf[qt][1], sa);
        sb = MFMA16(kb0, qf[qt][0], sb); sb = MFMA16(kb1, qf[qt][1], sb);
        const unsigned mb = ((qt == 0 ? mw0 : mw1) >> (fq * 8)) & 0xFFu;
        float pr[8];
#pragma unroll
        for (int i = 0; i < 4; ++i) {
          float pa_ = __builtin_amdgcn_exp2f(sa[i] * sc2 - mref[qt]);
          float pb_ = __builtin_amdgcn_exp2f(sb[i] * sc2 - mref[qt]);
          pr[i] = ((mb >> i) & 1u) ? pa_ : 0.f;
          pr[4 + i] = ((mb >> (4 + i)) & 1u) ? pb_ : 0.f;
        }
        lsum[qt] += ((pr[0] + pr[1]) + (pr[2] + pr[3])) + ((pr[4] + pr[5]) + (pr[6] + pr[7]));
        union { unsigned u[4]; bf16x8 v; } pk;
        pk.u[0] = pack2(pr[0], pr[1]); pk.u[1] = pack2(pr[2], pr[3]); pk.u[2] = pack2(pr[4], pr[5]); pk.u[3] = pack2(pr[6], pr[7]);
#pragma unroll
        for (int dt = 0; dt < 4; ++dt) o[qt][dt] = MFMA16(vf[dt], pk.v, o[qt][dt]);
      }
    }
    ka0 = nka0; ka1 = nka1; kb0 = nkb0; kb1 = nkb1;
#pragma unroll
    for (int dt = 0; dt < 4; ++dt) vf[dt] = nvf[dt];
    mw0 = nmw0; mw1 = nmw1;
  }
  bfr* gay = (bfr*)(p.ws + W_GA);
  bfr* dsty = (bfr*)(p.ws + dstoff);
#pragma unroll
  for (int qt = 0; qt < 2; ++qt) {
    if (qt < nqt) {
      float l = lsum[qt];
      l += __shfl_xor(l, 16);
      l += __shfl_xor(l, 32);
      const float inv = l > 0.f ? 1.f / l : 0.f;
      const long rowoff = (long)(qrow0 + qt * 16 + fr) * 512 + h * 64;
#pragma unroll
      for (int dt = 0; dt < 4; ++dt) {
        uint2* ptr = (uint2*)(gay + rowoff + dt * 16 + fq * 4);
        uint2 gv = *ptr;
        float g0 = __uint_as_float(gv.x << 16), g1 = __uint_as_float(gv.x & 0xFFFF0000u);
        float g2 = __uint_as_float(gv.y << 16), g3 = __uint_as_float(gv.y & 0xFFFF0000u);
        uint2 ov;
        ov.x = pack2(o[qt][dt][0] * inv * g0, o[qt][dt][1] * inv * g1);
        ov.y = pack2(o[qt][dt][2] * inv * g2, o[qt][dt][3] * inv * g3);
        *(uint2*)(dsty + rowoff + dt * 16 + fq * 4) = ov;
      }
    }
  }
}

#define XB_TMO      128
#define XB_XCNT(j)  (256  + 64 * (j))
#define XB_XSUB(j)  (1280 + 64 * (j))
#define XB_XGEN(j)  (2304 + 64 * (j))
#define XB_TOP      3328
#define XB_TOPGEN   3392
#define XCD_BAR_WORDS 3456
#define XB_SPIN_CAP (1u << 18)
#define LAS __attribute__((address_space(3)))

__device__ __forceinline__ unsigned xb_ld(unsigned* p)              { return __hip_atomic_load(p, __ATOMIC_RELAXED, __HIP_MEMORY_SCOPE_AGENT); }
__device__ __forceinline__ unsigned xb_add(unsigned* p, unsigned v) { return __hip_atomic_fetch_add(p, v, __ATOMIC_RELAXED, __HIP_MEMORY_SCOPE_AGENT); }
__device__ __forceinline__ unsigned xb_xcc_id() { return (unsigned)__builtin_amdgcn_s_getreg((3 << 11) | 20) & 0xFu; }
#define XB_SPIN(cond, bar) do { unsigned _sp = 0; while (cond) { __builtin_amdgcn_s_sleep(1); \
    if ((++_sp & 255u) == 0u) { if (xb_ld(&(bar)[XB_TMO])) break; if (_sp > XB_SPIN_CAP) { atomicAdd(&(bar)[XB_TMO], 1u); break; } } } } while (0)

struct XcdBarrier {
    unsigned* bar; unsigned x;
    volatile LAS unsigned* st;
};

__device__ __forceinline__ XcdBarrier xcd_barrier_post(unsigned* bar, volatile LAS unsigned* st) {
    XcdBarrier b; b.bar = bar; b.x = xb_xcc_id(); b.st = st;
    if (threadIdx.x == 0) (void)xb_add(&bar[XB_XCNT(b.x)], 1u);
    return b;
}
__device__ __forceinline__ void xcd_barrier_complete(unsigned* bar, unsigned x, unsigned& nloc, unsigned& nx) {
    const unsigned G = gridDim.x * gridDim.y * gridDim.z;
    unsigned sum, cnt, mine, sp = 0u;
    for (;;) {
        sum = 0u; cnt = 0u; mine = 0u;
#pragma unroll
        for (unsigned j = 0; j < 16; ++j) { const unsigned c = xb_ld(&bar[XB_XCNT(j)]); sum += c; cnt += (c > 0u) ? 1u : 0u; mine = (j == x) ? c : mine; }
        if (sum == G) break;
        __builtin_amdgcn_s_sleep(1);
        if ((++sp & 255u) == 0u) { if (xb_ld(&bar[XB_TMO])) break; if (sp > XB_SPIN_CAP) { atomicAdd(&bar[XB_TMO], 1u); break; } }
    }
    nloc = mine > 0u ? mine : 1u; nx = cnt > 0u ? cnt : 1u;
}

__device__ __forceinline__ void xcd_barrier(const XcdBarrier& b) {
    asm volatile("s_waitcnt vmcnt(0)" ::: "memory");
    __syncthreads();
    if (threadIdx.x == 0) {
        unsigned* bar = b.bar;
        __builtin_amdgcn_s_waitcnt(0);
        unsigned nloc = b.st[0], nx = b.st[1];
        if (nloc == 0u) { xcd_barrier_complete(bar, b.x, nloc, nx); b.st[0] = nloc; b.st[1] = nx; }
        const unsigned old = xb_add(&bar[XB_XSUB(b.x)], 1u);
        const unsigned gen = old / nloc;
        if (old + 1u == (gen + 1u) * nloc) {
            __builtin_amdgcn_fence(__ATOMIC_RELEASE, "agent");
            asm volatile("s_waitcnt vmcnt(0)" ::: "memory");
            const unsigned og = xb_add(&bar[XB_TOP], 1u);
            const unsigned tg = og / nx;
            if (og + 1u == (tg + 1u) * nx) xb_add(&bar[XB_TOPGEN], 1u);
            else XB_SPIN(xb_ld(&bar[XB_TOPGEN]) == tg, bar);
            __builtin_amdgcn_fence(__ATOMIC_ACQUIRE, "agent");
            xb_add(&bar[XB_XGEN(b.x)], 1u);
            asm volatile("s_waitcnt vmcnt(0)" ::: "memory");
        } else {
            XB_SPIN(xb_ld(&bar[XB_XGEN(b.x)]) == gen, bar);
            __builtin_amdgcn_fence(__ATOMIC_ACQUIRE, "agent");
            asm volatile("s_waitcnt vmcnt(0)" ::: "memory");
        }
    }
    __syncthreads();
}


DI void attn_block(const Params& p, int isP, int sq, int c, int h) {
  const int tid = get_tid(), wid = __builtin_amdgcn_readfirstlane(tid >> 6), lane = tid & 63, fr = lane & 15, fq = lane >> 4;
  int T0, nqt, nadm, rowbase, vld;
  const bfr *kb, *vt;
  if (isP) {
    if (c == 0) { T0 = 0; nqt = 1; nadm = 16; } else { T0 = 16 + 64 * (c - 1); nqt = 4; nadm = 16 + 64 * c; }
    rowbase = sq * T_P;
    kb = (const bfr*)(p.ws + W_KBP) + (long)sq * KP_PAD * 512;
    vt = (const bfr*)(p.ws + W_VTP) + (long)sq * 512 * KP_PAD;
    vld = KP_PAD;
  } else {
    T0 = 0; nqt = 4; nadm = S_S; rowbase = ROWS_P + sq * 64;
    kb = (const bfr*)(p.ws + W_KBS) + (long)sq * S_S * 512;
    vt = (const bfr*)(p.ws + W_VTS) + (long)sq * 512 * S_S;
    vld = S_S;
  }
  const int nsteps = (nadm + 31) >> 5;
  const int qrow0 = rowbase + T0;
  const bfr* qb = (const bfr*)(p.ws + W_QB);
  const unsigned* maskg = (const unsigned*)(p.ws + W_MASK);
  bf16x8 qf[4][2];
#pragma unroll
  for (int qt = 0; qt < 4; ++qt)
#pragma unroll
    for (int ks = 0; ks < 2; ++ks) {
      int r = qrow0 + (qt < nqt ? qt * 16 : 0) + fr;
      qf[qt][ks] = *(const bf16x8*)(qb + (long)r * 512 + h * 64 + ks * 32 + fq * 8);
    }
  f32x4 o[4][4];
#pragma unroll
  for (int qt = 0; qt < 4; ++qt)
#pragma unroll
    for (int dt = 0; dt < 4; ++dt) o[qt][dt] = f32x4{0.f, 0.f, 0.f, 0.f};
  const float sc2 = 0.125f * 1.4426950408889634f;
  const float kmax2 = ((const float*)(p.ws + W_KMAX))[(isP ? sq : NB_P + sq) * 8 + h];
  float mref[4], lsum[4] = {0.f, 0.f, 0.f, 0.f};
  const unsigned* mrow[4];
#pragma unroll
  for (int qt = 0; qt < 4; ++qt) {
    float ss = 0.f;
#pragma unroll
    for (int ks = 0; ks < 2; ++ks)
#pragma unroll
      for (int i = 0; i < 8; ++i) { float a = bf2f((bfr)qf[qt][ks][i]); ss += a * a; }
    ss += __shfl_xor(ss, 16);
    ss += __shfl_xor(ss, 32);
    mref[qt] = sqrtf(ss * kmax2) * sc2;
    mrow[qt] = maskg + (long)(qrow0 + (qt < nqt ? qt * 16 : 0) + fr) * MW;
  }
  const int kofs = (fr >> 2) * 8 + (fr & 3);
  const bfr* kptr = kb + (long)kofs * 512 + h * 64 + fq * 8;
  const bfr* vptr = vt + (long)(h * 64 + fr) * vld + fq * 8;
  if (wid < nsteps) {
    int s = wid;
    const bfr* pa0 = kptr + (long)s * 32 * 512;
    bf16x8 ka0 = *(const bf16x8*)pa0, ka1 = *(const bf16x8*)(pa0 + 32);
    bf16x8 kb0 = *(const bf16x8*)(pa0 + 4 * 512), kb1 = *(const bf16x8*)(pa0 + 4 * 512 + 32);
    bf16x8 vf[4];
#pragma unroll
    for (int dt = 0; dt < 4; ++dt) vf[dt] = *(const bf16x8*)(vptr + (long)dt * 16 * vld + s * 32);
    unsigned mw[4];
#pragma unroll
    for (int qt = 0; qt < 4; ++qt) mw[qt] = mrow[qt][s];
    for (; s < nsteps; s += 4) {
      const int sn = (s + 4 < nsteps) ? s + 4 : s;
      const bfr* pa = kptr + (long)sn * 32 * 512;
      const bf16x8 nka0 = *(const bf16x8*)pa, nka1 = *(const bf16x8*)(pa + 32);
      const bf16x8 nkb0 = *(const bf16x8*)(pa + 4 * 512), nkb1 = *(const bf16x8*)(pa + 4 * 512 + 32);
      bf16x8 nvf[4];
#pragma unroll
      for (int dt = 0; dt < 4; ++dt) nvf[dt] = *(const bf16x8*)(vptr + (long)dt * 16 * vld + sn * 32);
      unsigned nmw[4];
#pragma unroll
      for (int qt = 0; qt < 4; ++qt) nmw[qt] = mrow[qt][sn];
#pragma unroll
      for (int qt = 0; qt < 4; ++qt) {
        if (qt < nqt) {
          f32x4 sa = {0.f, 0.f, 0.f, 0.f}, sb = {0.f, 0.f, 0.f, 0.f};
          sa = MFMA16(ka0, qf[qt][0], sa); sa = MFMA16(ka1, qf[qt][1], sa);
          sb = MFMA16(kb0, qf[qt][0], sb); sb = MFMA16(kb1, qf[qt][1], sb);
          const unsigned mb = (mw[qt] >> (fq * 8)) & 0xFFu;
          float pr[8];
#pragma unroll
          for (int i = 0; i < 4; ++i) {
            float pa_ = __builtin_amdgcn_exp2f(sa[i] * sc2 - mref[qt]);
            float pb_ = __builtin_amdgcn_exp2f(sb[i] * sc2 - mref[qt]);
            pr[i] = ((mb >> i) & 1u) ? pa_ : 0.f;
            pr[4 + i] = ((mb >> (4 + i)) & 1u) ? pb_ : 0.f;
          }
          lsum[qt] += ((pr[0] + pr[1]) + (pr[2] + pr[3])) + ((pr[4] + pr[5]) + (pr[6] + pr[7]));
          union { unsigned u[4]; bf16x8 v; } pk;
          pk.u[0] = pack2(pr[0], pr[1]); pk.u[1] = pack2(pr[2], pr[3]); pk.u[2] = pack2(pr[4], pr[5]); pk.u[3] = pack2(pr[6], pr[7]);
#pragma unroll
          for (int dt = 0; dt < 4; ++dt) o[qt][dt] = MFMA16(vf[dt], pk.v, o[qt][dt]);
        }
      }
      ka0 = nka0; ka1 = nka1; kb0 = nkb0; kb1 = nkb1;
#pragma unroll
      for (int dt = 0; dt < 4; ++dt) vf[dt] = nvf[dt];
#pragma unroll
      for (int qt = 0; qt < 4; ++qt) mw[qt] = nmw[qt];
    }
  }
  float* OS = (float*)smem;
  float* LS = OS + 4 * 2048;
  bfr* gay = (bfr*)(p.ws + W_GA);
#pragma unroll
  for (int rd = 0; rd < 2; ++rd) {
    __syncthreads();
#pragma unroll
    for (int q2 = 0; q2 < 2; ++q2) {
      const int qt = rd * 2 + q2;
      float l = lsum[qt];
      l += __shfl_xor(l, 16);
      l += __shfl_xor(l, 32);
      LS[(wid * 2 + q2) * 64 + lane] = l;
#pragma unroll
      for (int dt = 0; dt < 4; ++dt)
#pragma unroll
        for (int j = 0; j < 4; ++j) OS[((wid * 2 + q2) * 16 + dt * 4 + j) * 64 + lane] = o[qt][dt][j];
    }
    __syncthreads();
    const int q2 = wid >> 1, qt = rd * 2 + q2;
    if (qt < nqt) {
      float l = 0.f;
#pragma unroll
      for (int w = 0; w < 4; ++w) l += LS[(w * 2 + q2) * 64 + lane];
      const float inv = l > 0.f ? 1.f / l : 0.f;
      const long rowoff = (long)(qrow0 + qt * 16 + fr) * 512 + h * 64;
#pragma unroll
      for (int d2 = 0; d2 < 2; ++d2) {
        const int dt = (wid & 1) * 2 + d2;
        float acc4[4];
#pragma unroll
        for (int j = 0; j < 4; ++j) {
          float a = 0.f;
#pragma unroll
          for (int w = 0; w < 4; ++w) a += OS[((w * 2 + q2) * 16 + dt * 4 + j) * 64 + lane];
          acc4[j] = a * inv;
        }
        uint2* ptr = (uint2*)(gay + rowoff + dt * 16 + fq * 4);
        uint2 gv = *ptr;
        float g0 = __uint_as_float(gv.x << 16), g1 = __uint_as_float(gv.x & 0xFFFF0000u);
        float g2 = __uint_as_float(gv.y << 16), g3 = __uint_as_float(gv.y & 0xFFFF0000u);
        uint2 ov;
        ov.x = pack2(acc4[0] * g0, acc4[1] * g1);
        ov.y = pack2(acc4[2] * g2, acc4[3] * g3);
        *ptr = ov;
      }
    }
  }
}

DI int pop_block(int* ctr, int*) {
  __syncthreads();
  if (threadIdx.x == 0) sh_item = atomicAdd(ctr, 1);
  __syncthreads();
  return __builtin_amdgcn_readfirstlane(sh_item);
}

constexpr int N_KMAX = 20 * 8;
constexpr int N_SEL = 64 * 16 + 64 + 4;
constexpr int N_LRU1 = NB_P * NTILE_P * 8;
constexpr int N_POOL = NB_P * NTILE_P * 4 + NB_S * 4;
constexpr int N_LRU2 = NB_P * NTILE_P * 8 + NB_S * 8;
constexpr int N_ATT = 64 * 64 + 256 + 32;

DI void phase_b1(const Params& p, int layer, char*, int*) {
  int* ctr = (int*)(p.ws + W_CTR) + layer * 4 + 0;
  for (;;) {
    int it = pop_block(ctr, nullptr);
    if (it >= N_SEL + N_LRU1 + N_POOL + N_KMAX) break;
    if (it >= N_SEL + N_LRU1 + N_POOL) { int j = it - (N_SEL + N_LRU1 + N_POOL); kmax_item(p, j >> 3, j & 7, smem); }
    else if (it < N_SEL) {
      if (it < 1024) { int c = 64 - (it >> 4), b = (it & 15) >> 2, sub = it & 3; select_item(p, 1, b, c, sub, smem); }
      else if (it < 1088) { int j = it - 1024; select_item(p, 0, j >> 2, 0, j & 3, smem); }
      else select_item(p, 1, it - 1088, 0, 0, smem);
    } else if (it < N_SEL + N_LRU1) {
      int j = it - N_SEL;
      int sq = j / (NTILE_P * 8), rem = j % (NTILE_P * 8);
      lru_tile(p, layer, 1, sq, rem >> 3, rem & 7, 0, smem);
    } else {
      int j = it - N_SEL - N_LRU1;
      if (j < NB_P * NTILE_P * 4) { int sq = j / (NTILE_P * 4), rem = j % (NTILE_P * 4); pool_item(p, layer, 1, sq, rem >> 2, rem & 3, smem); }
      else { j -= NB_P * NTILE_P * 4; pool_item(p, layer, 0, j >> 2, 0, j & 3, smem); }
    }
  }
}

constexpr size_t W_DUMMY = W_END;
DI void probe_select(const Params& p, int layer) {
  int* ctr = (int*)(p.ws + W_CTR) + layer * 4 + 3;
  for (;;) {
    int it = pop_block(ctr, nullptr);
    if (it >= N_SEL) break;
    if (it < 1024) { int c = 64 - (it >> 4), b = (it & 15) >> 2, sub = it & 3; select_item(p, 1, b, c, sub, smem); }
    else if (it < 1088) { int j = it - 1024; select_item(p, 0, j >> 2, 0, j & 3, smem); }
    else select_item(p, 1, it - 1088, 0, 0, smem);
  }
}
DI void probe_attn(const Params& p, int layer) {
  int* ctr2 = (int*)(p.ws + W_CTR) + layer * 4 + 3;
  const int lane = get_tid() & 63;
  for (;;) {
    int u = 0;
    if (lane == 0) u = atomicAdd(ctr2, 1);
    u = __builtin_amdgcn_readfirstlane(u);
    if (u >= N_ATT) break;
    if (u < 4096) { int c = 64 - (u >> 6), r = u & 63; attn_unit(p, 1, r >> 4, c, (r >> 1) & 7, r & 1, W_DUMMY); }
    else if (u < 4096 + 256) { int r = u - 4096; attn_unit(p, 0, r >> 4, 0, (r >> 1) & 7, r & 1, W_DUMMY); }
    else { int r = u - 4352; attn_unit(p, 1, r >> 3, 0, r & 7, 0, W_DUMMY); }
  }
}

DI void phase_b2(const Params& p, int layer, char*, int*) {
  int* ctr = (int*)(p.ws + W_CTR) + layer * 4 + 1;
  for (;;) {
    int it = pop_block(ctr, nullptr);
    if (it >= N_LRU2) break;
    if (it < NB_P * NTILE_P * 8) { int sq = it / (NTILE_P * 8), rem = it % (NTILE_P * 8); lru_tile(p, layer, 1, sq, rem >> 3, rem & 7, 1, smem); }
    else { int j = it - NB_P * NTILE_P * 8; lru_tile(p, layer, 0, j >> 3, 0, j & 7, 1, smem); }
  }
  int* ctr2 = (int*)(p.ws + W_CTR) + layer * 4 + 2;
  for (;;) {
    int it = pop_block(ctr2, nullptr);
    if (it >= 2208) break;
    if (it < 2048) { const int c = 64 - (it >> 5), pair = it & 31; attn_block(p, 1, pair >> 3, c, pair & 7); }
    else if (it < 2176) { const int r = it - 2048; attn_block(p, 0, r >> 3, 0, r & 7); }
    else { const int pair = it - 2176; attn_block(p, 1, pair >> 3, 0, pair & 7); }
  }
}

DI Params fresh(const Params& p) {
  Params q = p;
  int z = 0;
  asm volatile("s_mov_b32 %0, 0" : "=s"(z));
  q.ws = p.ws + z;
  q.out = p.out + z;
  return q;
}
DI int fresh_i(int v) {
  asm volatile("" : "+s"(v));
  return v;
}

__shared__ uint4 xb_words;

__global__ void __launch_bounds__(256, 2) fwd_megakernel(Params p) {
  cg::grid_group grid = cg::this_grid();
  if (threadIdx.x == 0) xb_words = make_uint4(0u, 0u, 0u, 0u);
  __syncthreads();
  XcdBarrier xb = xcd_barrier_post((unsigned*)(p.ws + W_BAR), (volatile LAS unsigned*)&xb_words);
  if (threadIdx.x == 0) sh_xinfo[0] = (int)atomicAdd((unsigned*)(p.ws + W_CTR) + 128 + xb.x, 1u);
  prep_phase(fresh(p), smem);
  grid.sync();
  if (threadIdx.x == 0) {
    unsigned* bar = (unsigned*)(p.ws + W_BAR);
    int na = 0, ia = 0, nloc = 1;
    for (unsigned j = 0; j < 16; ++j) {
      const unsigned cj = xb_ld(&bar[XB_XCNT(j)]);
      if (cj > 0u) { if (j < xb.x) ++ia; ++na; }
      if (j == xb.x) nloc = (int)cj;
    }
    sh_xinfo[1] = nloc > 0 ? nloc : 1; sh_xinfo[2] = ia; sh_xinfo[3] = na > 0 ? na : 1;
  }
  __syncthreads();
#if PROBE == 6
#pragma unroll 1
  for (int i = 0; i < 10; ++i) xcd_barrier(xb);
#endif
#pragma unroll 1
  for (int layer = 0; layer < 2; ++layer) {
    phase_inproj(fresh(p), fresh_i(layer), smem);
    xcd_barrier(xb);
#if PROBE == 2
    probe_select(fresh(p), fresh_i(layer));
    xcd_barrier(xb);
#endif
    phase_b1(fresh(p), fresh_i(layer), smem, &sh_item);
    xcd_barrier(xb);
#if PROBE == 3
    probe_attn(fresh(p), fresh_i(layer));
    xcd_barrier(xb);
#endif
    phase_b2(fresh(p), fresh_i(layer), smem, &sh_item);
    xcd_barrier(xb);
    phase_merge(fresh(p), fresh_i(layer), smem);
    xcd_barrier(xb);
#if PROBE == 4
    phase_merge(fresh(p), fresh_i(layer), smem);
    xcd_barrier(xb);
#endif
    phase_out(fresh(p), fresh_i(layer), smem);
    xcd_barrier(xb);
    if (layer == 0) { convert_cache(fresh(p), 1, smem); norm_phase(fresh(p), 1); xcd_barrier(xb); }
    else norm_phase(fresh(p), 2);
  }
}

extern "C" void kernel_launch(void* const* d_in, const int* in_sizes, int n_in, void* d_out, int out_size, void* d_ws,
                              size_t ws_size, hipStream_t stream) {
  constexpr int kDynLds = 65536;
  static int grid_blocks = 0;
  if (!grid_blocks) {
    int dev = 0, cus = 0, per_cu = 0;
    hipGetDevice(&dev);
    hipDeviceGetAttribute(&cus, hipDeviceAttributeMultiprocessorCount, dev);
    hipFuncSetAttribute((const void*)fwd_megakernel, hipFuncAttributeMaxDynamicSharedMemorySize, kDynLds);
    hipOccupancyMaxActiveBlocksPerMultiprocessor(&per_cu, fwd_megakernel, 256, kDynLds);
    if (per_cu > 2) per_cu = 2;
    if (per_cu < 1) per_cu = 1;
    grid_blocks = cus * per_cu;
  }
  if (ws_size < W_END) { fprintf(stderr, "workspace too small: %zu < %zu\n", ws_size, (size_t)W_END); return; }
  Params p{};
  const float** f = (const float**)&p;
  for (int i = 0; i < 23; ++i) f[i] = (const float*)d_in[i];
  p.out = (float*)d_out;
  p.ws = (char*)d_ws;
  hipMemsetAsync(d_ws, 0, 32768, stream);
  void* args[] = {&p};
  hipError_t e = hipLaunchCooperativeKernel((void*)fwd_megakernel, dim3(grid_blocks), dim3(256), args, kDynLds, stream);
  if (e != hipSuccess) fprintf(stderr, "cooperative launch failed: %s (grid %d)\n", hipGetErrorString(e), grid_blocks);
}
```

```cpp
#include <hip/hip_runtime.h>
#include <hip/hip_cooperative_groups.h>
#include <stdint.h>
#include <cstdio>
namespace cg = cooperative_groups;
#ifndef PROBE
#define PROBE 0
#endif

typedef unsigned short bfr;
typedef __attribute__((ext_vector_type(8))) short bf16x8;
typedef __attribute__((ext_vector_type(4))) float f32x4;
typedef __attribute__((ext_vector_type(2))) float f32x2;
typedef __attribute__((ext_vector_type(2))) __bf16 bf2_t;
#define DI __device__ __forceinline__
#define MFMA16(a, b, c) __builtin_amdgcn_mfma_f32_16x16x32_bf16((a), (b), (c), 0, 0, 0)

constexpr int DM = 1024;
constexpr int NB_P = 4, T_P = 4112, SEQ_P = 4096, NMETA = 16;
constexpr int NB_S = 16, T_S = 64, PAST = 2048, S_S = 2112;
constexpr int ROWS_P = NB_P * T_P;
constexpr int ROWS = ROWS_P + NB_S * T_S;
constexpr int MPAD = 17536;
constexpr int NIN = 7492, NPAD = 7552;
constexpr int KP_PAD = 4128;
constexpr int MW = 132;
constexpr int NTILE_P = 65;

constexpr int C_Q = 0, C_K = 512, C_V = 1024, C_GA = 1536, C_QI = 2048, C_KI = 2304, C_XB = 2368, C_GB = 2880,
              C_XC = 3392, C_GC = 3904, C_GM = 4416, C_WI = 7488;

constexpr long O_YP = 0;
constexpr long O_YS = O_YP + (long)NB_P * SEQ_P * DM;
constexpr long O_KP = O_YS + (long)NB_S * T_S * DM;
constexpr long O_VP = O_KP + 2L * NB_P * T_P * 512;
constexpr long O_KIP = O_VP + 2L * NB_P * T_P * 512;
constexpr long O_CONVP = O_KIP + 2L * NB_P * T_P * 64;
constexpr long O_LRUP = O_CONVP + 2L * NB_P * 3 * 512;
constexpr long O_POOLP = O_LRUP + 2L * NB_P * 512;
constexpr long O_KS = O_POOLP + 2L * NB_P * 15 * 512;
constexpr long O_VS = O_KS + 2L * NB_S * T_S * 512;
constexpr long O_KIS = O_VS + 2L * NB_S * T_S * 512;
constexpr long O_CONVS = O_KIS + 2L * NB_S * T_S * 64;
constexpr long O_LRUS = O_CONVS + 2L * NB_S * 3 * 512;
constexpr long O_POOLS = O_LRUS + 2L * NB_S * 512;

constexpr size_t al256(size_t x) { return (x + 255) & ~(size_t)255; }
constexpr size_t W_CTR = 0;
constexpr size_t W_BAR = 4096;
constexpr size_t W_ROPE = 32768;
constexpr size_t W_WINT = al256(W_ROPE + (size_t)T_P * 8 * 8);
constexpr size_t W_WBT = al256(W_WINT + 2ull * NPAD * 1024 * 2);
constexpr size_t W_WOT = al256(W_WBT + 2ull * 3 * 1024 * 512 * 2);
constexpr size_t W_WAT = al256(W_WOT + 2ull * 1024 * 1024 * 2);
constexpr size_t W_WXT = al256(W_WAT + 2ull * 8 * 64 * 64 * 2);
constexpr size_t W_PWT = al256(W_WXT + 2ull * 8 * 64 * 64 * 2);
constexpr size_t W_XRES = al256(W_PWT + 2ull * 4 * 128 * 128 * 2);
constexpr size_t W_HN = al256(W_XRES + (size_t)MPAD * 1024 * 4);
constexpr size_t W_QB = al256(W_HN + (size_t)MPAD * 1024 * 2);
constexpr size_t W_GA = al256(W_QB + (size_t)MPAD * 512 * 2);
constexpr size_t W_QIB = al256(W_GA + (size_t)MPAD * 512 * 2);
constexpr size_t W_WIB = al256(W_QIB + (size_t)MPAD * 256 * 2);
constexpr size_t W_XBB = al256(W_WIB + (size_t)MPAD * 4 * 4);
constexpr size_t W_GB = al256(W_XBB + (size_t)MPAD * 512 * 2);
constexpr size_t W_XCB = al256(W_GB + (size_t)MPAD * 512 * 2);
constexpr size_t W_GC = al256(W_XCB + (size_t)MPAD * 512 * 2);
constexpr size_t W_GM = al256(W_GC + (size_t)MPAD * 512 * 2);
constexpr size_t W_KBP = al256(W_GM + (size_t)MPAD * 3072 * 2);
constexpr size_t W_VTP = al256(W_KBP + (size_t)NB_P * KP_PAD * 512 * 2);
constexpr size_t W_KIBP = al256(W_VTP + (size_t)NB_P * 512 * KP_PAD * 2);
constexpr size_t W_KBS = al256(W_KIBP + (size_t)NB_P * KP_PAD * 64 * 2);
constexpr size_t W_VTS = al256(W_KBS + (size_t)NB_S * S_S * 512 * 2);
constexpr size_t W_KIBS = al256(W_VTS + (size_t)NB_S * 512 * S_S * 2);
constexpr size_t W_MASK = al256(W_KIBS + (size_t)NB_S * S_S * 64 * 2);
constexpr size_t W_AGG = al256(W_MASK + (size_t)ROWS * MW * 4);
constexpr size_t W_KMAX = al256(W_AGG + (size_t)NB_P * NTILE_P * 512 * 2 * 4);
constexpr size_t W_END = al256(W_KMAX + 1024);

struct Params {
  const float *x_prompt, *x_sample, *cache_k, *cache_v, *cache_kidx, *state_conv, *state_lru, *state_pool, *meta,
      *norm_g, *w_in, *conv_w, *conv_b, *lru_wa, *lru_ba, *lru_wx, *lru_bx, *lru_lambda, *pool_w, *pool_scale,
      *w_branch_out, *w_out, *final_g;
  float* out;
  char* ws;
};

extern __shared__ __attribute__((aligned(128))) char smem[];
__shared__ int sh_item;
__shared__ int sh_xinfo[4];

DI float bf2f(bfr b) { return __uint_as_float(((unsigned)b) << 16); }
DI unsigned pack2(float a, float b) {
  f32x2 v = {a, b};
  bf2_t r = __builtin_convertvector(v, bf2_t);
  return __builtin_bit_cast(unsigned, r);
}
DI bfr f2bf(float x) { return (bfr)(pack2(x, 0.f) & 0xFFFFu); }
DI float sigm(float x) { return __builtin_amdgcn_rcpf(1.f + __expf(-x)); }
DI float silu(float x) { return x * __builtin_amdgcn_rcpf(1.f + __expf(-x)); }
DI int get_tid() {
  int t = threadIdx.x;
  asm volatile("" : "+v"(t));
  return t;
}
DI unsigned sortable(float f) {
  unsigned u = __float_as_uint(f);
  return (u & 0x80000000u) ? ~u : (u | 0x80000000u);
}
DI void decode_row(int row, int& isP, int& sq, int& t) {
  if (row < ROWS_P) { isP = 1; sq = row / T_P; t = row - sq * T_P; }
  else { isP = 0; int r = row - ROWS_P; sq = r >> 6; t = r & 63; }
}

DI void tc_tile(const float* src, long sld, bfr* dst, long dld, int k0, int n0, float* tile, int mapmode) {
  const int tid = get_tid();
  const int nn = tid & 63, kk0 = tid >> 6;
  int n = n0 + nn, sn = n;
  if (mapmode) sn = n < 2368 ? n : (n < 7488 ? n + 4 : (n < 7492 ? 2368 + (n - 7488) : -1));
  float v[16];
#pragma unroll
  for (int i = 0; i < 16; ++i) v[i] = sn >= 0 ? __builtin_nontemporal_load(src + (long)(k0 + i * 4 + kk0) * sld + sn) : 0.f;
#pragma unroll
  for (int i = 0; i < 16; ++i) tile[(i * 4 + kk0) * 65 + nn] = v[i];
  __syncthreads();
#pragma unroll
  for (int i = 0; i < 16; ++i) {
    int nn2 = i * 4 + (tid >> 6), kk = tid & 63;
    dst[(long)(n0 + nn2) * dld + k0 + kk] = f2bf(tile[kk * 65 + nn2]);
  }
  __syncthreads();
}

DI void convert_cache(const Params& p, int layer, char*, bool doV = true) {
  const int tid = get_tid();
  bfr* kbs = (bfr*)(p.ws + W_KBS);
  bfr* vts = (bfr*)(p.ws + W_VTS);
  bfr* kibs = (bfr*)(p.ws + W_KIBS);
  for (int it = blockIdx.x; doV && it < NB_S * 32 * 8; it += gridDim.x) {
    int sb = it >> 8, r = it & 255, kt = r >> 3, nt = r & 7;
    tc_tile(p.cache_v + ((long)(layer * NB_S + sb) * PAST) * 512, 512, vts + (long)sb * 512 * S_S, S_S, kt * 64, nt * 64,
            (float*)smem, 0);
  }
  {
    const float4* src = (const float4*)(p.cache_k + (long)layer * NB_S * PAST * 512);
    const long n4 = (long)NB_S * PAST * 512 / 4;
    const long stride = (long)gridDim.x * 256;
    for (long i = (long)blockIdx.x * 256 + tid; i < n4; i += 4 * stride) {
      float4 v[4];
#pragma unroll
      for (int u = 0; u < 4; ++u) { const long ii = i + u * stride; if (ii < n4) { f32x4 t = __builtin_nontemporal_load((const f32x4*)src + ii); v[u] = make_float4(t[0], t[1], t[2], t[3]); } else v[u] = make_float4(0.f, 0.f, 0.f, 0.f); }
#pragma unroll
      for (int u = 0; u < 4; ++u) {
        const long ii = i + u * stride;
        if (ii < n4) {
          const long e = ii * 4;
          const int sb = (int)(e / ((long)PAST * 512));
          const long rem = e - (long)sb * PAST * 512;
          uint2 o; o.x = pack2(v[u].x, v[u].y); o.y = pack2(v[u].z, v[u].w);
          *(uint2*)(kbs + (long)sb * S_S * 512 + rem) = o;
        }
      }
    }
  }
  {
    const float4* src = (const float4*)(p.cache_kidx + (long)layer * NB_S * PAST * 64);
    const long n4 = (long)NB_S * PAST * 64 / 4;
    const long stride = (long)gridDim.x * 256;
    for (long i = (long)blockIdx.x * 256 + tid; i < n4; i += 4 * stride) {
      float4 v[4];
#pragma unroll
      for (int u = 0; u < 4; ++u) { const long ii = i + u * stride; if (ii < n4) { f32x4 t = __builtin_nontemporal_load((const f32x4*)src + ii); v[u] = make_float4(t[0], t[1], t[2], t[3]); } else v[u] = make_float4(0.f, 0.f, 0.f, 0.f); }
#pragma unroll
      for (int u = 0; u < 4; ++u) {
        const long ii = i + u * stride;
        if (ii < n4) {
          const long e = ii * 4;
          const int sb = (int)(e / ((long)PAST * 64));
          const long rem = e - (long)sb * PAST * 64;
          uint2 o; o.x = pack2(v[u].x, v[u].y); o.y = pack2(v[u].z, v[u].w);
          *(uint2*)(kibs + (long)sb * S_S * 64 + rem) = o;
        }
      }
    }
  }
}

DI void norm_phase(const Params& p, int mode) {
  const int tid = get_tid(), wid = __builtin_amdgcn_readfirstlane(tid >> 6), lane = tid & 63;
  float* xres = (float*)(p.ws + W_XRES);
  bfr* hn = (bfr*)(p.ws + W_HN);
  const float* g = mode == 0 ? p.norm_g : (mode == 1 ? p.norm_g + 1024 : p.final_g);
  for (int row = blockIdx.x * 4 + wid; row < ROWS; row += gridDim.x * 4) {
    int isP, sq, t;
    decode_row(row, isP, sq, t);
    const float* src;
    if (mode == 0) {
      if (isP) src = t < NMETA ? p.meta + (long)t * 1024 : p.x_prompt + ((long)sq * SEQ_P + t - NMETA) * 1024;
      else src = p.x_sample + (long)(row - ROWS_P) * 1024;
    } else src = xres + (long)row * 1024;
    float4 v[4];
    float ss = 0.f;
#pragma unroll
    for (int i = 0; i < 4; ++i) {
      { f32x4 t = (mode == 0) ? __builtin_nontemporal_load((const f32x4*)src + lane + i * 64) : *((const f32x4*)src + lane + i * 64); v[i] = make_float4(t[0], t[1], t[2], t[3]); }
      ss += v[i].x * v[i].x + v[i].y * v[i].y + v[i].z * v[i].z + v[i].w * v[i].w;
    }
#pragma unroll
    for (int o = 32; o >= 1; o >>= 1) ss += __shfl_xor(ss, o);
    const float inv = rsqrtf(ss * (1.f / 1024.f) + 1e-6f);
    float* dsty = nullptr;
    if (mode == 2) {
      if (isP) { if (t >= NMETA) dsty = p.out + O_YP + ((long)sq * SEQ_P + t - NMETA) * 1024; }
      else dsty = p.out + O_YS + (long)(row - ROWS_P) * 1024;
    }
#pragma unroll
    for (int i = 0; i < 4; ++i) {
      float4 gg = ((const float4*)g)[lane + i * 64];
      float4 y;
      y.x = v[i].x * inv * gg.x; y.y = v[i].y * inv * gg.y; y.z = v[i].z * inv * gg.z; y.w = v[i].w * inv * gg.w;
      if (mode == 0) ((float4*)(xres + (long)row * 1024))[lane + i * 64] = v[i];
      if (mode < 2) {
        uint2 o; o.x = pack2(y.x, y.y); o.y = pack2(y.z, y.w);
        *(uint2*)(hn + (long)row * 1024 + (lane + i * 64) * 4) = o;
      } else if (dsty) { f32x4 t = {y.x, y.y, y.z, y.w}; __builtin_nontemporal_store(t, (f32x4*)dsty + lane + i * 64); }
    }
  }
}

DI void prep_phase(const Params& p, char*) {
  const int tid = get_tid();
  for (int it0 = blockIdx.x; it0 < 9216; it0 += gridDim.x) {
    int it = it0;
    if (it < 3776) {
      int l = it / (118 * 16), r = it % (118 * 16), nt = r / 16, kt = r % 16;
      tc_tile(p.w_in + (long)l * 1024 * NIN, NIN, (bfr*)(p.ws + W_WINT) + (long)l * NPAD * 1024, 1024, kt * 64, nt * 64, (float*)smem, 1);
      continue;
    }
    it -= 3776;
    if (it < 768) {
      int mtx = it / 128, r = it % 128, nt = r / 8, kt = r % 8;
      tc_tile(p.w_branch_out + (long)mtx * 512 * 1024, 1024, (bfr*)(p.ws + W_WBT) + (long)mtx * 1024 * 512, 512, kt * 64, nt * 64, (float*)smem, 0);
      continue;
    }
    it -= 768;
    if (it < 512) {
      int l = it / 256, r = it % 256, nt = r / 16, kt = r % 16;
      tc_tile(p.w_out + (long)l * 1024 * 1024, 1024, (bfr*)(p.ws + W_WOT) + (long)l * 1024 * 1024, 1024, kt * 64, nt * 64, (float*)smem, 0);
      continue;
    }
    it -= 512;
    if (it < 32) {
      int which = it >> 4, mtx = it & 15;
      tc_tile((which ? p.lru_wx : p.lru_wa) + (long)mtx * 4096, 64, (bfr*)(p.ws + (which ? W_WXT : W_WAT)) + (long)mtx * 4096, 64, 0, 0, (float*)smem, 0);
      continue;
    }
    it -= 32;
    if (it < 32) {
      int mtx = it >> 2, r = it & 3, nt = r >> 1, kt = r & 1;
      tc_tile(p.pool_w + (long)mtx * 16384, 128, (bfr*)(p.ws + W_PWT) + (long)mtx * 16384, 128, kt * 64, nt * 64, (float*)smem, 0);
      continue;
    }
    it -= 32;
    {
      int sb = it >> 8, r = it & 255, kt = r >> 3, nt = r & 7;
      tc_tile(p.cache_v + ((long)sb * PAST) * 512, 512, (bfr*)(p.ws + W_VTS) + (long)sb * 512 * S_S, S_S, kt * 64, nt * 64, (float*)smem, 0);
    }
  }
  {
    float2* rt = (float2*)(p.ws + W_ROPE);
    for (int e = blockIdx.x * 256 + tid; e < T_P * 8; e += gridDim.x * 256) {
      int pos = e >> 3, d = e & 7;
      float inv = powf(500000.f, -(float)d * 0.125f);
      float ang = (float)pos * inv;
      rt[e] = make_float2(cosf(ang), sinf(ang));
    }
  }
  convert_cache(p, 0, smem, false);
  norm_phase(p, 0);
}

template <int NF>
DI void gemm128(const bfr* A, int lda, const bfr* Bt, int ldb, int K, int brow, int bcol, char*, f32x4 (&acc)[4][NF],
             bool chained = false, bool first = true, int nbrow = -1, int nbcol = 0, const bfr* nA = nullptr, const bfr* nBt = nullptr) {
  const int tid = get_tid(), wid = __builtin_amdgcn_readfirstlane(tid >> 6), lane = tid & 63, wr = wid >> 1, wc = wid & 1, fr = lane & 15, fq = lane >> 4;
  const int r0 = tid >> 3;
  const int cg = ((tid & 7) ^ (r0 & 7)) * 8;
  const bfr* ga = A + (long)(brow + r0) * lda + cg;
  const bfr* gb = Bt + (long)(bcol + r0) * ldb + cg;
  const long a32 = (long)32 * lda, b32 = (long)32 * ldb;
  const int nk = K / 64;
  auto stage = [&](int kt, int buf) {
    char* SA = smem + buf * 32768;
    char* SB = SA + 16384;
#pragma unroll
    for (int i = 0; i < 4; ++i)
      __builtin_amdgcn_global_load_lds((const unsigned*)(ga + i * a32 + kt * 64), (unsigned*)(SA + tid * 16 + i * 4096), 16, 0, 0);
#pragma unroll
    for (int i = 0; i < NF; ++i)
      __builtin_amdgcn_global_load_lds((const unsigned*)(gb + i * b32 + kt * 64), (unsigned*)(SB + tid * 16 + i * 4096), 16, 0, 0);
  };
  if (!chained || first) {
    asm volatile("s_waitcnt vmcnt(0)" ::: "memory");
    __syncthreads();
    stage(0, 0);
  }
  const unsigned lds0 = (unsigned)(size_t)smem;
  const unsigned sw0 = (unsigned)((fq ^ (fr & 7)) * 16), sw1 = (unsigned)(((4 + fq) ^ (fr & 7)) * 16);
  const unsigned arow = lds0 + (wr * 64 + fr) * 128, brw = lds0 + 16384 + (wc * NF * 16 + fr) * 128;
  for (int kt = 0; kt < nk; ++kt) {
    asm volatile("s_waitcnt vmcnt(0)" ::: "memory");
    __builtin_amdgcn_s_barrier();
    if (kt + 1 < nk) stage(kt + 1, (kt + 1) & 1);
    else if (chained && nbrow >= 0) {
      const bfr* na = (nA ? nA : A) + (long)(nbrow + r0) * lda + cg;
      const bfr* nb = (nBt ? nBt : Bt) + (long)(nbcol + r0) * ldb + cg;
#pragma unroll
      for (int i = 0; i < 4; ++i)
        __builtin_amdgcn_global_load_lds((const unsigned*)(na + i * a32), (unsigned*)(smem + tid * 16 + i * 4096), 16, 0, 0);
#pragma unroll
      for (int i = 0; i < NF; ++i)
        __builtin_amdgcn_global_load_lds((const unsigned*)(nb + i * b32), (unsigned*)(smem + 16384 + tid * 16 + i * 4096), 16, 0, 0);
    }
    const unsigned bo = (kt & 1) * 32768;
    bf16x8 af[2][4], bfg[2][4];
    if (NF == 4) {
      asm volatile(
          "ds_read_b128 %0, %16\n\tds_read_b128 %1, %16 offset:2048\n\tds_read_b128 %2, %16 offset:4096\n\tds_read_b128 %3, %16 offset:6144\n\t"
          "ds_read_b128 %4, %17\n\tds_read_b128 %5, %17 offset:2048\n\tds_read_b128 %6, %17 offset:4096\n\tds_read_b128 %7, %17 offset:6144\n\t"
          "ds_read_b128 %8, %18\n\tds_read_b128 %9, %18 offset:2048\n\tds_read_b128 %10, %18 offset:4096\n\tds_read_b128 %11, %18 offset:6144\n\t"
          "ds_read_b128 %12, %19\n\tds_read_b128 %13, %19 offset:2048\n\tds_read_b128 %14, %19 offset:4096\n\tds_read_b128 %15, %19 offset:6144\n\t"
          "s_waitcnt lgkmcnt(0)"
          : "=&v"(af[0][0]), "=&v"(af[0][1]), "=&v"(af[0][2]), "=&v"(af[0][3]), "=&v"(bfg[0][0]), "=&v"(bfg[0][1]), "=&v"(bfg[0][2]), "=&v"(bfg[0][3]),
            "=&v"(af[1][0]), "=&v"(af[1][1]), "=&v"(af[1][2]), "=&v"(af[1][3]), "=&v"(bfg[1][0]), "=&v"(bfg[1][1]), "=&v"(bfg[1][2]), "=&v"(bfg[1][3])
          : "v"(arow + sw0 + bo), "v"(brw + sw0 + bo), "v"(arow + sw1 + bo), "v"(brw + sw1 + bo)
          : "memory");
    } else {
      asm volatile(
          "ds_read_b128 %0, %12\n\tds_read_b128 %1, %12 offset:2048\n\tds_read_b128 %2, %12 offset:4096\n\tds_read_b128 %3, %12 offset:6144\n\t"
          "ds_read_b128 %4, %13\n\tds_read_b128 %5, %13 offset:2048\n\t"
          "ds_read_b128 %6, %14\n\tds_read_b128 %7, %14 offset:2048\n\tds_read_b128 %8, %14 offset:4096\n\tds_read_b128 %9, %14 offset:6144\n\t"
          "ds_read_b128 %10, %15\n\tds_read_b128 %11, %15 offset:2048\n\t"
          "s_waitcnt lgkmcnt(0)"
          : "=&v"(af[0][0]), "=&v"(af[0][1]), "=&v"(af[0][2]), "=&v"(af[0][3]), "=&v"(bfg[0][0]), "=&v"(bfg[0][1]),
            "=&v"(af[1][0]), "=&v"(af[1][1]), "=&v"(af[1][2]), "=&v"(af[1][3]), "=&v"(bfg[1][0]), "=&v"(bfg[1][1])
          : "v"(arow + sw0 + bo), "v"(brw + sw0 + bo), "v"(arow + sw1 + bo), "v"(brw + sw1 + bo)
          : "memory");
    }
#pragma unroll
    for (int ks = 0; ks < 2; ++ks)
#pragma unroll
      for (int m = 0; m < 4; ++m)
#pragma unroll
        for (int n = 0; n < NF; ++n) acc[m][n] = MFMA16(af[ks][m], bfg[ks][n], acc[m][n]);
  }
}

constexpr int EPI_PITCH = 64;
template <int REG>
DI void epi_region(const Params& p, int layer, f32x4 (&acc)[4][4], int rbase0, int rel, int lane, int wid) {
  const int fr = lane & 15, fq = lane >> 4;
  const float2* rt = (const float2*)(p.ws + W_ROPE);
  constexpr bool doRope = (REG == 0 || REG == 1 || REG == 4 || REG == 5);
  constexpr bool staged = (REG != 2 && REG != 11);
  bfr* img = (bfr*)(smem + 32768 + wid * (64 * EPI_PITCH * 2));
#pragma unroll
  for (int m = 0; m < 4; ++m) {
    const int rbase = rbase0 + m * 16 + fq * 4;
    const bool rowsValid = rbase < ROWS;
    int isP, sq, t0;
    decode_row(rowsValid ? rbase : 0, isP, sq, t0);
    if (doRope) {
      const int pos0 = isP ? t0 : PAST + t0;
#pragma unroll
      for (int j = 0; j < 4; ++j) {
        float v = acc[m][0][j];
        float pv = __shfl_xor(v, 8);
        float2 cs = rt[(pos0 + j) * 8 + (fr & 7)];
        acc[m][0][j] = (fr < 8) ? (v * cs.x - pv * cs.y) : (v * cs.x + pv * cs.y);
      }
    }
#pragma unroll
    for (int n = 0; n < 4; ++n) {
      const int col = rel + n * 16 + fr;
      if (REG == 2 && rowsValid) {
        uint2 pk; pk.x = pack2(acc[m][n][0], acc[m][n][1]); pk.y = pack2(acc[m][n][2], acc[m][n][3]);
        if (isP) *(uint2*)((bfr*)(p.ws + W_VTP) + ((long)sq * 512 + col) * KP_PAD + t0) = pk;
        else *(uint2*)((bfr*)(p.ws + W_VTS) + ((long)sq * 512 + col) * S_S + PAST + t0) = pk;
      }
#pragma unroll
      for (int j = 0; j < 4; ++j) {
        const float v = acc[m][n][j];
        const int row = rbase + j, t = t0 + j;
        if (rowsValid) {
          if (REG == 1) { if (isP) p.out[O_KP + ((long)(layer * NB_P + sq) * T_P + t) * 512 + col] = v; else p.out[O_KS + ((long)(layer * NB_S + sq) * T_S + t) * 512 + col] = v; }
          if (REG == 2) { if (isP) p.out[O_VP + ((long)(layer * NB_P + sq) * T_P + t) * 512 + col] = v; else p.out[O_VS + ((long)(layer * NB_S + sq) * T_S + t) * 512 + col] = v; }
          if (REG == 5) { if (isP) p.out[O_KIP + ((long)(layer * NB_P + sq) * T_P + t) * 64 + col] = v; else p.out[O_KIS + ((long)(layer * NB_S + sq) * T_S + t) * 64 + col] = v; }
          if (REG == 6) {
            if (isP) { if (t >= T_P - 3) p.out[O_CONVP + ((long)(layer * NB_P + sq) * 3 + (t - (T_P - 3))) * 512 + col] = v; }
            else { if (t >= T_S - 3) p.out[O_CONVS + ((long)(layer * NB_S + sq) * 3 + (t - (T_S - 3))) * 512 + col] = v; }
          }
          if (REG == 8) {
            if (isP) { if (t >= T_P - 15) p.out[O_POOLP + ((long)(layer * NB_P + sq) * 15 + (t - (T_P - 15))) * 512 + col] = v; }
            else { if (t >= T_S - 15) p.out[O_POOLS + ((long)(layer * NB_S + sq) * 15 + (t - (T_S - 15))) * 512 + col] = v; }
          }
          if (REG == 11) { if (col < 4) ((float*)(p.ws + W_WIB))[(long)row * 4 + col] = v; }
        }
        if (staged) {
          float y = v;
          if (REG == 3 || REG == 7 || REG == 9) y = silu(v);
          if (REG == 10) y = sigm(v);
          img[(m * 16 + fq * 4 + j) * EPI_PITCH + n * 16 + fr] = f2bf(y);
        }
      }
    }
  }
  if (staged) {
    asm volatile("s_waitcnt lgkmcnt(0)" ::: "memory");
#pragma unroll
    for (int it = 0; it < 8; ++it) {
      const int r = it * 8 + (lane >> 3), ch = lane & 7;
      const int row = rbase0 + r;
      if (row < ROWS) {
        int isP, sq, t;
        decode_row(row, isP, sq, t);
        bfr* dst;
        if (REG == 0) dst = (bfr*)(p.ws + W_QB) + (long)row * 512;
        else if (REG == 1) dst = isP ? (bfr*)(p.ws + W_KBP) + ((long)sq * KP_PAD + t) * 512 : (bfr*)(p.ws + W_KBS) + ((long)sq * S_S + PAST + t) * 512;
        else if (REG == 3) dst = (bfr*)(p.ws + W_GA) + (long)row * 512;
        else if (REG == 4) dst = (bfr*)(p.ws + W_QIB) + (long)row * 256;
        else if (REG == 5) dst = isP ? (bfr*)(p.ws + W_KIBP) + ((long)sq * KP_PAD + t) * 64 : (bfr*)(p.ws + W_KIBS) + ((long)sq * S_S + PAST + t) * 64;
        else if (REG == 6) dst = (bfr*)(p.ws + W_XBB) + (long)row * 512;
        else if (REG == 7) dst = (bfr*)(p.ws + W_GB) + (long)row * 512;
        else if (REG == 8) dst = (bfr*)(p.ws + W_XCB) + (long)row * 512;
        else if (REG == 9) dst = (bfr*)(p.ws + W_GC) + (long)row * 512;
        else dst = (bfr*)(p.ws + W_GM) + (long)row * 3072;
        const uint4 val = *(const uint4*)(img + r * EPI_PITCH + ch * 8);
        *(uint4*)(dst + rel + ch * 8) = val;
      }
    }
  }
}

DI void epi_inproj(const Params& p, int layer, f32x4 (&acc)[4][4], int brow, int bcol) {
  const int tid = get_tid(), wid = __builtin_amdgcn_readfirstlane(tid >> 6), lane = tid & 63, wr = wid >> 1, wc = wid & 1;
  const int c0 = bcol + wc * 64;
  const int rb = brow + wr * 64;
  asm volatile("s_waitcnt lgkmcnt(0)" ::: "memory");
  __builtin_amdgcn_s_barrier();
  if (c0 < C_K) epi_region<0>(p, layer, acc, rb, c0 - C_Q, lane, wid);
  else if (c0 < C_V) epi_region<1>(p, layer, acc, rb, c0 - C_K, lane, wid);
  else if (c0 < C_GA) epi_region<2>(p, layer, acc, rb, c0 - C_V, lane, wid);
  else if (c0 < C_QI) epi_region<3>(p, layer, acc, rb, c0 - C_GA, lane, wid);
  else if (c0 < C_KI) epi_region<4>(p, layer, acc, rb, c0 - C_QI, lane, wid);
  else if (c0 < C_XB) epi_region<5>(p, layer, acc, rb, c0 - C_KI, lane, wid);
  else if (c0 < C_GB) epi_region<6>(p, layer, acc, rb, c0 - C_XB, lane, wid);
  else if (c0 < C_XC) epi_region<7>(p, layer, acc, rb, c0 - C_GB, lane, wid);
  else if (c0 < C_GC) epi_region<8>(p, layer, acc, rb, c0 - C_XC, lane, wid);
  else if (c0 < C_GM) epi_region<9>(p, layer, acc, rb, c0 - C_GC, lane, wid);
  else if (c0 < C_WI) epi_region<10>(p, layer, acc, rb, c0 - C_GM, lane, wid);
  else epi_region<11>(p, layer, acc, rb, c0 - C_WI, lane, wid);
}

DI void phase_inproj(const Params& p, int layer, char*) {
  const bfr* A = (const bfr*)(p.ws + W_HN);
  const bfr* Bt = (const bfr*)(p.ws + W_WINT) + (long)layer * NPAD * 1024;
  constexpr int NTM = MPAD / 128, NTN = NPAD / 128;
  const int rank = sh_xinfo[0], nloc = sh_xinfo[1], ia = sh_xinfo[2], na = sh_xinfo[3];
  const int nbase = NTN / na, nrem = NTN % na;
  const int nn = nbase + (ia < nrem ? 1 : 0), n0 = ia * nbase + min(ia, nrem);
  const int target = (NTM * NTN + na - 1) / na;
  const int keep = min(NTM * nn, target);
  int poff = 0, stot = 0;
  for (int a = 0; a < na; ++a) {
    const int o = NTM * (nbase + (a < nrem ? 1 : 0)), kp = min(o, target);
    if (a < ia) poff += target - kp;
    stot += o - kp;
  }
  const int dend = min(poff + (target - keep), stot);
  const int kown = rank < keep ? (keep - rank + nloc - 1) / nloc : 0;
  auto get_tile = [&](int k, int& tm_, int& tn_) -> bool {
    if (k < kown) { const int i = rank + k * nloc; tm_ = i / nn; tn_ = n0 + (i - tm_ * nn); return true; }
    const int e = poff + rank + (k - kown) * nloc;
    if (e >= dend) return false;
    int accs = 0;
    for (int a = 0; a < na; ++a) {
      const int nna = nbase + (a < nrem ? 1 : 0), o = NTM * nna, kp = min(o, target), sp = o - kp;
      if (e < accs + sp) {
        const int i = kp + (e - accs);
        tm_ = i / nna;
        tn_ = a * nbase + min(a, nrem) + (i - tm_ * nna);
        return true;
      }
      accs += sp;
    }
    return false;
  };
  bool first = true;
  int tm = 0, tn = 0;
  bool have = get_tile(0, tm, tn);
#pragma unroll 1
  for (int k = 0; have; ++k) {
    int tm2 = 0, tn2 = 0;
    const bool nxt = get_tile(k + 1, tm2, tn2);
    const int nbr = nxt ? tm2 * 128 : -1, nbc = tn2 * 128;
    f32x4 acc[4][4];
#pragma unroll
    for (int m = 0; m < 4; ++m)
#pragma unroll
      for (int n = 0; n < 4; ++n) acc[m][n] = f32x4{0.f, 0.f, 0.f, 0.f};
    gemm128<4>(A, 1024, Bt, 1024, 1024, tm * 128, tn * 128, smem, acc, true, first, nbr, nbc);
    first = false;
    epi_inproj(p, layer, acc, tm * 128, tn * 128);
    tm = tm2; tn = tn2; have = nxt;
  }
}

template <int NF>
DI void merge_tile(const Params& p, int layer, int brow, int bcol, bool& first, bool hasNext, int nbrow, int nbcol) {
  const int tid = get_tid(), wid = __builtin_amdgcn_readfirstlane(tid >> 6), lane = tid & 63, wr = wid >> 1, wc = wid & 1, fr = lane & 15, fq = lane >> 4;
  const bfr* gmb = (const bfr*)(p.ws + W_GM);
  bfr* merged = (bfr*)(p.ws + W_HN);
  unsigned tot[4][NF][2];
#pragma unroll
  for (int m = 0; m < 4; ++m)
#pragma unroll
    for (int n = 0; n < NF; ++n) { tot[m][n][0] = 0u; tot[m][n][1] = 0u; }
#pragma unroll 1
  for (int br = 0; br < 3; ++br) {
    const bfr* A = (const bfr*)(p.ws + (br == 0 ? W_GA : (br == 1 ? W_GB : W_GC)));
    const bfr* Bt = (const bfr*)(p.ws + W_WBT) + (long)(layer * 3 + br) * 1024 * 512;
    const bfr* nA = (const bfr*)(p.ws + (br == 0 ? W_GB : (br == 1 ? W_GC : W_GA)));
    const bfr* nBt = (const bfr*)(p.ws + W_WBT) + (long)(layer * 3 + (br == 2 ? 0 : br + 1)) * 1024 * 512;
    const bool nx = br < 2 || hasNext;
    f32x4 acc[4][NF];
#pragma unroll
    for (int m = 0; m < 4; ++m)
#pragma unroll
      for (int n = 0; n < NF; ++n) acc[m][n] = f32x4{0.f, 0.f, 0.f, 0.f};
    gemm128<NF>(A, 512, Bt, 512, 512, brow, bcol, smem, acc, true, first, nx ? (br < 2 ? brow : nbrow) : -1, br < 2 ? bcol : nbcol, nA, nBt);
    first = false;
#pragma unroll
    for (int m = 0; m < 4; ++m) {
      const int row0 = brow + wr * 64 + m * 16 + fq * 4;
      if (row0 < ROWS) {
#pragma unroll
        for (int n = 0; n < NF; ++n) {
          const int col = bcol + wc * (NF * 16) + n * 16 + fr;
          const bfr* gp = gmb + (long)row0 * 3072 + br * 1024 + col;
          const float g0 = bf2f(gp[0]), g1 = bf2f(gp[3072]), g2 = bf2f(gp[2 * 3072]), g3 = bf2f(gp[3 * 3072]);
          const unsigned t0 = tot[m][n][0], t1 = tot[m][n][1];
          tot[m][n][0] = pack2(__uint_as_float(t0 << 16) + g0 * acc[m][n][0], __uint_as_float(t0 & 0xFFFF0000u) + g1 * acc[m][n][1]);
          tot[m][n][1] = pack2(__uint_as_float(t1 << 16) + g2 * acc[m][n][2], __uint_as_float(t1 & 0xFFFF0000u) + g3 * acc[m][n][3]);
        }
      }
    }
  }
#pragma unroll
  for (int m = 0; m < 4; ++m) {
    const int row0 = brow + wr * 64 + m * 16 + fq * 4;
    if (row0 < ROWS) {
#pragma unroll
      for (int n = 0; n < NF; ++n) {
        bfr* mp = merged + (long)row0 * 1024 + bcol + wc * (NF * 16) + n * 16 + fr;
        mp[0] = (bfr)(tot[m][n][0] & 0xFFFFu); mp[1024] = (bfr)(tot[m][n][0] >> 16);
        mp[2048] = (bfr)(tot[m][n][1] & 0xFFFFu); mp[3072] = (bfr)(tot[m][n][1] >> 16);
      }
    }
  }
}

DI void phase_merge(const Params& p, int layer, char*) {
  constexpr int NTM = MPAD / 128, NTN = 8, NT = NTM * NTN;
  const int G = gridDim.x;
  const int nfull = (NT / G) * G, rem = NT - nfull;
  const bool split = rem > 0 && 2 * rem <= G;
  const int lim = split ? nfull : NT;
  const bool cv = (layer == 0);
  if (cv && (blockIdx.x & 1)) convert_cache(p, 1, smem);
  bool first = true;
  for (int tile = blockIdx.x; tile < lim; tile += G) {
    const int tn = tile / NTM, tm = tile % NTM;
    const int t2 = tile + G;
    const bool hasNext = t2 < lim;
    merge_tile<4>(p, layer, tm * 128, tn * 128, first, hasNext, (t2 % NTM) * 128, (t2 / NTM) * 128);
  }
  if (split && (int)blockIdx.x < 2 * rem) {
    const int tile = nfull + ((int)blockIdx.x >> 1), half = blockIdx.x & 1;
    const int tn = tile / NTM, tm = tile % NTM;
    bool f2 = true;
    merge_tile<2>(p, layer, tm * 128, tn * 128 + half * 64, f2, false, 0, 0);
  }
  if (cv && !(blockIdx.x & 1)) { __syncthreads(); convert_cache(p, 1, smem); }
}

template <int NF>
DI void out_tile(const Params& p, int layer, int brow, int bcol, bool& first, bool hasNext, int nbrow, int nbcol) {
  const int tid = get_tid(), wid = __builtin_amdgcn_readfirstlane(tid >> 6), lane = tid & 63, wr = wid >> 1, wc = wid & 1, fr = lane & 15, fq = lane >> 4;
  const bfr* A = (const bfr*)(p.ws + W_HN);
  const bfr* Bt = (const bfr*)(p.ws + W_WOT) + (long)layer * 1024 * 1024;
  float* xres = (float*)(p.ws + W_XRES);
  f32x4 acc[4][NF];
#pragma unroll
  for (int m = 0; m < 4; ++m)
#pragma unroll
    for (int n = 0; n < NF; ++n) acc[m][n] = f32x4{0.f, 0.f, 0.f, 0.f};
  gemm128<NF>(A, 1024, Bt, 1024, 1024, brow, bcol, smem, acc, true, first, hasNext ? nbrow : -1, nbcol);
  first = false;
#pragma unroll
  for (int m = 0; m < 4; ++m)
#pragma unroll
    for (int j = 0; j < 4; ++j) {
      int row = brow + wr * 64 + m * 16 + fq * 4 + j;
      if (row < ROWS) {
#pragma unroll
        for (int n = 0; n < NF; ++n) xres[(long)row * 1024 + bcol + wc * (NF * 16) + n * 16 + fr] += acc[m][n][j];
      }
    }
}

DI void phase_out(const Params& p, int layer, char*) {
  constexpr int NTM = MPAD / 128, NTN = 8, NT = NTM * NTN;
  const int G = gridDim.x;
  const int nfull = (NT / G) * G, rem = NT - nfull;
  const bool split = rem > 0 && 2 * rem <= G;
  const int lim = split ? nfull : NT;
  bool first = true;
  for (int tile = blockIdx.x; tile < lim; tile += G) {
    const int tn = tile / NTM, tm = tile % NTM;
    const int t2 = tile + G;
    out_tile<4>(p, layer, tm * 128, tn * 128, first, t2 < lim, (t2 % NTM) * 128, (t2 / NTM) * 128);
  }
  if (split && (int)blockIdx.x < 2 * rem) {
    const int tile = nfull + ((int)blockIdx.x >> 1), half = blockIdx.x & 1;
    const int tn = tile / NTM, tm = tile % NTM;
    bool f2 = true;
    out_tile<2>(p, layer, tm * 128, tn * 128 + half * 64, f2, false, 0, 0);
  }
}

constexpr int SEL_QS = 2120;
DI void select_item(const Params& p, int isP, int sq, int c, int sub, char*) {
  const int tid = get_tid(), wid = __builtin_amdgcn_readfirstlane(tid >> 6), lane = tid & 63, fr = lane & 15, fq = lane >> 4;
  int T0, nadm, rowbase;
  const bfr* kib;
  if (isP) {
    if (c == 0) { T0 = 0; nadm = 16; } else { T0 = 16 + 64 * (c - 1) + 16 * sub; nadm = 16 + 64 * c; }
    rowbase = sq * T_P;
    kib = (const bfr*)(p.ws + W_KIBP) + (long)sq * KP_PAD * 64;
  } else {
    T0 = 16 * sub; nadm = S_S; rowbase = ROWS_P + sq * 64;
    kib = (const bfr*)(p.ws + W_KIBS) + (long)sq * S_S * 64;
  }
  unsigned* maskg = (unsigned*)(p.ws + W_MASK);
  const int nsteps = (nadm + 31) >> 5;
  if (nadm <= 256) {
    for (int e = tid; e < 16 * nsteps; e += 256) {
      int q = e / nsteps, s = e - q * nsteps;
      unsigned w = (s * 32 + 32 <= nadm) ? 0xFFFFFFFFu : 0xFFFFu;
      maskg[(long)(rowbase + T0 + q) * MW + s] = w;
    }
    return;
  }
  const int nkt = nadm >> 4;
  const int nmine = (nkt - wid + 3) >> 2;
  const int nregs = (nadm + 63) >> 6;
  const bfr* qib = (const bfr*)(p.ws + W_QIB);
  const float* wib = (const float*)(p.ws + W_WIB);
  unsigned* S = (unsigned*)smem;
#pragma unroll 1
  for (int g = 0; g < 4; ++g) {
    const int qrow = rowbase + T0 + g * 4;
    int koff = (wid * 16 + fr) * 64 + fq * 8;
    asm volatile("" : "+v"(koff));
    const bfr* kbase = kib + koff;
    int nm = nmine;
    asm volatile("" : "+v"(nm));
    nm = __builtin_amdgcn_readfirstlane(nm);
    const bfr* qp = qib + (long)(qrow + (fr >> 2)) * 256 + (fr & 3) * 64 + fq * 8;
    const bf16x8 a0 = *(const bf16x8*)qp;
    const bf16x8 a1 = *(const bf16x8*)(qp + 32);
    const float4 w = *(const float4*)(wib + (long)(qrow + fq) * 4);
    unsigned sc[65];
#pragma unroll
    for (int ch = 0; ch < 5; ++ch) {
      if (ch * 13 < nm) {
        bf16x8 b0[13], b1[13];
#pragma unroll
        for (int u = 0; u < 13; ++u) {
          const int ic = min(ch * 13 + u, nm - 1);
          const bfr* kp = kbase + (long)ic * 4096;
          b0[u] = *(const bf16x8*)kp;
          b1[u] = *(const bf16x8*)(kp + 32);
        }
#pragma unroll
        for (int u = 0; u < 13; ++u) {
          const int i = ch * 13 + u;
          f32x4 a = {0.f, 0.f, 0.f, 0.f};
          a = MFMA16(a0, b0[u], a);
          a = MFMA16(a1, b1[u], a);
          float s = w.x * fmaxf(a[0], 0.f) + w.y * fmaxf(a[1], 0.f) + w.z * fmaxf(a[2], 0.f) + w.w * fmaxf(a[3], 0.f);
          sc[i] = (i < nm) ? sortable(s) : 0u;
        }
      } else {
#pragma unroll
        for (int u = 0; u < 13; ++u) sc[ch * 13 + u] = 0u;
      }
      __builtin_amdgcn_sched_barrier(0);
    }
    unsigned v[65];
    __syncthreads();
#pragma unroll
    for (int i = 0; i < 33; ++i) S[fq * SEL_QS + (i * 4 + wid) * 16 + fr] = sc[i];
    __syncthreads();
#pragma unroll
    for (int j = 0; j < 33; ++j) v[j] = S[wid * SEL_QS + j * 64 + lane];
    if (nregs > 33) {
      __syncthreads();
#pragma unroll
      for (int i = 33; i < 65; ++i) S[fq * SEL_QS + (i * 4 + wid - 132) * 16 + fr] = sc[i];
      __syncthreads();
#pragma unroll
      for (int j = 0; j < 32; ++j) v[33 + j] = S[wid * SEL_QS + j * 64 + lane];
    } else {
#pragma unroll
      for (int j = 0; j < 32; ++j) v[33 + j] = 0u;
    }
    int nr = nregs;
    asm volatile("" : "+v"(nr));
    nr = __builtin_amdgcn_readfirstlane(nr);
    unsigned vmax = 0u;
#pragma unroll
    for (int r = 0; r < 65; ++r) vmax = max(vmax, v[r]);
#pragma unroll
    for (int o = 32; o >= 1; o >>= 1) vmax = max(vmax, (unsigned)__shfl_xor((int)vmax, o));
    vmax = __builtin_amdgcn_readfirstlane(vmax);
    unsigned thr = 0u;
    int exact = 0;
#pragma unroll 1
    for (int bit = 31; bit >= 0; --bit) {
      const unsigned cand = thr | (1u << bit);
      if (cand > vmax) continue;
      int cnt = 0;
#pragma unroll
      for (int ch = 0; ch < 5; ++ch) {
        if (ch * 13 < nr) {
#pragma unroll
          for (int u = 0; u < 13; ++u) cnt += __popcll(__ballot(v[ch * 13 + u] >= cand));
        }
      }
      if (cnt >= 256) {
        thr = cand;
        if (cnt == 256) { exact = 1; break; }
      }
    }
    if (exact) {
      unsigned mn = 0xFFFFFFFFu;
#pragma unroll
      for (int r = 0; r < 65; ++r) mn = min(mn, v[r] >= thr ? v[r] : 0xFFFFFFFFu);
#pragma unroll
      for (int o = 32; o >= 1; o >>= 1) mn = min(mn, (unsigned)__shfl_xor((int)mn, o));
      thr = __builtin_amdgcn_readfirstlane(mn);
    }
    int gt = 0, eq = 0;
#pragma unroll
    for (int r = 0; r < 65; ++r) {
      gt += __popcll(__ballot(v[r] > thr));
      eq += __popcll(__ballot(v[r] == thr));
    }
    const int need = 256 - gt;
    int idxcut = 0x7fffffff;
    if (eq != need) {
      int run = 0;
      bool done = false;
#pragma unroll
      for (int r = 0; r < 65; ++r) {
        if (!done) {
          unsigned long long m = __ballot(v[r] == thr);
          int pc = __popcll(m);
          if (run + pc >= need) {
            const int k = need - run;
            for (int t = 1; t < k; ++t) m &= m - 1ull;
            idxcut = r * 64 + (__ffsll((long long)m) - 1);
            done = true;
          } else run += pc;
        }
      }
    }
    unsigned* mrowp = maskg + (long)(qrow + wid) * MW;
#pragma unroll
    for (int r = 0; r < 65; ++r) {
      if (r < nr) {
        const bool sel = (v[r] > thr) || (v[r] == thr && (r * 64 + lane) <= idxcut);
        const unsigned long long bal = __ballot(sel);
        if (lane == 0) *(uint2*)(mrowp + r * 2) = make_uint2((unsigned)bal, (unsigned)(bal >> 32));
      }
    }
  }
}

DI void lru_tile(const Params& p, int layer, int isP, int sq, int tile, int nb, int pass, char*) {
  const int tid = get_tid(), wid = __builtin_amdgcn_readfirstlane(tid >> 6), lane = tid & 63, fr = lane & 15, fq = lane >> 4;
  float* xbs = (float*)smem;
  float* as_ = xbs;
  float* xcs = xbs + 67 * 64;
  float* bs_ = xcs + 64 * 64;
  float* ab = bs_ + 64 * 64;
  bfr* xca = (bfr*)(ab + 512);
  const int T = isP ? T_P : T_S;
  const int rowbase = isP ? sq * T_P : ROWS_P + sq * 64;
  const int t0 = tile * 64, ch0 = nb * 64;
  const bfr* xbb = (const bfr*)(p.ws + W_XBB);
  bfr* gby = (bfr*)(p.ws + W_GB);
  float* agg = (float*)(p.ws + W_AGG);
  const bfr* WaT = (const bfr*)(p.ws + W_WAT) + (long)(layer * 8 + nb) * 4096;
  const bfr* WxT = (const bfr*)(p.ws + W_WXT) + (long)(layer * 8 + nb) * 4096;
  bf16x8 wfa0[4], wfa1[4], wfx0[4], wfx1[4];
  float pbav[4], pbxv[4], plam[4];
#pragma unroll
  for (int nt = 0; nt < 4; ++nt) {
    const int d = nt * 16 + fr;
    wfa0[nt] = *(const bf16x8*)(WaT + d * 64 + fq * 8); wfa1[nt] = *(const bf16x8*)(WaT + d * 64 + 32 + fq * 8);
    wfx0[nt] = *(const bf16x8*)(WxT + d * 64 + fq * 8); wfx1[nt] = *(const bf16x8*)(WxT + d * 64 + 32 + fq * 8);
    pbav[nt] = p.lru_ba[layer * 512 + ch0 + d]; pbxv[nt] = p.lru_bx[layer * 512 + ch0 + d];
    plam[nt] = p.lru_lambda[layer * 512 + ch0 + d];
  }
  const float pcb = p.conv_b[layer * 512 + ch0 + (tid & 63)];
  const float pw0 = p.conv_w[(layer * 4 + 0) * 512 + ch0 + (tid & 63)], pw1 = p.conv_w[(layer * 4 + 1) * 512 + ch0 + (tid & 63)],
              pw2 = p.conv_w[(layer * 4 + 2) * 512 + ch0 + (tid & 63)], pw3 = p.conv_w[(layer * 4 + 3) * 512 + ch0 + (tid & 63)];
  {
    const int c = tid & 63;
    float vv[17];
#pragma unroll
    for (int i = 0; i < 17; ++i) {
      const int rr = i * 4 + (tid >> 6);
      const int tt = t0 - 3 + rr;
      float v = 0.f;
      if (rr < 67) {
        if (tt < 0) { if (!isP) v = p.state_conv[((long)(layer * NB_S + sq) * 3 + (3 + tt)) * 512 + ch0 + c]; }
        else if (tt < T) v = bf2f(xbb[(long)(rowbase + tt) * 512 + ch0 + c]);
      }
      vv[i] = v;
    }
#pragma unroll
    for (int i = 0; i < 17; ++i) { const int rr = i * 4 + (tid >> 6); if (rr < 67) xbs[rr * 64 + c] = vv[i]; }
  }
  __syncthreads();
  {
    const int c = tid & 63;
    const float cb = pcb, w0 = pw0, w1 = pw1, w2 = pw2, w3 = pw3;
    for (int t = tid >> 6; t < 64; t += 4) {
      float xc = cb + w0 * xbs[t * 64 + c] + w1 * xbs[(t + 1) * 64 + c] + w2 * xbs[(t + 2) * 64 + c] + w3 * xbs[(t + 3) * 64 + c];
      xcs[t * 64 + c] = xc;
      xca[t * 72 + c] = f2bf(xc);
    }
  }
  __syncthreads();
  {
    bf16x8 af0 = *(const bf16x8*)(xca + (wid * 16 + fr) * 72 + fq * 8);
    bf16x8 af1 = *(const bf16x8*)(xca + (wid * 16 + fr) * 72 + 32 + fq * 8);
#pragma unroll
    for (int nt = 0; nt < 4; ++nt) {
      const int d = nt * 16 + fr;
      const bf16x8 ba0 = wfa0[nt], ba1 = wfa1[nt], bx0 = wfx0[nt], bx1 = wfx1[nt];
      f32x4 ar = {0.f, 0.f, 0.f, 0.f}, ai = {0.f, 0.f, 0.f, 0.f};
      ar = MFMA16(af0, ba0, ar); ar = MFMA16(af1, ba1, ar);
      ai = MFMA16(af0, bx0, ai); ai = MFMA16(af1, bx1, ai);
      const float bav = pbav[nt], bxv = pbxv[nt];
      const float sp = log1pf(__expf(-plam[nt]));
#pragma unroll
      for (int j = 0; j < 4; ++j) {
        const int t = wid * 16 + fq * 4 + j;
        float r = sigm(ar[j] + bav), ig = sigm(ai[j] + bxv);
        float la = -8.f * r * sp;
        float a = __expf(la);
        float b = sqrtf(1.f - __expf(2.f * la)) * (ig * xcs[t * 64 + d]);
        if (t0 + t >= T) { a = 1.f; b = 0.f; }
        as_[t * 64 + d] = a;
        bs_[t * 64 + d] = b;
      }
    }
  }
  __syncthreads();
  const int c = tid & 63;
  {
    float A = 1.f, B = 0.f;
#pragma unroll
    for (int tt = 0; tt < 16; ++tt) {
      float a = as_[(wid * 16 + tt) * 64 + c], b = bs_[(wid * 16 + tt) * 64 + c];
      A *= a; B = a * B + b;
    }
    ab[(wid * 64 + c) * 2] = A;
    ab[(wid * 64 + c) * 2 + 1] = B;
  }
  __syncthreads();
  if (pass == 0) {
    if (wid == 0) {
      float A = 1.f, B = 0.f;
#pragma unroll
      for (int w = 0; w < 4; ++w) { float a = ab[(w * 64 + c) * 2], b = ab[(w * 64 + c) * 2 + 1]; A *= a; B = a * B + b; }
      *(float2*)(agg + ((long)(sq * NTILE_P + tile) * 512 + ch0 + c) * 2) = make_float2(A, B);
    }
  } else {
    float h = isP ? 0.f : p.state_lru[(long)(layer * NB_S + sq) * 512 + ch0 + c];
    for (int i0 = 0; i0 < tile; i0 += 16) {
      float2 e[16];
#pragma unroll
      for (int u = 0; u < 16; ++u)
        e[u] = (i0 + u < tile) ? *(const float2*)(agg + ((long)(sq * NTILE_P + i0 + u) * 512 + ch0 + c) * 2) : make_float2(1.f, 0.f);
#pragma unroll
      for (int u = 0; u < 16; ++u) h = e[u].x * h + e[u].y;
    }
    for (int w = 0; w < wid; ++w) h = ab[(w * 64 + c) * 2] * h + ab[(w * 64 + c) * 2 + 1];
#pragma unroll
    for (int tt = 0; tt < 16; ++tt) {
      const int t = wid * 16 + tt;
      h = as_[t * 64 + c] * h + bs_[t * 64 + c];
      if (t0 + t < T) {
        const long idx = (long)(rowbase + t0 + t) * 512 + ch0 + c;
        gby[idx] = f2bf(h * bf2f(gby[idx]));
        if (t0 + t == T - 1) {
          if (isP) p.out[O_LRUP + (long)(layer * NB_P + sq) * 512 + ch0 + c] = h;
          else p.out[O_LRUS + (long)(layer * NB_S + sq) * 512 + ch0 + c] = h;
        }
      }
    }
  }
}

DI void pool_item(const Params& p, int layer, int isP, int sq, int tile, int g, char*) {
  const int tid = get_tid(), wid = __builtin_amdgcn_readfirstlane(tid >> 6), lane = tid & 63, fr = lane & 15, fq = lane >> 4;
  float* xps = (float*)smem;
  bfr* pa = (bfr*)(xps + 79 * 128);
  const int T = isP ? T_P : T_S;
  const int rowbase = isP ? sq * T_P : ROWS_P + sq * 64;
  const int t0 = tile * 64, ch0 = g * 128;
  const bfr* xcb = (const bfr*)(p.ws + W_XCB);
  bfr* gcy = (bfr*)(p.ws + W_GC);
  {
    const int c = tid & 127;
#pragma unroll
    for (int b8 = 0; b8 < 5; ++b8) {
      float vv[8];
#pragma unroll
      for (int u = 0; u < 8; ++u) {
        const int rr = (b8 * 8 + u) * 2 + (tid >> 7);
        const int tt = t0 - 15 + rr;
        float v = 0.f;
        if (rr < 79) {
          if (tt < 0) { if (!isP) v = p.state_pool[((long)(layer * NB_S + sq) * 15 + (15 + tt)) * 512 + ch0 + c]; }
          else if (tt < T) v = bf2f(xcb[(long)(rowbase + tt) * 512 + ch0 + c]);
        }
        vv[u] = v;
      }
#pragma unroll
      for (int u = 0; u < 8; ++u) { const int rr = (b8 * 8 + u) * 2 + (tid >> 7); if (rr < 79) xps[rr * 128 + c] = vv[u]; }
    }
  }
  __syncthreads();
  {
    const int c = tid & 127;
    const int w = 2 << g;
    const int nh = isP ? 0 : PAST;
    for (int t = tid >> 7; t < 64; t += 2) {
      float s = 0.f;
      for (int i = 0; i < w; ++i) s += xps[(15 + t - i) * 128 + c];
      int cnt = min(w, t0 + t + 1 + nh);
      float v = s / (float)cnt - xps[(15 + t) * 128 + c];
      pa[t * 136 + c] = f2bf(v);
    }
  }
  __syncthreads();
  {
    const bfr* PwT = (const bfr*)(p.ws + W_PWT) + (long)(layer * 4 + g) * 16384;
    bf16x8 af[4];
#pragma unroll
    for (int ks = 0; ks < 4; ++ks) af[ks] = *(const bf16x8*)(pa + (wid * 16 + fr) * 136 + ks * 32 + fq * 8);
#pragma unroll
    for (int nt = 0; nt < 8; ++nt) {
      const int d = nt * 16 + fr;
      f32x4 acc = {0.f, 0.f, 0.f, 0.f};
#pragma unroll
      for (int ks = 0; ks < 4; ++ks) {
        bf16x8 bq = *(const bf16x8*)(PwT + d * 128 + ks * 32 + fq * 8);
        acc = MFMA16(af[ks], bq, acc);
      }
      const float scl = p.pool_scale[layer * 512 + ch0 + d];
#pragma unroll
      for (int j = 0; j < 4; ++j) {
        const int t = wid * 16 + fq * 4 + j;
        if (t0 + t < T) {
          const long idx = (long)(rowbase + t0 + t) * 512 + ch0 + d;
          gcy[idx] = f2bf(acc[j] * scl * bf2f(gcy[idx]));
        }
      }
    }
  }
}

DI void kmax_item(const Params& p, int seq, int h, char*) {
  const int tid = get_tid(), wid = __builtin_amdgcn_readfirstlane(tid >> 6), lane = tid & 63;
  const bfr* kb; int S;
  if (seq < NB_P) { kb = (const bfr*)(p.ws + W_KBP) + (long)seq * KP_PAD * 512; S = T_P; }
  else { kb = (const bfr*)(p.ws + W_KBS) + (long)(seq - NB_P) * S_S * 512; S = S_S; }
  float mx = 0.f;
  for (int key = tid; key < S; key += 256) {
    const uint4* r = (const uint4*)(kb + (long)key * 512 + h * 64);
    float ss = 0.f;
#pragma unroll
    for (int i = 0; i < 8; ++i) {
      uint4 v = r[i];
      unsigned u[4] = {v.x, v.y, v.z, v.w};
#pragma unroll
      for (int j = 0; j < 4; ++j) {
        float a = __uint_as_float(u[j] << 16), b = __uint_as_float(u[j] & 0xFFFF0000u);
        ss += a * a + b * b;
      }
    }
    mx = fmaxf(mx, ss);
  }
#pragma unroll
  for (int o = 32; o >= 1; o >>= 1) mx = fmaxf(mx, __shfl_xor(mx, o));
  float* red = (float*)smem;
  if (lane == 0) red[wid] = mx;
  __syncthreads();
  if (tid == 0) ((float*)(p.ws + W_KMAX))[seq * 8 + h] = fmaxf(fmaxf(red[0], red[1]), fmaxf(red[2], red[3]));
}

DI void attn_unit(const Params& p, int isP, int sq, int c, int h, int half, size_t dstoff = W_GA) {
  const int lane = get_tid() & 63, fr = lane & 15, fq = lane >> 4;
  int T0, nqt, nadm, rowbase, vld;
  const bfr *kb, *vt;
  if (isP) {
    if (c == 0) { T0 = 0; nqt = 1; nadm = 16; } else { T0 = 16 + 64 * (c - 1) + 32 * half; nqt = 2; nadm = 16 + 64 * c; }
    rowbase = sq * T_P;
    kb = (const bfr*)(p.ws + W_KBP) + (long)sq * KP_PAD * 512;
    vt = (const bfr*)(p.ws + W_VTP) + (long)sq * 512 * KP_PAD;
    vld = KP_PAD;
  } else {
    T0 = 32 * half; nqt = 2; nadm = S_S; rowbase = ROWS_P + sq * 64;
    kb = (const bfr*)(p.ws + W_KBS) + (long)sq * S_S * 512;
    vt = (const bfr*)(p.ws + W_VTS) + (long)sq * 512 * S_S;
    vld = S_S;
  }
  const int nsteps = (nadm + 31) >> 5;
  const int qrow0 = rowbase + T0;
  const bfr* qb = (const bfr*)(p.ws + W_QB);
  const unsigned* maskg = (const unsigned*)(p.ws + W_MASK);
  bf16x8 qf[2][2];
#pragma unroll
  for (int qt = 0; qt < 2; ++qt)
#pragma unroll
    for (int ks = 0; ks < 2; ++ks) {
      int r = qrow0 + (qt < nqt ? qt * 16 : 0) + fr;
      qf[qt][ks] = *(const bf16x8*)(qb + (long)r * 512 + h * 64 + ks * 32 + fq * 8);
    }
  f32x4 o[2][4];
#pragma unroll
  for (int qt = 0; qt < 2; ++qt)
#pragma unroll
    for (int dt = 0; dt < 4; ++dt) o[qt][dt] = f32x4{0.f, 0.f, 0.f, 0.f};
  const float sc2 = 0.125f * 1.4426950408889634f;
  const float kmax2 = ((const float*)(p.ws + W_KMAX))[(isP ? sq : NB_P + sq) * 8 + h];
  float mref[2], lsum[2] = {0.f, 0.f};
#pragma unroll
  for (int qt = 0; qt < 2; ++qt) {
    float ss = 0.f;
#pragma unroll
    for (int ks = 0; ks < 2; ++ks)
#pragma unroll
      for (int i = 0; i < 8; ++i) { float a = bf2f((bfr)qf[qt][ks][i]); ss += a * a; }
    ss += __shfl_xor(ss, 16);
    ss += __shfl_xor(ss, 32);
    mref[qt] = sqrtf(ss * kmax2) * sc2;
  }
  const unsigned* mrow0 = maskg + (long)(qrow0 + fr) * MW;
  const unsigned* mrow1 = maskg + (long)(qrow0 + (nqt > 1 ? 16 : 0) + fr) * MW;
  const int kofs = (fr >> 2) * 8 + (fr & 3);
  const bfr* kptr = kb + (long)kofs * 512 + h * 64 + fq * 8;
  const bfr* vptr = vt + (long)(h * 64 + fr) * vld + fq * 8;
  bf16x8 ka0 = *(const bf16x8*)kptr, ka1 = *(const bf16x8*)(kptr + 32);
  bf16x8 kb0 = *(const bf16x8*)(kptr + 4 * 512), kb1 = *(const bf16x8*)(kptr + 4 * 512 + 32);
  bf16x8 vf[4];
#pragma unroll
  for (int dt = 0; dt < 4; ++dt) vf[dt] = *(const bf16x8*)(vptr + (long)dt * 16 * vld);
  unsigned mw0 = mrow0[0], mw1 = mrow1[0];
  for (int s = 0; s < nsteps; ++s) {
    const int sn = min(s + 1, nsteps - 1);
    const bfr* pa = kptr + (long)sn * 32 * 512;
    const bf16x8 nka0 = *(const bf16x8*)pa, nka1 = *(const bf16x8*)(pa + 32);
    const bf16x8 nkb0 = *(const bf16x8*)(pa + 4 * 512), nkb1 = *(const bf16x8*)(pa + 4 * 512 + 32);
    bf16x8 nvf[4];
#pragma unroll
    for (int dt = 0; dt < 4; ++dt) nvf[dt] = *(const bf16x8*)(vptr + (long)dt * 16 * vld + sn * 32);
    const unsigned nmw0 = mrow0[sn], nmw1 = mrow1[sn];
#pragma unroll
    for (int qt = 0; qt < 2; ++qt) {
      if (qt < nqt) {
        f32x4 sa = {0.f, 0.f, 0.f, 0.f}, sb = {0.f, 0.f, 0.f, 0.f};
        sa = MFMA16(ka0, qf[qt][0], sa); sa = MFMA16(ka1, qf[qt][1], sa);
        sb = MFMA16(kb0, qf[qt][0], sb); sb = MFMA16(kb1, qf[qt][1], sb);
        const unsigned mb = ((qt == 0 ? mw0 : mw1) >> (fq * 8)) & 0xFFu;
        float pr[8];
#pragma unroll
        for (int i = 0; i < 4; ++i) {
          float pa_ = __builtin_amdgcn_exp2f(sa[i] * sc2 - mref[qt]);
          float pb_ = __builtin_amdgcn_exp2f(sb[i] * sc2 - mref[qt]);
          pr[i] = ((mb >> i) & 1u) ? pa_ : 0.f;
          pr[4 + i] = ((mb >> (4 + i)) & 1u) ? pb_ : 0.f;
        }
        lsum[qt] += ((pr[0] + pr[1]) + (pr[2] + pr[3])) + ((pr[4] + pr[5]) + (pr[6] + pr[7]));
        union { unsigned u[4]; bf16x8 v; } pk;
        pk.u[0] = pack2(pr[0], pr[1]); pk.u[1] = pack2(pr[2], pr[3]); pk.u[2] = pack2(pr[4], pr[5]); pk.u[3] = pack2(pr[6], pr[7]);
#pragma unroll
        for (int dt = 0; dt < 4; ++dt) o[qt][dt] = MFMA16(vf[dt], pk.v, o[qt][dt]);
      }
    }
    ka0 = nka0; ka1 = nka1; kb0 = nkb0; kb1 = nkb1;
#pragma unroll
    for (int dt = 0; dt < 4; ++dt) vf[dt] = nvf[dt];
    mw0 = nmw0; mw1 = nmw1;
  }
  bfr* gay = (bfr*)(p.ws + W_GA);
  bfr* dsty = (bfr*)(p.ws + dstoff);
#pragma unroll
  for (int qt = 0; qt < 2; ++qt) {
    if (qt < nqt) {
      float l = lsum[qt];
      l += __shfl_xor(l, 16);
      l += __shfl_xor(l, 32);
      const float inv = l > 0.f ? 1.f / l : 0.f;
      const long rowoff = (long)(qrow0 + qt * 16 + fr) * 512 + h * 64;
#pragma unroll
      for (int dt = 0; dt < 4; ++dt) {
        uint2* ptr = (uint2*)(gay + rowoff + dt * 16 + fq * 4);
        uint2 gv = *ptr;
        float g0 = __uint_as_float(gv.x << 16), g1 = __uint_as_float(gv.x & 0xFFFF0000u);
        float g2 = __uint_as_float(gv.y << 16), g3 = __uint_as_float(gv.y & 0xFFFF0000u);
        uint2 ov;
        ov.x = pack2(o[qt][dt][0] * inv * g0, o[qt][dt][1] * inv * g1);
        ov.y = pack2(o[qt][dt][2] * inv * g2, o[qt][dt][3] * inv * g3);
        *(uint2*)(dsty + rowoff + dt * 16 + fq * 4) = ov;
      }
    }
  }
}

#define XB_TMO      128
#define XB_XCNT(j)  (256  + 64 * (j))
#define XB_XSUB(j)  (1280 + 64 * (j))
#define XB_XGEN(j)  (2304 + 64 * (j))
#define XB_TOP      3328
#define XB_TOPGEN   3392
#define XCD_BAR_WORDS 3456
#define XB_SPIN_CAP (1u << 18)
#define LAS __attribute__((address_space(3)))

__device__ __forceinline__ unsigned xb_ld(unsigned* p)              { return __hip_atomic_load(p, __ATOMIC_RELAXED, __HIP_MEMORY_SCOPE_AGENT); }
__device__ __forceinline__ unsigned xb_add(unsigned* p, unsigned v) { return __hip_atomic_fetch_add(p, v, __ATOMIC_RELAXED, __HIP_MEMORY_SCOPE_AGENT); }
__device__ __forceinline__ unsigned xb_xcc_id() { return (unsigned)__builtin_amdgcn_s_getreg((3 << 11) | 20) & 0xFu; }
#define XB_SPIN(cond, bar) do { unsigned _sp = 0; while (cond) { __builtin_amdgcn_s_sleep(1); \
    if ((++_sp & 255u) == 0u) { if (xb_ld(&(bar)[XB_TMO])) break; if (_sp > XB_SPIN_CAP) { atomicAdd(&(bar)[XB_TMO], 1u); break; } } } } while (0)

struct XcdBarrier {
    unsigned* bar; unsigned x;
    volatile LAS unsigned* st;
};

__device__ __forceinline__ XcdBarrier xcd_barrier_post(unsigned* bar, volatile LAS unsigned* st) {
    XcdBarrier b; b.bar = bar; b.x = xb_xcc_id(); b.st = st;
    if (threadIdx.x == 0) (void)xb_add(&bar[XB_XCNT(b.x)], 1u);
    return b;
}
__device__ __forceinline__ void xcd_barrier_complete(unsigned* bar, unsigned x, unsigned& nloc, unsigned& nx) {
    const unsigned G = gridDim.x * gridDim.y * gridDim.z;
    unsigned sum, cnt, mine, sp = 0u;
    for (;;) {
        sum = 0u; cnt = 0u; mine = 0u;
#pragma unroll
        for (unsigned j = 0; j < 16; ++j) { const unsigned c = xb_ld(&bar[XB_XCNT(j)]); sum += c; cnt += (c > 0u) ? 1u : 0u; mine = (j == x) ? c : mine; }
        if (sum == G) break;
        __builtin_amdgcn_s_sleep(1);
        if ((++sp & 255u) == 0u) { if (xb_ld(&bar[XB_TMO])) break; if (sp > XB_SPIN_CAP) { atomicAdd(&bar[XB_TMO], 1u); break; } }
    }
    nloc = mine > 0u ? mine : 1u; nx = cnt > 0u ? cnt : 1u;
}

__device__ __forceinline__ void xcd_barrier(const XcdBarrier& b) {
    asm volatile("s_waitcnt vmcnt(0)" ::: "memory");
    __syncthreads();
    if (threadIdx.x == 0) {
        unsigned* bar = b.bar;
        __builtin_amdgcn_s_waitcnt(0);
        unsigned nloc = b.st[0], nx = b.st[1];
        if (nloc == 0u) { xcd_barrier_complete(bar, b.x, nloc, nx); b.st[0] = nloc; b.st[1] = nx; }
        const unsigned old = xb_add(&bar[XB_XSUB(b.x)], 1u);
        const unsigned gen = old / nloc;
        if (old + 1u == (gen + 1u) * nloc) {
            __builtin_amdgcn_fence(__ATOMIC_RELEASE, "agent");
            asm volatile("s_waitcnt vmcnt(0)" ::: "memory");
            const unsigned og = xb_add(&bar[XB_TOP], 1u);
            const unsigned tg = og / nx;
            if (og + 1u == (tg + 1u) * nx) xb_add(&bar[XB_TOPGEN], 1u);
            else XB_SPIN(xb_ld(&bar[XB_TOPGEN]) == tg, bar);
            __builtin_amdgcn_fence(__ATOMIC_ACQUIRE, "agent");
            xb_add(&bar[XB_XGEN(b.x)], 1u);
            asm volatile("s_waitcnt vmcnt(0)" ::: "memory");
        } else {
            XB_SPIN(xb_ld(&bar[XB_XGEN(b.x)]) == gen, bar);
            __builtin_amdgcn_fence(__ATOMIC_ACQUIRE, "agent");
            asm volatile("s_waitcnt vmcnt(0)" ::: "memory");
        }
    }
    __syncthreads();
}


DI void attn_block(const Params& p, int isP, int sq, int c, int h) {
  const int tid = get_tid(), wid = __builtin_amdgcn_readfirstlane(tid >> 6), lane = tid & 63, fr = lane & 15, fq = lane >> 4;
  int T0, nqt, nadm, rowbase, vld;
  const bfr *kb, *vt;
  if (isP) {
    if (c == 0) { T0 = 0; nqt = 1; nadm = 16; } else { T0 = 16 + 64 * (c - 1); nqt = 4; nadm = 16 + 64 * c; }
    rowbase = sq * T_P;
    kb = (const bfr*)(p.ws + W_KBP) + (long)sq * KP_PAD * 512;
    vt = (const bfr*)(p.ws + W_VTP) + (long)sq * 512 * KP_PAD;
    vld = KP_PAD;
  } else {
    T0 = 0; nqt = 4; nadm = S_S; rowbase = ROWS_P + sq * 64;
    kb = (const bfr*)(p.ws + W_KBS) + (long)sq * S_S * 512;
    vt = (const bfr*)(p.ws + W_VTS) + (long)sq * 512 * S_S;
    vld = S_S;
  }
  const int nsteps = (nadm + 31) >> 5;
  const int qrow0 = rowbase + T0;
  const bfr* qb = (const bfr*)(p.ws + W_QB);
  const unsigned* maskg = (const unsigned*)(p.ws + W_MASK);
  bf16x8 qf[4][2];
#pragma unroll
  for (int qt = 0; qt < 4; ++qt)
#pragma unroll
    for (int ks = 0; ks < 2; ++ks) {
      int r = qrow0 + (qt < nqt ? qt * 16 : 0) + fr;
      qf[qt][ks] = *(const bf16x8*)(qb + (long)r * 512 + h * 64 + ks * 32 + fq * 8);
    }
  f32x4 o[4][4];
#pragma unroll
  for (int qt = 0; qt < 4; ++qt)
#pragma unroll
    for (int dt = 0; dt < 4; ++dt) o[qt][dt] = f32x4{0.f, 0.f, 0.f, 0.f};
  const float sc2 = 0.125f * 1.4426950408889634f;
  const float kmax2 = ((const float*)(p.ws + W_KMAX))[(isP ? sq : NB_P + sq) * 8 + h];
  float mref[4], lsum[4] = {0.f, 0.f, 0.f, 0.f};
  const unsigned* mrow[4];
#pragma unroll
  for (int qt = 0; qt < 4; ++qt) {
    float ss = 0.f;
#pragma unroll
    for (int ks = 0; ks < 2; ++ks)
#pragma unroll
      for (int i = 0; i < 8; ++i) { float a = bf2f((bfr)qf[qt][ks][i]); ss += a * a; }
    ss += __shfl_xor(ss, 16);
    ss += __shfl_xor(ss, 32);
    mref[qt] = sqrtf(ss * kmax2) * sc2;
    mrow[qt] = maskg + (long)(qrow0 + (qt < nqt ? qt * 16 : 0) + fr) * MW;
  }
  const int kofs = (fr >> 2) * 8 + (fr & 3);
  const bfr* kptr = kb + (long)kofs * 512 + h * 64 + fq * 8;
  const bfr* vptr = vt + (long)(h * 64 + fr) * vld + fq * 8;
  if (wid < nsteps) {
    int s = wid;
    const bfr* pa0 = kptr + (long)s * 32 * 512;
    bf16x8 ka0 = *(const bf16x8*)pa0, ka1 = *(const bf16x8*)(pa0 + 32);
    bf16x8 kb0 = *(const bf16x8*)(pa0 + 4 * 512), kb1 = *(const bf16x8*)(pa0 + 4 * 512 + 32);
    bf16x8 vf[4];
#pragma unroll
    for (int dt = 0; dt < 4; ++dt) vf[dt] = *(const bf16x8*)(vptr + (long)dt * 16 * vld + s * 32);
    unsigned mw[4];
#pragma unroll
    for (int qt = 0; qt < 4; ++qt) mw[qt] = mrow[qt][s];
    for (; s < nsteps; s += 4) {
      const int sn = (s + 4 < nsteps) ? s + 4 : s;
      const bfr* pa = kptr + (long)sn * 32 * 512;
      const bf16x8 nka0 = *(const bf16x8*)pa, nka1 = *(const bf16x8*)(pa + 32);
      const bf16x8 nkb0 = *(const bf16x8*)(pa + 4 * 512), nkb1 = *(const bf16x8*)(pa + 4 * 512 + 32);
      bf16x8 nvf[4];
#pragma unroll
      for (int dt = 0; dt < 4; ++dt) nvf[dt] = *(const bf16x8*)(vptr + (long)dt * 16 * vld + sn * 32);
      unsigned nmw[4];
#pragma unroll
      for (int qt = 0; qt < 4; ++qt) nmw[qt] = mrow[qt][sn];
#pragma unroll
      for (int qt = 0; qt < 4; ++qt) {
        if (qt < nqt) {
          f32x4 sa = {0.f, 0.f, 0.f, 0.f}, sb = {0.f, 0.f, 0.f, 0.f};
          sa = MFMA16(ka0, qf[qt][0], sa); sa = MFMA16(ka1, qf[qt][1], sa);
          sb = MFMA16(kb0, qf[qt][0], sb); sb = MFMA16(kb1, qf[qt][1], sb);
          const unsigned mb = (mw[qt] >> (fq * 8)) & 0xFFu;
          float pr[8];
#pragma unroll
          for (int i = 0; i < 4; ++i) {
            float pa_ = __builtin_amdgcn_exp2f(sa[i] * sc2 - mref[qt]);
            float pb_ = __builtin_amdgcn_exp2f(sb[i] * sc2 - mref[qt]);
            pr[i] = ((mb >> i) & 1u) ? pa_ : 0.f;
            pr[4 + i] = ((mb >> (4 + i)) & 1u) ? pb_ : 0.f;
          }
          lsum[qt] += ((pr[0] + pr[1]) + (pr[2] + pr[3])) + ((pr[4] + pr[5]) + (pr[6] + pr[7]));
          union { unsigned u[4]; bf16x8 v; } pk;
          pk.u[0] = pack2(pr[0], pr[1]); pk.u[1] = pack2(pr[2], pr[3]); pk.u[2] = pack2(pr[4], pr[5]); pk.u[3] = pack2(pr[6], pr[7]);
#pragma unroll
          for (int dt = 0; dt < 4; ++dt) o[qt][dt] = MFMA16(vf[dt], pk.v, o[qt][dt]);
        }
      }
      ka0 = nka0; ka1 = nka1; kb0 = nkb0; kb1 = nkb1;
#pragma unroll
      for (int dt = 0; dt < 4; ++dt) vf[dt] = nvf[dt];
#pragma unroll
      for (int qt = 0; qt < 4; ++qt) mw[qt] = nmw[qt];
    }
  }
  float* OS = (float*)smem;
  float* LS = OS + 4 * 2048;
  bfr* gay = (bfr*)(p.ws + W_GA);
#pragma unroll
  for (int rd = 0; rd < 2; ++rd) {
    __syncthreads();
#pragma unroll
    for (int q2 = 0; q2 < 2; ++q2) {
      const int qt = rd * 2 + q2;
      float l = lsum[qt];
      l += __shfl_xor(l, 16);
      l += __shfl_xor(l, 32);
      LS[(wid * 2 + q2) * 64 + lane] = l;
#pragma unroll
      for (int dt = 0; dt < 4; ++dt)
#pragma unroll
        for (int j = 0; j < 4; ++j) OS[((wid * 2 + q2) * 16 + dt * 4 + j) * 64 + lane] = o[qt][dt][j];
    }
    __syncthreads();
    const int q2 = wid >> 1, qt = rd * 2 + q2;
    if (qt < nqt) {
      float l = 0.f;
#pragma unroll
      for (int w = 0; w < 4; ++w) l += LS[(w * 2 + q2) * 64 + lane];
      const float inv = l > 0.f ? 1.f / l : 0.f;
      const long rowoff = (long)(qrow0 + qt * 16 + fr) * 512 + h * 64;
#pragma unroll
      for (int d2 = 0; d2 < 2; ++d2) {
        const int dt = (wid & 1) * 2 + d2;
        float acc4[4];
#pragma unroll
        for (int j = 0; j < 4; ++j) {
          float a = 0.f;
#pragma unroll
          for (int w = 0; w < 4; ++w) a += OS[((w * 2 + q2) * 16 + dt * 4 + j) * 64 + lane];
          acc4[j] = a * inv;
        }
        uint2* ptr = (uint2*)(gay + rowoff + dt * 16 + fq * 4);
        uint2 gv = *ptr;
        float g0 = __uint_as_float(gv.x << 16), g1 = __uint_as_float(gv.x & 0xFFFF0000u);
        float g2 = __uint_as_float(gv.y << 16), g3 = __uint_as_float(gv.y & 0xFFFF0000u);
        uint2 ov;
        ov.x = pack2(acc4[0] * g0, acc4[1] * g1);
        ov.y = pack2(acc4[2] * g2, acc4[3] * g3);
        *ptr = ov;
      }
    }
  }
}

DI int pop_block(int* ctr, int*) {
  __syncthreads();
  if (threadIdx.x == 0) sh_item = atomicAdd(ctr, 1);
  __syncthreads();
  return __builtin_amdgcn_readfirstlane(sh_item);
}

constexpr int N_KMAX = 20 * 8;
constexpr int N_SEL = 64 * 16 + 64 + 4;
constexpr int N_LRU1 = NB_P * NTILE_P * 8;
constexpr int N_POOL = NB_P * NTILE_P * 4 + NB_S * 4;
constexpr int N_LRU2 = NB_P * NTILE_P * 8 + NB_S * 8;
constexpr int N_ATT = 64 * 64 + 256 + 32;

DI void phase_b1(const Params& p, int layer, char*, int*) {
  int* ctr = (int*)(p.ws + W_CTR) + layer * 4 + 0;
  for (;;) {
    int it = pop_block(ctr, nullptr);
    if (it >= N_SEL + N_LRU1 + N_POOL + N_KMAX) break;
    if (it >= N_SEL + N_LRU1 + N_POOL) { int j = it - (N_SEL + N_LRU1 + N_POOL); kmax_item(p, j >> 3, j & 7, smem); }
    else if (it < N_SEL) {
      if (it < 1024) { int c = 64 - (it >> 4), b = (it & 15) >> 2, sub = it & 3; select_item(p, 1, b, c, sub, smem); }
      else if (it < 1088) { int j = it - 1024; select_item(p, 0, j >> 2, 0, j & 3, smem); }
      else select_item(p, 1, it - 1088, 0, 0, smem);
    } else if (it < N_SEL + N_LRU1) {
      int j = it - N_SEL;
      int sq = j / (NTILE_P * 8), rem = j % (NTILE_P * 8);
      lru_tile(p, layer, 1, sq, rem >> 3, rem & 7, 0, smem);
    } else {
      int j = it - N_SEL - N_LRU1;
      if (j < NB_P * NTILE_P * 4) { int sq = j / (NTILE_P * 4), rem = j % (NTILE_P * 4); pool_item(p, layer, 1, sq, rem >> 2, rem & 3, smem); }
      else { j -= NB_P * NTILE_P * 4; pool_item(p, layer, 0, j >> 2, 0, j & 3, smem); }
    }
  }
}

constexpr size_t W_DUMMY = W_END;
DI void probe_select(const Params& p, int layer) {
  int* ctr = (int*)(p.ws + W_CTR) + layer * 4 + 3;
  for (;;) {
    int it = pop_block(ctr, nullptr);
    if (it >= N_SEL) break;
    if (it < 1024) { int c = 64 - (it >> 4), b = (it & 15) >> 2, sub = it & 3; select_item(p, 1, b, c, sub, smem); }
    else if (it < 1088) { int j = it - 1024; select_item(p, 0, j >> 2, 0, j & 3, smem); }
    else select_item(p, 1, it - 1088, 0, 0, smem);
  }
}
DI void probe_attn(const Params& p, int layer) {
  int* ctr2 = (int*)(p.ws + W_CTR) + layer * 4 + 3;
  const int lane = get_tid() & 63;
  for (;;) {
    int u = 0;
    if (lane == 0) u = atomicAdd(ctr2, 1);
    u = __builtin_amdgcn_readfirstlane(u);
    if (u >= N_ATT) break;
    if (u < 4096) { int c = 64 - (u >> 6), r = u & 63; attn_unit(p, 1, r >> 4, c, (r >> 1) & 7, r & 1, W_DUMMY); }
    else if (u < 4096 + 256) { int r = u - 4096; attn_unit(p, 0, r >> 4, 0, (r >> 1) & 7, r & 1, W_DUMMY); }
    else { int r = u - 4352; attn_unit(p, 1, r >> 3, 0, r & 7, 0, W_DUMMY); }
  }
}

DI void phase_b2(const Params& p, int layer, char*, int*) {
  int* ctr = (int*)(p.ws + W_CTR) + layer * 4 + 1;
  for (;;) {
    int it = pop_block(ctr, nullptr);
    if (it >= N_LRU2) break;
    if (it < NB_P * NTILE_P * 8) { int sq = it / (NTILE_P * 8), rem = it % (NTILE_P * 8); lru_tile(p, layer, 1, sq, rem >> 3, rem & 7, 1, smem); }
    else { int j = it - NB_P * NTILE_P * 8; lru_tile(p, layer, 0, j >> 3, 0, j & 7, 1, smem); }
  }
  int* ctr2 = (int*)(p.ws + W_CTR) + layer * 4 + 2;
  for (;;) {
    int it = pop_block(ctr2, nullptr);
    if (it >= 2208) break;
    if (it < 2048) { const int c = 64 - (it >> 5), pair = it & 31; attn_block(p, 1, pair >> 3, c, pair & 7); }
    else if (it < 2176) { const int r = it - 2048; attn_block(p, 0, r >> 3, 0, r & 7); }
    else { const int pair = it - 2176; attn_block(p, 1, pair >> 3, 0, pair & 7); }
  }
}

DI Params fresh(const Params& p) {
  Params q = p;
  int z = 0;
  asm volatile("s_mov_b32 %0, 0" : "=s"(z));
  q.ws = p.ws + z;
  q.out = p.out + z;
  return q;
}
DI int fresh_i(int v) {
  asm volatile("" : "+s"(v));
  return v;
}

__shared__ uint4 xb_words;

__global__ void __launch_bounds__(256, 2) fwd_megakernel(Params p) {
  cg::grid_group grid = cg::this_grid();
  if (threadIdx.x == 0) xb_words = make_uint4(0u, 0u, 0u, 0u);
  __syncthreads();
  XcdBarrier xb = xcd_barrier_post((unsigned*)(p.ws + W_BAR), (volatile LAS unsigned*)&xb_words);
  if (threadIdx.x == 0) sh_xinfo[0] = (int)atomicAdd((unsigned*)(p.ws + W_CTR) + 128 + xb.x, 1u);
  prep_phase(fresh(p), smem);
  grid.sync();
  if (threadIdx.x == 0) {
    unsigned* bar = (unsigned*)(p.ws + W_BAR);
    int na = 0, ia = 0, nloc = 1;
    for (unsigned j = 0; j < 16; ++j) {
      const unsigned cj = xb_ld(&bar[XB_XCNT(j)]);
      if (cj > 0u) { if (j < xb.x) ++ia; ++na; }
      if (j == xb.x) nloc = (int)cj;
    }
    sh_xinfo[1] = nloc > 0 ? nloc : 1; sh_xinfo[2] = ia; sh_xinfo[3] = na > 0 ? na : 1;
  }
  __syncthreads();
#if PROBE == 6
#pragma unroll 1
  for (int i = 0; i < 10; ++i) xcd_barrier(xb);
#endif
#pragma unroll 1
  for (int layer = 0; layer < 2; ++layer) {
    phase_inproj(fresh(p), fresh_i(layer), smem);
    xcd_barrier(xb);
#if PROBE == 2
    probe_select(fresh(p), fresh_i(layer));
    xcd_barrier(xb);
#endif
    phase_b1(fresh(p), fresh_i(layer), smem, &sh_item);
    xcd_barrier(xb);
#if PROBE == 3
    probe_attn(fresh(p), fresh_i(layer));
    xcd_barrier(xb);
#endif
    phase_b2(fresh(p), fresh_i(layer), smem, &sh_item);
    xcd_barrier(xb);
    phase_merge(fresh(p), fresh_i(layer), smem);
    xcd_barrier(xb);
#if PROBE == 4
    phase_merge(fresh(p), fresh_i(layer), smem);
    xcd_barrier(xb);
#endif
    phase_out(fresh(p), fresh_i(layer), smem);
    xcd_barrier(xb);
    if (layer == 0) { norm_phase(fresh(p), 1); xcd_barrier(xb); }
    else norm_phase(fresh(p), 2);
  }
}

extern "C" void kernel_launch(void* const* d_in, const int* in_sizes, int n_in, void* d_out, int out_size, void* d_ws,
                              size_t ws_size, hipStream_t stream) {
  constexpr int kDynLds = 65536;
  static int grid_blocks = 0;
  if (!grid_blocks) {
    int dev = 0, cus = 0, per_cu = 0;
    hipGetDevice(&dev);
    hipDeviceGetAttribute(&cus, hipDeviceAttributeMultiprocessorCount, dev);
    hipFuncSetAttribute((const void*)fwd_megakernel, hipFuncAttributeMaxDynamicSharedMemorySize, kDynLds);
    hipOccupancyMaxActiveBlocksPerMultiprocessor(&per_cu, fwd_megakernel, 256, kDynLds);
    if (per_cu > 2) per_cu = 2;
    if (per_cu < 1) per_cu = 1;
    grid_blocks = cus * per_cu;
  }
  if (ws_size < W_END) { fprintf(stderr, "workspace too small: %zu < %zu\n", ws_size, (size_t)W_END); return; }
  Params p{};
  const float** f = (const float**)&p;
  for (int i = 0; i < 23; ++i) f[i] = (const float*)d_in[i];
  p.out = (float*)d_out;
  p.ws = (char*)d_ws;
  hipMemsetAsync(d_ws, 0, 32768, stream);
  void* args[] = {&p};
  hipError_t e = hipLaunchCooperativeKernel((void*)fwd_megakernel, dim3(grid_blocks), dim3(256), args, kDynLds, stream);
  if (e != hipSuccess) fprintf(stderr, "cooperative launch failed: %s (grid %d)\n", hipGetErrorString(e), grid_blocks);
}
```

```cpp
#include <hip/hip_runtime.h>
#include <hip/hip_cooperative_groups.h>
#include <stdint.h>
#include <cstdio>
namespace cg = cooperative_groups;
#ifndef PROBE
#define PROBE 0
#endif

typedef unsigned short bfr;
typedef __attribute__((ext_vector_type(8))) short bf16x8;
typedef __attribute__((ext_vector_type(4))) float f32x4;
typedef __attribute__((ext_vector_type(2))) float f32x2;
typedef __attribute__((ext_vector_type(2))) __bf16 bf2_t;
#define DI __device__ __forceinline__
#define MFMA16(a, b, c) __builtin_amdgcn_mfma_f32_16x16x32_bf16((a), (b), (c), 0, 0, 0)

constexpr int DM = 1024;
constexpr int NB_P = 4, T_P = 4112, SEQ_P = 4096, NMETA = 16;
constexpr int NB_S = 16, T_S = 64, PAST = 2048, S_S = 2112;
constexpr int ROWS_P = NB_P * T_P;
constexpr int ROWS = ROWS_P + NB_S * T_S;
constexpr int MPAD = 17536;
constexpr int NIN = 7492, NPAD = 7552;
constexpr int KP_PAD = 4128;
constexpr int MW = 132;
constexpr int NTILE_P = 65;

constexpr int C_Q = 0, C_K = 512, C_V = 1024, C_GA = 1536, C_QI = 2048, C_KI = 2304, C_XB = 2368, C_GB = 2880,
              C_XC = 3392, C_GC = 3904, C_GM = 4416, C_WI = 7488;

constexpr long O_YP = 0;
constexpr long O_YS = O_YP + (long)NB_P * SEQ_P * DM;
constexpr long O_KP = O_YS + (long)NB_S * T_S * DM;
constexpr long O_VP = O_KP + 2L * NB_P * T_P * 512;
constexpr long O_KIP = O_VP + 2L * NB_P * T_P * 512;
constexpr long O_CONVP = O_KIP + 2L * NB_P * T_P * 64;
constexpr long O_LRUP = O_CONVP + 2L * NB_P * 3 * 512;
constexpr long O_POOLP = O_LRUP + 2L * NB_P * 512;
constexpr long O_KS = O_POOLP + 2L * NB_P * 15 * 512;
constexpr long O_VS = O_KS + 2L * NB_S * T_S * 512;
constexpr long O_KIS = O_VS + 2L * NB_S * T_S * 512;
constexpr long O_CONVS = O_KIS + 2L * NB_S * T_S * 64;
constexpr long O_LRUS = O_CONVS + 2L * NB_S * 3 * 512;
constexpr long O_POOLS = O_LRUS + 2L * NB_S * 512;

constexpr size_t al256(size_t x) { return (x + 255) & ~(size_t)255; }
constexpr size_t W_CTR = 0;
constexpr size_t W_BAR = 4096;
constexpr size_t W_ROPE = 32768;
constexpr size_t W_WINT = al256(W_ROPE + (size_t)T_P * 8 * 8);
constexpr size_t W_WBT = al256(W_WINT + 2ull * NPAD * 1024 * 2);
constexpr size_t W_WOT = al256(W_WBT + 2ull * 3 * 1024 * 512 * 2);
constexpr size_t W_WAT = al256(W_WOT + 2ull * 1024 * 1024 * 2);
constexpr size_t W_WXT = al256(W_WAT + 2ull * 8 * 64 * 64 * 2);
constexpr size_t W_PWT = al256(W_WXT + 2ull * 8 * 64 * 64 * 2);
constexpr size_t W_XRES = al256(W_PWT + 2ull * 4 * 128 * 128 * 2);
constexpr size_t W_HN = al256(W_XRES + (size_t)MPAD * 1024 * 4);
constexpr size_t W_QB = al256(W_HN + (size_t)MPAD * 1024 * 2);
constexpr size_t W_GA = al256(W_QB + (size_t)MPAD * 512 * 2);
constexpr size_t W_QIB = al256(W_GA + (size_t)MPAD * 512 * 2);
constexpr size_t W_WIB = al256(W_QIB + (size_t)MPAD * 256 * 2);
constexpr size_t W_XBB = al256(W_WIB + (size_t)MPAD * 4 * 4);
constexpr size_t W_GB = al256(W_XBB + (size_t)MPAD * 512 * 2);
constexpr size_t W_XCB = al256(W_GB + (size_t)MPAD * 512 * 2);
constexpr size_t W_GC = al256(W_XCB + (size_t)MPAD * 512 * 2);
constexpr size_t W_GM = al256(W_GC + (size_t)MPAD * 512 * 2);
constexpr size_t W_KBP = al256(W_GM + (size_t)MPAD * 3072 * 2);
constexpr size_t W_VTP = al256(W_KBP + (size_t)NB_P * KP_PAD * 512 * 2);
constexpr size_t W_KIBP = al256(W_VTP + (size_t)NB_P * 512 * KP_PAD * 2);
constexpr size_t W_KBS = al256(W_KIBP + (size_t)NB_P * KP_PAD * 64 * 2);
constexpr size_t W_VTS = al256(W_KBS + (size_t)NB_S * S_S * 512 * 2);
constexpr size_t W_KIBS = al256(W_VTS + (size_t)NB_S * 512 * S_S * 2);
constexpr size_t W_MASK = al256(W_KIBS + (size_t)NB_S * S_S * 64 * 2);
constexpr size_t W_AGG = al256(W_MASK + (size_t)ROWS * MW * 4);
constexpr size_t W_KMAX = al256(W_AGG + (size_t)NB_P * NTILE_P * 512 * 2 * 4);
constexpr size_t W_END = al256(W_KMAX + 1024);

struct Params {
  const float *x_prompt, *x_sample, *cache_k, *cache_v, *cache_kidx, *state_conv, *state_lru, *state_pool, *meta,
      *norm_g, *w_in, *conv_w, *conv_b, *lru_wa, *lru_ba, *lru_wx, *lru_bx, *lru_lambda, *pool_w, *pool_scale,
      *w_branch_out, *w_out, *final_g;
  float* out;
  char* ws;
};

extern __shared__ __attribute__((aligned(128))) char smem[];
__shared__ int sh_item;
__shared__ int sh_xinfo[4];

DI float bf2f(bfr b) { return __uint_as_float(((unsigned)b) << 16); }
DI unsigned pack2(float a, float b) {
  f32x2 v = {a, b};
  bf2_t r = __builtin_convertvector(v, bf2_t);
  return __builtin_bit_cast(unsigned, r);
}
DI bfr f2bf(float x) { return (bfr)(pack2(x, 0.f) & 0xFFFFu); }
DI float sigm(float x) { return __builtin_amdgcn_rcpf(1.f + __expf(-x)); }
DI float silu(float x) { return x * __builtin_amdgcn_rcpf(1.f + __expf(-x)); }
DI int get_tid() {
  int t = threadIdx.x;
  asm volatile("" : "+v"(t));
  return t;
}
DI unsigned sortable(float f) {
  unsigned u = __float_as_uint(f);
  return (u & 0x80000000u) ? ~u : (u | 0x80000000u);
}
DI void decode_row(int row, int& isP, int& sq, int& t) {
  if (row < ROWS_P) { isP = 1; sq = row / T_P; t = row - sq * T_P; }
  else { isP = 0; int r = row - ROWS_P; sq = r >> 6; t = r & 63; }
}

DI void tc_tile(const float* src, long sld, bfr* dst, long dld, int k0, int n0, float* tile, int mapmode) {
  const int tid = get_tid();
  const int nn = tid & 63, kk0 = tid >> 6;
  int n = n0 + nn, sn = n;
  if (mapmode) sn = n < 2368 ? n : (n < 7488 ? n + 4 : (n < 7492 ? 2368 + (n - 7488) : -1));
  float v[16];
#pragma unroll
  for (int i = 0; i < 16; ++i) v[i] = sn >= 0 ? __builtin_nontemporal_load(src + (long)(k0 + i * 4 + kk0) * sld + sn) : 0.f;
#pragma unroll
  for (int i = 0; i < 16; ++i) tile[(i * 4 + kk0) * 65 + nn] = v[i];
  __syncthreads();
#pragma unroll
  for (int i = 0; i < 16; ++i) {
    int nn2 = i * 4 + (tid >> 6), kk = tid & 63;
    dst[(long)(n0 + nn2) * dld + k0 + kk] = f2bf(tile[kk * 65 + nn2]);
  }
  __syncthreads();
}

DI void convert_cache(const Params& p, int layer, char*, bool doV = true) {
  const int tid = get_tid();
  bfr* kbs = (bfr*)(p.ws + W_KBS);
  bfr* vts = (bfr*)(p.ws + W_VTS);
  bfr* kibs = (bfr*)(p.ws + W_KIBS);
  for (int it = blockIdx.x; doV && it < NB_S * 32 * 8; it += gridDim.x) {
    int sb = it >> 8, r = it & 255, kt = r >> 3, nt = r & 7;
    tc_tile(p.cache_v + ((long)(layer * NB_S + sb) * PAST) * 512, 512, vts + (long)sb * 512 * S_S, S_S, kt * 64, nt * 64,
            (float*)smem, 0);
  }
  {
    const float4* src = (const float4*)(p.cache_k + (long)layer * NB_S * PAST * 512);
    const long n4 = (long)NB_S * PAST * 512 / 4;
    const long stride = (long)gridDim.x * 256;
    for (long i = (long)blockIdx.x * 256 + tid; i < n4; i += 4 * stride) {
      float4 v[4];
#pragma unroll
      for (int u = 0; u < 4; ++u) { const long ii = i + u * stride; if (ii < n4) { f32x4 t = __builtin_nontemporal_load((const f32x4*)src + ii); v[u] = make_float4(t[0], t[1], t[2], t[3]); } else v[u] = make_float4(0.f, 0.f, 0.f, 0.f); }
#pragma unroll
      for (int u = 0; u < 4; ++u) {
        const long ii = i + u * stride;
        if (ii < n4) {
          const long e = ii * 4;
          const int sb = (int)(e / ((long)PAST * 512));
          const long rem = e - (long)sb * PAST * 512;
          uint2 o; o.x = pack2(v[u].x, v[u].y); o.y = pack2(v[u].z, v[u].w);
          *(uint2*)(kbs + (long)sb * S_S * 512 + rem) = o;
        }
      }
    }
  }
  {
    const float4* src = (const float4*)(p.cache_kidx + (long)layer * NB_S * PAST * 64);
    const long n4 = (long)NB_S * PAST * 64 / 4;
    const long stride = (long)gridDim.x * 256;
    for (long i = (long)blockIdx.x * 256 + tid; i < n4; i += 4 * stride) {
      float4 v[4];
#pragma unroll
      for (int u = 0; u < 4; ++u) { const long ii = i + u * stride; if (ii < n4) { f32x4 t = __builtin_nontemporal_load((const f32x4*)src + ii); v[u] = make_float4(t[0], t[1], t[2], t[3]); } else v[u] = make_float4(0.f, 0.f, 0.f, 0.f); }
#pragma unroll
      for (int u = 0; u < 4; ++u) {
        const long ii = i + u * stride;
        if (ii < n4) {
          const long e = ii * 4;
          const int sb = (int)(e / ((long)PAST * 64));
          const long rem = e - (long)sb * PAST * 64;
          uint2 o; o.x = pack2(v[u].x, v[u].y); o.y = pack2(v[u].z, v[u].w);
          *(uint2*)(kibs + (long)sb * S_S * 64 + rem) = o;
        }
      }
    }
  }
}

DI void norm_phase(const Params& p, int mode) {
  const int tid = get_tid(), wid = __builtin_amdgcn_readfirstlane(tid >> 6), lane = tid & 63;
  float* xres = (float*)(p.ws + W_XRES);
  bfr* hn = (bfr*)(p.ws + W_HN);
  const float* g = mode == 0 ? p.norm_g : (mode == 1 ? p.norm_g + 1024 : p.final_g);
  for (int row = blockIdx.x * 4 + wid; row < ROWS; row += gridDim.x * 4) {
    int isP, sq, t;
    decode_row(row, isP, sq, t);
    const float* src;
    if (mode == 0) {
      if (isP) src = t < NMETA ? p.meta + (long)t * 1024 : p.x_prompt + ((long)sq * SEQ_P + t - NMETA) * 1024;
      else src = p.x_sample + (long)(row - ROWS_P) * 1024;
    } else src = xres + (long)row * 1024;
    float4 v[4];
    float ss = 0.f;
#pragma unroll
    for (int i = 0; i < 4; ++i) {
      { f32x4 t = (mode == 0) ? __builtin_nontemporal_load((const f32x4*)src + lane + i * 64) : *((const f32x4*)src + lane + i * 64); v[i] = make_float4(t[0], t[1], t[2], t[3]); }
      ss += v[i].x * v[i].x + v[i].y * v[i].y + v[i].z * v[i].z + v[i].w * v[i].w;
    }
#pragma unroll
    for (int o = 32; o >= 1; o >>= 1) ss += __shfl_xor(ss, o);
    const float inv = rsqrtf(ss * (1.f / 1024.f) + 1e-6f);
    float* dsty = nullptr;
    if (mode == 2) {
      if (isP) { if (t >= NMETA) dsty = p.out + O_YP + ((long)sq * SEQ_P + t - NMETA) * 1024; }
      else dsty = p.out + O_YS + (long)(row - ROWS_P) * 1024;
    }
#pragma unroll
    for (int i = 0; i < 4; ++i) {
      float4 gg = ((const float4*)g)[lane + i * 64];
      float4 y;
      y.x = v[i].x * inv * gg.x; y.y = v[i].y * inv * gg.y; y.z = v[i].z * inv * gg.z; y.w = v[i].w * inv * gg.w;
      if (mode == 0) ((float4*)(xres + (long)row * 1024))[lane + i * 64] = v[i];
      if (mode < 2) {
        uint2 o; o.x = pack2(y.x, y.y); o.y = pack2(y.z, y.w);
        *(uint2*)(hn + (long)row * 1024 + (lane + i * 64) * 4) = o;
      } else if (dsty) { f32x4 t = {y.x, y.y, y.z, y.w}; __builtin_nontemporal_store(t, (f32x4*)dsty + lane + i * 64); }
    }
  }
}

DI void prep_phase(const Params& p, char*) {
  const int tid = get_tid();
  for (int it0 = blockIdx.x; it0 < 9216; it0 += gridDim.x) {
    int it = it0;
    if (it < 3776) {
      int l = it / (118 * 16), r = it % (118 * 16), nt = r / 16, kt = r % 16;
      tc_tile(p.w_in + (long)l * 1024 * NIN, NIN, (bfr*)(p.ws + W_WINT) + (long)l * NPAD * 1024, 1024, kt * 64, nt * 64, (float*)smem, 1);
      continue;
    }
    it -= 3776;
    if (it < 768) {
      int mtx = it / 128, r = it % 128, nt = r / 8, kt = r % 8;
      tc_tile(p.w_branch_out + (long)mtx * 512 * 1024, 1024, (bfr*)(p.ws + W_WBT) + (long)mtx * 1024 * 512, 512, kt * 64, nt * 64, (float*)smem, 0);
      continue;
    }
    it -= 768;
    if (it < 512) {
      int l = it / 256, r = it % 256, nt = r / 16, kt = r % 16;
      tc_tile(p.w_out + (long)l * 1024 * 1024, 1024, (bfr*)(p.ws + W_WOT) + (long)l * 1024 * 1024, 1024, kt * 64, nt * 64, (float*)smem, 0);
      continue;
    }
    it -= 512;
    if (it < 32) {
      int which = it >> 4, mtx = it & 15;
      tc_tile((which ? p.lru_wx : p.lru_wa) + (long)mtx * 4096, 64, (bfr*)(p.ws + (which ? W_WXT : W_WAT)) + (long)mtx * 4096, 64, 0, 0, (float*)smem, 0);
      continue;
    }
    it -= 32;
    if (it < 32) {
      int mtx = it >> 2, r = it & 3, nt = r >> 1, kt = r & 1;
      tc_tile(p.pool_w + (long)mtx * 16384, 128, (bfr*)(p.ws + W_PWT) + (long)mtx * 16384, 128, kt * 64, nt * 64, (float*)smem, 0);
      continue;
    }
    it -= 32;
    {
      int sb = it >> 8, r = it & 255, kt = r >> 3, nt = r & 7;
      tc_tile(p.cache_v + ((long)sb * PAST) * 512, 512, (bfr*)(p.ws + W_VTS) + (long)sb * 512 * S_S, S_S, kt * 64, nt * 64, (float*)smem, 0);
    }
  }
  {
    float2* rt = (float2*)(p.ws + W_ROPE);
    for (int e = blockIdx.x * 256 + tid; e < T_P * 8; e += gridDim.x * 256) {
      int pos = e >> 3, d = e & 7;
      float inv = powf(500000.f, -(float)d * 0.125f);
      float ang = (float)pos * inv;
      rt[e] = make_float2(cosf(ang), sinf(ang));
    }
  }
  convert_cache(p, 0, smem, false);
  norm_phase(p, 0);
}

template <int NF>
DI void gemm128(const bfr* A, int lda, const bfr* Bt, int ldb, int K, int brow, int bcol, char*, f32x4 (&acc)[4][NF],
             bool chained = false, bool first = true, int nbrow = -1, int nbcol = 0, const bfr* nA = nullptr, const bfr* nBt = nullptr) {
  const int tid = get_tid(), wid = __builtin_amdgcn_readfirstlane(tid >> 6), lane = tid & 63, wr = wid >> 1, wc = wid & 1, fr = lane & 15, fq = lane >> 4;
  const int r0 = tid >> 3;
  const int cg = ((tid & 7) ^ (r0 & 7)) * 8;
  const bfr* ga = A + (long)(brow + r0) * lda + cg;
  const bfr* gb = Bt + (long)(bcol + r0) * ldb + cg;
  const long a32 = (long)32 * lda, b32 = (long)32 * ldb;
  const int nk = K / 64;
  auto stage = [&](int kt, int buf) {
    char* SA = smem + buf * 32768;
    char* SB = SA + 16384;
#pragma unroll
    for (int i = 0; i < 4; ++i)
      __builtin_amdgcn_global_load_lds((const unsigned*)(ga + i * a32 + kt * 64), (unsigned*)(SA + tid * 16 + i * 4096), 16, 0, 0);
#pragma unroll
    for (int i = 0; i < NF; ++i)
      __builtin_amdgcn_global_load_lds((const unsigned*)(gb + i * b32 + kt * 64), (unsigned*)(SB + tid * 16 + i * 4096), 16, 0, 0);
  };
  if (!chained || first) {
    asm volatile("s_waitcnt vmcnt(0)" ::: "memory");
    __syncthreads();
    stage(0, 0);
  }
  const unsigned lds0 = (unsigned)(size_t)smem;
  const unsigned sw0 = (unsigned)((fq ^ (fr & 7)) * 16), sw1 = (unsigned)(((4 + fq) ^ (fr & 7)) * 16);
  const unsigned arow = lds0 + (wr * 64 + fr) * 128, brw = lds0 + 16384 + (wc * NF * 16 + fr) * 128;
  for (int kt = 0; kt < nk; ++kt) {
    asm volatile("s_waitcnt vmcnt(0)" ::: "memory");
    __builtin_amdgcn_s_barrier();
    if (kt + 1 < nk) stage(kt + 1, (kt + 1) & 1);
    else if (chained && nbrow >= 0) {
      const bfr* na = (nA ? nA : A) + (long)(nbrow + r0) * lda + cg;
      const bfr* nb = (nBt ? nBt : Bt) + (long)(nbcol + r0) * ldb + cg;
#pragma unroll
      for (int i = 0; i < 4; ++i)
        __builtin_amdgcn_global_load_lds((const unsigned*)(na + i * a32), (unsigned*)(smem + tid * 16 + i * 4096), 16, 0, 0);
#pragma unroll
      for (int i = 0; i < NF; ++i)
        __builtin_amdgcn_global_load_lds((const unsigned*)(nb + i * b32), (unsigned*)(smem + 16384 + tid * 16 + i * 4096), 16, 0, 0);
    }
    const unsigned bo = (kt & 1) * 32768;
    bf16x8 af[2][4], bfg[2][4];
    if (NF == 4) {
      asm volatile(
          "ds_read_b128 %0, %16\n\tds_read_b128 %1, %16 offset:2048\n\tds_read_b128 %2, %16 offset:4096\n\tds_read_b128 %3, %16 offset:6144\n\t"
          "ds_read_b128 %4, %17\n\tds_read_b128 %5, %17 offset:2048\n\tds_read_b128 %6, %17 offset:4096\n\tds_read_b128 %7, %17 offset:6144\n\t"
          "ds_read_b128 %8, %18\n\tds_read_b128 %9, %18 offset:2048\n\tds_read_b128 %10, %18 offset:4096\n\tds_read_b128 %11, %18 offset:6144\n\t"
          "ds_read_b128 %12, %19\n\tds_read_b128 %13, %19 offset:2048\n\tds_read_b128 %14, %19 offset:4096\n\tds_read_b128 %15, %19 offset:6144\n\t"
          "s_waitcnt lgkmcnt(0)"
          : "=&v"(af[0][0]), "=&v"(af[0][1]), "=&v"(af[0][2]), "=&v"(af[0][3]), "=&v"(bfg[0][0]), "=&v"(bfg[0][1]), "=&v"(bfg[0][2]), "=&v"(bfg[0][3]),
            "=&v"(af[1][0]), "=&v"(af[1][1]), "=&v"(af[1][2]), "=&v"(af[1][3]), "=&v"(bfg[1][0]), "=&v"(bfg[1][1]), "=&v"(bfg[1][2]), "=&v"(bfg[1][3])
          : "v"(arow + sw0 + bo), "v"(brw + sw0 + bo), "v"(arow + sw1 + bo), "v"(brw + sw1 + bo)
          : "memory");
    } else {
      asm volatile(
          "ds_read_b128 %0, %12\n\tds_read_b128 %1, %12 offset:2048\n\tds_read_b128 %2, %12 offset:4096\n\tds_read_b128 %3, %12 offset:6144\n\t"
          "ds_read_b128 %4, %13\n\tds_read_b128 %5, %13 offset:2048\n\t"
          "ds_read_b128 %6, %14\n\tds_read_b128 %7, %14 offset:2048\n\tds_read_b128 %8, %14 offset:4096\n\tds_read_b128 %9, %14 offset:6144\n\t"
          "ds_read_b128 %10, %15\n\tds_read_b128 %11, %15 offset:2048\n\t"
          "s_waitcnt lgkmcnt(0)"
          : "=&v"(af[0][0]), "=&v"(af[0][1]), "=&v"(af[0][2]), "=&v"(af[0][3]), "=&v"(bfg[0][0]), "=&v"(bfg[0][1]),
            "=&v"(af[1][0]), "=&v"(af[1][1]), "=&v"(af[1][2]), "=&v"(af[1][3]), "=&v"(bfg[1][0]), "=&v"(bfg[1][1])
          : "v"(arow + sw0 + bo), "v"(brw + sw0 + bo), "v"(arow + sw1 + bo), "v"(brw + sw1 + bo)
          : "memory");
    }
#pragma unroll
    for (int ks = 0; ks < 2; ++ks)
#pragma unroll
      for (int m = 0; m < 4; ++m)
#pragma unroll
        for (int n = 0; n < NF; ++n) acc[m][n] = MFMA16(af[ks][m], bfg[ks][n], acc[m][n]);
  }
}

constexpr int EPI_PITCH = 64;
template <int REG>
DI void epi_region(const Params& p, int layer, f32x4 (&acc)[4][4], int rbase0, int rel, int lane, int wid) {
  const int fr = lane & 15, fq = lane >> 4;
  const float2* rt = (const float2*)(p.ws + W_ROPE);
  constexpr bool doRope = (REG == 0 || REG == 1 || REG == 4 || REG == 5);
  constexpr bool staged = (REG != 2 && REG != 11);
  bfr* img = (bfr*)(smem + 32768 + wid * (64 * EPI_PITCH * 2));
#pragma unroll
  for (int m = 0; m < 4; ++m) {
    const int rbase = rbase0 + m * 16 + fq * 4;
    const bool rowsValid = rbase < ROWS;
    int isP, sq, t0;
    decode_row(rowsValid ? rbase : 0, isP, sq, t0);
    if (doRope) {
      const int pos0 = isP ? t0 : PAST + t0;
#pragma unroll
      for (int j = 0; j < 4; ++j) {
        float v = acc[m][0][j];
        float pv = __shfl_xor(v, 8);
        float2 cs = rt[(pos0 + j) * 8 + (fr & 7)];
        acc[m][0][j] = (fr < 8) ? (v * cs.x - pv * cs.y) : (v * cs.x + pv * cs.y);
      }
    }
#pragma unroll
    for (int n = 0; n < 4; ++n) {
      const int col = rel + n * 16 + fr;
      if (REG == 2 && rowsValid) {
        uint2 pk; pk.x = pack2(acc[m][n][0], acc[m][n][1]); pk.y = pack2(acc[m][n][2], acc[m][n][3]);
        if (isP) *(uint2*)((bfr*)(p.ws + W_VTP) + ((long)sq * 512 + col) * KP_PAD + t0) = pk;
        else *(uint2*)((bfr*)(p.ws + W_VTS) + ((long)sq * 512 + col) * S_S + PAST + t0) = pk;
      }
#pragma unroll
      for (int j = 0; j < 4; ++j) {
        const float v = acc[m][n][j];
        const int row = rbase + j, t = t0 + j;
        if (rowsValid) {
          if (REG == 1) { if (isP) p.out[O_KP + ((long)(layer * NB_P + sq) * T_P + t) * 512 + col] = v; else p.out[O_KS + ((long)(layer * NB_S + sq) * T_S + t) * 512 + col] = v; }
          if (REG == 2) { if (isP) p.out[O_VP + ((long)(layer * NB_P + sq) * T_P + t) * 512 + col] = v; else p.out[O_VS + ((long)(layer * NB_S + sq) * T_S + t) * 512 + col] = v; }
          if (REG == 5) { if (isP) p.out[O_KIP + ((long)(layer * NB_P + sq) * T_P + t) * 64 + col] = v; else p.out[O_KIS + ((long)(layer * NB_S + sq) * T_S + t) * 64 + col] = v; }
          if (REG == 6) {
            if (isP) { if (t >= T_P - 3) p.out[O_CONVP + ((long)(layer * NB_P + sq) * 3 + (t - (T_P - 3))) * 512 + col] = v; }
            else { if (t >= T_S - 3) p.out[O_CONVS + ((long)(layer * NB_S + sq) * 3 + (t - (T_S - 3))) * 512 + col] = v; }
          }
          if (REG == 8) {
            if (isP) { if (t >= T_P - 15) p.out[O_POOLP + ((long)(layer * NB_P + sq) * 15 + (t - (T_P - 15))) * 512 + col] = v; }
            else { if (t >= T_S - 15) p.out[O_POOLS + ((long)(layer * NB_S + sq) * 15 + (t - (T_S - 15))) * 512 + col] = v; }
          }
          if (REG == 11) { if (col < 4) ((float*)(p.ws + W_WIB))[(long)row * 4 + col] = v; }
        }
        if (staged) {
          float y = v;
          if (REG == 3 || REG == 7 || REG == 9) y = silu(v);
          if (REG == 10) y = sigm(v);
          img[(m * 16 + fq * 4 + j) * EPI_PITCH + n * 16 + fr] = f2bf(y);
        }
      }
    }
  }
  if (staged) {
    asm volatile("s_waitcnt lgkmcnt(0)" ::: "memory");
#pragma unroll
    for (int it = 0; it < 8; ++it) {
      const int r = it * 8 + (lane >> 3), ch = lane & 7;
      const int row = rbase0 + r;
      if (row < ROWS) {
        int isP, sq, t;
        decode_row(row, isP, sq, t);
        bfr* dst;
        if (REG == 0) dst = (bfr*)(p.ws + W_QB) + (long)row * 512;
        else if (REG == 1) dst = isP ? (bfr*)(p.ws + W_KBP) + ((long)sq * KP_PAD + t) * 512 : (bfr*)(p.ws + W_KBS) + ((long)sq * S_S + PAST + t) * 512;
        else if (REG == 3) dst = (bfr*)(p.ws + W_GA) + (long)row * 512;
        else if (REG == 4) dst = (bfr*)(p.ws + W_QIB) + (long)row * 256;
        else if (REG == 5) dst = isP ? (bfr*)(p.ws + W_KIBP) + ((long)sq * KP_PAD + t) * 64 : (bfr*)(p.ws + W_KIBS) + ((long)sq * S_S + PAST + t) * 64;
        else if (REG == 6) dst = (bfr*)(p.ws + W_XBB) + (long)row * 512;
        else if (REG == 7) dst = (bfr*)(p.ws + W_GB) + (long)row * 512;
        else if (REG == 8) dst = (bfr*)(p.ws + W_XCB) + (long)row * 512;
        else if (REG == 9) dst = (bfr*)(p.ws + W_GC) + (long)row * 512;
        else dst = (bfr*)(p.ws + W_GM) + (long)row * 3072;
        const uint4 val = *(const uint4*)(img + r * EPI_PITCH + ch * 8);
        *(uint4*)(dst + rel + ch * 8) = val;
      }
    }
  }
}

DI void epi_inproj(const Params& p, int layer, f32x4 (&acc)[4][4], int brow, int bcol) {
  const int tid = get_tid(), wid = __builtin_amdgcn_readfirstlane(tid >> 6), lane = tid & 63, wr = wid >> 1, wc = wid & 1;
  const int c0 = bcol + wc * 64;
  const int rb = brow + wr * 64;
  asm volatile("s_waitcnt lgkmcnt(0)" ::: "memory");
  __builtin_amdgcn_s_barrier();
  if (c0 < C_K) epi_region<0>(p, layer, acc, rb, c0 - C_Q, lane, wid);
  else if (c0 < C_V) epi_region<1>(p, layer, acc, rb, c0 - C_K, lane, wid);
  else if (c0 < C_GA) epi_region<2>(p, layer, acc, rb, c0 - C_V, lane, wid);
  else if (c0 < C_QI) epi_region<3>(p, layer, acc, rb, c0 - C_GA, lane, wid);
  else if (c0 < C_KI) epi_region<4>(p, layer, acc, rb, c0 - C_QI, lane, wid);
  else if (c0 < C_XB) epi_region<5>(p, layer, acc, rb, c0 - C_KI, lane, wid);
  else if (c0 < C_GB) epi_region<6>(p, layer, acc, rb, c0 - C_XB, lane, wid);
  else if (c0 < C_XC) epi_region<7>(p, layer, acc, rb, c0 - C_GB, lane, wid);
  else if (c0 < C_GC) epi_region<8>(p, layer, acc, rb, c0 - C_XC, lane, wid);
  else if (c0 < C_GM) epi_region<9>(p, layer, acc, rb, c0 - C_GC, lane, wid);
  else if (c0 < C_WI) epi_region<10>(p, layer, acc, rb, c0 - C_GM, lane, wid);
  else epi_region<11>(p, layer, acc, rb, c0 - C_WI, lane, wid);
}

DI void phase_inproj(const Params& p, int layer, char*) {
  const bfr* A = (const bfr*)(p.ws + W_HN);
  const bfr* Bt = (const bfr*)(p.ws + W_WINT) + (long)layer * NPAD * 1024;
  constexpr int NTM = MPAD / 128, NTN = NPAD / 128;
  const int rank = sh_xinfo[0], nloc = sh_xinfo[1], ia = sh_xinfo[2], na = sh_xinfo[3];
  const int nbase = NTN / na, nrem = NTN % na;
  const int nn = nbase + (ia < nrem ? 1 : 0), n0 = ia * nbase + min(ia, nrem);
  const int target = (NTM * NTN + na - 1) / na;
  const int keep = min(NTM * nn, target);
  int poff = 0, stot = 0;
  for (int a = 0; a < na; ++a) {
    const int o = NTM * (nbase + (a < nrem ? 1 : 0)), kp = min(o, target);
    if (a < ia) poff += target - kp;
    stot += o - kp;
  }
  const int dend = min(poff + (target - keep), stot);
  const int kown = rank < keep ? (keep - rank + nloc - 1) / nloc : 0;
  auto get_tile = [&](int k, int& tm_, int& tn_) -> bool {
    if (k < kown) { const int i = rank + k * nloc; tm_ = i / nn; tn_ = n0 + (i - tm_ * nn); return true; }
    const int e = poff + rank + (k - kown) * nloc;
    if (e >= dend) return false;
    int accs = 0;
    for (int a = 0; a < na; ++a) {
      const int nna = nbase + (a < nrem ? 1 : 0), o = NTM * nna, kp = min(o, target), sp = o - kp;
      if (e < accs + sp) {
        const int i = kp + (e - accs);
        tm_ = i / nna;
        tn_ = a * nbase + min(a, nrem) + (i - tm_ * nna);
        return true;
      }
      accs += sp;
    }
    return false;
  };
  bool first = true;
  int tm = 0, tn = 0;
  bool have = get_tile(0, tm, tn);
#pragma unroll 1
  for (int k = 0; have; ++k) {
    int tm2 = 0, tn2 = 0;
    const bool nxt = get_tile(k + 1, tm2, tn2);
    const int nbr = nxt ? tm2 * 128 : -1, nbc = tn2 * 128;
    f32x4 acc[4][4];
#pragma unroll
    for (int m = 0; m < 4; ++m)
#pragma unroll
      for (int n = 0; n < 4; ++n) acc[m][n] = f32x4{0.f, 0.f, 0.f, 0.f};
    gemm128<4>(A, 1024, Bt, 1024, 1024, tm * 128, tn * 128, smem, acc, true, first, nbr, nbc);
    first = false;
    epi_inproj(p, layer, acc, tm * 128, tn * 128);
    tm = tm2; tn = tn2; have = nxt;
  }
}

template <int NF>
DI void merge_tile(const Params& p, int layer, int brow, int bcol, bool& first, bool hasNext, int nbrow, int nbcol) {
  const int tid = get_tid(), wid = __builtin_amdgcn_readfirstlane(tid >> 6), lane = tid & 63, wr = wid >> 1, wc = wid & 1, fr = lane & 15, fq = lane >> 4;
  const bfr* gmb = (const bfr*)(p.ws + W_GM);
  bfr* merged = (bfr*)(p.ws + W_HN);
  unsigned tot[4][NF][2];
#pragma unroll
  for (int m = 0; m < 4; ++m)
#pragma unroll
    for (int n = 0; n < NF; ++n) { tot[m][n][0] = 0u; tot[m][n][1] = 0u; }
#pragma unroll 1
  for (int br = 0; br < 3; ++br) {
    const bfr* A = (const bfr*)(p.ws + (br == 0 ? W_GA : (br == 1 ? W_GB : W_GC)));
    const bfr* Bt = (const bfr*)(p.ws + W_WBT) + (long)(layer * 3 + br) * 1024 * 512;
    const bfr* nA = (const bfr*)(p.ws + (br == 0 ? W_GB : (br == 1 ? W_GC : W_GA)));
    const bfr* nBt = (const bfr*)(p.ws + W_WBT) + (long)(layer * 3 + (br == 2 ? 0 : br + 1)) * 1024 * 512;
    const bool nx = br < 2 || hasNext;
    f32x4 acc[4][NF];
#pragma unroll
    for (int m = 0; m < 4; ++m)
#pragma unroll
      for (int n = 0; n < NF; ++n) acc[m][n] = f32x4{0.f, 0.f, 0.f, 0.f};
    gemm128<NF>(A, 512, Bt, 512, 512, brow, bcol, smem, acc, true, first, nx ? (br < 2 ? brow : nbrow) : -1, br < 2 ? bcol : nbcol, nA, nBt);
    first = false;
#pragma unroll
    for (int m = 0; m < 4; ++m) {
      const int row0 = brow + wr * 64 + m * 16 + fq * 4;
      if (row0 < ROWS) {
#pragma unroll
        for (int n = 0; n < NF; ++n) {
          const int col = bcol + wc * (NF * 16) + n * 16 + fr;
          const bfr* gp = gmb + (long)row0 * 3072 + br * 1024 + col;
          const float g0 = bf2f(gp[0]), g1 = bf2f(gp[3072]), g2 = bf2f(gp[2 * 3072]), g3 = bf2f(gp[3 * 3072]);
          const unsigned t0 = tot[m][n][0], t1 = tot[m][n][1];
          tot[m][n][0] = pack2(__uint_as_float(t0 << 16) + g0 * acc[m][n][0], __uint_as_float(t0 & 0xFFFF0000u) + g1 * acc[m][n][1]);
          tot[m][n][1] = pack2(__uint_as_float(t1 << 16) + g2 * acc[m][n][2], __uint_as_float(t1 & 0xFFFF0000u) + g3 * acc[m][n][3]);
        }
      }
    }
  }
#pragma unroll
  for (int m = 0; m < 4; ++m) {
    const int row0 = brow + wr * 64 + m * 16 + fq * 4;
    if (row0 < ROWS) {
#pragma unroll
      for (int n = 0; n < NF; ++n) {
        bfr* mp = merged + (long)row0 * 1024 + bcol + wc * (NF * 16) + n * 16 + fr;
        mp[0] = (bfr)(tot[m][n][0] & 0xFFFFu); mp[1024] = (bfr)(tot[m][n][0] >> 16);
        mp[2048] = (bfr)(tot[m][n][1] & 0xFFFFu); mp[3072] = (bfr)(tot[m][n][1] >> 16);
      }
    }
  }
}

DI void phase_merge(const Params& p, int layer, char*) {
  constexpr int NTM = MPAD / 128, NTN = 8, NT = NTM * NTN;
  const int G = gridDim.x;
  const int nfull = (NT / G) * G, rem = NT - nfull;
  const bool split = rem > 0 && 2 * rem <= G;
  const int lim = split ? nfull : NT;
  const bool cv = (layer == 0);
  if (cv && (blockIdx.x & 1)) convert_cache(p, 1, smem);
  bool first = true;
  for (int tile = blockIdx.x; tile < lim; tile += G) {
    const int tn = tile / NTM, tm = tile % NTM;
    const int t2 = tile + G;
    const bool hasNext = t2 < lim;
    merge_tile<4>(p, layer, tm * 128, tn * 128, first, hasNext, (t2 % NTM) * 128, (t2 / NTM) * 128);
  }
  if (split && (int)blockIdx.x < 2 * rem) {
    const int tile = nfull + ((int)blockIdx.x >> 1), half = blockIdx.x & 1;
    const int tn = tile / NTM, tm = tile % NTM;
    bool f2 = true;
    merge_tile<2>(p, layer, tm * 128, tn * 128 + half * 64, f2, false, 0, 0);
  }
  if (cv && !(blockIdx.x & 1)) { __syncthreads(); convert_cache(p, 1, smem); }
}

template <int NF>
DI void out_tile(const Params& p, int layer, int brow, int bcol, bool& first, bool hasNext, int nbrow, int nbcol) {
  const int tid = get_tid(), wid = __builtin_amdgcn_readfirstlane(tid >> 6), lane = tid & 63, wr = wid >> 1, wc = wid & 1, fr = lane & 15, fq = lane >> 4;
  const bfr* A = (const bfr*)(p.ws + W_HN);
  const bfr* Bt = (const bfr*)(p.ws + W_WOT) + (long)layer * 1024 * 1024;
  float* xres = (float*)(p.ws + W_XRES);
  f32x4 acc[4][NF];
#pragma unroll
  for (int m = 0; m < 4; ++m)
#pragma unroll
    for (int n = 0; n < NF; ++n) acc[m][n] = f32x4{0.f, 0.f, 0.f, 0.f};
  gemm128<NF>(A, 1024, Bt, 1024, 1024, brow, bcol, smem, acc, true, first, hasNext ? nbrow : -1, nbcol);
  first = false;
#pragma unroll
  for (int m = 0; m < 4; ++m)
#pragma unroll
    for (int j = 0; j < 4; ++j) {
      int row = brow + wr * 64 + m * 16 + fq * 4 + j;
      if (row < ROWS) {
#pragma unroll
        for (int n = 0; n < NF; ++n) xres[(long)row * 1024 + bcol + wc * (NF * 16) + n * 16 + fr] += acc[m][n][j];
      }
    }
}

DI void phase_out(const Params& p, int layer, char*) {
  constexpr int NTM = MPAD / 128, NTN = 8, NT = NTM * NTN;
  const int G = gridDim.x;
  const int nfull = (NT / G) * G, rem = NT - nfull;
  const bool split = rem > 0 && 2 * rem <= G;
  const int lim = split ? nfull : NT;
  bool first = true;
  for (int tile = blockIdx.x; tile < lim; tile += G) {
    const int tn = tile / NTM, tm = tile % NTM;
    const int t2 = tile + G;
    out_tile<4>(p, layer, tm * 128, tn * 128, first, t2 < lim, (t2 % NTM) * 128, (t2 / NTM) * 128);
  }
  if (split && (int)blockIdx.x < 2 * rem) {
    const int tile = nfull + ((int)blockIdx.x >> 1), half = blockIdx.x & 1;
    const int tn = tile / NTM, tm = tile % NTM;
    bool f2 = true;
    out_tile<2>(p, layer, tm * 128, tn * 128 + half * 64, f2, false, 0, 0);
  }
}

constexpr int SEL_QS = 2120;
DI void select_item(const Params& p, int isP, int sq, int c, int sub, char*) {
  const int tid = get_tid(), wid = __builtin_amdgcn_readfirstlane(tid >> 6), lane = tid & 63, fr = lane & 15, fq = lane >> 4;
  int T0, nadm, rowbase;
  const bfr* kib;
  if (isP) {
    if (c == 0) { T0 = 0; nadm = 16; } else { T0 = 16 + 64 * (c - 1) + 16 * sub; nadm = 16 + 64 * c; }
    rowbase = sq * T_P;
    kib = (const bfr*)(p.ws + W_KIBP) + (long)sq * KP_PAD * 64;
  } else {
    T0 = 16 * sub; nadm = S_S; rowbase = ROWS_P + sq * 64;
    kib = (const bfr*)(p.ws + W_KIBS) + (long)sq * S_S * 64;
  }
  unsigned* maskg = (unsigned*)(p.ws + W_MASK);
  const int nsteps = (nadm + 31) >> 5;
  if (nadm <= 256) {
    for (int e = tid; e < 16 * nsteps; e += 256) {
      int q = e / nsteps, s = e - q * nsteps;
      unsigned w = (s * 32 + 32 <= nadm) ? 0xFFFFFFFFu : 0xFFFFu;
      maskg[(long)(rowbase + T0 + q) * MW + s] = w;
    }
    return;
  }
  const int nkt = nadm >> 4;
  const int nmine = (nkt - wid + 3) >> 2;
  const int nregs = (nadm + 63) >> 6;
  const bfr* qib = (const bfr*)(p.ws + W_QIB);
  const float* wib = (const float*)(p.ws + W_WIB);
  unsigned* S = (unsigned*)smem;
#pragma unroll 1
  for (int g = 0; g < 4; ++g) {
    const int qrow = rowbase + T0 + g * 4;
    int koff = (wid * 16 + fr) * 64 + fq * 8;
    asm volatile("" : "+v"(koff));
    const bfr* kbase = kib + koff;
    int nm = nmine;
    asm volatile("" : "+v"(nm));
    nm = __builtin_amdgcn_readfirstlane(nm);
    const bfr* qp = qib + (long)(qrow + (fr >> 2)) * 256 + (fr & 3) * 64 + fq * 8;
    const bf16x8 a0 = *(const bf16x8*)qp;
    const bf16x8 a1 = *(const bf16x8*)(qp + 32);
    const float4 w = *(const float4*)(wib + (long)(qrow + fq) * 4);
    unsigned sc[65];
#pragma unroll
    for (int ch = 0; ch < 5; ++ch) {
      if (ch * 13 < nm) {
        bf16x8 b0[13], b1[13];
#pragma unroll
        for (int u = 0; u < 13; ++u) {
          const int ic = min(ch * 13 + u, nm - 1);
          const bfr* kp = kbase + (long)ic * 4096;
          b0[u] = *(const bf16x8*)kp;
          b1[u] = *(const bf16x8*)(kp + 32);
        }
#pragma unroll
        for (int u = 0; u < 13; ++u) {
          const int i = ch * 13 + u;
          f32x4 a = {0.f, 0.f, 0.f, 0.f};
          a = MFMA16(a0, b0[u], a);
          a = MFMA16(a1, b1[u], a);
          float s = w.x * fmaxf(a[0], 0.f) + w.y * fmaxf(a[1], 0.f) + w.z * fmaxf(a[2], 0.f) + w.w * fmaxf(a[3], 0.f);
          sc[i] = (i < nm) ? sortable(s) : 0u;
        }
      } else {
#pragma unroll
        for (int u = 0; u < 13; ++u) sc[ch * 13 + u] = 0u;
      }
      __builtin_amdgcn_sched_barrier(0);
    }
    unsigned v[65];
    __syncthreads();
#pragma unroll
    for (int i = 0; i < 33; ++i) S[fq * SEL_QS + (i * 4 + wid) * 16 + fr] = sc[i];
    __syncthreads();
#pragma unroll
    for (int j = 0; j < 33; ++j) v[j] = S[wid * SEL_QS + j * 64 + lane];
    if (nregs > 33) {
      __syncthreads();
#pragma unroll
      for (int i = 33; i < 65; ++i) S[fq * SEL_QS + (i * 4 + wid - 132) * 16 + fr] = sc[i];
      __syncthreads();
#pragma unroll
      for (int j = 0; j < 32; ++j) v[33 + j] = S[wid * SEL_QS + j * 64 + lane];
    } else {
#pragma unroll
      for (int j = 0; j < 32; ++j) v[33 + j] = 0u;
    }
    int nr = nregs;
    asm volatile("" : "+v"(nr));
    nr = __builtin_amdgcn_readfirstlane(nr);
    unsigned vmax = 0u;
#pragma unroll
    for (int r = 0; r < 65; ++r) vmax = max(vmax, v[r]);
#pragma unroll
    for (int o = 32; o >= 1; o >>= 1) vmax = max(vmax, (unsigned)__shfl_xor((int)vmax, o));
    vmax = __builtin_amdgcn_readfirstlane(vmax);
    unsigned thr = 0u;
    int exact = 0;
#pragma unroll 1
    for (int bit = 31; bit >= 0; --bit) {
      const unsigned cand = thr | (1u << bit);
      if (cand > vmax) continue;
      int cnt = 0;
#pragma unroll
      for (int ch = 0; ch < 5; ++ch) {
        if (ch * 13 < nr) {
#pragma unroll
          for (int u = 0; u < 13; ++u) cnt += __popcll(__ballot(v[ch * 13 + u] >= cand));
        }
      }
      if (cnt >= 256) {
        thr = cand;
        if (cnt == 256) { exact = 1; break; }
      }
    }
    if (exact) {
      unsigned mn = 0xFFFFFFFFu;
#pragma unroll
      for (int r = 0; r < 65; ++r) mn = min(mn, v[r] >= thr ? v[r] : 0xFFFFFFFFu);
#pragma unroll
      for (int o = 32; o >= 1; o >>= 1) mn = min(mn, (unsigned)__shfl_xor((int)mn, o));
      thr = __builtin_amdgcn_readfirstlane(mn);
    }
    int gt = 0, eq = 0;
#pragma unroll
    for (int r = 0; r < 65; ++r) {
      gt += __popcll(__ballot(v[r] > thr));
      eq += __popcll(__ballot(v[r] == thr));
    }
    const int need = 256 - gt;
    int idxcut = 0x7fffffff;
    if (eq != need) {
      int run = 0;
      bool done = false;
#pragma unroll
      for (int r = 0; r < 65; ++r) {
        if (!done) {
          unsigned long long m = __ballot(v[r] == thr);
          int pc = __popcll(m);
          if (run + pc >= need) {
            const int k = need - run;
            for (int t = 1; t < k; ++t) m &= m - 1ull;
            idxcut = r * 64 + (__ffsll((long long)m) - 1);
            done = true;
          } else run += pc;
        }
      }
    }
    unsigned* mrowp = maskg + (long)(qrow + wid) * MW;
#pragma unroll
    for (int r = 0; r < 65; ++r) {
      if (r < nr) {
        const bool sel = (v[r] > thr) || (v[r] == thr && (r * 64 + lane) <= idxcut);
        const unsigned long long bal = __ballot(sel);
        if (lane == 0) *(uint2*)(mrowp + r * 2) = make_uint2((unsigned)bal, (unsigned)(bal >> 32));
      }
    }
  }
}

DI void lru_tile(const Params& p, int layer, int isP, int sq, int tile, int nb, int pass, char*) {
  const int tid = get_tid(), wid = __builtin_amdgcn_readfirstlane(tid >> 6), lane = tid & 63, fr = lane & 15, fq = lane >> 4;
  float* xbs = (float*)smem;
  float* as_ = xbs;
  float* xcs = xbs + 67 * 64;
  float* bs_ = xcs + 64 * 64;
  float* ab = bs_ + 64 * 64;
  bfr* xca = (bfr*)(ab + 512);
  const int T = isP ? T_P : T_S;
  const int rowbase = isP ? sq * T_P : ROWS_P + sq * 64;
  const int t0 = tile * 64, ch0 = nb * 64;
  const bfr* xbb = (const bfr*)(p.ws + W_XBB);
  bfr* gby = (bfr*)(p.ws + W_GB);
  float* agg = (float*)(p.ws + W_AGG);
  const bfr* WaT = (const bfr*)(p.ws + W_WAT) + (long)(layer * 8 + nb) * 4096;
  const bfr* WxT = (const bfr*)(p.ws + W_WXT) + (long)(layer * 8 + nb) * 4096;
  bf16x8 wfa0[4], wfa1[4], wfx0[4], wfx1[4];
  float pbav[4], pbxv[4], plam[4];
#pragma unroll
  for (int nt = 0; nt < 4; ++nt) {
    const int d = nt * 16 + fr;
    wfa0[nt] = *(const bf16x8*)(WaT + d * 64 + fq * 8); wfa1[nt] = *(const bf16x8*)(WaT + d * 64 + 32 + fq * 8);
    wfx0[nt] = *(const bf16x8*)(WxT + d * 64 + fq * 8); wfx1[nt] = *(const bf16x8*)(WxT + d * 64 + 32 + fq * 8);
    pbav[nt] = p.lru_ba[layer * 512 + ch0 + d]; pbxv[nt] = p.lru_bx[layer * 512 + ch0 + d];
    plam[nt] = p.lru_lambda[layer * 512 + ch0 + d];
  }
  const float pcb = p.conv_b[layer * 512 + ch0 + (tid & 63)];
  const float pw0 = p.conv_w[(layer * 4 + 0) * 512 + ch0 + (tid & 63)], pw1 = p.conv_w[(layer * 4 + 1) * 512 + ch0 + (tid & 63)],
              pw2 = p.conv_w[(layer * 4 + 2) * 512 + ch0 + (tid & 63)], pw3 = p.conv_w[(layer * 4 + 3) * 512 + ch0 + (tid & 63)];
  {
    const int c = tid & 63;
    float vv[17];
#pragma unroll
    for (int i = 0; i < 17; ++i) {
      const int rr = i * 4 + (tid >> 6);
      const int tt = t0 - 3 + rr;
      float v = 0.f;
      if (rr < 67) {
        if (tt < 0) { if (!isP) v = p.state_conv[((long)(layer * NB_S + sq) * 3 + (3 + tt)) * 512 + ch0 + c]; }
        else if (tt < T) v = bf2f(xbb[(long)(rowbase + tt) * 512 + ch0 + c]);
      }
      vv[i] = v;
    }
#pragma unroll
    for (int i = 0; i < 17; ++i) { const int rr = i * 4 + (tid >> 6); if (rr < 67) xbs[rr * 64 + c] = vv[i]; }
  }
  __syncthreads();
  {
    const int c = tid & 63;
    const float cb = pcb, w0 = pw0, w1 = pw1, w2 = pw2, w3 = pw3;
    for (int t = tid >> 6; t < 64; t += 4) {
      float xc = cb + w0 * xbs[t * 64 + c] + w1 * xbs[(t + 1) * 64 + c] + w2 * xbs[(t + 2) * 64 + c] + w3 * xbs[(t + 3) * 64 + c];
      xcs[t * 64 + c] = xc;
      xca[t * 72 + c] = f2bf(xc);
    }
  }
  __syncthreads();
  {
    bf16x8 af0 = *(const bf16x8*)(xca + (wid * 16 + fr) * 72 + fq * 8);
    bf16x8 af1 = *(const bf16x8*)(xca + (wid * 16 + fr) * 72 + 32 + fq * 8);
#pragma unroll
    for (int nt = 0; nt < 4; ++nt) {
      const int d = nt * 16 + fr;
      const bf16x8 ba0 = wfa0[nt], ba1 = wfa1[nt], bx0 = wfx0[nt], bx1 = wfx1[nt];
      f32x4 ar = {0.f, 0.f, 0.f, 0.f}, ai = {0.f, 0.f, 0.f, 0.f};
      ar = MFMA16(af0, ba0, ar); ar = MFMA16(af1, ba1, ar);
      ai = MFMA16(af0, bx0, ai); ai = MFMA16(af1, bx1, ai);
      const float bav = pbav[nt], bxv = pbxv[nt];
      const float sp = log1pf(__expf(-plam[nt]));
#pragma unroll
      for (int j = 0; j < 4; ++j) {
        const int t = wid * 16 + fq * 4 + j;
        float r = sigm(ar[j] + bav), ig = sigm(ai[j] + bxv);
        float la = -8.f * r * sp;
        float a = __expf(la);
        float b = sqrtf(1.f - __expf(2.f * la)) * (ig * xcs[t * 64 + d]);
        if (t0 + t >= T) { a = 1.f; b = 0.f; }
        as_[t * 64 + d] = a;
        bs_[t * 64 + d] = b;
      }
    }
  }
  __syncthreads();
  const int c = tid & 63;
  {
    float A = 1.f, B = 0.f;
#pragma unroll
    for (int tt = 0; tt < 16; ++tt) {
      float a = as_[(wid * 16 + tt) * 64 + c], b = bs_[(wid * 16 + tt) * 64 + c];
      A *= a; B = a * B + b;
    }
    ab[(wid * 64 + c) * 2] = A;
    ab[(wid * 64 + c) * 2 + 1] = B;
  }
  __syncthreads();
  if (pass == 0) {
    if (wid == 0) {
      float A = 1.f, B = 0.f;
#pragma unroll
      for (int w = 0; w < 4; ++w) { float a = ab[(w * 64 + c) * 2], b = ab[(w * 64 + c) * 2 + 1]; A *= a; B = a * B + b; }
      *(float2*)(agg + ((long)(sq * NTILE_P + tile) * 512 + ch0 + c) * 2) = make_float2(A, B);
    }
  } else {
    float h = isP ? 0.f : p.state_lru[(long)(layer * NB_S + sq) * 512 + ch0 + c];
    for (int i0 = 0; i0 < tile; i0 += 16) {
      float2 e[16];
#pragma unroll
      for (int u = 0; u < 16; ++u)
        e[u] = (i0 + u < tile) ? *(const float2*)(agg + ((long)(sq * NTILE_P + i0 + u) * 512 + ch0 + c) * 2) : make_float2(1.f, 0.f);
#pragma unroll
      for (int u = 0; u < 16; ++u) h = e[u].x * h + e[u].y;
    }
    for (int w = 0; w < wid; ++w) h = ab[(w * 64 + c) * 2] * h + ab[(w * 64 + c) * 2 + 1];
#pragma unroll
    for (int tt = 0; tt < 16; ++tt) {
      const int t = wid * 16 + tt;
      h = as_[t * 64 + c] * h + bs_[t * 64 + c];
      if (t0 + t < T) {
        const long idx = (long)(rowbase + t0 + t) * 512 + ch0 + c;
        gby[idx] = f2bf(h * bf2f(gby[idx]));
        if (t0 + t == T - 1) {
          if (isP) p.out[O_LRUP + (long)(layer * NB_P + sq) * 512 + ch0 + c] = h;
          else p.out[O_LRUS + (long)(layer * NB_S + sq) * 512 + ch0 + c] = h;
        }
      }
    }
  }
}

DI void pool_item(const Params& p, int layer, int isP, int sq, int tile, int g, char*) {
  const int tid = get_tid(), wid = __builtin_amdgcn_readfirstlane(tid >> 6), lane = tid & 63, fr = lane & 15, fq = lane >> 4;
  float* xps = (float*)smem;
  bfr* pa = (bfr*)(xps + 79 * 128);
  const int T = isP ? T_P : T_S;
  const int rowbase = isP ? sq * T_P : ROWS_P + sq * 64;
  const int t0 = tile * 64, ch0 = g * 128;
  const bfr* xcb = (const bfr*)(p.ws + W_XCB);
  bfr* gcy = (bfr*)(p.ws + W_GC);
  {
    const int c = tid & 127;
#pragma unroll
    for (int b8 = 0; b8 < 5; ++b8) {
      float vv[8];
#pragma unroll
      for (int u = 0; u < 8; ++u) {
        const int rr = (b8 * 8 + u) * 2 + (tid >> 7);
        const int tt = t0 - 15 + rr;
        float v = 0.f;
        if (rr < 79) {
          if (tt < 0) { if (!isP) v = p.state_pool[((long)(layer * NB_S + sq) * 15 + (15 + tt)) * 512 + ch0 + c]; }
          else if (tt < T) v = bf2f(xcb[(long)(rowbase + tt) * 512 + ch0 + c]);
        }
        vv[u] = v;
      }
#pragma unroll
      for (int u = 0; u < 8; ++u) { const int rr = (b8 * 8 + u) * 2 + (tid >> 7); if (rr < 79) xps[rr * 128 + c] = vv[u]; }
    }
  }
  __syncthreads();
  {
    const int c = tid & 127;
    const int w = 2 << g;
    const int nh = isP ? 0 : PAST;
    for (int t = tid >> 7; t < 64; t += 2) {
      float s = 0.f;
      for (int i = 0; i < w; ++i) s += xps[(15 + t - i) * 128 + c];
      int cnt = min(w, t0 + t + 1 + nh);
      float v = s / (float)cnt - xps[(15 + t) * 128 + c];
      pa[t * 136 + c] = f2bf(v);
    }
  }
  __syncthreads();
  {
    const bfr* PwT = (const bfr*)(p.ws + W_PWT) + (long)(layer * 4 + g) * 16384;
    bf16x8 af[4];
#pragma unroll
    for (int ks = 0; ks < 4; ++ks) af[ks] = *(const bf16x8*)(pa + (wid * 16 + fr) * 136 + ks * 32 + fq * 8);
#pragma unroll
    for (int nt = 0; nt < 8; ++nt) {
      const int d = nt * 16 + fr;
      f32x4 acc = {0.f, 0.f, 0.f, 0.f};
#pragma unroll
      for (int ks = 0; ks < 4; ++ks) {
        bf16x8 bq = *(const bf16x8*)(PwT + d * 128 + ks * 32 + fq * 8);
        acc = MFMA16(af[ks], bq, acc);
      }
      const float scl = p.pool_scale[layer * 512 + ch0 + d];
#pragma unroll
      for (int j = 0; j < 4; ++j) {
        const int t = wid * 16 + fq * 4 + j;
        if (t0 + t < T) {
          const long idx = (long)(rowbase + t0 + t) * 512 + ch0 + d;
          gcy[idx] = f2bf(acc[j] * scl * bf2f(gcy[idx]));
        }
      }
    }
  }
}

DI void kmax_item(const Params& p, int seq, int h, char*) {
  const int tid = get_tid(), wid = __builtin_amdgcn_readfirstlane(tid >> 6), lane = tid & 63;
  const bfr* kb; int S;
  if (seq < NB_P) { kb = (const bfr*)(p.ws + W_KBP) + (long)seq * KP_PAD * 512; S = T_P; }
  else { kb = (const bfr*)(p.ws + W_KBS) + (long)(seq - NB_P) * S_S * 512; S = S_S; }
  float mx = 0.f;
  for (int key = tid; key < S; key += 256) {
    const uint4* r = (const uint4*)(kb + (long)key * 512 + h * 64);
    float ss = 0.f;
#pragma unroll
    for (int i = 0; i < 8; ++i) {
      uint4 v = r[i];
      unsigned u[4] = {v.x, v.y, v.z, v.w};
#pragma unroll
      for (int j = 0; j < 4; ++j) {
        float a = __uint_as_float(u[j] << 16), b = __uint_as_float(u[j] & 0xFFFF0000u);
        ss += a * a + b * b;
      }
    }
    mx = fmaxf(mx, ss);
  }
#pragma unroll
  for (int o = 32; o >= 1; o >>= 1) mx = fmaxf(mx, __shfl_xor(mx, o));
  float* red = (float*)smem;
  if (lane == 0) red[wid] = mx;
  __syncthreads();
  if (tid == 0) ((float*)(p.ws + W_KMAX))[seq * 8 + h] = fmaxf(fmaxf(red[0], red[1]), fmaxf(red[2], red[3]));
}

DI void attn_unit(const Params& p, int isP, int sq, int c, int h, int half, size_t dstoff = W_GA) {
  const int lane = get_tid() & 63, fr = lane & 15, fq = lane >> 4;
  int T0, nqt, nadm, rowbase, vld;
  const bfr *kb, *vt;
  if (isP) {
    if (c == 0) { T0 = 0; nqt = 1; nadm = 16; } else { T0 = 16 + 64 * (c - 1) + 32 * half; nqt = 2; nadm = 16 + 64 * c; }
    rowbase = sq * T_P;
    kb = (const bfr*)(p.ws + W_KBP) + (long)sq * KP_PAD * 512;
    vt = (const bfr*)(p.ws + W_VTP) + (long)sq * 512 * KP_PAD;
    vld = KP_PAD;
  } else {
    T0 = 32 * half; nqt = 2; nadm = S_S; rowbase = ROWS_P + sq * 64;
    kb = (const bfr*)(p.ws + W_KBS) + (long)sq * S_S * 512;
    vt = (const bfr*)(p.ws + W_VTS) + (long)sq * 512 * S_S;
    vld = S_S;
  }
  const int nsteps = (nadm + 31) >> 5;
  const int qrow0 = rowbase + T0;
  const bfr* qb = (const bfr*)(p.ws + W_QB);
  const unsigned* maskg = (const unsigned*)(p.ws + W_MASK);
  bf16x8 qf[2][2];
#pragma unroll
  for (int qt = 0; qt < 2; ++qt)
#pragma unroll
    for (int ks = 0; ks < 2; ++ks) {
      int r = qrow0 + (qt < nqt ? qt * 16 : 0) + fr;
      qf[qt][ks] = *(const bf16x8*)(qb + (long)r * 512 + h * 64 + ks * 32 + fq * 8);
    }
  f32x4 o[2][4];
#pragma unroll
  for (int qt = 0; qt < 2; ++qt)
#pragma unroll
    for (int dt = 0; dt < 4; ++dt) o[qt][dt] = f32x4{0.f, 0.f, 0.f, 0.f};
  const float sc2 = 0.125f * 1.4426950408889634f;
  const float kmax2 = ((const float*)(p.ws + W_KMAX))[(isP ? sq : NB_P + sq) * 8 + h];
  float mref[2], lsum[2] = {0.f, 0.f};
#pragma unroll
  for (int qt = 0; qt < 2; ++qt) {
    float ss = 0.f;
#pragma unroll
    for (int ks = 0; ks < 2; ++ks)
#pragma unroll
      for (int i = 0; i < 8; ++i) { float a = bf2f((bfr)qf[qt][ks][i]); ss += a * a; }
    ss += __shfl_xor(ss, 16);
    ss += __shfl_xor(ss, 32);
    mref[qt] = sqrtf(ss * kmax2) * sc2;
  }
  const unsigned* mrow0 = maskg + (long)(qrow0 + fr) * MW;
  const unsigned* mrow1 = maskg + (long)(qrow0 + (nqt > 1 ? 16 : 0) + fr) * MW;
  const int kofs = (fr >> 2) * 8 + (fr & 3);
  const bfr* kptr = kb + (long)kofs * 512 + h * 64 + fq * 8;
  const bfr* vptr = vt + (long)(h * 64 + fr) * vld + fq * 8;
  bf16x8 ka0 = *(const bf16x8*)kptr, ka1 = *(const bf16x8*)(kptr + 32);
  bf16x8 kb0 = *(const bf16x8*)(kptr + 4 * 512), kb1 = *(const bf16x8*)(kptr + 4 * 512 + 32);
  bf16x8 vf[4];
#pragma unroll
  for (int dt = 0; dt < 4; ++dt) vf[dt] = *(const bf16x8*)(vptr + (long)dt * 16 * vld);
  unsigned mw0 = mrow0[0], mw1 = mrow1[0];
  for (int s = 0; s < nsteps; ++s) {
    const int sn = min(s + 1, nsteps - 1);
    const bfr* pa = kptr + (long)sn * 32 * 512;
    const bf16x8 nka0 = *(const bf16x8*)pa, nka1 = *(const bf16x8*)(pa + 32);
    const bf16x8 nkb0 = *(const bf16x8*)(pa + 4 * 512), nkb1 = *(const bf16x8*)(pa + 4 * 512 + 32);
    bf16x8 nvf[4];
#pragma unroll
    for (int dt = 0; dt < 4; ++dt) nvf[dt] = *(const bf16x8*)(vptr + (long)dt * 16 * vld + sn * 32);
    const unsigned nmw0 = mrow0[sn], nmw1 = mrow1[sn];
#pragma unroll
    for (int qt = 0; qt < 2; ++qt) {
      if (qt < nqt) {
        f32x4 sa = {0.f, 0.f, 0.f, 0.f}, sb = {0.f, 0.f, 0.f, 0.f};
        sa = MFMA16(ka0, qf[qt][0], sa); sa = MFMA16(ka1, qf[qt][1], sa);
        sb = MFMA16(kb0, qf[qt][0], sb); sb = MFMA16(kb1, qf[qt][1], sb);
        const unsigned mb = ((qt == 0 ? mw0 : mw1) >> (fq * 8)) & 0xFFu;
        float pr[8];
#pragma unroll
        for (int i = 0; i < 4; ++i) {
          float pa_ = __builtin_amdgcn_exp2f(sa[i] * sc2 - mref[qt]);
          float pb_ = __builtin_amdgcn_exp2f(sb[i] * sc2 - mref[qt]);
          pr[i] = ((mb >> i) & 1u) ? pa_ : 0.f;
          pr[4 + i] = ((mb >> (4 + i)) & 1u) ? pb_ : 0.f;
        }
        lsum[qt] += ((pr[0] + pr[1]) + (pr[2] + pr[3])) + ((pr[4] + pr[5]) + (pr[6] + pr[7]));
        union { unsigned u[4]; bf16x8 v; } pk;
        pk.u[0] = pack2(pr[0], pr[1]); pk.u[1] = pack2(pr[2], pr[3]); pk.u[2] = pack2(pr[4], pr[5]); pk.u[3] = pack2(pr[6], pr[7]);
#pragma unroll
        for (int dt = 0; dt < 4; ++dt) o[qt][dt] = MFMA16(vf[dt], pk.v, o[qt][dt]);
      }
    }
    ka0 = nka0; ka1 = nka1; kb0 = nkb0; kb1 = nkb1;
#pragma unroll
    for (int dt = 0; dt < 4; ++dt) vf[dt] = nvf[dt];
    mw0 = nmw0; mw1 = nmw1;
  }
  bfr* gay = (bfr*)(p.ws + W_GA);
  bfr* dsty = (bfr*)(p.ws + dstoff);
#pragma unroll
  for (int qt = 0; qt < 2; ++qt) {
    if (qt < nqt) {
      float l = lsum[qt];
      l += __shfl_xor(l, 16);
      l += __shfl_xor(l, 32);
      const float inv = l > 0.f ? 1.f / l : 0.f;
      const long rowoff = (long)(qrow0 + qt * 16 + fr) * 512 + h * 64;
#pragma unroll
      for (int dt = 0; dt < 4; ++dt) {
        uint2* ptr = (uint2*)(gay + rowoff + dt * 16 + fq * 4);
        uint2 gv = *ptr;
        float g0 = __uint_as_float(gv.x << 16), g1 = __uint_as_float(gv.x & 0xFFFF0000u);
        float g2 = __uint_as_float(gv.y << 16), g3 = __uint_as_float(gv.y & 0xFFFF0000u);
        uint2 ov;
        ov.x = pack2(o[qt][dt][0] * inv * g0, o[qt][dt][1] * inv * g1);
        ov.y = pack2(o[qt][dt][2] * inv * g2, o[qt][dt][3] * inv * g3);
        *(uint2*)(dsty + rowoff + dt * 16 + fq * 4) = ov;
      }
    }
  }
}

#define XB_TMO      128
#define XB_XCNT(j)  (256  + 64 * (j))
#define XB_XSUB(j)  (1280 + 64 * (j))
#define XB_XGEN(j)  (2304 + 64 * (j))
#define XB_TOP      3328
#define XB_TOPGEN   3392
#define XCD_BAR_WORDS 3456
#define XB_SPIN_CAP (1u << 18)
#define LAS __attribute__((address_space(3)))

__device__ __forceinline__ unsigned xb_ld(unsigned* p)              { return __hip_atomic_load(p, __ATOMIC_RELAXED, __HIP_MEMORY_SCOPE_AGENT); }
__device__ __forceinline__ unsigned xb_add(unsigned* p, unsigned v) { return __hip_atomic_fetch_add(p, v, __ATOMIC_RELAXED, __HIP_MEMORY_SCOPE_AGENT); }
__device__ __forceinline__ unsigned xb_xcc_id() { return (unsigned)__builtin_amdgcn_s_getreg((3 << 11) | 20) & 0xFu; }
#define XB_SPIN(cond, bar) do { unsigned _sp = 0; while (cond) { __builtin_amdgcn_s_sleep(1); \
    if ((++_sp & 255u) == 0u) { if (xb_ld(&(bar)[XB_TMO])) break; if (_sp > XB_SPIN_CAP) { atomicAdd(&(bar)[XB_TMO], 1u); break; } } } } while (0)

struct XcdBarrier {
    unsigned* bar; unsigned x;
    volatile LAS unsigned* st;
};

__device__ __forceinline__ XcdBarrier xcd_barrier_post(unsigned* bar, volatile LAS unsigned* st) {
    XcdBarrier b; b.bar = bar; b.x = xb_xcc_id(); b.st = st;
    if (threadIdx.x == 0) (void)xb_add(&bar[XB_XCNT(b.x)], 1u);
    return b;
}
__device__ __forceinline__ void xcd_barrier_complete(unsigned* bar, unsigned x, unsigned& nloc, unsigned& nx) {
    const unsigned G = gridDim.x * gridDim.y * gridDim.z;
    unsigned sum, cnt, mine, sp = 0u;
    for (;;) {
        sum = 0u; cnt = 0u; mine = 0u;
#pragma unroll
        for (unsigned j = 0; j < 16; ++j) { const unsigned c = xb_ld(&bar[XB_XCNT(j)]); sum += c; cnt += (c > 0u) ? 1u : 0u; mine = (j == x) ? c : mine; }
        if (sum == G) break;
        __builtin_amdgcn_s_sleep(1);
        if ((++sp & 255u) == 0u) { if (xb_ld(&bar[XB_TMO])) break; if (sp > XB_SPIN_CAP) { atomicAdd(&bar[XB_TMO], 1u); break; } }
    }
    nloc = mine > 0u ? mine : 1u; nx = cnt > 0u ? cnt : 1u;
}

__device__ __forceinline__ void xcd_barrier(const XcdBarrier& b) {
    asm volatile("s_waitcnt vmcnt(0)" ::: "memory");
    __syncthreads();
    if (threadIdx.x == 0) {
        unsigned* bar = b.bar;
        __builtin_amdgcn_s_waitcnt(0);
        unsigned nloc = b.st[0], nx = b.st[1];
        if (nloc == 0u) { xcd_barrier_complete(bar, b.x, nloc, nx); b.st[0] = nloc; b.st[1] = nx; }
        const unsigned old = xb_add(&bar[XB_XSUB(b.x)], 1u);
        const unsigned gen = old / nloc;
        if (old + 1u == (gen + 1u) * nloc) {
            __builtin_amdgcn_fence(__ATOMIC_RELEASE, "agent");
            asm volatile("s_waitcnt vmcnt(0)" ::: "memory");
            const unsigned og = xb_add(&bar[XB_TOP], 1u);
            const unsigned tg = og / nx;
            if (og + 1u == (tg + 1u) * nx) xb_add(&bar[XB_TOPGEN], 1u);
            else XB_SPIN(xb_ld(&bar[XB_TOPGEN]) == tg, bar);
            __builtin_amdgcn_fence(__ATOMIC_ACQUIRE, "agent");
            xb_add(&bar[XB_XGEN(b.x)], 1u);
            asm volatile("s_waitcnt vmcnt(0)" ::: "memory");
        } else {
            XB_SPIN(xb_ld(&bar[XB_XGEN(b.x)]) == gen, bar);
            __builtin_amdgcn_fence(__ATOMIC_ACQUIRE, "agent");
            asm volatile("s_waitcnt vmcnt(0)" ::: "memory");
        }
    }
    __syncthreads();
}


DI void attn_block(const Params& p, int isP, int sq, int c, int h) {
  const int tid = get_tid(), wid = __builtin_amdgcn_readfirstlane(tid >> 6), lane = tid & 63, fr = lane & 15, fq = lane >> 4;
  int T0, nqt, nadm, rowbase, vld;
  const bfr *kb, *vt;
  if (isP) {
    if (c == 0) { T0 = 0; nqt = 1; nadm = 16; } else { T0 = 16 + 64 * (c - 1); nqt = 4; nadm = 16 + 64 * c; }
    rowbase = sq * T_P;
    kb = (const bfr*)(p.ws + W_KBP) + (long)sq * KP_PAD * 512;
    vt = (const bfr*)(p.ws + W_VTP) + (long)sq * 512 * KP_PAD;
    vld = KP_PAD;
  } else {
    T0 = 0; nqt = 4; nadm = S_S; rowbase = ROWS_P + sq * 64;
    kb = (const bfr*)(p.ws + W_KBS) + (long)sq * S_S * 512;
    vt = (const bfr*)(p.ws + W_VTS) + (long)sq * 512 * S_S;
    vld = S_S;
  }
  const int nsteps = (nadm + 31) >> 5;
  const int qrow0 = rowbase + T0;
  const bfr* qb = (const bfr*)(p.ws + W_QB);
  const unsigned* maskg = (const unsigned*)(p.ws + W_MASK);
  bf16x8 qf[4][2];
#pragma unroll
  for (int qt = 0; qt < 4; ++qt)
#pragma unroll
    for (int ks = 0; ks < 2; ++ks) {
      int r = qrow0 + (qt < nqt ? qt * 16 : 0) + fr;
      qf[qt][ks] = *(const bf16x8*)(qb + (long)r * 512 + h * 64 + ks * 32 + fq * 8);
    }
  f32x4 o[4][4];
#pragma unroll
  for (int qt = 0; qt < 4; ++qt)
#pragma unroll
    for (int dt = 0; dt < 4; ++dt) o[qt][dt] = f32x4{0.f, 0.f, 0.f, 0.f};
  const float sc2 = 0.125f * 1.4426950408889634f;
  const float kmax2 = ((const float*)(p.ws + W_KMAX))[(isP ? sq : NB_P + sq) * 8 + h];
  float mref[4], lsum[4] = {0.f, 0.f, 0.f, 0.f};
  const unsigned* mrow[4];
#pragma unroll
  for (int qt = 0; qt < 4; ++qt) {
    float ss = 0.f;
#pragma unroll
    for (int ks = 0; ks < 2; ++ks)
#pragma unroll
      for (int i = 0; i < 8; ++i) { float a = bf2f((bfr)qf[qt][ks][i]); ss += a * a; }
    ss += __shfl_xor(ss, 16);
    ss += __shfl_xor(ss, 32);
    mref[qt] = sqrtf(ss * kmax2) * sc2;
    mrow[qt] = maskg + (long)(qrow0 + (qt < nqt ? qt * 16 : 0) + fr) * MW;
  }
  const int kofs = (fr >> 2) * 8 + (fr & 3);
  const bfr* kptr = kb + (long)kofs * 512 + h * 64 + fq * 8;
  const bfr* vptr = vt + (long)(h * 64 + fr) * vld + fq * 8;
  if (wid < nsteps) {
    int s = wid;
    const bfr* pa0 = kptr + (long)s * 32 * 512;
    bf16x8 ka0 = *(const bf16x8*)pa0, ka1 = *(const bf16x8*)(pa0 + 32);
    bf16x8 kb0 = *(const bf16x8*)(pa0 + 4 * 512), kb1 = *(const bf16x8*)(pa0 + 4 * 512 + 32);
    bf16x8 vf[4];
#pragma unroll
    for (int dt = 0; dt < 4; ++dt) vf[dt] = *(const bf16x8*)(vptr + (long)dt * 16 * vld + s * 32);
    unsigned mw[4];
#pragma unroll
    for (int qt = 0; qt < 4; ++qt) mw[qt] = mrow[qt][s];
    for (; s < nsteps; s += 4) {
      const int sn = (s + 4 < nsteps) ? s + 4 : s;
      const bfr* pa = kptr + (long)sn * 32 * 512;
      const bf16x8 nka0 = *(const bf16x8*)pa, nka1 = *(const bf16x8*)(pa + 32);
      const bf16x8 nkb0 = *(const bf16x8*)(pa + 4 * 512), nkb1 = *(const bf16x8*)(pa + 4 * 512 + 32);
      bf16x8 nvf[4];
#pragma unroll
      for (int dt = 0; dt < 4; ++dt) nvf[dt] = *(const bf16x8*)(vptr + (long)dt * 16 * vld + sn * 32);
      unsigned nmw[4];
#pragma unroll
      for (int qt = 0; qt < 4; ++qt) nmw[qt] = mrow[qt][sn];
#pragma unroll
      for (int qt = 0; qt < 4; ++qt) {
        if (qt < nqt) {
          f32x4 sa = {0.f, 0.f, 0.f, 0.f}, sb = {0.f, 0.f, 0.f, 0.f};
          sa = MFMA16(ka0, qf[qt][0], sa); sa = MFMA16(ka1, qf[qt][1], sa);
          sb = MFMA16(kb0, qf[qt][0], sb); sb = MFMA16(kb1, qf[qt][1], sb);
          const unsigned mb = (mw[qt] >> (fq * 8)) & 0xFFu;
          float pr[8];
#pragma unroll
          for (int i = 0; i < 4; ++i) {
            float pa_ = __builtin_amdgcn_exp2f(sa[i] * sc2 - mref[qt]);
            float pb_ = __builtin_amdgcn_exp2f(sb[i] * sc2 - mref[qt]);
            pr[i] = ((mb >> i) & 1u) ? pa_ : 0.f;
            pr[4 + i] = ((mb >> (4 + i)) & 1u) ? pb_ : 0.f;
          }
          lsum[qt] += ((pr[0] + pr[1]) + (pr[2] + pr[3])) + ((pr[4] + pr[5]) + (pr[6] + pr[7]));
          union { unsigned u[4]; bf16x8 v; } pk;
          pk.u[0] = pack2(pr[0], pr[1]); pk.u[1] = pack2(pr[2], pr[3]); pk.u[2] = pack2(pr[4], pr[5]); pk.u[3] = pack2(pr[6], pr[7]);
#pragma unroll
          for (int dt = 0; dt < 4; ++dt) o[qt][dt] = MFMA16(vf[dt], pk.v, o[qt][dt]);
        }
      }
      ka0 = nka0; ka1 = nka1; kb0 = nkb0; kb1 = nkb1;
#pragma unroll
      for (int dt = 0; dt < 4; ++dt) vf[dt] = nvf[dt];
#pragma unroll
      for (int qt = 0; qt < 4; ++qt) mw[qt] = nmw[qt];
    }
  }
  float* OS = (float*)smem;
  float* LS = OS + 4 * 2048;
  bfr* gay = (bfr*)(p.ws + W_GA);
#pragma unroll
  for (int rd = 0; rd < 2; ++rd) {
    __syncthreads();
#pragma unroll
    for (int q2 = 0; q2 < 2; ++q2) {
      const int qt = rd * 2 + q2;
      float l = lsum[qt];
      l += __shfl_xor(l, 16);
      l += __shfl_xor(l, 32);
      LS[(wid * 2 + q2) * 64 + lane] = l;
#pragma unroll
      for (int dt = 0; dt < 4; ++dt)
#pragma unroll
        for (int j = 0; j < 4; ++j) OS[((wid * 2 + q2) * 16 + dt * 4 + j) * 64 + lane] = o[qt][dt][j];
    }
    __syncthreads();
    const int q2 = wid >> 1, qt = rd * 2 + q2;
    if (qt < nqt) {
      float l = 0.f;
#pragma unroll
      for (int w = 0; w < 4; ++w) l += LS[(w * 2 + q2) * 64 + lane];
      const float inv = l > 0.f ? 1.f / l : 0.f;
      const long rowoff = (long)(qrow0 + qt * 16 + fr) * 512 + h * 64;
#pragma unroll
      for (int d2 = 0; d2 < 2; ++d2) {
        const int dt = (wid & 1) * 2 + d2;
        float acc4[4];
#pragma unroll
        for (int j = 0; j < 4; ++j) {
          float a = 0.f;
#pragma unroll
          for (int w = 0; w < 4; ++w) a += OS[((w * 2 + q2) * 16 + dt * 4 + j) * 64 + lane];
          acc4[j] = a * inv;
        }
        uint2* ptr = (uint2*)(gay + rowoff + dt * 16 + fq * 4);
        uint2 gv = *ptr;
        float g0 = __uint_as_float(gv.x << 16), g1 = __uint_as_float(gv.x & 0xFFFF0000u);
        float g2 = __uint_as_float(gv.y << 16), g3 = __uint_as_float(gv.y & 0xFFFF0000u);
        uint2 ov;
        ov.x = pack2(acc4[0] * g0, acc4[1] * g1);
        ov.y = pack2(acc4[2] * g2, acc4[3] * g3);
        *ptr = ov;
      }
    }
  }
}

DI int pop_block(int* ctr, int*) {
  __syncthreads();
  if (threadIdx.x == 0) sh_item = atomicAdd(ctr, 1);
  __syncthreads();
  return __builtin_amdgcn_readfirstlane(sh_item);
}

constexpr int N_KMAX = 20 * 8;
constexpr int N_SEL = 64 * 16 + 64 + 4;
constexpr int N_LRU1 = NB_P * NTILE_P * 8;
constexpr int N_POOL = NB_P * NTILE_P * 4 + NB_S * 4;
constexpr int N_LRU2 = NB_P * NTILE_P * 8 + NB_S * 8;
constexpr int N_ATT = 64 * 64 + 256 + 32;

DI void phase_b1(const Params& p, int layer, char*, int*) {
  int* ctr = (int*)(p.ws + W_CTR) + layer * 4 + 0;
  for (;;) {
    int it = pop_block(ctr, nullptr);
    if (it >= N_SEL + N_LRU1 + N_POOL + N_KMAX) break;
    if (it >= N_SEL + N_LRU1 + N_POOL) { int j = it - (N_SEL + N_LRU1 + N_POOL); kmax_item(p, j >> 3, j & 7, smem); }
    else if (it < N_SEL) {
      if (it < 1024) { int c = 64 - (it >> 4), b = (it & 15) >> 2, sub = it & 3; select_item(p, 1, b, c, sub, smem); }
      else if (it < 1088) { int j = it - 1024; select_item(p, 0, j >> 2, 0, j & 3, smem); }
      else select_item(p, 1, it - 1088, 0, 0, smem);
    } else if (it < N_SEL + N_LRU1) {
      int j = it - N_SEL;
      int sq = j / (NTILE_P * 8), rem = j % (NTILE_P * 8);
      lru_tile(p, layer, 1, sq, rem >> 3, rem & 7, 0, smem);
    } else {
      int j = it - N_SEL - N_LRU1;
      if (j < NB_P * NTILE_P * 4) { int sq = j / (NTILE_P * 4), rem = j % (NTILE_P * 4); pool_item(p, layer, 1, sq, rem >> 2, rem & 3, smem); }
      else { j -= NB_P * NTILE_P * 4; pool_item(p, layer, 0, j >> 2, 0, j & 3, smem); }
    }
  }
}

constexpr size_t W_DUMMY = W_END;
DI void probe_select(const Params& p, int layer) {
  int* ctr = (int*)(p.ws + W_CTR) + layer * 4 + 3;
  for (;;) {
    int it = pop_block(ctr, nullptr);
    if (it >= N_SEL) break;
    if (it < 1024) { int c = 64 - (it >> 4), b = (it & 15) >> 2, sub = it & 3; select_item(p, 1, b, c, sub, smem); }
    else if (it < 1088) { int j = it - 1024; select_item(p, 0, j >> 2, 0, j & 3, smem); }
    else select_item(p, 1, it - 1088, 0, 0, smem);
  }
}
DI void probe_attn(const Params& p, int layer) {
  int* ctr2 = (int*)(p.ws + W_CTR) + layer * 4 + 3;
  const int lane = get_tid() & 63;
  for (;;) {
    int u = 0;
    if (lane == 0) u = atomicAdd(ctr2, 1);
    u = __builtin_amdgcn_readfirstlane(u);
    if (u >= N_ATT) break;
    if (u < 4096) { int c = 64 - (u >> 6), r = u & 63; attn_unit(p, 1, r >> 4, c, (r >> 1) & 7, r & 1, W_DUMMY); }
    else if (u < 4096 + 256) { int r = u - 4096; attn_unit(p, 0, r >> 4, 0, (r >> 1) & 7, r & 1, W_DUMMY); }
    else { int r = u - 4352; attn_unit(p, 1, r >> 3, 0, r & 7, 0, W_DUMMY); }
  }
}

DI void phase_b2(const Params& p, int layer, char*, int*) {
  int* ctr = (int*)(p.ws + W_CTR) + layer * 4 + 1;
  for (;;) {
    int it = pop_block(ctr, nullptr);
    if (it >= N_LRU2) break;
    if (it < NB_P * NTILE_P * 8) { int sq = it / (NTILE_P * 8), rem = it % (NTILE_P * 8); lru_tile(p, layer, 1, sq, rem >> 3, rem & 7, 1, smem); }
    else { int j = it - NB_P * NTILE_P * 8; lru_tile(p, layer, 0, j >> 3, 0, j & 7, 1, smem); }
  }
  int* ctr2 = (int*)(p.ws + W_CTR) + layer * 4 + 2;
  for (;;) {
    int it = pop_block(ctr2, nullptr);
    if (it >= 2208) break;
    if (it < 2048) { const int c = 64 - (it >> 5), pair = it & 31; attn_block(p, 1, pair >> 3, c, pair & 7); }
    else if (it < 2176) { const int r = it - 2048; attn_block(p, 0, r >> 3, 0, r & 7); }
    else { const int pair = it - 2176; attn_block(p, 1, pair >> 3, 0, pair & 7); }
  }
}

DI Params fresh(const Params& p) {
  Params q = p;
  int z = 0;
  asm volatile("s_mov_b32 %0, 0" : "=s"(z));
  q.ws = p.ws + z;
  q.out = p.out + z;
  return q;
}
DI int fresh_i(int v) {
  asm volatile("" : "+s"(v));
  return v;
}

__shared__ uint4 xb_words;

__global__ void __launch_bounds__(256, 2) fwd_megakernel(Params p) {
  cg::grid_group grid = cg::this_grid();
  if (threadIdx.x == 0) xb_words = make_uint4(0u, 0u, 0u, 0u);
  __syncthreads();
  XcdBarrier xb = xcd_barrier_post((unsigned*)(p.ws + W_BAR), (volatile LAS unsigned*)&xb_words);
  if (threadIdx.x == 0) sh_xinfo[0] = (int)atomicAdd((unsigned*)(p.ws + W_CTR) + 128 + xb.x, 1u);
  prep_phase(fresh(p), smem);
  if (p.out == nullptr) grid.sync();
  xcd_barrier(xb);
  if (threadIdx.x == 0) {
    unsigned* bar = (unsigned*)(p.ws + W_BAR);
    int na = 0, ia = 0, nloc = 1;
    for (unsigned j = 0; j < 16; ++j) {
      const unsigned cj = xb_ld(&bar[XB_XCNT(j)]);
      if (cj > 0u) { if (j < xb.x) ++ia; ++na; }
      if (j == xb.x) nloc = (int)cj;
    }
    sh_xinfo[1] = nloc > 0 ? nloc : 1; sh_xinfo[2] = ia; sh_xinfo[3] = na > 0 ? na : 1;
  }
  __syncthreads();
#if PROBE == 6
#pragma unroll 1
  for (int i = 0; i < 10; ++i) xcd_barrier(xb);
#endif
#pragma unroll 1
  for (int layer = 0; layer < 2; ++layer) {
    phase_inproj(fresh(p), fresh_i(layer), smem);
    xcd_barrier(xb);
#if PROBE == 2
    probe_select(fresh(p), fresh_i(layer));
    xcd_barrier(xb);
#endif
    phase_b1(fresh(p), fresh_i(layer), smem, &sh_item);
    xcd_barrier(xb);
#if PROBE == 3
    probe_attn(fresh(p), fresh_i(layer));
    xcd_barrier(xb);
#endif
    phase_b2(fresh(p), fresh_i(layer), smem, &sh_item);
    xcd_barrier(xb);
    phase_merge(fresh(p), fresh_i(layer), smem);
    xcd_barrier(xb);
#if PROBE == 4
    phase_merge(fresh(p), fresh_i(layer), smem);
    xcd_barrier(xb);
#endif
    phase_out(fresh(p), fresh_i(layer), smem);
    xcd_barrier(xb);
    if (layer == 0) { norm_phase(fresh(p), 1); xcd_barrier(xb); }
    else norm_phase(fresh(p), 2);
  }
}

extern "C" void kernel_launch(void* const* d_in, const int* in_sizes, int n_in, void* d_out, int out_size, void* d_ws,
                              size_t ws_size, hipStream_t stream) {
  constexpr int kDynLds = 65536;
  static int grid_blocks = 0;
  if (!grid_blocks) {
    int dev = 0, cus = 0, per_cu = 0;
    hipGetDevice(&dev);
    hipDeviceGetAttribute(&cus, hipDeviceAttributeMultiprocessorCount, dev);
    hipFuncSetAttribute((const void*)fwd_megakernel, hipFuncAttributeMaxDynamicSharedMemorySize, kDynLds);
    hipOccupancyMaxActiveBlocksPerMultiprocessor(&per_cu, fwd_megakernel, 256, kDynLds);
    if (per_cu > 2) per_cu = 2;
    if (per_cu < 1) per_cu = 1;
    grid_blocks = cus * per_cu;
  }
  if (ws_size < W_END) { fprintf(stderr, "workspace too small: %zu < %zu\n", ws_size, (size_t)W_END); return; }
  Params p{};
  const float** f = (const float**)&p;
  for (int i = 0; i < 23; ++i) f[i] = (const float*)d_in[i];
  p.out = (float*)d_out;
  p.ws = (char*)d_ws;
  hipMemsetAsync(d_ws, 0, 32768, stream);
  void* args[] = {&p};
  hipError_t e = hipLaunchCooperativeKernel((void*)fwd_megakernel, dim3(grid_blocks), dim3(256), args, kDynLds, stream);
  if (e != hipSuccess) fprintf(stderr, "cooperative launch failed: %s (grid %d)\n", hipGetErrorString(e), grid_blocks);
}
```
